# Optimizing an MI355X kernel written in HIP

```python
import jax, jax.numpy as jnp
from jax import lax
import numpy as np

D_MODEL = 1024
BATCH = 32
SEQ = 2048
DEPTH = 1

HEAD_DIM = 64
ROPE_THETA = 10000.0
EPS = 1e-6
NEG_INF = -1e30
FORCE_SCORE = 1e9
ATTN_BLOCK = 128
NSA_HEADS = 8
NSA_KV_HEADS = 2
NSA_GROUP = NSA_HEADS // NSA_KV_HEADS
CMP_BLOCK = 32
CMP_STRIDE = 16
CMP_HIDDEN = 256
SEL_BLOCK = 64
N_SEL = 8
N_LOCAL_SEL = 2
WINDOW = 512
QUERY_CHUNK = 32
DIL_PAIRS = ((128, 1), (512, 4), (2048, 16))
DIL_HEADS_PER_GROUP = 2
DIL_HEADS = DIL_HEADS_PER_GROUP * len(DIL_PAIRS)
A_Q = NSA_HEADS * HEAD_DIM
A_KV = NSA_KV_HEADS * HEAD_DIM
DIL_W = DIL_HEADS * HEAD_DIM
IN_COLS = A_Q + 6 * A_KV + 3 * NSA_HEADS + 3 * DIL_W + 2 * D_MODEL
N_GROUPS = 4
EXPERTS_PER_GROUP = 8
N_EXPERTS = N_GROUPS * EXPERTS_PER_GROUP
TOP_K_INNER = 2
EXPERT_FF = 512
MOE_BLOCK = 256

kernel_name = "nsa_dilated_hmoe_hybrid_block"


def rms_norm(x, g):
    xf = x.astype(jnp.float32)
    y = xf * lax.rsqrt(jnp.mean(xf * xf, axis=-1, keepdims=True) + EPS)
    return (y * g.astype(jnp.float32)).astype(x.dtype)


def rope_tables(pos):
    inv = ROPE_THETA ** (-jnp.arange(0, HEAD_DIM, 2, dtype=jnp.float32) / HEAD_DIM)
    ang = pos.astype(jnp.float32)[..., None] * inv
    return jnp.cos(ang)[:, None], jnp.sin(ang)[:, None]


def apply_rope(x, cos, sin):
    x1, x2 = jnp.split(x.astype(jnp.float32), 2, axis=-1)
    return jnp.concatenate([x1 * cos - x2 * sin, x1 * sin + x2 * cos], axis=-1).astype(x.dtype)


def to_heads(t, n):
    b, s, _ = t.shape
    return t.reshape(b, s, n, HEAD_DIM).transpose(0, 2, 1, 3)


def banded_attention(q, k, v, window):
    b, hk, g, L, dh = q.shape
    blk = ATTN_BLOCK
    Lp = -(-L // blk) * blk
    nback = -(-window // blk)
    pad_end = Lp - L
    nkeys = (nback + 1) * blk
    qp = jnp.pad(q, ((0, 0), (0, 0), (0, 0), (0, pad_end), (0, 0)))
    kp = jnp.pad(k, ((0, 0), (0, 0), (nback * blk, pad_end), (0, 0)))
    vp = jnp.pad(v, ((0, 0), (0, 0), (nback * blk, pad_end), (0, 0)))
    scale = dh ** -0.5
    qi = jnp.arange(blk)
    kj = jnp.arange(nkeys) - nback * blk
    dist = qi[:, None] - kj[None, :]

    def one_block(bi):
        start = bi * blk
        qb = lax.dynamic_slice_in_dim(qp, start, blk, axis=3)
        kb = lax.dynamic_slice_in_dim(kp, start, nkeys, axis=2)
        vb = lax.dynamic_slice_in_dim(vp, start, nkeys, axis=2)
        s = jnp.einsum('bkgqd,bknd->bkgqn', qb, kb, preferred_element_type=jnp.float32) * scale
        valid = (dist >= 0) & (dist <= window) & ((start + kj)[None, :] >= 0)
        s = jnp.where(valid, s, -jnp.inf)
        lse = jax.nn.logsumexp(s, axis=-1)
        p = jnp.exp(s - lse[..., None])
        o = jnp.einsum('bkgqn,bknd->bkgqd', p.astype(vb.dtype), vb)
        return o, lse

    o, lse = lax.map(one_block, jnp.arange(Lp // blk))
    o = jnp.moveaxis(o, 0, 3).reshape(b, hk, g, Lp, dh)[:, :, :, :L]
    lse = jnp.moveaxis(lse, 0, 3).reshape(b, hk, g, Lp)[..., :L]
    return o, lse


def compress_blocks(kv, pe, w1, w2):
    s = kv.shape[2]
    n_c = (s - CMP_BLOCK) // CMP_STRIDE + 1
    idx = jnp.arange(n_c)[:, None] * CMP_STRIDE + jnp.arange(CMP_BLOCK)[None, :]
    blocks = kv[:, :, idx] + pe
    flat = blocks.reshape(*blocks.shape[:3], CMP_BLOCK * HEAD_DIM)
    return jax.nn.silu(flat @ w1) @ w2


def nsa_compressed_and_selected(q, kc, vc, k_slc, v_slc):
    b, hk, g, s_len, dh = q.shape
    n_c = kc.shape[2]
    n_s = s_len // SEL_BLOCK
    n_sel = min(N_SEL, n_s)
    scale = dh ** -0.5
    cmp_start = jnp.arange(n_c) * CMP_STRIDE
    cmp_end = cmp_start + CMP_BLOCK - 1
    sel_start = jnp.arange(n_s) * SEL_BLOCK
    overlap = jnp.clip(jnp.minimum(cmp_start[:, None] + CMP_BLOCK, sel_start[None, :] + SEL_BLOCK)
                       - jnp.maximum(cmp_start[:, None], sel_start[None, :]), 0, None).astype(jnp.float32) / CMP_BLOCK
    k_blocks = k_slc.reshape(b, hk, n_s, SEL_BLOCK, dh)
    v_blocks = v_slc.reshape(b, hk, n_s, SEL_BLOCK, dh)
    b_idx = jnp.arange(b)[:, None, None, None]
    h_idx = jnp.arange(hk)[None, :, None, None]
    blk_ids = jnp.arange(n_s)
    tok_in_blk = jnp.arange(SEL_BLOCK)

    def chunk(ci):
        start = ci * QUERY_CHUNK
        t = start + jnp.arange(QUERY_CHUNK)
        qc = lax.dynamic_slice_in_dim(q, start, QUERY_CHUNK, axis=3)
        s = jnp.einsum('bkgqd,bknd->bkgqn', qc, kc, preferred_element_type=jnp.float32) * scale
        valid = cmp_end[None, :] <= t[:, None]
        p = jnp.where(valid, jax.nn.softmax(jnp.where(valid, s, NEG_INF), axis=-1), 0.0)
        o_cmp = jnp.einsum('bkgqn,bknd->bkgqd', p.astype(vc.dtype), vc)
        imp = jnp.einsum('bkgqn,ns->bkqs', p, overlap)
        rel = (t // SEL_BLOCK)[:, None] - blk_ids[None, :]
        forced = (blk_ids[None, :] == 0) | ((rel >= 0) & (rel < N_LOCAL_SEL))
        score = jnp.where(rel < 0, NEG_INF, jnp.where(forced, FORCE_SCORE, imp))
        _, idx = lax.top_k(score, n_sel)
        kg = k_blocks[b_idx, h_idx, idx]
        vg = v_blocks[b_idx, h_idx, idx]
        tok = idx[..., None] * SEL_BLOCK + tok_in_blk
        ok = tok <= t[None, None, :, None, None]
        s2 = jnp.einsum('bkgqd,bkqnld->bkgqnl', qc, kg, preferred_element_type=jnp.float32) * scale
        p2 = jax.nn.softmax(jnp.where(ok[:, :, None], s2, -jnp.inf), axis=(-2, -1))
        o_slc = jnp.einsum('bkgqnl,bkqnld->bkgqd', p2.astype(vg.dtype), vg)
        return o_cmp, o_slc

    o_cmp, o_slc = lax.map(chunk, jnp.arange(s_len // QUERY_CHUNK))
    o_cmp = jnp.moveaxis(o_cmp, 0, 3).reshape(b, hk, g, s_len, dh)
    o_slc = jnp.moveaxis(o_slc, 0, 3).reshape(b, hk, g, s_len, dh)
    return o_cmp, o_slc


def dilated_attention(q, k, v):
    b, _, s_len, dh = q.shape
    hpg = DIL_HEADS_PER_GROUP
    outs, lses = [], []
    for gi, (w, d) in enumerate(DIL_PAIRS):
        sl = slice(gi * hpg, (gi + 1) * hpg)
        L = s_len // d

        def strided(t):
            return t[:, sl].reshape(b, hpg, L, d, dh).transpose(0, 1, 3, 2, 4).reshape(b, hpg * d, L, dh)

        o, lse = banded_attention(strided(q)[:, :, None], strided(k), strided(v), w // d)
        outs.append(o[:, :, 0].reshape(b, hpg, d, L, dh).transpose(0, 1, 3, 2, 4).reshape(b, hpg, s_len, dh))
        lses.append(lse[:, :, 0].reshape(b, hpg, d, L).transpose(0, 1, 3, 2).reshape(b, hpg, s_len))
    alpha = jax.nn.softmax(jnp.stack(lses), axis=0)
    o = jnp.stack(outs) * alpha[..., None].astype(outs[0].dtype)
    return o.transpose(1, 3, 0, 2, 4).reshape(b, s_len, DIL_W)


def hybrid_mixer(h, positions, w_in, nsa_q_norm, nsa_k_norm, cmp_pe_k, cmp_w1_k, cmp_w2_k,
                 cmp_pe_v, cmp_w1_v, cmp_w2_v, dil_q_norm, dil_k_norm, w_up_a, w_up_b, w_out):
    b, s_len, _ = h.shape
    proj = h @ w_in
    c1 = A_Q
    c2 = c1 + 6 * A_KV
    c3 = c2 + 3 * NSA_HEADS
    c4 = c3 + 3 * DIL_W
    q_a, kv_a, g_a, qkv_b, g_m = jnp.split(proj, [c1, c2, c3, c4], axis=-1)
    cos, sin = rope_tables(positions)

    q = apply_rope(rms_norm(to_heads(q_a, NSA_HEADS), nsa_q_norm), cos, sin)
    q = q.reshape(b, NSA_KV_HEADS, NSA_GROUP, s_len, HEAD_DIM)
    k_cmp, v_cmp, k_slc, v_slc, k_win, v_win = [to_heads(t, NSA_KV_HEADS) for t in jnp.split(kv_a, 6, axis=-1)]
    n_c = (s_len - CMP_BLOCK) // CMP_STRIDE + 1
    cmp_pos = positions[:, jnp.arange(n_c) * CMP_STRIDE + CMP_BLOCK - 1]
    ccos, csin = rope_tables(cmp_pos)
    kc = apply_rope(rms_norm(compress_blocks(k_cmp, cmp_pe_k, cmp_w1_k, cmp_w2_k), nsa_k_norm), ccos, csin)
    vc = compress_blocks(v_cmp, cmp_pe_v, cmp_w1_v, cmp_w2_v)
    k_slc = apply_rope(rms_norm(k_slc, nsa_k_norm), cos, sin)
    k_win = apply_rope(rms_norm(k_win, nsa_k_norm), cos, sin)
    o_cmp, o_slc = nsa_compressed_and_selected(q, kc, vc, k_slc, v_slc)
    o_win, _ = banded_attention(q, k_win, v_win, WINDOW)
    gates = jax.nn.sigmoid(g_a).reshape(b, s_len, 3, NSA_KV_HEADS, NSA_GROUP).transpose(2, 0, 3, 4, 1)[..., None]
    o_a = gates[0] * o_cmp + gates[1] * o_slc + gates[2] * o_win
    o_a = o_a.transpose(0, 3, 1, 2, 4).reshape(b, s_len, A_Q)

    q_b, k_b, v_b = [to_heads(t, DIL_HEADS) for t in jnp.split(qkv_b, 3, axis=-1)]
    q_b = apply_rope(rms_norm(q_b, dil_q_norm), cos, sin)
    k_b = apply_rope(rms_norm(k_b, dil_k_norm), cos, sin)
    o_b = dilated_attention(q_b, k_b, v_b)

    gm_a, gm_b = jnp.split(jax.nn.sigmoid(g_m), 2, axis=-1)
    y = gm_a * (o_a @ w_up_a) + gm_b * (o_b @ w_up_b)
    return y @ w_out


def hierarchical_moe(h, w_group, b_group, w_router, b_router, w_gate, w_up, w_down):
    b, s_len, d = h.shape
    T = b * s_len
    xt = h.reshape(T, d)
    g_logits = jnp.matmul(xt, w_group, preferred_element_type=jnp.float32) + b_group
    g_w, g_idx = lax.top_k(jax.nn.softmax(g_logits, axis=-1), 1)
    e_logits = jnp.einsum('td,gde->tge', xt, w_router, preferred_element_type=jnp.float32) + b_router
    e_logits = jnp.take_along_axis(e_logits, g_idx[:, :, None], axis=1)[:, 0]
    e_val, e_idx = lax.top_k(e_logits, TOP_K_INNER)
    weights = g_w * jax.nn.softmax(e_val, axis=-1)
    expert = g_idx * EXPERTS_PER_GROUP + e_idx

    A = T * TOP_K_INNER
    flat_e = expert.reshape(A)
    flat_tok = jnp.arange(A, dtype=jnp.int32) // TOP_K_INNER
    order = jnp.argsort(flat_e)
    sorted_e = flat_e[order]
    counts = jnp.bincount(flat_e, length=N_EXPERTS)
    starts = jnp.cumsum(counts) - counts
    padded = (counts + MOE_BLOCK - 1) // MOE_BLOCK * MOE_BLOCK
    pad_ends = jnp.cumsum(padded)
    pad_starts = pad_ends - padded
    dest_sorted = pad_starts[sorted_e] + jnp.arange(A, dtype=jnp.int32) - starts[sorted_e]
    P = A + N_EXPERTS * MOE_BLOCK
    n_blk = P // MOE_BLOCK
    slot_tok = jnp.full((P,), T, jnp.int32).at[dest_sorted].set(flat_tok[order])
    blk_expert = jnp.minimum(jnp.searchsorted(pad_ends, jnp.arange(n_blk) * MOE_BLOCK, side='right'), N_EXPERTS - 1)
    x_pad = jnp.concatenate([xt, jnp.zeros((1, d), xt.dtype)], axis=0)

    def run_block(args):
        tok, e = args
        xb = x_pad[tok]
        hid = jax.nn.silu(xb @ w_gate[e]) * (xb @ w_up[e])
        return hid @ w_down[e]

    y_slots = lax.map(run_block, (slot_tok.reshape(n_blk, MOE_BLOCK), blk_expert)).reshape(P, d)
    dest = jnp.zeros((A,), jnp.int32).at[order].set(dest_sorted)
    y = jnp.einsum('tkd,tk->td', y_slots[dest].reshape(T, TOP_K_INNER, d), weights.astype(xt.dtype))
    return y.reshape(b, s_len, d)


def setup_inputs(seed: int = 0) -> dict:
    key = jax.random.key(seed)
    ks = jax.random.split(key, 32)
    nrm = lambda k, shape, s: jax.random.normal(k, shape, jnp.float32) * s
    L, D = DEPTH, D_MODEL
    return {
        "x": nrm(ks[0], (BATCH, SEQ, D), 1.0),
        "c": nrm(ks[1], (BATCH, D), 1.0),
        "positions": (jnp.arange(SEQ, dtype=jnp.int32)[None, :]
                      + jax.random.randint(ks[2], (BATCH, 1), 0, 1024, dtype=jnp.int32)),
        "w_ada": nrm(ks[3], (L, D, 6 * D), 0.5 * D ** -0.5),
        "b_ada": nrm(ks[4], (L, 6 * D), 0.02),
        "norm1_g": 1.0 + nrm(ks[5], (L, D), 0.02),
        "norm2_g": 1.0 + nrm(ks[6], (L, D), 0.02),
        "w_in": nrm(ks[7], (L, D, IN_COLS), D ** -0.5),
        "nsa_q_norm": 1.0 + nrm(ks[8], (L, HEAD_DIM), 0.02),
        "nsa_k_norm": 1.0 + nrm(ks[9], (L, HEAD_DIM), 0.02),
        "cmp_pe_k": nrm(ks[10], (L, CMP_BLOCK, HEAD_DIM), 0.02),
        "cmp_w1_k": nrm(ks[11], (L, CMP_BLOCK * HEAD_DIM, CMP_HIDDEN), (CMP_BLOCK * HEAD_DIM) ** -0.5),
        "cmp_w2_k": nrm(ks[12], (L, CMP_HIDDEN, HEAD_DIM), CMP_HIDDEN ** -0.5),
        "cmp_pe_v": nrm(ks[13], (L, CMP_BLOCK, HEAD_DIM), 0.02),
        "cmp_w1_v": nrm(ks[14], (L, CMP_BLOCK * HEAD_DIM, CMP_HIDDEN), (CMP_BLOCK * HEAD_DIM) ** -0.5),
        "cmp_w2_v": nrm(ks[15], (L, CMP_HIDDEN, HEAD_DIM), CMP_HIDDEN ** -0.5),
        "dil_q_norm": 1.0 + nrm(ks[16], (L, HEAD_DIM), 0.02),
        "dil_k_norm": 1.0 + nrm(ks[17], (L, HEAD_DIM), 0.02),
        "w_up_a": nrm(ks[18], (L, A_Q, D), A_Q ** -0.5),
        "w_up_b": nrm(ks[19], (L, DIL_W, D), DIL_W ** -0.5),
        "w_out": nrm(ks[20], (L, D, D), D ** -0.5),
        "w_group": nrm(ks[21], (L, D, N_GROUPS), D ** -0.5),
        "b_group": nrm(ks[22], (L, N_GROUPS), 0.01),
        "w_router": nrm(ks[23], (L, N_GROUPS, D, EXPERTS_PER_GROUP), D ** -0.5),
        "b_router": nrm(ks[24], (L, N_GROUPS, EXPERTS_PER_GROUP), 0.01),
        "w_e_gate": nrm(ks[25], (L, N_EXPERTS, D, EXPERT_FF), D ** -0.5),
        "w_e_up": nrm(ks[26], (L, N_EXPERTS, D, EXPERT_FF), D ** -0.5),
        "w_e_down": nrm(ks[27], (L, N_EXPERTS, EXPERT_FF, D), EXPERT_FF ** -0.5),
    }


def reference(x, c, positions, w_ada, b_ada, norm1_g, norm2_g, w_in, nsa_q_norm, nsa_k_norm,
              cmp_pe_k, cmp_w1_k, cmp_w2_k, cmp_pe_v, cmp_w1_v, cmp_w2_v, dil_q_norm, dil_k_norm,
              w_up_a, w_up_b, w_out, w_group, b_group, w_router, b_router, w_e_gate, w_e_up, w_e_down):
    c_act = jax.nn.silu(c)
    for l in range(DEPTH):
        mod = (c_act @ w_ada[l] + b_ada[l])[:, None, :]
        sh1, sc1, gt1, sh2, sc2, gt2 = jnp.split(mod, 6, axis=-1)
        h = rms_norm(x, norm1_g[l]) * (1.0 + sc1) + sh1
        x = x + gt1 * hybrid_mixer(h, positions, w_in[l], nsa_q_norm[l], nsa_k_norm[l],
                                   cmp_pe_k[l], cmp_w1_k[l], cmp_w2_k[l], cmp_pe_v[l], cmp_w1_v[l], cmp_w2_v[l],
                                   dil_q_norm[l], dil_k_norm[l], w_up_a[l], w_up_b[l], w_out[l])
        h = rms_norm(x, norm2_g[l]) * (1.0 + sc2) + sh2
        x = x + gt2 * hierarchical_moe(h, w_group[l], b_group[l], w_router[l], b_router[l],
                                       w_e_gate[l], w_e_up[l], w_e_down[l])
    return x
```

```cpp
#include <hip/hip_runtime.h>
#include <hip/hip_cooperative_groups.h>
#include <cstdio>
#include <cstdint>
#include <cmath>
namespace cg = cooperative_groups;

#define LAS __attribute__((address_space(3)))
#define GAS __attribute__((address_space(1)))
typedef unsigned short bf16_t;
typedef short bf16x8 __attribute__((ext_vector_type(8)));
typedef short s16x4 __attribute__((ext_vector_type(4)));
typedef float f32x2 __attribute__((ext_vector_type(2)));
typedef float f32x4 __attribute__((ext_vector_type(4)));
typedef float f32x16 __attribute__((ext_vector_type(16)));
typedef unsigned u32x2 __attribute__((ext_vector_type(2)));
typedef unsigned u32x4 __attribute__((ext_vector_type(4)));
typedef __bf16 bf16x2_t __attribute__((ext_vector_type(2)));

constexpr int NB = 32, SEQ = 2048, NT_TOK = NB * SEQ, DM = 1024;
constexpr int IN_COLS = 4504, NSLOT = 72, NPROJ = NSLOT * 64;
constexpr int NEXP = 32, EFF = 512;
constexpr float EPS = 1e-6f;
constexpr float C2 = 0.125f * 1.4426950408889634f;
constexpr int SL_QA = 0, SL_KCMP = 8, SL_VCMP = 10, SL_KSLC = 12, SL_VSLC = 14, SL_KWIN = 16, SL_VWIN = 18, SL_QB = 20, SL_KB = 26, SL_VB = 32, SL_GMA = 38, SL_GMB = 54, SL_GA = 70;

constexpr size_t MiB = 1u << 20;
constexpr size_t WS_CTL = 0, CTL_ZERO_BYTES = 256 * 1024;
constexpr size_t WS_MOD = 1 * MiB;
constexpr size_t WS_SMALL = 2 * MiB;
constexpr size_t WS_ROPE = 3 * MiB;
constexpr size_t WS_CROPE = 19 * MiB;
constexpr size_t WS_WIN = 20 * MiB;
constexpr size_t WS_WUPA = 29 * MiB;
constexpr size_t WS_WUPB = 30 * MiB;
constexpr size_t WS_WOUT = 31 * MiB;
constexpr size_t WS_CW1 = 33 * MiB;
constexpr size_t WS_CW2 = 35 * MiB;
constexpr size_t WS_WGU = 36 * MiB;
constexpr size_t WS_WD = 100 * MiB;
constexpr size_t WS_KC = 132 * MiB;
constexpr size_t WS_CHID = 134 * MiB;
constexpr size_t WS_LSE = 142 * MiB;
constexpr size_t WS_ROWSS = 144 * MiB;
constexpr size_t WS_PICK = 148 * MiB;
constexpr size_t WS_LIST = 150 * MiB;
constexpr size_t WS_H = 160 * MiB;
constexpr size_t WS_Y = 288 * MiB;
constexpr size_t WS_R1 = 416 * MiB;
constexpr size_t WS_R2 = 720 * MiB;
constexpr size_t WS_END = 992 * MiB;
constexpr size_t SLOT_BYTES = (size_t)NT_TOK * 64 * 2;
__host__ __device__ __forceinline__ size_t slot_off(int s) { return s < 38 ? WS_R1 + (size_t)s * SLOT_BYTES : WS_R2 + (size_t)(s - 38) * SLOT_BYTES; }
constexpr int CW_BAR = 4096;
constexpr int CW_CNT = 16384;

constexpr int LDS_BYTES = 163840;
constexpr int LDS_STAGE = 0;
constexpr int LDS_X = 131072;
constexpr int LDS_MISC = LDS_BYTES - 256;
constexpr int LDS_TOK = 135168;
constexpr int LDS_EXP = 147456;

#define RLX_AGENT __ATOMIC_RELAXED, __HIP_MEMORY_SCOPE_AGENT
#define LDS_WAIT() asm volatile("s_waitcnt lgkmcnt(0)" ::: "memory")
#define VM_WAIT() asm volatile("s_waitcnt vmcnt(0)" ::: "memory")
__device__ __forceinline__ unsigned cvtpk(float lo, float hi) { f32x2 v = {lo, hi}; bf16x2_t b = __builtin_convertvector(v, bf16x2_t); return __builtin_bit_cast(unsigned, b); }
__device__ __forceinline__ float bf2f(unsigned short h) { return __uint_as_float(((unsigned)h) << 16); }
__device__ __forceinline__ float bflo(unsigned w) { return __uint_as_float(w << 16); }
__device__ __forceinline__ float bfhi(unsigned w) { return __uint_as_float(w & 0xffff0000u); }
__device__ __forceinline__ float wave_sum(float v) {
#pragma unroll
    for (int o = 1; o < 64; o <<= 1) v += __shfl_xor(v, o);
    return v;
}
__device__ __forceinline__ float sigmoidf_(float x) { return 1.0f / (1.0f + __expf(-x)); }
__device__ __forceinline__ float siluf_(float x) { return x / (1.0f + __expf(-x)); }
__host__ __device__ __forceinline__ int slot_col0(int H) { return H < 8 ? 64 * H : H < 20 ? 512 + 64 * (H - 8) : H < 38 ? 1304 + 64 * (H - 20) : H < 70 ? 2456 + 64 * (H - 38) : H == 70 ? 1280 : 0; }
__host__ __device__ __forceinline__ int slot_valid(int H) { return H < 70 ? 64 : H == 70 ? 24 : 0; }

#define XB_TMO      128
#define XB_XCNT(j)  (256  + 64 * (j))
#define XB_XSUB(j)  (1280 + 64 * (j))
#define XB_XGEN(j)  (2304 + 64 * (j))
#define XB_TOP      3328
#define XB_TOPGEN   3392
#define XCD_BAR_WORDS 3456
#define XB_SPIN_CAP (1u << 22)
__device__ __forceinline__ unsigned xb_ld(unsigned* p)              { return __hip_atomic_load(p, __ATOMIC_RELAXED, __HIP_MEMORY_SCOPE_AGENT); }
__device__ __forceinline__ unsigned xb_add(unsigned* p, unsigned v) { return __hip_atomic_fetch_add(p, v, __ATOMIC_RELAXED, __HIP_MEMORY_SCOPE_AGENT); }
__device__ __forceinline__ unsigned xb_xcc_id() { return (unsigned)__builtin_amdgcn_s_getreg((3 << 11) | 20) & 0xFu; }
#define XB_SPIN(cond, bar) do { unsigned _sp = 0; while (cond) { __builtin_amdgcn_s_sleep(1); \
    if ((++_sp & 255u) == 0u) { if (xb_ld(&(bar)[XB_TMO])) break; if (_sp > XB_SPIN_CAP) { atomicAdd(&(bar)[XB_TMO], 1u); break; } } } } while (0)
struct XcdBarrier { unsigned* bar; unsigned x; volatile LAS unsigned* st; };
__device__ __forceinline__ XcdBarrier xcd_barrier_post(unsigned* bar, volatile LAS unsigned* st) {
    XcdBarrier b; b.bar = bar; b.x = xb_xcc_id(); b.st = st;
    if (threadIdx.x == 0) (void)xb_add(&bar[XB_XCNT(b.x)], 1u);
    return b;
}
__device__ __forceinline__ void xcd_barrier_complete(unsigned* bar, unsigned x, unsigned& nloc, unsigned& nx) {
    const unsigned G = gridDim.x * gridDim.y * gridDim.z;
    unsigned sum, cnt, mine, sp = 0u;
    for (;;) {
        sum = 0u; cnt = 0u; mine = 0u;
#pragma unroll
        for (unsigned j = 0; j < 16; ++j) { const unsigned c = xb_ld(&bar[XB_XCNT(j)]); sum += c; cnt += (c > 0u) ? 1u : 0u; mine = (j == x) ? c : mine; }
        if (sum == G) break;
        __builtin_amdgcn_s_sleep(1);
        if ((++sp & 255u) == 0u) { if (xb_ld(&bar[XB_TMO])) break; if (sp > XB_SPIN_CAP) { atomicAdd(&bar[XB_TMO], 1u); break; } }
    }
    nloc = mine > 0u ? mine : 1u; nx = cnt > 0u ? cnt : 1u;
}
__device__ __forceinline__ void xcd_barrier(const XcdBarrier& b) {
    asm volatile("s_waitcnt vmcnt(0)" ::: "memory");
    __syncthreads();
    if (threadIdx.x == 0) {
        unsigned* bar = b.bar;
        __builtin_amdgcn_s_waitcnt(0);
        unsigned nloc = b.st[0], nx = b.st[1];
        if (nloc == 0u) { xcd_barrier_complete(bar, b.x, nloc, nx); b.st[0] = nloc; b.st[1] = nx; }
        const unsigned old = xb_add(&bar[XB_XSUB(b.x)], 1u);
        const unsigned gen = old / nloc;
        if (old + 1u == (gen + 1u) * nloc) {
            __builtin_amdgcn_fence(__ATOMIC_RELEASE, "agent");
            asm volatile("s_waitcnt vmcnt(0)" ::: "memory");
            const unsigned og = xb_add(&bar[XB_TOP], 1u);
            const unsigned tg = og / nx;
            if (og + 1u == (tg + 1u) * nx) xb_add(&bar[XB_TOPGEN], 1u);
            else XB_SPIN(xb_ld(&bar[XB_TOPGEN]) == tg, bar);
            __builtin_amdgcn_fence(__ATOMIC_ACQUIRE, "agent");
            xb_add(&bar[XB_XGEN(b.x)], 1u);
            asm volatile("s_waitcnt vmcnt(0)" ::: "memory");
        } else {
            XB_SPIN(xb_ld(&bar[XB_XGEN(b.x)]) == gen, bar);
            __builtin_amdgcn_fence(__ATOMIC_ACQUIRE, "agent");
            asm volatile("s_waitcnt vmcnt(0)" ::: "memory");
        }
    }
    __syncthreads();
}
namespace pg8 {
constexpr int BM = 256, BK = 64, HALF = 128, HTB = HALF * BK * 2, STAGE_BYTES = 8 * HTB;
__host__ __device__ __forceinline__ int lds_byte(int r, int c) { const int st = (r >> 4) * 2 + (c >> 5), rr = r & 15, cc = c & 31, ob = rr * 64 + cc * 2; return st * 1024 + (ob ^ (((ob >> 9) & 1) << 5)); }
__host__ __device__ __forceinline__ void stage_rc(int b, int& R, int& C) { const int st = b / 1024, sb = b % 1024, swz = sb ^ (((sb >> 9) & 1) << 5); R = (st >> 1) * 16 + swz / 64; C = (st & 1) * 32 + (swz % 64) / 2; }
__host__ __device__ __forceinline__ int perm32(int rho) { const int n = rho >> 4, i = rho & 15; return 8 * (i >> 2) + 4 * n + (i & 3); }

struct Unit { int pm, pn, e, mt; };

template <class Epi, class Sched, bool ALIGN_EPI = true>
__device__ __forceinline__ void gemm_phase(LAS unsigned char* lds, const int K, const Sched& S, const Epi& E) {
    const int tid = threadIdx.x, wid = __builtin_amdgcn_readfirstlane(tid >> 6), lane = tid & 63, wr = wid >> 2, wc = wid & 3, fr = lane & 15, fq = lane >> 4;
    const int nt = K / BK;
    int Rr[2], Cc[2]; unsigned voffB[2];
#pragma unroll
    for (int i = 0; i < 2; ++i) { stage_rc(tid * 16 + i * 8192, Rr[i], Cc[i]); const int Rb = Epi::PERM ? ((Rr[i] & ~31) + perm32(Rr[i] & 31)) : Rr[i];
        voffB[i] = (unsigned)(Rb * S.ldb + Cc[i]) * 2u; }
    const size_t kstep = (size_t)(BK * 2);
    const size_t hstepB = (size_t)HALF * S.ldb * 2;
    const unsigned ldsw = (unsigned)wid * 1024u;
    const int aoff = lds_byte(wr * 64 + fr, fq * 8), boff = lds_byte(wc * 32 + fr, fq * 8);
#define PG8_SA(b, h) (((b) * 2 + (h)) * HTB)
#define PG8_SB(b, h) ((4 + (b) * 2 + (h)) * HTB)
#define PG8_STAGE(bufoff, gbase, voff) do { _Pragma("unroll") for (int _i = 0; _i < 2; ++_i) \
        __builtin_amdgcn_global_load_lds((const unsigned*)((const char*)(gbase) + (voff)[_i]), (LAS unsigned*)(lds + (bufoff) + ldsw + _i * 8192), 16, 0, 0); } while (0)
#define PG8_LDA(dst, b, h) do { _Pragma("unroll") for (int m = 0; m < 4; ++m) _Pragma("unroll") for (int k = 0; k < 2; ++k) dst[m][k] = *(const LAS bf16x8*)(lds + PG8_SA(b, h) + aoff + m * 2048 + k * 1024); } while (0)
#define PG8_LDB(dst, b, h) do { _Pragma("unroll") for (int n = 0; n < 2; ++n) _Pragma("unroll") for (int k = 0; k < 2; ++k) dst[n][k] = *(const LAS bf16x8*)(lds + PG8_SB(b, h) + boff + n * 2048 + k * 1024); } while (0)
#define PG8_MMA(ai, bj, At, Bt) do { __builtin_amdgcn_s_setprio(1); _Pragma("unroll") for (int m = 0; m < 4; ++m) _Pragma("unroll") for (int n = 0; n < 2; ++n) _Pragma("unroll") for (int k = 0; k < 2; ++k) \
        acc[ai][bj][m][n] = __builtin_amdgcn_mfma_f32_16x16x32_bf16(Bt[n][k], At[m][k], acc[ai][bj][m][n], 0, 0, 0); __builtin_amdgcn_s_setprio(0); } while (0)
#define PG8_WAIT_V(n) asm volatile("s_waitcnt vmcnt(" #n ")" ::: "memory")
#define PG8_WAIT_L(n) asm volatile("s_waitcnt lgkmcnt(" #n ")" ::: "memory")
#define PG8_BAR __builtin_amdgcn_s_barrier()
#define PG8_SCHED __builtin_amdgcn_sched_barrier(0)
    Unit cur, nxt; int ui = 0;
    if (!S.next(0, cur)) return;
    f32x4 acc[2][2][4][2];
#pragma unroll
    for (int a = 0; a < 2; ++a)
#pragma unroll
        for (int b = 0; b < 2; ++b)
#pragma unroll
            for (int m = 0; m < 4; ++m)
#pragma unroll
                for (int n = 0; n < 2; ++n) acc[a][b][m][n] = (f32x4){0.f, 0.f, 0.f, 0.f};
    bf16x8 At[4][2], B0[2][2], B1[2][2];
    unsigned vaC[2][2], vaN[2][2];
#pragma unroll
    for (int h = 0; h < 2; ++h)
#pragma unroll
        for (int i = 0; i < 2; ++i) vaC[h][i] = S.a_voff(cur, 0, h, Rr[i], Cc[i]);
    const char* cA = S.a_base(cur); const char* cB = S.b_base(cur);
    PG8_STAGE(PG8_SB(0, 0), cB, voffB); PG8_STAGE(PG8_SB(0, 1), cB + hstepB, voffB); PG8_STAGE(PG8_SA(0, 0), cA, vaC[0]); PG8_STAGE(PG8_SA(0, 1), cA, vaC[1]);
    if (wr == 1) PG8_BAR;
    PG8_WAIT_V(2); PG8_BAR;
    PG8_STAGE(PG8_SB(1, 0), cB + kstep, voffB); PG8_STAGE(PG8_SA(1, 0), cA + kstep, vaC[0]); PG8_STAGE(PG8_SB(1, 1), cB + hstepB + kstep, voffB);
    PG8_WAIT_V(6); PG8_BAR;
    for (;;) {
        const bool has_next = S.next(ui + 1, nxt);
        const char* nA = cA; const char* nB = cB;
        if (has_next) { nA = S.a_base(nxt); nB = S.b_base(nxt);
#pragma unroll
            for (int h = 0; h < 2; ++h)
#pragma unroll
                for (int i = 0; i < 2; ++i) vaN[h][i] = S.a_voff(nxt, ui + 1, h, Rr[i], Cc[i]);
        } else {
#pragma unroll
            for (int h = 0; h < 2; ++h)
#pragma unroll
                for (int i = 0; i < 2; ++i) vaN[h][i] = vaC[h][i];
        }
#pragma unroll 1
        for (int t = 0; t < nt; t += 2) {
            const bool last = (t == nt - 2);
            const char* a1 = cA + (size_t)(t + 1) * kstep;
            const char* a2 = last ? nA : cA + (size_t)(t + 2) * kstep; const char* b2 = last ? nB : cB + (size_t)(t + 2) * kstep;
            const char* a3 = a2 + kstep; const char* b3 = b2 + kstep;
            unsigned va2[2][2];
#pragma unroll
            for (int h = 0; h < 2; ++h)
#pragma unroll
                for (int i = 0; i < 2; ++i) va2[h][i] = last ? vaN[h][i] : vaC[h][i];
            PG8_LDB(B0, 0, 0); PG8_LDB(B1, 0, 1); PG8_SCHED; PG8_LDA(At, 0, 0); PG8_STAGE(PG8_SA(1, 1), a1, vaC[1]);
            PG8_WAIT_V(8); PG8_WAIT_L(0); PG8_BAR; PG8_MMA(0, 0, At, B0); PG8_MMA(0, 1, At, B1); PG8_BAR; PG8_SCHED;
            PG8_LDA(At, 0, 1); PG8_STAGE(PG8_SB(0, 0), b2, voffB); PG8_STAGE(PG8_SB(0, 1), b2 + hstepB, voffB); PG8_STAGE(PG8_SA(0, 0), a2, va2[0]);
            PG8_WAIT_V(8); PG8_WAIT_L(0); PG8_BAR; PG8_MMA(1, 0, At, B0); PG8_MMA(1, 1, At, B1); PG8_BAR; PG8_SCHED;
            PG8_LDB(B0, 1, 0); PG8_LDB(B1, 1, 1); PG8_SCHED; PG8_LDA(At, 1, 0); PG8_STAGE(PG8_SA(0, 1), a2, va2[1]);
            PG8_WAIT_V(8); PG8_WAIT_L(0); PG8_BAR; PG8_MMA(0, 0, At, B0); PG8_MMA(0, 1, At, B1); PG8_BAR; PG8_SCHED;
            PG8_LDA(At, 1, 1); PG8_STAGE(PG8_SB(1, 0), b3, voffB); PG8_STAGE(PG8_SB(1, 1), b3 + hstepB, voffB); PG8_STAGE(PG8_SA(1, 0), a3, va2[0]);
            PG8_WAIT_V(8); PG8_WAIT_L(0); PG8_BAR; PG8_MMA(1, 0, At, B0); PG8_MMA(1, 1, At, B1); PG8_BAR; PG8_SCHED;
        }
        if constexpr (ALIGN_EPI) { if (wr == 0) PG8_BAR; }
        { int fr_ = fr, fq_ = fq; asm volatile("" : "+v"(fr_), "+v"(fq_)); E(acc, cur, ui, wr, wc, fr_, fq_); }
        if (!has_next) break;
#pragma unroll
        for (int a = 0; a < 2; ++a)
#pragma unroll
            for (int b = 0; b < 2; ++b)
#pragma unroll
                for (int m = 0; m < 4; ++m)
#pragma unroll
                    for (int n = 0; n < 2; ++n) acc[a][b][m][n] = (f32x4){0.f, 0.f, 0.f, 0.f};
        cur = nxt; cA = nA; cB = nB; ++ui;
#pragma unroll
        for (int h = 0; h < 2; ++h)
#pragma unroll
            for (int i = 0; i < 2; ++i) vaC[h][i] = vaN[h][i];
        if constexpr (ALIGN_EPI) { if (wr == 1) PG8_BAR; }
    }
    PG8_WAIT_V(0);
    if constexpr (!ALIGN_EPI) { if (wr == 0) PG8_BAR; }
    PG8_BAR;
#undef PG8_SA
#undef PG8_SB
#undef PG8_STAGE
#undef PG8_LDA
#undef PG8_LDB
#undef PG8_MMA
#undef PG8_WAIT_V
#undef PG8_WAIT_L
#undef PG8_BAR
#undef PG8_SCHED
}

struct DenseSched {
    const char* A; const char* Bt; int lda, ldb; int nM, nN, nwg, G, c;
    __device__ __forceinline__ void init(const void* A_, int lda_, const void* Bt_, int ldb_, int M, int N, int G_, int c_) {
        A = (const char*)A_; Bt = (const char*)Bt_; lda = lda_; ldb = ldb_; nM = M / BM; nN = N / BM; nwg = nM * nN; G = G_; c = c_; }
    __device__ __forceinline__ bool next(int i, Unit& u) const {
        const long L = (long)i * G + c; if (L >= nwg) return false;
        int wgid = (int)L; { const int q = nwg / 8, r = nwg % 8, xcd = wgid % 8, off = wgid / 8; wgid = (xcd < r ? xcd * (q + 1) : r * (q + 1) + (xcd - r) * q) + off; }
        const int nig = 8 * nN, gid = wgid / nig, fm = gid * 8, gsz = (nM - fm) < 8 ? (nM - fm) : 8;
        u.pm = fm + ((wgid % nig) % gsz); u.pn = (wgid % nig) / gsz; u.e = 0; u.mt = 0; return true;
    }
    __device__ __forceinline__ const char* a_base(const Unit& u) const { return A + (size_t)u.pm * BM * lda * 2; }
    __device__ __forceinline__ unsigned a_voff(const Unit&, int, int h, int R, int C) const { return (unsigned)((h * HALF + R) * lda + C) * 2u; }
    __device__ __forceinline__ const char* b_base(const Unit& u) const { return Bt + (size_t)u.pn * BM * ldb * 2; }
};
}
struct Args { const void* in[28]; float* out; unsigned char* ws; int ph_lo, ph_hi; };
struct Frame {
    LAS unsigned char* lds; volatile LAS unsigned* MISC; unsigned* ctl; unsigned char* ws;
    int tid, lane, wave, vcu, G;
};
#define WSP(T_, off) ((T_*)(F.ws + (off)))

__device__ __forceinline__ void transpose_item(const float* src, int src_ld, int k0, int n0, int nvalid, bf16_t* dst, int dst_ld, int drow0, LAS float* scr, int lane) {
    const int cl = lane & 31;
#pragma unroll 8
    for (int i = 0; i < 32; ++i) { const int kk = 2 * i + (lane >> 5); scr[kk * 33 + cl] = (cl < nvalid) ? src[(size_t)(k0 + kk) * src_ld + n0 + cl] : 0.f; }
    LDS_WAIT(); asm volatile("" ::: "memory");
    const int c = lane & 7;
#pragma unroll
    for (int j = 0; j < 4; ++j) { const int n = (lane >> 3) + 8 * j; const LAS float* s = scr + (8 * c) * 33 + n;
        u32x4 o; o.x = cvtpk(s[0 * 33], s[1 * 33]); o.y = cvtpk(s[2 * 33], s[3 * 33]); o.z = cvtpk(s[4 * 33], s[5 * 33]); o.w = cvtpk(s[6 * 33], s[7 * 33]);
        *(u32x4*)(dst + (size_t)(drow0 + n) * dst_ld + k0 + 8 * c) = o; }
    LDS_WAIT(); asm volatile("" ::: "memory");
}

__device__ __forceinline__ void pa_prologue(Frame& F, const Args& a) {
    const float* c_in = (const float*)a.in[1]; const int* pos = (const int*)a.in[2];
    const float* w_ada = (const float*)a.in[3]; const float* b_ada = (const float*)a.in[4];
    if ((int)blockIdx.x < 96) {
        LAS float* sc = (LAS float*)(F.lds);
        for (int idx = F.tid; idx < 32 * 1024; idx += 512) sc[idx] = siluf_(c_in[idx]);
        __syncthreads();
        for (int u = blockIdx.x; u < 96; u += F.G) {
            const int n = 64 * u + F.lane, b0 = 4 * F.wave;
            float acc0 = 0.f, acc1 = 0.f, acc2 = 0.f, acc3 = 0.f;
#pragma unroll 4
            for (int k = 0; k < 1024; ++k) { const float w = w_ada[(size_t)k * 6144 + n];
                acc0 += sc[(b0 + 0) * 1024 + k] * w; acc1 += sc[(b0 + 1) * 1024 + k] * w; acc2 += sc[(b0 + 2) * 1024 + k] * w; acc3 += sc[(b0 + 3) * 1024 + k] * w; }
            float* mod = WSP(float, WS_MOD); const float bb = b_ada[n];
            mod[(size_t)(b0 + 0) * 6144 + n] = acc0 + bb; mod[(size_t)(b0 + 1) * 6144 + n] = acc1 + bb; mod[(size_t)(b0 + 2) * 6144 + n] = acc2 + bb; mod[(size_t)(b0 + 3) * 6144 + n] = acc3 + bb;
        }
        __syncthreads();
    }
    {
        LAS float* scr = (LAS float*)(F.lds + F.wave * 16384);
        const int gw = F.vcu * 8 + F.wave, NGW = F.G * 8;
        constexpr int I_WIN = 16 * 144, I_UPA = 8 * 32, I_UPB = 6 * 32, I_OUT = 16 * 32, I_CW1 = 32 * 8, I_CW2 = 4 * 2, I_GU = 16 * 32, I_WD = 8 * 32;
        constexpr int NITEMS = I_WIN + I_UPA + I_UPB + I_OUT + 2 * I_CW1 + 2 * I_CW2 + NEXP * (I_GU + I_WD);
        for (int it = gw; it < NITEMS; it += NGW) {
            int r = it;
            if (r < I_WIN) { const int kb = r / 144, rb = r % 144, rho0 = 32 * rb, pn = rho0 >> 8, bj = (rho0 >> 7) & 1, wc = (rho0 >> 5) & 3, H = 4 * pn + wc;
                int nv = slot_valid(H) - 32 * bj; nv = nv < 0 ? 0 : (nv > 32 ? 32 : nv);
                transpose_item((const float*)a.in[7], IN_COLS, 64 * kb, slot_col0(H) + 32 * bj, nv, WSP(bf16_t, WS_WIN), 1024, rho0, scr, F.lane); continue; } r -= I_WIN;
            if (r < I_UPA) { const int kb = r / 32, rb = r % 32; transpose_item((const float*)a.in[18], 1024, 64 * kb, 32 * rb, 32, WSP(bf16_t, WS_WUPA), 512, 32 * rb, scr, F.lane); continue; } r -= I_UPA;
            if (r < I_UPB) { const int kb = r / 32, rb = r % 32; transpose_item((const float*)a.in[19], 1024, 64 * kb, 32 * rb, 32, WSP(bf16_t, WS_WUPB), 384, 32 * rb, scr, F.lane); continue; } r -= I_UPB;
            if (r < I_OUT) { const int kb = r / 32, rb = r % 32; transpose_item((const float*)a.in[20], 1024, 64 * kb, 32 * rb, 32, WSP(bf16_t, WS_WOUT), 1024, 32 * rb, scr, F.lane); continue; } r -= I_OUT;
            if (r < 2 * I_CW1) { const int kv = r / I_CW1, q = r % I_CW1, kb = q / 8, rb = q % 8;
                transpose_item((const float*)a.in[kv ? 14 : 11], 256, 64 * kb, 32 * rb, 32, WSP(bf16_t, WS_CW1) + (size_t)kv * 256 * 2048, 2048, 32 * rb, scr, F.lane); continue; } r -= 2 * I_CW1;
            if (r < 2 * I_CW2) { const int kv = r / I_CW2, q = r % I_CW2, kb = q / 2, rb = q % 2;
                transpose_item((const float*)a.in[kv ? 15 : 12], 64, 64 * kb, 32 * rb, 32, WSP(bf16_t, WS_CW2) + (size_t)kv * 64 * 256, 256, 32 * rb, scr, F.lane); continue; } r -= 2 * I_CW2;
            { const int e = r / (I_GU + I_WD); int q = r % (I_GU + I_WD);
              if (q < I_GU) { const int kb = q / 32, rb = q % 32, rho0 = 32 * rb, pn = rho0 >> 8, bj = (rho0 >> 7) & 1, y0 = rho0 & 127;
                  transpose_item((const float*)a.in[bj ? 26 : 25] + (size_t)e * 1024 * 512, 512, 64 * kb, 128 * pn + y0, 32, WSP(bf16_t, WS_WGU) + (size_t)e * 1024 * 1024, 1024, rho0, scr, F.lane); }
              else { q -= I_GU; const int kb = q / 32, rb = q % 32;
                  transpose_item((const float*)a.in[27] + (size_t)e * 512 * 1024, 1024, 64 * kb, 32 * rb, 32, WSP(bf16_t, WS_WD) + (size_t)e * 1024 * 512, 512, 32 * rb, scr, F.lane); } }
        }
    }
    {
        const int gt = F.vcu * 512 + F.tid, NGT = F.G * 512;
        float* cosT = WSP(float, WS_ROPE); float* sinT = cosT + (size_t)NT_TOK * 32;
        for (int idx = gt; idx < NT_TOK * 32; idx += NGT) { const int t = idx >> 5, f = idx & 31;
            const double inv = exp2(-(double)f * (13.287712379549449 / 32.0)); const double ang = (double)pos[t] * inv;
            double s, c; sincos(ang, &s, &c); cosT[idx] = (float)c; sinT[idx] = (float)s; }
        float* ccos = WSP(float, WS_CROPE); float* csin = ccos + 32 * 128 * 32;
        for (int idx = gt; idx < 32 * 128 * 32; idx += NGT) { const int f = idx & 31, n = (idx >> 5) & 127, b = idx >> 12;
            const int tt = 16 * n + 31; const int p = pos[b * SEQ + (tt < SEQ ? tt : SEQ - 1)];
            const double inv = exp2(-(double)f * (13.287712379549449 / 32.0)); const double ang = (double)p * inv;
            double s, c; sincos(ang, &s, &c); ccos[idx] = (float)c; csin[idx] = (float)s; }
        bf16_t* rhi = (bf16_t*)(F.ws + WS_SMALL + 65536); bf16_t* rlo = (bf16_t*)(F.ws + WS_SMALL + 196608);
        const float* w_group = (const float*)a.in[21]; const float* w_router = (const float*)a.in[23];
        for (int idx = gt; idx < 64 * 1024; idx += NGT) { const int c = idx >> 10, k = idx & 1023;
            float w = 0.f; if (c < 4) w = w_group[k * 4 + c]; else if (c < 36) { const int g = (c - 4) >> 3, e = (c - 4) & 7; w = w_router[((size_t)g * 1024 + k) * 8 + e]; }
            const unsigned hi = cvtpk(w, 0.f) & 0xffffu; const float lo = w - bf2f((unsigned short)hi);
            rhi[idx] = (bf16_t)hi; rlo[idx] = (bf16_t)(cvtpk(lo, 0.f) & 0xffffu); }
        float* bias = WSP(float, WS_SMALL);
        for (int idx = gt; idx < 16 * 512; idx += NGT) { const int ks = idx >> 9, kv = (idx >> 8) & 1, col = idx & 255; const float* pe = (const float*)a.in[kv ? 13 : 10]; const float* w1 = (const float*)a.in[kv ? 14 : 11];
            float s = 0.f;
#pragma unroll 8
            for (int i = 128 * ks; i < 128 * ks + 128; ++i) s += pe[i] * w1[(size_t)i * 256 + col];
            bias[idx] = s; }
        if (gt < NEXP) F.ctl[CW_CNT + 64 * gt] = 0u;
    }
}

__device__ __forceinline__ void pb_modnorm(Frame& F, const float* x, const float* g, const float* mod, int sh_off, int sc_off, bf16_t* out) {
    const int gw = F.vcu * 8 + F.wave, NGW = F.G * 8;
    for (int m = gw; m < NT_TOK; m += NGW) {
        const int b = m >> 11;
        const f32x4* xr = (const f32x4*)(x + (size_t)m * DM) + F.lane;
        f32x4 v[4]; float s = 0.f;
#pragma unroll
        for (int j = 0; j < 4; ++j) { v[j] = xr[64 * j]; s += (v[j].x * v[j].x + v[j].y * v[j].y) + (v[j].z * v[j].z + v[j].w * v[j].w); }
        const float rstd = 1.0f / sqrtf(wave_sum(s) * (1.f / DM) + EPS);
        const f32x4* gr = (const f32x4*)g + F.lane; const f32x4* scr = (const f32x4*)(mod + (size_t)b * 6144 + sc_off) + F.lane; const f32x4* shr = (const f32x4*)(mod + (size_t)b * 6144 + sh_off) + F.lane;
        u32x2* o8 = (u32x2*)(out + (size_t)m * DM) + F.lane;
#pragma unroll
        for (int j = 0; j < 4; ++j) { const f32x4 gg = gr[64 * j], sc = scr[64 * j], sh = shr[64 * j];
            const f32x4 y = (v[j] * rstd) * gg; const f32x4 h = y * (sc + 1.0f) + sh;
            u32x2 w; w.x = cvtpk(h.x, h.y); w.y = cvtpk(h.z, h.w); o8[64 * j] = w; }
    }
}
namespace pg8 {
struct ProjEpi {
    static constexpr bool PERM = true;
    unsigned char* ws; const float* cosT; const float* sinT; const float* nq; const float* nk; const float* dq; const float* dk;
    __device__ __forceinline__ void operator()(const f32x4 (&acc)[2][2][4][2], const Unit& u, int, int wr, int wc, int fr, int fq) const {
        const int H = __builtin_amdgcn_readfirstlane(4 * u.pn + wc);
        int type = 0; const float* gn = nq; float qs = 1.f;
        if (H < 8) { type = 1; gn = nq; qs = C2; }
        else if (H == 12 || H == 13 || H == 16 || H == 17) { type = 1; gn = nk; }
        else if (H >= 20 && H < 26) { type = 1; gn = dq; qs = C2; }
        else if (H >= 26 && H < 32) { type = 1; gn = dk; }
        else if (H >= 38 && H <= 70) type = 2;
        bf16_t* dst = (bf16_t*)(ws + slot_off(H));
        const int row0 = u.pm * BM + wr * 64 + fr;
        if (type == 1) {
            f32x4 g0[2], g1[2];
#pragma unroll
            for (int n = 0; n < 2; ++n) { g0[n] = *(const f32x4*)(gn + 8 * fq + 4 * n) * qs; g1[n] = *(const f32x4*)(gn + 32 + 8 * fq + 4 * n) * qs; }
#pragma unroll
            for (int ai = 0; ai < 2; ++ai)
#pragma unroll
                for (int m = 0; m < 4; ++m) {
                    const int tok = row0 + ai * HALF + m * 16;
                    float ss = 0.f;
#pragma unroll
                    for (int bj = 0; bj < 2; ++bj)
#pragma unroll
                        for (int n = 0; n < 2; ++n) { const f32x4 v = acc[ai][bj][m][n]; ss += (v[0] * v[0] + v[1] * v[1]) + (v[2] * v[2] + v[3] * v[3]); }
                    ss += __shfl_xor(ss, 16); ss += __shfl_xor(ss, 32);
                    const float rstd = 1.0f / sqrtf(ss * (1.f / 64.f) + EPS);
                    u32x4 w0, w1;
#pragma unroll
                    for (int n = 0; n < 2; ++n) {
                        const f32x4 cs = *(const f32x4*)(cosT + (size_t)tok * 32 + 8 * fq + 4 * n), sn = *(const f32x4*)(sinT + (size_t)tok * 32 + 8 * fq + 4 * n);
                        const f32x4 x1 = acc[ai][0][m][n] * rstd * g0[n], x2 = acc[ai][1][m][n] * rstd * g1[n];
                        const f32x4 o1 = x1 * cs - x2 * sn, o2 = x1 * sn + x2 * cs;
                        w0[2 * n] = cvtpk(o1[0], o1[1]); w0[2 * n + 1] = cvtpk(o1[2], o1[3]); w1[2 * n] = cvtpk(o2[0], o2[1]); w1[2 * n + 1] = cvtpk(o2[2], o2[3]);
                    }
                    bf16_t* rp = dst + (size_t)tok * 64 + 8 * fq;
                    *(u32x4*)rp = w0; *(u32x4*)(rp + 32) = w1;
                }
        } else {
#pragma unroll
            for (int ai = 0; ai < 2; ++ai)
#pragma unroll
                for (int m = 0; m < 4; ++m) {
                    const int tok = row0 + ai * HALF + m * 16;
                    bf16_t* rp = dst + (size_t)tok * 64 + 8 * fq;
#pragma unroll
                    for (int bj = 0; bj < 2; ++bj) { f32x4 v0 = acc[ai][bj][m][0], v1 = acc[ai][bj][m][1];
                        if (type == 2) {
#pragma unroll
                            for (int i = 0; i < 4; ++i) { v0[i] = sigmoidf_(v0[i]); v1[i] = sigmoidf_(v1[i]); } }
                        u32x4 w; w.x = cvtpk(v0[0], v0[1]); w.y = cvtpk(v0[2], v0[3]); w.z = cvtpk(v1[0], v1[1]); w.w = cvtpk(v1[2], v1[3]);
                        *(u32x4*)(rp + 32 * bj) = w; }
                }
        }
    }
};

template <bool ADD> struct UpEpi {
    static constexpr bool PERM = true;
    unsigned char* ws; bf16_t* Y; int gslot0;
    __device__ __forceinline__ void operator()(const f32x4 (&acc)[2][2][4][2], const Unit& u, int, int wr, int wc, int fr, int fq) const {
        const int row0 = u.pm * BM + wr * 64 + fr;
#pragma unroll
        for (int bj = 0; bj < 2; ++bj) {
            const int gs = __builtin_amdgcn_readfirstlane(gslot0 + 4 * u.pn + 2 * bj + (wc >> 1));
            const bf16_t* gp = (const bf16_t*)(ws + slot_off(gs)) + 32 * (wc & 1) + 8 * fq;
            const int col = u.pn * BM + bj * HALF + wc * 32 + 8 * fq;
#pragma unroll
            for (int ai = 0; ai < 2; ++ai)
#pragma unroll
                for (int m = 0; m < 4; ++m) {
                    const int tok = row0 + ai * HALF + m * 16;
                    const u32x4 g = *(const u32x4*)(gp + (size_t)tok * 64);
                    bf16_t* yp = Y + (size_t)tok * DM + col;
                    f32x4 v0 = acc[ai][bj][m][0], v1 = acc[ai][bj][m][1];
                    v0[0] *= bflo(g.x); v0[1] *= bfhi(g.x); v0[2] *= bflo(g.y); v0[3] *= bfhi(g.y); v1[0] *= bflo(g.z); v1[1] *= bfhi(g.z); v1[2] *= bflo(g.w); v1[3] *= bfhi(g.w);
                    if (ADD) { const u32x4 y = *(const u32x4*)yp;
                        v0[0] += bflo(y.x); v0[1] += bfhi(y.x); v0[2] += bflo(y.y); v0[3] += bfhi(y.y); v1[0] += bflo(y.z); v1[1] += bfhi(y.z); v1[2] += bflo(y.w); v1[3] += bfhi(y.w); }
                    u32x4 w; w.x = cvtpk(v0[0], v0[1]); w.y = cvtpk(v0[2], v0[3]); w.z = cvtpk(v1[0], v1[1]); w.w = cvtpk(v1[2], v1[3]);
                    *(u32x4*)yp = w;
                    if (m & 1) asm volatile("" ::: "memory");
                }
        }
    }
};

struct OutEpi {
    static constexpr bool PERM = false;
    const float* x; float* out; const float* mod; float* rowss;
    __device__ __forceinline__ void operator()(const f32x4 (&acc)[2][2][4][2], const Unit& u, int, int wr, int wc, int fr, int fq) const {
        const int row0 = u.pm * BM + wr * 64 + fr, col0 = u.pn * BM + wc * 32 + 4 * fq;
        const int b = (u.pm * BM) >> 11;
        const float* gt = mod + (size_t)b * 6144 + 2048 + col0;
        f32x4 gv[2][2];
#pragma unroll
        for (int bj = 0; bj < 2; ++bj)
#pragma unroll
            for (int n = 0; n < 2; ++n) gv[bj][n] = *(const f32x4*)(gt + bj * HALF + n * 16);
#pragma unroll
        for (int ai = 0; ai < 2; ++ai)
#pragma unroll
            for (int m = 0; m < 4; ++m) {
                const int tok = row0 + ai * HALF + m * 16; const size_t off = (size_t)tok * DM + col0; float ss = 0.f;
#pragma unroll
                for (int bj = 0; bj < 2; ++bj)
#pragma unroll
                    for (int n = 0; n < 2; ++n) { const f32x4 xv = *(const f32x4*)(x + off + bj * HALF + n * 16); const f32x4 o = xv + gv[bj][n] * acc[ai][bj][m][n];
                        ss += (o[0] * o[0] + o[1] * o[1]) + (o[2] * o[2] + o[3] * o[3]); *(f32x4*)(out + off + bj * HALF + n * 16) = o; }
                ss += __shfl_xor(ss, 16); ss += __shfl_xor(ss, 32);
                if (fq == 0) rowss[(size_t)tok * 16 + 4 * u.pn + wc] = ss;
            }
    }
};

struct CmpEpi {
    static constexpr bool PERM = true;
    const float* biasp; bf16_t* hid;
    __device__ __forceinline__ void operator()(const f32x4 (&acc)[2][2][4][2], const Unit& u, int, int wr, int wc, int fr, int fq) const {
        const int kv = u.pm >= 32 ? 1 : 0; const int row0 = u.pm * BM + wr * 64 + fr;
#pragma unroll
        for (int bj = 0; bj < 2; ++bj) {
            const int col = bj * HALF + wc * 32 + 8 * fq;
            f32x4 b0 = (f32x4){0.f, 0.f, 0.f, 0.f}, b1 = b0;
            for (int ks = 0; ks < 16; ++ks) { b0 += *(const f32x4*)(biasp + ks * 512 + kv * 256 + col); b1 += *(const f32x4*)(biasp + ks * 512 + kv * 256 + col + 4); }
#pragma unroll
            for (int ai = 0; ai < 2; ++ai)
#pragma unroll
                for (int m = 0; m < 4; ++m) {
                    const int row = row0 + ai * HALF + m * 16;
                    f32x4 v0 = acc[ai][bj][m][0] + b0, v1 = acc[ai][bj][m][1] + b1;
#pragma unroll
                    for (int i = 0; i < 4; ++i) { v0[i] = siluf_(v0[i]); v1[i] = siluf_(v1[i]); }
                    u32x4 w; w.x = cvtpk(v0[0], v0[1]); w.y = cvtpk(v0[2], v0[3]); w.z = cvtpk(v1[0], v1[1]); w.w = cvtpk(v1[2], v1[3]);
                    *(u32x4*)(hid + (size_t)row * 256 + col) = w;
                }
        }
    }
};
struct CmpSched {
    const char* A; const char* Bt; int ldb; int nwg_c, c;
    __device__ __forceinline__ bool next(int i, Unit& u) const { if (c < 0) return false; const int L = i * nwg_c + c; if (L >= 64) return false; u.pm = L; u.pn = 0; u.e = 0; u.mt = 0; return true; }
    __device__ __forceinline__ const char* a_base(const Unit& u) const { return A + (size_t)u.pm * BM * 1024 * 2; }
    __device__ __forceinline__ unsigned a_voff(const Unit&, int, int h, int R, int C) const { return (unsigned)((h * HALF + R) * 1024 + C) * 2u; }
    __device__ __forceinline__ const char* b_base(const Unit& u) const { return Bt + (u.pm >= 32 ? (size_t)256 * 2048 * 2 : 0); }
};
}
namespace att {
constexpr int A_KV = 0;
constexpr int A_WSF = 65536;
constexpr int A_OST = 67584;
constexpr int A_IMP = 100352;
constexpr int A_SEL = 133120;
constexpr float NEG_INF = -INFINITY;
constexpr float THR = 8.0f;
__device__ __forceinline__ int crow(int r, int hi) { return (r & 3) + 8 * (r >> 2) + 4 * hi; }
__device__ __forceinline__ void glds16(const void* gsrc, unsigned lds_dst) { unsigned keep;
    asm volatile("s_mov_b32 %0, m0\n\ts_mov_b32 m0, %2\n\ts_nop 0\n\tglobal_load_lds_dwordx4 %1, off\n\ts_mov_b32 m0, %0" : "=&s"(keep) : "v"(gsrc), "s"(lds_dst) : "memory"); }
#define ATT_WAIT_BAR(N) asm volatile("s_waitcnt vmcnt(" #N ") lgkmcnt(0)\n\ts_barrier" ::: "memory")
#define ATT_SBAR() __builtin_amdgcn_sched_barrier(0)

struct Ctx { LAS unsigned char* lds; int lane, r32, hi, wid; unsigned lds0; };
__device__ __forceinline__ int fresh(int v) { asm volatile("" : "+v"(v)); return v; }

__device__ __forceinline__ void qkt(f32x16& p0, f32x16& p1, const LAS unsigned char* Kslot, const bf16x8 (&qr)[4], int r32_, int hi_) {
    const int lq = fresh(r32_ + 32 * hi_); const int r32 = lq & 31, hi = lq >> 5;
    const LAS unsigned char* kb = Kslot + hi * 1024 + r32 * 16;
    const f32x16 z = {};
#pragma unroll
    for (int d0 = 0; d0 < 4; ++d0) {
        const bf16x8 b0 = *(const LAS bf16x8*)(kb + d0 * 2048);
        const bf16x8 b1 = *(const LAS bf16x8*)(kb + d0 * 2048 + 512);
        if (d0 == 0) { p0 = __builtin_amdgcn_mfma_f32_32x32x16_bf16(b0, qr[0], z, 0, 0, 0); p1 = __builtin_amdgcn_mfma_f32_32x32x16_bf16(b1, qr[0], z, 0, 0, 0); }
        else { p0 = __builtin_amdgcn_mfma_f32_32x32x16_bf16(b0, qr[d0], p0, 0, 0, 0); p1 = __builtin_amdgcn_mfma_f32_32x32x16_bf16(b1, qr[d0], p1, 0, 0, 0); } }
}
__device__ __forceinline__ void pv(f32x16 (&o)[2], int vb, bf16x8 pa0, bf16x8 pa1, bf16x8 pa2, bf16x8 pa3) {
#pragma unroll
    for (int d0 = 0; d0 < 2; ++d0) { s16x4 lo[4], hh[4];
#pragma unroll
        for (int ks = 0; ks < 4; ++ks) {
            asm volatile("ds_read_b64_tr_b16 %0,%1 offset:%c2" : "=&v"(lo[ks]) : "v"(vb), "i"(d0 * 4096 + ks * 1024) : "memory");
            asm volatile("ds_read_b64_tr_b16 %0,%1 offset:%c2" : "=&v"(hh[ks]) : "v"(vb), "i"(d0 * 4096 + ks * 1024 + 512) : "memory"); }
        asm volatile("s_waitcnt lgkmcnt(0)" ::: "memory"); ATT_SBAR();
#define ATT_PK(k) (bf16x8){lo[k][0], lo[k][1], lo[k][2], lo[k][3], hh[k][0], hh[k][1], hh[k][2], hh[k][3]}
        o[d0] = __builtin_amdgcn_mfma_f32_32x32x16_bf16(pa0, ATT_PK(0), o[d0], 0, 0, 0);
        o[d0] = __builtin_amdgcn_mfma_f32_32x32x16_bf16(pa1, ATT_PK(1), o[d0], 0, 0, 0);
        o[d0] = __builtin_amdgcn_mfma_f32_32x32x16_bf16(pa2, ATT_PK(2), o[d0], 0, 0, 0);
        o[d0] = __builtin_amdgcn_mfma_f32_32x32x16_bf16(pa3, ATT_PK(3), o[d0], 0, 0, 0);
#undef ATT_PK
    }
}
__device__ __forceinline__ float rowmax(const f32x16& p0, const f32x16& p1) {
    float a = fmaxf(p0[0], p1[0]);
#pragma unroll
    for (int r = 1; r < 16; ++r) a = fmaxf(a, fmaxf(p0[r], p1[r]));
    auto rr = __builtin_amdgcn_permlane32_swap(__float_as_uint(a), __float_as_uint(a), false, false);
    return fmaxf(__uint_as_float(rr[0]), __uint_as_float(rr[1]));
}
__device__ __forceinline__ float halfsum(float v) { auto rr = __builtin_amdgcn_permlane32_swap(__float_as_uint(v), __float_as_uint(v), false, false); return __uint_as_float(rr[0]) + __uint_as_float(rr[1]); }
#define ATT_PACK4(P, B) (u32x4){cvtpk(P[B], P[B + 1]), cvtpk(P[B + 2], P[B + 3]), cvtpk(P[B + 4], P[B + 5]), cvtpk(P[B + 6], P[B + 7])}
__device__ __forceinline__ void pv_tile(f32x16 (&o)[2], int vb, const f32x16& p0, const f32x16& p1) {
    const u32x4 w0 = ATT_PACK4(p0, 0), w1 = ATT_PACK4(p0, 8), w2 = ATT_PACK4(p1, 0), w3 = ATT_PACK4(p1, 8);
    pv(o, vb, __builtin_bit_cast(bf16x8, w0), __builtin_bit_cast(bf16x8, w1), __builtin_bit_cast(bf16x8, w2), __builtin_bit_cast(bf16x8, w3));
}
__device__ __forceinline__ void scale_rows(f32x16 (&o)[2], float f, const Ctx& C_) {
    Ctx C = C_; { const int l = fresh(C_.lane); C.r32 = l & 31; C.hi = l >> 5; }
    LAS float* wsf = (LAS float*)(C.lds + A_WSF) + C.wid * 64;
    if (C.hi == 0) wsf[C.r32] = f;
    asm volatile("s_waitcnt lgkmcnt(0)" ::: "memory");
#pragma unroll
    for (int g = 0; g < 4; ++g) { const f32x4 fv = *(const LAS f32x4*)(wsf + 8 * g + 4 * C.hi);
#pragma unroll
        for (int i = 0; i < 4; ++i) { o[0][4 * g + i] *= fv[i]; o[1][4 * g + i] *= fv[i]; } }
    asm volatile("s_waitcnt lgkmcnt(0)" ::: "memory");
}
__device__ __forceinline__ void axpy_rows(f32x16 (&acc)[2], const f32x16 (&o)[2], float f, const Ctx& C_) {
    Ctx C = C_; { const int l = fresh(C_.lane); C.r32 = l & 31; C.hi = l >> 5; }
    LAS float* wsf = (LAS float*)(C.lds + A_WSF) + C.wid * 64;
    if (C.hi == 0) wsf[C.r32] = f;
    asm volatile("s_waitcnt lgkmcnt(0)" ::: "memory");
#pragma unroll
    for (int g = 0; g < 4; ++g) { const f32x4 fv = *(const LAS f32x4*)(wsf + 8 * g + 4 * C.hi);
#pragma unroll
        for (int i = 0; i < 4; ++i) { acc[0][4 * g + i] += o[0][4 * g + i] * fv[i]; acc[1][4 * g + i] += o[1][4 * g + i] * fv[i]; } }
    asm volatile("s_waitcnt lgkmcnt(0)" ::: "memory");
}
struct SM { float m, l; f32x16 o[2]; };
__device__ __forceinline__ void sm_init(SM& s) { s.m = -1e30f; s.l = 0.f; s.o[0] = f32x16{}; s.o[1] = f32x16{}; }
__device__ __forceinline__ void sm_step(SM& s, f32x16& p0, f32x16& p1, int vb, const Ctx& C) {
    const float rm = rowmax(p0, p1);
    if (__any(rm > s.m + THR)) {
        const float mn = fmaxf(s.m, rm); const float f = __builtin_amdgcn_exp2f(s.m - mn);
        s.l *= f; s.m = mn; scale_rows(s.o, f, C);
    }
    float sum = 0.f;
#pragma unroll
    for (int r = 0; r < 16; ++r) { p0[r] = __builtin_amdgcn_exp2f(p0[r] - s.m); p1[r] = __builtin_amdgcn_exp2f(p1[r] - s.m); sum += p0[r] + p1[r]; }
    s.l += sum;
    pv_tile(s.o, vb, p0, p1);
}
template <int NS> __device__ __forceinline__ void dma_tile(const Ctx& C, const bf16_t* Kp, const bf16_t* Vp, long rs, int tile, int stage, int q) {
    const unsigned base = C.lds0 + (unsigned)((stage * 2 + q) * 16384);
    const long k0 = (long)tile * 64; const int lane = fresh(C.lane);
#pragma unroll
    for (int j = 0; j < NS; ++j) {
        const int pw = (NS == 1) ? C.wid : (2 * (C.wid & 3) + j);
        const bf16_t* ks = Kp + (k0 + lane) * rs + pw * 8;
        const bf16_t* vs = Vp + (k0 + 16 * (pw & 3) + (lane >> 2)) * rs + (pw >> 2) * 32 + (lane & 3) * 8;
        glds16(ks, (unsigned)__builtin_amdgcn_readfirstlane(base + pw * 1024));
        glds16(vs, (unsigned)__builtin_amdgcn_readfirstlane(base + 8192 + pw * 1024));
    }
}
template <int NS, class MaskF, class SkipF>
__device__ __forceinline__ void run_pass(const Ctx& C, SM& st, const bf16x8 (&qr)[4], const bf16_t* Kp, const bf16_t* Vp, long rs, int t_lo, int t_hi, int nsteps, MaskF mask, SkipF skip) {
    const int q = (NS == 1) ? 0 : (C.wid >> 2);
    if (t_lo < t_hi) dma_tile<NS>(C, Kp, Vp, rs, t_lo, 0, q);
    for (int step = 0; step < nsteps; ++step) {
        const int tile = t_lo + step; const bool act = tile < t_hi; const bool nact = (step + 1 < nsteps) && (tile + 1 < t_hi);
        if (nact) dma_tile<NS>(C, Kp, Vp, rs, tile + 1, (step + 1) & 1, q);
        if (nact) { if (NS == 1) ATT_WAIT_BAR(2); else ATT_WAIT_BAR(4); } else ATT_WAIT_BAR(0);
        if (act && !skip(tile)) {
            const int sb = ((step & 1) * 2 + q) * 16384;
            const int lv = fresh(C.lane); const int vlane = ((lv >> 4) & 1) * 32 + (lv & 3) * 8 + (4 * (lv >> 5) + ((lv & 15) >> 2)) * 64;
            f32x16 p0, p1; qkt(p0, p1, C.lds + sb, qr, C.r32, C.hi);
            mask(p0, p1, tile);
            sm_step(st, p0, p1, (int)C.lds0 + sb + 8192 + vlane, C);
        }
        ATT_WAIT_BAR(0);
    }
}
__device__ __forceinline__ void store_o(const f32x16 (&o)[2], bf16_t* Ow, long pitch, const Ctx& C_) {
    Ctx C = C_; { const int l = fresh(C_.lane); C.lane = l; C.r32 = l & 31; C.hi = l >> 5; }
    LAS bf16_t* stg = (LAS bf16_t*)(C.lds + A_OST) + C.wid * 2048;
#pragma unroll
    for (int r = 0; r < 16; ++r) { const int orow = crow(r, C.hi);
#pragma unroll
        for (int d0 = 0; d0 < 2; ++d0) stg[orow * 64 + d0 * 32 + C.r32] = (bf16_t)(cvtpk(o[d0][r], 0.f) & 0xffffu); }
    asm volatile("s_waitcnt lgkmcnt(0)" ::: "memory");
#pragma unroll
    for (int i = 0; i < 4; ++i) { const int row = i * 8 + (C.lane >> 3), ch = C.lane & 7; const u32x4 v = *(const LAS u32x4*)(stg + row * 64 + ch * 8); *(u32x4*)(Ow + (long)row * pitch + ch * 8) = v; }
    asm volatile("s_waitcnt lgkmcnt(0)" ::: "memory");
}
__device__ __forceinline__ void load_q(bf16x8 (&qr)[4], const bf16_t* Qrow, int hi) {
#pragma unroll
    for (int d0 = 0; d0 < 4; ++d0) qr[d0] = *(const bf16x8*)(Qrow + d0 * 16 + hi * 8);
}

__device__ __forceinline__ void dil_unit(const Ctx& C, unsigned char* ws, int u, bf16_t* obraw, float* lse) {
    const int gi = u >> 9, v = u & 511, hw = C.wid >> 2, w4 = C.wid & 3;
    const int b = v >> 4, j = (v >> 3) & 1;
    int ds, res, blk, L;
    if (gi == 0) { ds = 1; res = 0; blk = 2 * (v & 7) + hw; L = 2048; }
    else if (gi == 1) { ds = 4; res = (v >> 1) & 3; blk = 2 * (v & 1) + hw; L = 512; }
    else { ds = 16; res = 2 * (v & 7) + hw; blk = 0; L = 128; }
    const int h6 = gi * 2 + j;
    const size_t tokbase = (size_t)b * SEQ + res;
    const bf16_t* Qp = (const bf16_t*)(ws + slot_off(SL_QB + h6)) + tokbase * 64;
    const bf16_t* Kp = (const bf16_t*)(ws + slot_off(SL_KB + h6)) + tokbase * 64;
    const bf16_t* Vp = (const bf16_t*)(ws + slot_off(SL_VB + h6)) + tokbase * 64;
    const long rs = (long)ds * 64;
    int t_lo = 2 * blk - 2; if (t_lo < 0) t_lo = 0; int t_hi = 2 * blk + 2; if (t_hi > L / 64) t_hi = L / 64;
    const int nsteps = (gi == 2) ? 2 : 4;
    const int i0 = 128 * blk + 32 * w4, iq = i0 + C.r32;
    bf16x8 qr[4]; load_q(qr, Qp + (long)iq * rs, C.hi);
    SM st; sm_init(st);
    const int hi = C.hi;
    auto mask = [&](f32x16& p0, f32x16& p1, int tile) {
        const int lim = fresh(iq - 64 * tile - 4 * hi), lim2 = lim - 128;
#pragma unroll
        for (int r = 0; r < 16; ++r) { const int c = (r & 3) + 8 * (r >> 2);
            if (c > lim || c < lim2) p0[r] = NEG_INF;
            if (c + 32 > lim || c + 32 < lim2) p1[r] = NEG_INF; }
    };
    auto skip = [&](int tile) { return (64 * tile > i0 + 31) || (64 * tile + 63 < i0 - 128); };
    run_pass<2>(C, st, qr, Kp, Vp, rs, t_lo, t_hi, nsteps, mask, skip);
    const float lt = halfsum(st.l);
    const float inv = 1.0f / lt;
    scale_rows(st.o, inv, C);
    store_o(st.o, obraw + (tokbase + (size_t)i0 * ds) * 384 + h6 * 64, (long)ds * 384, C);
    if (C.hi == 0) lse[(tokbase + (size_t)iq * ds) * 8 + h6] = (st.m + __builtin_amdgcn_logf(lt)) * 0.6931471805599453f;
    ATT_WAIT_BAR(0);
}

__device__ __forceinline__ void nsa_unit(const Ctx& C, unsigned char* ws, int b, int hk, int blk, bf16_t* oa) {
    const int g = C.wid >> 1, head = hk * 4 + g, hi = C.hi;
    const int tq = 64 * blk + 32 * (C.wid & 1) + C.r32;
    const size_t tokbase = (size_t)b * SEQ;
    bf16x8 qr[4]; load_q(qr, (const bf16_t*)(ws + slot_off(SL_QA + head)) + (tokbase + tq) * 64, hi);
    const bf16_t* ga = (const bf16_t*)(ws + slot_off(SL_GA)) + (tokbase + tq) * 64;
    const float g_cmp = bf2f(ga[head]), g_slc = bf2f(ga[8 + head]), g_win = bf2f(ga[16 + head]);
    f32x16 ot[2]; ot[0] = f32x16{}; ot[1] = f32x16{};
    LAS float* imp = (LAS float*)(C.lds + A_IMP);
    LAS unsigned* sel = (LAS unsigned*)(C.lds + A_SEL);
    {
        const int pair = hk * 32 + b;
        const bf16_t* Kc = (const bf16_t*)(ws + WS_KC) + (size_t)pair * 128 * 64;
        const bf16_t* Vc = (const bf16_t*)(ws + WS_KC + MiB) + (size_t)pair * 128 * 64;
        const bool two = blk >= 16;
        dma_tile<1>(C, Kc, Vc, 64, 0, 0, 0);
        if (two) dma_tile<1>(C, Kc, Vc, 64, 1, 1, 0);
        ATT_WAIT_BAR(0);
        const int nlim = (tq - 31) >> 4;
        auto cmask = [&](f32x16& p0, f32x16& p1, int tile) {
            { const int lim = fresh(nlim - 64 * tile - 4 * hi);
#pragma unroll
              for (int r = 0; r < 16; ++r) { const int c = (r & 3) + 8 * (r >> 2); if (c > lim) p0[r] = NEG_INF; if (c + 32 > lim) p1[r] = NEG_INF; } } };
        float rm;
        { f32x16 s0, s1; qkt(s0, s1, C.lds + 0, qr, C.r32, hi); cmask(s0, s1, 0); rm = rowmax(s0, s1);
          if (two) { qkt(s0, s1, C.lds + 32768, qr, C.r32, hi); cmask(s0, s1, 1); rm = fmaxf(rm, rowmax(s0, s1)); } }
        const bool has = rm > -1e29f; if (!has) rm = 0.f;
        LAS float* irh; { unsigned a_ = (unsigned)(size_t)(imp + (g * 64 + 32 * (C.wid & 1) + C.r32) * 32 + hi); asm volatile("" : "+v"(a_)); irh = (LAS float*)(size_t)a_; }
        float sum = 0.f;
#pragma unroll
        for (int gq = 0; gq < 8; ++gq) irh[16 + 2 * gq] = 0.f;
        asm volatile("s_waitcnt lgkmcnt(0)" ::: "memory");
#pragma unroll
        for (int tile = 0; tile < 2; ++tile) {
            if (tile == 0 || two) {
                f32x16 s0, s1; qkt(s0, s1, C.lds + tile * 32768, qr, C.r32, hi); cmask(s0, s1, tile);
#pragma unroll
                for (int r = 0; r < 16; ++r) { s0[r] = __builtin_amdgcn_exp2f(s0[r] - rm); s1[r] = __builtin_amdgcn_exp2f(s1[r] - rm); sum += s0[r] + s1[r]; }
#pragma unroll
                for (int gq = 0; gq < 4; ++gq) { const float A0 = (s0[4 * gq] + s0[4 * gq + 1]) + (s0[4 * gq + 2] + 0.5f * s0[4 * gq + 3]), A1 = (s1[4 * gq] + s1[4 * gq + 1]) + (s1[4 * gq + 2] + 0.5f * s1[4 * gq + 3]);
                    if (tile == 0) { irh[2 * gq] = A0; irh[8 + 2 * gq] = A1; } else { irh[16 + 2 * gq] += A0; irh[24 + 2 * gq] += A1; } }
                asm volatile("s_waitcnt lgkmcnt(0)" ::: "memory");
#pragma unroll
                for (int gq = 0; gq < 4; ++gq) { const int j0 = 16 * tile + 2 * gq + 1, j1 = j0 + 8;
                    irh[j0] += 0.5f * s0[4 * gq + 3];
                    if (j1 < 31) irh[j1] += 0.5f * s1[4 * gq + 3]; else if (hi == 0) irh[j1] += 0.5f * s1[4 * gq + 3]; }
                asm volatile("s_waitcnt lgkmcnt(0)" ::: "memory");
                { const int lv = fresh(C.lane); const int vlane = ((lv >> 4) & 1) * 32 + (lv & 3) * 8 + (4 * (lv >> 5) + ((lv & 15) >> 2)) * 64;
                  pv_tile(ot, (int)C.lds0 + tile * 32768 + 8192 + vlane, s0, s1); }
            }
        }
        const float lt = halfsum(sum); const float inv = has ? 1.0f / lt : 0.f;
        if (hi == 0) ((LAS float*)(C.lds + A_SEL + 256))[g * 64 + 32 * (C.wid & 1) + C.r32] = inv;
        scale_rows(ot, g_cmp * inv, C);
        ATT_WAIT_BAR(0);
        if (C.wid == 0) {
            const int q = C.lane; unsigned m = 0u; const LAS float* nrm = (const LAS float*)(C.lds + A_SEL + 256);
            m |= 1u; m |= 1u << blk; if (blk >= 1) m |= 1u << (blk - 1);
            int need = 8 - __builtin_popcount(m);
            const int ncand = blk - 2;
            if (ncand > 0) {
                if (ncand <= need) { for (int jb = 1; jb <= blk - 2; ++jb) m |= 1u << jb; }
                else {
                    for (int it = 0; it < need; ++it) { float best = -1.f; int bj = 1;
                        for (int jb = 1; jb <= blk - 2; ++jb) { if (m & (1u << jb)) continue;
                            const float sc = (imp[(0 * 64 + q) * 32 + jb] * nrm[q] + imp[(1 * 64 + q) * 32 + jb] * nrm[64 + q]) + (imp[(2 * 64 + q) * 32 + jb] * nrm[128 + q] + imp[(3 * 64 + q) * 32 + jb] * nrm[192 + q]);
                            if (sc > best) { best = sc; bj = jb; } }
                        m |= 1u << bj; }
                }
            }
            sel[q] = m;
        }
        ATT_WAIT_BAR(0);
    }
    const unsigned mysel = sel[32 * (C.wid & 1) + C.r32];
    {
        const bf16_t* Kp = (const bf16_t*)(ws + slot_off(SL_KSLC + hk)) + tokbase * 64;
        const bf16_t* Vp = (const bf16_t*)(ws + slot_off(SL_VSLC + hk)) + tokbase * 64;
        SM st; sm_init(st);
        auto mask = [&](f32x16& p0, f32x16& p1, int tile) {
            if (!((mysel >> tile) & 1u)) {
#pragma unroll
                for (int r = 0; r < 16; ++r) { p0[r] = NEG_INF; p1[r] = NEG_INF; } }
            else if (tile == blk) { const int lim = fresh(tq - 64 * tile - 4 * hi);
#pragma unroll
                for (int r = 0; r < 16; ++r) { const int c = (r & 3) + 8 * (r >> 2); if (c > lim) p0[r] = NEG_INF; if (c + 32 > lim) p1[r] = NEG_INF; } }
        };
        auto skip = [&](int tile) { return !__any((mysel >> tile) & 1u); };
        run_pass<1>(C, st, qr, Kp, Vp, 64, 0, blk + 1, blk + 1, mask, skip);
        const float lt = halfsum(st.l);
        axpy_rows(ot, st.o, g_slc / lt, C);
    }
    {
        const bf16_t* Kp = (const bf16_t*)(ws + slot_off(SL_KWIN + hk)) + tokbase * 64;
        const bf16_t* Vp = (const bf16_t*)(ws + slot_off(SL_VWIN + hk)) + tokbase * 64;
        SM st; sm_init(st);
        const int t_lo = blk >= 8 ? blk - 8 : 0;
        auto mask = [&](f32x16& p0, f32x16& p1, int tile) {
            if (tile == blk || tile == blk - 8) { const int lim = fresh(tq - 64 * tile - 4 * hi), lim2 = lim - 512;
#pragma unroll
                for (int r = 0; r < 16; ++r) { const int c = (r & 3) + 8 * (r >> 2);
                    if (c > lim || c < lim2) p0[r] = NEG_INF; if (c + 32 > lim || c + 32 < lim2) p1[r] = NEG_INF; } }
        };
        auto skip = [&](int) { return false; };
        run_pass<1>(C, st, qr, Kp, Vp, 64, t_lo, blk + 1, blk + 1 - t_lo, mask, skip);
        const float lt = halfsum(st.l);
        axpy_rows(ot, st.o, g_win / lt, C);
    }
    store_o(ot, oa + (tokbase + 64 * blk + 32 * (C.wid & 1)) * 512 + head * 64, 512, C);
    ATT_WAIT_BAR(0);
}
}
__device__ __forceinline__ void pf4_router(Frame& F, const Args& a) {
    const float* x1 = a.out; const float* g2 = (const float*)a.in[6]; const float* mod = WSP(float, WS_MOD); const float* rowss = WSP(float, WS_ROWSS);
    const float* b_group = (const float*)a.in[22]; const float* b_router = (const float*)a.in[24];
    const bf16_t* rhi = (const bf16_t*)(F.ws + WS_SMALL + 65536); const bf16_t* rlo = (const bf16_t*)(F.ws + WS_SMALL + 196608);
    bf16_t* h2 = WSP(bf16_t, WS_H);
    int* pick_e = (int*)(F.ws + WS_PICK); int* pick_pos = (int*)(F.ws + WS_PICK + 524288); float* pick_w = (float*)(F.ws + WS_PICK + 1048576); int* list = WSP(int, WS_LIST);
    LAS float* lg = (LAS float*)(F.lds) + F.wave * (32 * 40);
    LAS int* lc = (LAS int*)(F.lds + 65536); LAS int* gb = lc + 32;
    const int r32 = F.lane & 31, hi = F.lane >> 5;
    const int NGW = F.G * 8, ntask = NT_TOK / 32, iters = (ntask + NGW - 1) / NGW;
    for (int it = 0; it < iters; ++it) {
        const int task = it * NGW + F.vcu * 8 + F.wave; const bool valid = task < ntask;
        if (F.tid < 32) lc[F.tid] = 0;
        __syncthreads();
        int e1 = 0, e2 = 0, p1 = 0, p2 = 0; float w1 = 0.f, w2 = 0.f; int row = 0;
        if (valid) {
            row = task * 32 + r32; const int b = row >> 11;
            float ss = 0.f; { const f32x4* rp = (const f32x4*)(rowss + (size_t)row * 16); const f32x4 s0 = rp[0], s1 = rp[1], s2 = rp[2], s3 = rp[3];
                ss = ((s0[0] + s0[1]) + (s0[2] + s0[3])) + ((s1[0] + s1[1]) + (s1[2] + s1[3])) + ((s2[0] + s2[1]) + (s2[2] + s2[3])) + ((s3[0] + s3[1]) + (s3[2] + s3[3])); }
            const float rstd = 1.0f / sqrtf(ss * (1.f / DM) + EPS);
            const float* xr = x1 + (size_t)row * DM + 8 * hi; const float* gp = g2 + 8 * hi; const float* scp = mod + (size_t)b * 6144 + 4096 + 8 * hi; const float* shp = mod + (size_t)b * 6144 + 3072 + 8 * hi;
            bf16_t* hp = h2 + (size_t)row * DM + 8 * hi;
            const bf16_t* wh0 = rhi + (size_t)r32 * 1024 + 8 * hi; const bf16_t* wl0 = rlo + (size_t)r32 * 1024 + 8 * hi;
            f32x16 acc0 = {}, acc1 = {};
#pragma unroll 2
            for (int s = 0; s < 64; ++s) {
                const f32x4 xa = *(const f32x4*)(xr + 16 * s), xb = *(const f32x4*)(xr + 16 * s + 4);
                const f32x4 ga = *(const f32x4*)(gp + 16 * s), gbv = *(const f32x4*)(gp + 16 * s + 4);
                const f32x4 sa = *(const f32x4*)(scp + 16 * s), sb = *(const f32x4*)(scp + 16 * s + 4);
                const f32x4 ha = *(const f32x4*)(shp + 16 * s), hb = *(const f32x4*)(shp + 16 * s + 4);
                const f32x4 va = (xa * rstd) * ga * (sa + 1.0f) + ha, vb = (xb * rstd) * gbv * (sb + 1.0f) + hb;
                u32x4 whi; whi.x = cvtpk(va[0], va[1]); whi.y = cvtpk(va[2], va[3]); whi.z = cvtpk(vb[0], vb[1]); whi.w = cvtpk(vb[2], vb[3]);
                *(u32x4*)(hp + 16 * s) = whi;
                u32x4 wlo; wlo.x = cvtpk(va[0] - bflo(whi.x), va[1] - bfhi(whi.x)); wlo.y = cvtpk(va[2] - bflo(whi.y), va[3] - bfhi(whi.y));
                wlo.z = cvtpk(vb[0] - bflo(whi.z), vb[1] - bfhi(whi.z)); wlo.w = cvtpk(vb[2] - bflo(whi.w), vb[3] - bfhi(whi.w));
                const bf16x8 Bh = __builtin_bit_cast(bf16x8, whi), Bl = __builtin_bit_cast(bf16x8, wlo);
                const bf16x8 Ah0 = *(const bf16x8*)(wh0 + 16 * s), Al0 = *(const bf16x8*)(wl0 + 16 * s);
                const bf16x8 Ah1 = *(const bf16x8*)(wh0 + 32 * 1024 + 16 * s), Al1 = *(const bf16x8*)(wl0 + 32 * 1024 + 16 * s);
                acc0 = __builtin_amdgcn_mfma_f32_32x32x16_bf16(Ah0, Bh, acc0, 0, 0, 0); acc0 = __builtin_amdgcn_mfma_f32_32x32x16_bf16(Ah0, Bl, acc0, 0, 0, 0); acc0 = __builtin_amdgcn_mfma_f32_32x32x16_bf16(Al0, Bh, acc0, 0, 0, 0);
                acc1 = __builtin_amdgcn_mfma_f32_32x32x16_bf16(Ah1, Bh, acc1, 0, 0, 0); acc1 = __builtin_amdgcn_mfma_f32_32x32x16_bf16(Ah1, Bl, acc1, 0, 0, 0); acc1 = __builtin_amdgcn_mfma_f32_32x32x16_bf16(Al1, Bh, acc1, 0, 0, 0);
            }
            LAS float* lr = lg + r32 * 40;
#pragma unroll
            for (int gq = 0; gq < 4; ++gq) *(LAS f32x4*)(lr + 8 * gq + 4 * hi) = (f32x4){acc0[4 * gq], acc0[4 * gq + 1], acc0[4 * gq + 2], acc0[4 * gq + 3]};
            if (hi == 0) *(LAS f32x4*)(lr + 32) = (f32x4){acc1[0], acc1[1], acc1[2], acc1[3]};
            asm volatile("s_waitcnt lgkmcnt(0)" ::: "memory");
            if (hi == 0) {
                float gl[4];
#pragma unroll
                for (int i = 0; i < 4; ++i) gl[i] = lr[i] + b_group[i];
                int gi = 0; float gm = gl[0];
#pragma unroll
                for (int i = 1; i < 4; ++i) if (gl[i] > gm) { gm = gl[i]; gi = i; }
                float gsum = 0.f;
#pragma unroll
                for (int i = 0; i < 4; ++i) gsum += __expf(gl[i] - gm);
                const float gw = 1.0f / gsum;
                float el[8];
#pragma unroll
                for (int i = 0; i < 8; ++i) el[i] = lr[4 + 8 * gi + i] + b_router[gi * 8 + i];
                int i1 = 0; float v1 = el[0];
#pragma unroll
                for (int i = 1; i < 8; ++i) if (el[i] > v1) { v1 = el[i]; i1 = i; }
                int i2 = -1; float v2 = -INFINITY;
#pragma unroll
                for (int i = 0; i < 8; ++i) if (i != i1 && el[i] > v2) { v2 = el[i]; i2 = i; }
                const float pa = 1.0f / (1.0f + __expf(v2 - v1));
                w1 = gw * pa; w2 = gw * (1.0f - pa); e1 = gi * 8 + i1; e2 = gi * 8 + i2;
                p1 = __hip_atomic_fetch_add((int*)(lc + e1), 1, __ATOMIC_RELAXED, __HIP_MEMORY_SCOPE_WORKGROUP);
                p2 = __hip_atomic_fetch_add((int*)(lc + e2), 1, __ATOMIC_RELAXED, __HIP_MEMORY_SCOPE_WORKGROUP);
            }
        }
        __syncthreads();
        if (F.tid < 32) { const int c = lc[F.tid]; gb[F.tid] = c ? (int)__hip_atomic_fetch_add(F.ctl + CW_CNT + 64 * F.tid, (unsigned)c, RLX_AGENT) : 0; }
        __syncthreads();
        if (valid && hi == 0) {
            p1 += gb[e1]; p2 += gb[e2];
            pick_e[row * 2] = e1; pick_e[row * 2 + 1] = e2; pick_pos[row * 2] = p1; pick_pos[row * 2 + 1] = p2; pick_w[row * 2] = w1; pick_w[row * 2 + 1] = w2;
            list[(size_t)e1 * NT_TOK + p1] = row; list[(size_t)e2 * NT_TOK + p2] = row;
        }
        __syncthreads();
    }
}

__device__ __forceinline__ void moe_tables(Frame& F) {
    LAS int* cnt = (LAS int*)(F.lds + LDS_EXP); LAS int* pre = cnt + 32;
    if (F.tid < 32) cnt[F.tid] = (int)__hip_atomic_load(F.ctl + CW_CNT + 64 * F.tid, RLX_AGENT);
    __syncthreads();
    if (F.tid == 0) { int s = 0; for (int e = 0; e < 32; ++e) { pre[e] = s; s += (cnt[e] + 255) >> 8; } pre[32] = s; }
    __syncthreads();
}
namespace pg8 {
struct MoeSched {
    const char* A; const char* Bt; int lda, ldb; size_t bstride; bool gather; LAS unsigned char* lds; int G, c;
    __device__ __forceinline__ bool next(int i, Unit& u) const {
        const LAS int* pre = (const LAS int*)(lds + LDS_EXP) + 32;
        const int L = i * G + c; if (L >= 4 * pre[32]) return false;
        const int mtg = L >> 2; int e = 0;
#pragma unroll 1
        for (int k = 1; k < 32; ++k) if (pre[k] <= mtg) e = k;
        u.pm = mtg; u.pn = L & 3; u.e = e; u.mt = mtg - pre[e]; return true;
    }
    __device__ __forceinline__ const char* a_base(const Unit& u) const { return gather ? A : A + (size_t)u.pm * BM * lda * 2; }
    __device__ __forceinline__ unsigned a_voff(const Unit&, int ui, int h, int R, int C) const {
        if (gather) { const int tok = ((const LAS int*)(lds + LDS_TOK))[ui * 256 + h * HALF + R]; return (unsigned)(tok * lda + C) * 2u; }
        return (unsigned)((h * HALF + R) * lda + C) * 2u; }
    __device__ __forceinline__ const char* b_base(const Unit& u) const { return Bt + (size_t)u.e * bstride + (size_t)u.pn * BM * ldb * 2; }
};
struct GuEpi {
    static constexpr bool PERM = true;
    bf16_t* hid;
    __device__ __forceinline__ void operator()(const f32x4 (&acc)[2][2][4][2], const Unit& u, int, int wr, int wc, int fr, int fq) const {
        const int row0 = u.pm * BM + wr * 64 + fr, col = u.pn * HALF + wc * 32 + 8 * fq;
#pragma unroll
        for (int ai = 0; ai < 2; ++ai)
#pragma unroll
            for (int m = 0; m < 4; ++m) {
                f32x4 v0, v1;
#pragma unroll
                for (int i = 0; i < 4; ++i) { v0[i] = siluf_(acc[ai][0][m][0][i]) * acc[ai][1][m][0][i]; v1[i] = siluf_(acc[ai][0][m][1][i]) * acc[ai][1][m][1][i]; }
                u32x4 w; w.x = cvtpk(v0[0], v0[1]); w.y = cvtpk(v0[2], v0[3]); w.z = cvtpk(v1[0], v1[1]); w.w = cvtpk(v1[2], v1[3]);
                *(u32x4*)(hid + (size_t)(row0 + ai * HALF + m * 16) * EFF + col) = w;
            }
    }
};
struct YEpi {
    static constexpr bool PERM = true;
    bf16_t* Y;
    __device__ __forceinline__ void operator()(const f32x4 (&acc)[2][2][4][2], const Unit& u, int, int wr, int wc, int fr, int fq) const {
        const int row0 = u.pm * BM + wr * 64 + fr, col0 = u.pn * BM + wc * 32 + 8 * fq;
#pragma unroll
        for (int ai = 0; ai < 2; ++ai)
#pragma unroll
            for (int m = 0; m < 4; ++m)
#pragma unroll
                for (int bj = 0; bj < 2; ++bj) { const f32x4 v0 = acc[ai][bj][m][0], v1 = acc[ai][bj][m][1];
                    u32x4 w; w.x = cvtpk(v0[0], v0[1]); w.y = cvtpk(v0[2], v0[3]); w.z = cvtpk(v1[0], v1[1]); w.w = cvtpk(v1[2], v1[3]);
                    *(u32x4*)(Y + (size_t)(row0 + ai * HALF + m * 16) * DM + col0 + bj * HALF) = w; }
    }
};
}

__device__ __forceinline__ void moe_fill_tokens(Frame& F, const pg8::MoeSched& S) {
    const LAS int* cnt = (const LAS int*)(F.lds + LDS_EXP); LAS int* tokt = (LAS int*)(F.lds + LDS_TOK); const int* list = WSP(int, WS_LIST);
    pg8::Unit u;
    for (int i = 0; i < 12 && S.next(i, u); ++i) {
        if (F.tid < 256) { const int idx = u.mt * 256 + F.tid; tokt[i * 256 + F.tid] = list[(size_t)u.e * NT_TOK + (idx < cnt[u.e] ? idx : 0)]; }
    }
    __syncthreads();
}

__device__ __forceinline__ void pi_combine(Frame& F, const Args& a) {
    const LAS int* pre = (const LAS int*)(F.lds + LDS_EXP) + 32;
    const int* pick_e = (const int*)(F.ws + WS_PICK); const int* pick_pos = (const int*)(F.ws + WS_PICK + 524288); const float* pick_w = (const float*)(F.ws + WS_PICK + 1048576);
    const bf16_t* Y = WSP(bf16_t, WS_R1); const float* mod = WSP(float, WS_MOD); float* out = a.out;
    const int gw = F.vcu * 8 + F.wave, NGW = F.G * 8;
    for (int m = gw; m < NT_TOK; m += NGW) {
        const int b = m >> 11;
        const int e0 = pick_e[2 * m], e1 = pick_e[2 * m + 1]; const float w0 = pick_w[2 * m], w1 = pick_w[2 * m + 1];
        const size_t s0 = (size_t)pre[e0] * 256 + pick_pos[2 * m], s1 = (size_t)pre[e1] * 256 + pick_pos[2 * m + 1];
        const u32x2* y0 = (const u32x2*)(Y + s0 * DM) + F.lane; const u32x2* y1 = (const u32x2*)(Y + s1 * DM) + F.lane;
        f32x4* xr = (f32x4*)(out + (size_t)m * DM) + F.lane; const f32x4* gt = (const f32x4*)(mod + (size_t)b * 6144 + 5120) + F.lane;
#pragma unroll
        for (int j = 0; j < 4; ++j) { const u32x2 a0 = y0[64 * j], a1 = y1[64 * j]; const f32x4 g = gt[64 * j]; f32x4 x = xr[64 * j];
            x[0] += g[0] * (w0 * bflo(a0.x) + w1 * bflo(a1.x)); x[1] += g[1] * (w0 * bfhi(a0.x) + w1 * bfhi(a1.x));
            x[2] += g[2] * (w0 * bflo(a0.y) + w1 * bflo(a1.y)); x[3] += g[3] * (w0 * bfhi(a0.y) + w1 * bfhi(a1.y)); xr[64 * j] = x; }
    }
}
#ifndef MK_MODE
#define MK_MODE 1
#endif
constexpr int NPHASE = 12;

__device__ __forceinline__ void pd_compress_stage2(Frame& F, const Args& a, int pm) {
    const int r32 = F.lane & 31, hi = F.lane >> 5, kv = pm >= 32 ? 1 : 0;
    const bf16_t* w2t = WSP(bf16_t, WS_CW2) + (size_t)kv * 64 * 256;
    const int rowg = 256 * pm + 32 * F.wave + r32;
    const bf16_t* hp = WSP(bf16_t, WS_CHID) + (size_t)rowg * 256 + 8 * hi;
    f32x16 acc0 = {}, acc1 = {};
#pragma unroll 4
    for (int s = 0; s < 16; ++s) {
        const bf16x8 B = *(const bf16x8*)(hp + 16 * s);
        const bf16x8 A0 = *(const bf16x8*)(w2t + (size_t)r32 * 256 + 16 * s + 8 * hi), A1 = *(const bf16x8*)(w2t + (size_t)(32 + r32) * 256 + 16 * s + 8 * hi);
        acc0 = __builtin_amdgcn_mfma_f32_32x32x16_bf16(A0, B, acc0, 0, 0, 0); acc1 = __builtin_amdgcn_mfma_f32_32x32x16_bf16(A1, B, acc1, 0, 0, 0);
    }
    const int mrow = rowg & 8191;
    bf16_t* dst = (bf16_t*)(F.ws + WS_KC + (kv ? MiB : 0)) + (size_t)mrow * 64;
    if (kv == 0) {
        float ss = 0.f;
#pragma unroll
        for (int r = 0; r < 16; ++r) ss += acc0[r] * acc0[r] + acc1[r] * acc1[r];
        ss = att::halfsum(ss);
        const float rstd = 1.0f / sqrtf(ss * (1.f / 64.f) + EPS);
        const float* nk = (const float*)a.in[9];
        const int b = (mrow >> 7) & 31, n = mrow & 127;
        const float* cc = WSP(float, WS_CROPE) + ((size_t)b * 128 + n) * 32; const float* sn = cc + 32 * 128 * 32;
#pragma unroll
        for (int gq = 0; gq < 4; ++gq) { const int d = 8 * gq + 4 * hi;
            const f32x4 g1 = *(const f32x4*)(nk + d), g2 = *(const f32x4*)(nk + 32 + d), c4 = *(const f32x4*)(cc + d), s4 = *(const f32x4*)(sn + d);
            f32x4 x1, x2;
#pragma unroll
            for (int i = 0; i < 4; ++i) { x1[i] = acc0[4 * gq + i] * rstd * g1[i]; x2[i] = acc1[4 * gq + i] * rstd * g2[i]; }
            const f32x4 o1 = x1 * c4 - x2 * s4, o2 = x1 * s4 + x2 * c4;
            u32x2 w1, w2; w1.x = cvtpk(o1[0], o1[1]); w1.y = cvtpk(o1[2], o1[3]); w2.x = cvtpk(o2[0], o2[1]); w2.y = cvtpk(o2[2], o2[3]);
            *(u32x2*)(dst + d) = w1; *(u32x2*)(dst + 32 + d) = w2; }
    } else {
#pragma unroll
        for (int gq = 0; gq < 4; ++gq) { const int d = 8 * gq + 4 * hi;
            u32x2 w1, w2; w1.x = cvtpk(acc0[4 * gq], acc0[4 * gq + 1]); w1.y = cvtpk(acc0[4 * gq + 2], acc0[4 * gq + 3]); w2.x = cvtpk(acc1[4 * gq], acc1[4 * gq + 1]); w2.y = cvtpk(acc1[4 * gq + 2], acc1[4 * gq + 3]);
            *(u32x2*)(dst + d) = w1; *(u32x2*)(dst + 32 + d) = w2; }
    }
}

__device__ __forceinline__ void pf1_scale_ob(Frame& F) {
    const float* lse = WSP(float, WS_LSE); const unsigned* src = (const unsigned*)(F.ws + WS_H + 64 * MiB); unsigned* dst = (unsigned*)(F.ws + WS_R1);
    const int gw = F.vcu * 8 + F.wave, NGW = F.G * 8, j = F.lane >> 5;
    for (int m = gw; m < NT_TOK; m += NGW) {
        const float l0 = lse[(size_t)m * 8 + j], l1 = lse[(size_t)m * 8 + 2 + j], l2 = lse[(size_t)m * 8 + 4 + j];
        const float mx = fmaxf(l0, fmaxf(l1, l2)); const float e0 = __expf(l0 - mx), e1 = __expf(l1 - mx), e2 = __expf(l2 - mx); const float inv = 1.0f / (e0 + e1 + e2);
        const float al[3] = {e0 * inv, e1 * inv, e2 * inv};
#pragma unroll
        for (int gi = 0; gi < 3; ++gi) { const unsigned w = src[(size_t)m * 192 + gi * 64 + F.lane]; dst[(size_t)m * 192 + gi * 64 + F.lane] = cvtpk(bflo(w) * al[gi], bfhi(w) * al[gi]); }
    }
}

__global__ void __launch_bounds__(512, 2) mk_fwd(Args args) {
    extern __shared__ __attribute__((aligned(16))) unsigned char lds_raw[];
    Frame F;
    F.lds = (LAS unsigned char*)lds_raw;
    F.MISC = (volatile LAS unsigned*)(F.lds + LDS_MISC);
    F.tid = threadIdx.x; F.lane = F.tid & 63; F.wave = __builtin_amdgcn_readfirstlane(F.tid >> 6);
    F.G = gridDim.x; { const int bx = blockIdx.x; F.vcu = (F.G % 8 == 0) ? (bx % 8) * (F.G / 8) + bx / 8 : bx; }
    F.ws = args.ws; F.ctl = (unsigned*)(args.ws + WS_CTL);
    if (F.tid < 64) ((LAS unsigned*)(F.lds + LDS_MISC))[F.tid] = 0u;
    __syncthreads();
#if MK_MODE == 1
    cg::grid_group grid = cg::this_grid();
#define GRID_BAR() grid.sync()
#elif MK_MODE == 2
    XcdBarrier bar = xcd_barrier_post(F.ctl + CW_BAR, F.MISC + 8);
#define GRID_BAR() xcd_barrier(bar)
#else
#define GRID_BAR() do {} while (0)
#endif
    const int lo = args.ph_lo, hi = args.ph_hi;
#ifndef PH_MASK
#define PH_MASK 0xfff
#endif
#define IN(k) (((PH_MASK >> (k)) & 1) && lo <= (k) && (k) < hi)
#define SEAM(k) do { if (IN(k) && IN((k) + 1)) GRID_BAR(); } while (0)

    if (IN(0)) { pa_prologue(F, args); } SEAM(0);
    if (IN(1)) { pb_modnorm(F, (const float*)args.in[0], (const float*)args.in[5], WSP(float, WS_MOD), 0, 1024, WSP(bf16_t, WS_H)); } SEAM(1);
    if (IN(2)) {
        pg8::DenseSched S; S.init(WSP(bf16_t, WS_H), 1024, WSP(bf16_t, WS_WIN), 1024, NT_TOK, NPROJ, F.G, (int)blockIdx.x);
        pg8::ProjEpi E{F.ws, WSP(float, WS_ROPE), WSP(float, WS_ROPE) + (size_t)NT_TOK * 32, (const float*)args.in[8], (const float*)args.in[9], (const float*)args.in[16], (const float*)args.in[17]};
        pg8::gemm_phase<pg8::ProjEpi, pg8::DenseSched>(F.lds, 1024, S, E);
    } SEAM(2);
    if (IN(3)) {
        const int ncw = F.G >= 128 ? 64 : (F.G > 1 ? F.G / 2 : 1);
        if ((int)blockIdx.x < ncw) {
            pg8::CmpSched S{(const char*)(F.ws + slot_off(SL_KCMP)), (const char*)(F.ws + WS_CW1), 2048, ncw, (int)blockIdx.x};
            pg8::CmpEpi E{WSP(float, WS_SMALL), WSP(bf16_t, WS_CHID)};
            pg8::gemm_phase<pg8::CmpEpi, pg8::CmpSched>(F.lds, 2048, S, E);
            VM_WAIT(); __syncthreads();
            pg8::Unit u; for (int i = 0; S.next(i, u); ++i) pd_compress_stage2(F, args, u.pm);
        }
        if ((int)blockIdx.x >= ncw || F.G == 1) {
            att::Ctx C; C.lds = F.lds; C.lane = F.lane; C.r32 = F.lane & 31; C.hi = F.lane >> 5; C.wid = F.wave; C.lds0 = (unsigned)(size_t)F.lds;
            const int nd = F.G == 1 ? 1 : F.G - ncw, c = F.G == 1 ? 0 : (int)blockIdx.x - ncw;
            for (int u = c; u < 1536; u += nd) att::dil_unit(C, F.ws, u, (bf16_t*)(F.ws + WS_H + 64 * MiB), WSP(float, WS_LSE));
        }
    } SEAM(3);
    if (IN(4)) {
        att::Ctx C; C.lds = F.lds; C.lane = F.lane; C.r32 = F.lane & 31; C.hi = F.lane >> 5; C.wid = F.wave; C.lds0 = (unsigned)(size_t)F.lds;
        for (int v = F.vcu; v < 256; v += F.G) {
            const int bh = v >> 2, k = v & 3, b = bh >> 1, hk = bh & 1;
            for (int i = 0; i < 8; ++i) { const int blk = (i & 1) ? (8 * (i >> 1) + 7 - k) : (8 * (i >> 1) + k); att::nsa_unit(C, F.ws, b, hk, 31 - blk, WSP(bf16_t, WS_H)); }
        }
    } SEAM(4);
    if (IN(5)) {
        pf1_scale_ob(F);
        pg8::DenseSched S; S.init(WSP(bf16_t, WS_H), 512, WSP(bf16_t, WS_WUPA), 512, NT_TOK, DM, F.G, (int)blockIdx.x);
        pg8::UpEpi<false> E{F.ws, WSP(bf16_t, WS_Y), SL_GMA};
        pg8::gemm_phase<pg8::UpEpi<false>, pg8::DenseSched>(F.lds, 512, S, E);
    } SEAM(5);
    if (IN(6)) {
        pg8::DenseSched S; S.init(WSP(bf16_t, WS_R1), 384, WSP(bf16_t, WS_WUPB), 384, NT_TOK, DM, F.G, (int)blockIdx.x);
        pg8::UpEpi<true> E{F.ws, WSP(bf16_t, WS_Y), SL_GMB};
        pg8::gemm_phase<pg8::UpEpi<true>, pg8::DenseSched>(F.lds, 384, S, E);
    } SEAM(6);
    if (IN(7)) {
        pg8::DenseSched S; S.init(WSP(bf16_t, WS_Y), 1024, WSP(bf16_t, WS_WOUT), 1024, NT_TOK, DM, F.G, (int)blockIdx.x);
        pg8::OutEpi E{(const float*)args.in[0], args.out, WSP(float, WS_MOD), WSP(float, WS_ROWSS)};
        pg8::gemm_phase<pg8::OutEpi, pg8::DenseSched>(F.lds, 1024, S, E);
    } SEAM(7);
    if (IN(8)) { pf4_router(F, args); } SEAM(8);
    if (IN(9)) {
        moe_tables(F);
        pg8::MoeSched S{(const char*)(F.ws + WS_H), (const char*)(F.ws + WS_WGU), 1024, 1024, (size_t)1024 * 1024 * 2, true, F.lds, F.G, F.vcu};
        moe_fill_tokens(F, S);
        pg8::GuEpi E{WSP(bf16_t, WS_R2)};
        pg8::gemm_phase<pg8::GuEpi, pg8::MoeSched>(F.lds, 1024, S, E);
    } SEAM(9);
    if (IN(10)) {
        moe_tables(F);
        pg8::MoeSched S{(const char*)(F.ws + WS_R2), (const char*)(F.ws + WS_WD), 512, 512, (size_t)1024 * 512 * 2, false, F.lds, F.G, F.vcu};
        pg8::YEpi E{WSP(bf16_t, WS_R1)};
        pg8::gemm_phase<pg8::YEpi, pg8::MoeSched>(F.lds, 512, S, E);
    } SEAM(10);
    if (IN(11)) { moe_tables(F); pi_combine(F, args); }
#undef IN
#undef SEAM
}

extern "C" void kernel_launch(void* const* d_in, const int* in_sizes, int n_in, void* d_out, int out_size, void* d_ws, size_t ws_size, hipStream_t stream) {
    static int grid = 0;
    if (grid == 0) {
        if (n_in != 28 || in_sizes[0] != NT_TOK * DM || out_size != NT_TOK * DM || ws_size < WS_END) {
            fprintf(stderr, "kernel_launch: shape/workspace mismatch (n_in %d, in0 %d, out %d, ws %zu, need %zu)\n", n_in, n_in > 0 ? in_sizes[0] : -1, out_size, ws_size, (size_t)WS_END); grid = -1; return; }
        int dev = 0, cus = 0, per_cu = 0;
        hipGetDevice(&dev); hipDeviceGetAttribute(&cus, hipDeviceAttributeMultiprocessorCount, dev);
        if (hipFuncSetAttribute((const void*)mk_fwd, hipFuncAttributeMaxDynamicSharedMemorySize, LDS_BYTES) != hipSuccess) { fprintf(stderr, "kernel_launch: hipFuncSetAttribute failed\n"); grid = -1; return; }
        if (hipOccupancyMaxActiveBlocksPerMultiprocessor(&per_cu, (const void*)mk_fwd, 512, LDS_BYTES) != hipSuccess || per_cu < 1) { fprintf(stderr, "kernel_launch: occupancy query says %d blocks per CU\n", per_cu); per_cu = 1; }
        (void)hipGetLastError();
        grid = cus;
        fprintf(stderr, "kernel_launch: %d CUs, occupancy %d, grid %d\n", cus, per_cu, grid);
    }
    if (grid < 0) return;
    hipMemsetAsync((char*)d_ws + WS_CTL, 0, CTL_ZERO_BYTES, stream);
    Args a{};
    for (int i = 0; i < 28; ++i) a.in[i] = d_in[i];
    a.out = (float*)d_out; a.ws = (unsigned char*)d_ws;
#if MK_MODE == 0
    for (int p = 0; p < NPHASE; ++p) { a.ph_lo = p; a.ph_hi = p + 1; hipLaunchKernelGGL(mk_fwd, dim3(grid), dim3(512), LDS_BYTES, stream, a); }
#elif MK_MODE == 1
    a.ph_lo = 0; a.ph_hi = NPHASE;
    void* kargs[] = {&a};
    hipError_t e = hipLaunchCooperativeKernel((const void*)mk_fwd, dim3(grid), dim3(512), kargs, LDS_BYTES, stream);
    if (e != hipSuccess) fprintf(stderr, "cooperative launch failed: %s (grid %d)\n", hipGetErrorString(e), grid);
#else
    a.ph_lo = 0; a.ph_hi = NPHASE;
    hipLaunchKernelGGL(mk_fwd, dim3(grid), dim3(512), LDS_BYTES, stream, a);
#endif
}
```

```cpp
#include <hip/hip_runtime.h>
#include <hip/hip_cooperative_groups.h>
#include <cstdio>
#include <cstdint>
#include <cmath>
namespace cg = cooperative_groups;

#define LAS __attribute__((address_space(3)))
#define GAS __attribute__((address_space(1)))
typedef unsigned short bf16_t;
typedef short bf16x8 __attribute__((ext_vector_type(8)));
typedef short s16x4 __attribute__((ext_vector_type(4)));
typedef float f32x2 __attribute__((ext_vector_type(2)));
typedef float f32x4 __attribute__((ext_vector_type(4)));
typedef float f32x16 __attribute__((ext_vector_type(16)));
typedef unsigned u32x2 __attribute__((ext_vector_type(2)));
typedef unsigned u32x4 __attribute__((ext_vector_type(4)));
typedef __bf16 bf16x2_t __attribute__((ext_vector_type(2)));

constexpr int NB = 32, SEQ = 2048, NT_TOK = NB * SEQ, DM = 1024;
constexpr int IN_COLS = 4504, NSLOT = 72, NPROJ = NSLOT * 64;
constexpr int NEXP = 32, EFF = 512;
constexpr float EPS = 1e-6f;
constexpr float C2 = 0.125f * 1.4426950408889634f;
constexpr int SL_QA = 0, SL_KCMP = 8, SL_VCMP = 10, SL_KSLC = 12, SL_VSLC = 14, SL_KWIN = 16, SL_VWIN = 18, SL_QB = 20, SL_KB = 26, SL_VB = 32, SL_GMA = 38, SL_GMB = 54, SL_GA = 70;

constexpr size_t MiB = 1u << 20;
constexpr size_t WS_CTL = 0, CTL_ZERO_BYTES = 256 * 1024;
constexpr size_t WS_MOD = 1 * MiB;
constexpr size_t WS_SMALL = 2 * MiB;
constexpr size_t WS_ROPE = 3 * MiB;
constexpr size_t WS_CROPE = 19 * MiB;
constexpr size_t WS_WIN = 20 * MiB;
constexpr size_t WS_WUPA = 29 * MiB;
constexpr size_t WS_WUPB = 30 * MiB;
constexpr size_t WS_WOUT = 31 * MiB;
constexpr size_t WS_CW1 = 33 * MiB;
constexpr size_t WS_CW2 = 35 * MiB;
constexpr size_t WS_WGU = 36 * MiB;
constexpr size_t WS_WD = 100 * MiB;
constexpr size_t WS_KC = 132 * MiB;
constexpr size_t WS_CHID = 134 * MiB;
constexpr size_t WS_LSE = 142 * MiB;
constexpr size_t WS_ROWSS = 144 * MiB;
constexpr size_t WS_PICK = 148 * MiB;
constexpr size_t WS_LIST = 150 * MiB;
constexpr size_t WS_H = 160 * MiB;
constexpr size_t WS_Y = 288 * MiB;
constexpr size_t WS_R1 = 416 * MiB;
constexpr size_t WS_R2 = 720 * MiB;
constexpr size_t WS_END = 992 * MiB;
constexpr size_t SLOT_BYTES = (size_t)NT_TOK * 64 * 2;
__host__ __device__ __forceinline__ size_t slot_off(int s) { return s < 38 ? WS_R1 + (size_t)s * SLOT_BYTES : WS_R2 + (size_t)(s - 38) * SLOT_BYTES; }
constexpr int CW_BAR = 4096;
constexpr int CW_CNT = 16384;

constexpr int LDS_BYTES = 163840;
constexpr int LDS_STAGE = 0;
constexpr int LDS_X = 131072;
constexpr int LDS_MISC = LDS_BYTES - 256;
constexpr int LDS_TOK = 135168;
constexpr int LDS_EXP = 147456;

#define RLX_AGENT __ATOMIC_RELAXED, __HIP_MEMORY_SCOPE_AGENT
#define LDS_WAIT() asm volatile("s_waitcnt lgkmcnt(0)" ::: "memory")
#define VM_WAIT() asm volatile("s_waitcnt vmcnt(0)" ::: "memory")
__device__ __forceinline__ unsigned cvtpk(float lo, float hi) { f32x2 v = {lo, hi}; bf16x2_t b = __builtin_convertvector(v, bf16x2_t); return __builtin_bit_cast(unsigned, b); }
__device__ __forceinline__ float bf2f(unsigned short h) { return __uint_as_float(((unsigned)h) << 16); }
__device__ __forceinline__ float bflo(unsigned w) { return __uint_as_float(w << 16); }
__device__ __forceinline__ float bfhi(unsigned w) { return __uint_as_float(w & 0xffff0000u); }
__device__ __forceinline__ float wave_sum(float v) {
#pragma unroll
    for (int o = 1; o < 64; o <<= 1) v += __shfl_xor(v, o);
    return v;
}
__device__ __forceinline__ float sigmoidf_(float x) { return 1.0f / (1.0f + __expf(-x)); }
__device__ __forceinline__ float siluf_(float x) { return x / (1.0f + __expf(-x)); }
__host__ __device__ __forceinline__ int slot_col0(int H) { return H < 8 ? 64 * H : H < 20 ? 512 + 64 * (H - 8) : H < 38 ? 1304 + 64 * (H - 20) : H < 70 ? 2456 + 64 * (H - 38) : H == 70 ? 1280 : 0; }
__host__ __device__ __forceinline__ int slot_valid(int H) { return H < 70 ? 64 : H == 70 ? 24 : 0; }

#define XB_TMO      128
#define XB_XCNT(j)  (256  + 64 * (j))
#define XB_XSUB(j)  (1280 + 64 * (j))
#define XB_XGEN(j)  (2304 + 64 * (j))
#define XB_TOP      3328
#define XB_TOPGEN   3392
#define XCD_BAR_WORDS 3456
#define XB_SPIN_CAP (1u << 22)
__device__ __forceinline__ unsigned xb_ld(unsigned* p)              { return __hip_atomic_load(p, __ATOMIC_RELAXED, __HIP_MEMORY_SCOPE_AGENT); }
__device__ __forceinline__ unsigned xb_add(unsigned* p, unsigned v) { return __hip_atomic_fetch_add(p, v, __ATOMIC_RELAXED, __HIP_MEMORY_SCOPE_AGENT); }
__device__ __forceinline__ unsigned xb_xcc_id() { return (unsigned)__builtin_amdgcn_s_getreg((3 << 11) | 20) & 0xFu; }
#define XB_SPIN(cond, bar) do { unsigned _sp = 0; while (cond) { __builtin_amdgcn_s_sleep(1); \
    if ((++_sp & 255u) == 0u) { if (xb_ld(&(bar)[XB_TMO])) break; if (_sp > XB_SPIN_CAP) { atomicAdd(&(bar)[XB_TMO], 1u); break; } } } } while (0)
struct XcdBarrier { unsigned* bar; unsigned x; volatile LAS unsigned* st; };
__device__ __forceinline__ XcdBarrier xcd_barrier_post(unsigned* bar, volatile LAS unsigned* st) {
    XcdBarrier b; b.bar = bar; b.x = xb_xcc_id(); b.st = st;
    if (threadIdx.x == 0) (void)xb_add(&bar[XB_XCNT(b.x)], 1u);
    return b;
}
__device__ __forceinline__ void xcd_barrier_complete(unsigned* bar, unsigned x, unsigned& nloc, unsigned& nx) {
    const unsigned G = gridDim.x * gridDim.y * gridDim.z;
    unsigned sum, cnt, mine, sp = 0u;
    for (;;) {
        sum = 0u; cnt = 0u; mine = 0u;
#pragma unroll
        for (unsigned j = 0; j < 16; ++j) { const unsigned c = xb_ld(&bar[XB_XCNT(j)]); sum += c; cnt += (c > 0u) ? 1u : 0u; mine = (j == x) ? c : mine; }
        if (sum == G) break;
        __builtin_amdgcn_s_sleep(1);
        if ((++sp & 255u) == 0u) { if (xb_ld(&bar[XB_TMO])) break; if (sp > XB_SPIN_CAP) { atomicAdd(&bar[XB_TMO], 1u); break; } }
    }
    nloc = mine > 0u ? mine : 1u; nx = cnt > 0u ? cnt : 1u;
}
__device__ __forceinline__ void xcd_barrier(const XcdBarrier& b) {
    asm volatile("s_waitcnt vmcnt(0)" ::: "memory");
    __syncthreads();
    if (threadIdx.x == 0) {
        unsigned* bar = b.bar;
        __builtin_amdgcn_s_waitcnt(0);
        unsigned nloc = b.st[0], nx = b.st[1];
        if (nloc == 0u) { xcd_barrier_complete(bar, b.x, nloc, nx); b.st[0] = nloc; b.st[1] = nx; }
        const unsigned old = xb_add(&bar[XB_XSUB(b.x)], 1u);
        const unsigned gen = old / nloc;
        if (old + 1u == (gen + 1u) * nloc) {
            __builtin_amdgcn_fence(__ATOMIC_RELEASE, "agent");
            asm volatile("s_waitcnt vmcnt(0)" ::: "memory");
            const unsigned og = xb_add(&bar[XB_TOP], 1u);
            const unsigned tg = og / nx;
            if (og + 1u == (tg + 1u) * nx) xb_add(&bar[XB_TOPGEN], 1u);
            else XB_SPIN(xb_ld(&bar[XB_TOPGEN]) == tg, bar);
            __builtin_amdgcn_fence(__ATOMIC_ACQUIRE, "agent");
            xb_add(&bar[XB_XGEN(b.x)], 1u);
            asm volatile("s_waitcnt vmcnt(0)" ::: "memory");
        } else {
            XB_SPIN(xb_ld(&bar[XB_XGEN(b.x)]) == gen, bar);
            __builtin_amdgcn_fence(__ATOMIC_ACQUIRE, "agent");
            asm volatile("s_waitcnt vmcnt(0)" ::: "memory");
        }
    }
    __syncthreads();
}
namespace pg8 {
constexpr int BM = 256, BK = 64, HALF = 128, HTB = HALF * BK * 2, STAGE_BYTES = 8 * HTB;
__host__ __device__ __forceinline__ int lds_byte(int r, int c) { const int st = (r >> 4) * 2 + (c >> 5), rr = r & 15, cc = c & 31, ob = rr * 64 + cc * 2; return st * 1024 + (ob ^ (((ob >> 9) & 1) << 5)); }
__host__ __device__ __forceinline__ void stage_rc(int b, int& R, int& C) { const int st = b / 1024, sb = b % 1024, swz = sb ^ (((sb >> 9) & 1) << 5); R = (st >> 1) * 16 + swz / 64; C = (st & 1) * 32 + (swz % 64) / 2; }
__host__ __device__ __forceinline__ int perm32(int rho) { const int n = rho >> 4, i = rho & 15; return 8 * (i >> 2) + 4 * n + (i & 3); }

struct Unit { int pm, pn, e, mt; };

template <class Epi, class Sched, bool ALIGN_EPI = true>
__device__ __forceinline__ void gemm_phase(LAS unsigned char* lds, const int K, const Sched& S, const Epi& E) {
    const int tid = threadIdx.x, wid = __builtin_amdgcn_readfirstlane(tid >> 6), lane = tid & 63, wr = wid >> 2, wc = wid & 3, fr = lane & 15, fq = lane >> 4;
    const int nt = K / BK;
    int Rr[2], Cc[2]; unsigned voffB[2];
#pragma unroll
    for (int i = 0; i < 2; ++i) { stage_rc(tid * 16 + i * 8192, Rr[i], Cc[i]); const int Rb = Epi::PERM ? ((Rr[i] & ~31) + perm32(Rr[i] & 31)) : Rr[i];
        voffB[i] = (unsigned)(Rb * S.ldb + Cc[i]) * 2u; }
    const size_t kstep = (size_t)(BK * 2);
    const size_t hstepB = (size_t)HALF * S.ldb * 2;
    const unsigned ldsw = (unsigned)wid * 1024u;
    const int aoff = lds_byte(wr * 64 + fr, fq * 8), boff = lds_byte(wc * 32 + fr, fq * 8);
#define PG8_SA(b, h) (((b) * 2 + (h)) * HTB)
#define PG8_SB(b, h) ((4 + (b) * 2 + (h)) * HTB)
#define PG8_STAGE(bufoff, gbase, voff) do { _Pragma("unroll") for (int _i = 0; _i < 2; ++_i) \
        __builtin_amdgcn_global_load_lds((const unsigned*)((const char*)(gbase) + (voff)[_i]), (LAS unsigned*)(lds + (bufoff) + ldsw + _i * 8192), 16, 0, 0); } while (0)
#define PG8_LDA(dst, b, h) do { _Pragma("unroll") for (int m = 0; m < 4; ++m) _Pragma("unroll") for (int k = 0; k < 2; ++k) dst[m][k] = *(const LAS bf16x8*)(lds + PG8_SA(b, h) + aoff + m * 2048 + k * 1024); } while (0)
#define PG8_LDB(dst, b, h) do { _Pragma("unroll") for (int n = 0; n < 2; ++n) _Pragma("unroll") for (int k = 0; k < 2; ++k) dst[n][k] = *(const LAS bf16x8*)(lds + PG8_SB(b, h) + boff + n * 2048 + k * 1024); } while (0)
#define PG8_MMA(ai, bj, At, Bt) do { __builtin_amdgcn_s_setprio(1); _Pragma("unroll") for (int m = 0; m < 4; ++m) _Pragma("unroll") for (int n = 0; n < 2; ++n) _Pragma("unroll") for (int k = 0; k < 2; ++k) \
        acc[ai][bj][m][n] = __builtin_amdgcn_mfma_f32_16x16x32_bf16(Bt[n][k], At[m][k], acc[ai][bj][m][n], 0, 0, 0); __builtin_amdgcn_s_setprio(0); } while (0)
#define PG8_WAIT_V(n) asm volatile("s_waitcnt vmcnt(" #n ")" ::: "memory")
#define PG8_WAIT_L(n) asm volatile("s_waitcnt lgkmcnt(" #n ")" ::: "memory")
#define PG8_BAR __builtin_amdgcn_s_barrier()
#define PG8_SCHED __builtin_amdgcn_sched_barrier(0)
    Unit cur, nxt; int ui = 0;
    if (!S.next(0, cur)) return;
    f32x4 acc[2][2][4][2];
#pragma unroll
    for (int a = 0; a < 2; ++a)
#pragma unroll
        for (int b = 0; b < 2; ++b)
#pragma unroll
            for (int m = 0; m < 4; ++m)
#pragma unroll
                for (int n = 0; n < 2; ++n) acc[a][b][m][n] = (f32x4){0.f, 0.f, 0.f, 0.f};
    bf16x8 At[4][2], B0[2][2], B1[2][2];
    unsigned vaC[2][2], vaN[2][2];
#pragma unroll
    for (int h = 0; h < 2; ++h)
#pragma unroll
        for (int i = 0; i < 2; ++i) vaC[h][i] = S.a_voff(cur, 0, h, Rr[i], Cc[i]);
    const char* cA = S.a_base(cur); const char* cB = S.b_base(cur);
    PG8_STAGE(PG8_SB(0, 0), cB, voffB); PG8_STAGE(PG8_SB(0, 1), cB + hstepB, voffB); PG8_STAGE(PG8_SA(0, 0), cA, vaC[0]); PG8_STAGE(PG8_SA(0, 1), cA, vaC[1]);
    if (wr == 1) PG8_BAR;
    PG8_WAIT_V(2); PG8_BAR;
    PG8_STAGE(PG8_SB(1, 0), cB + kstep, voffB); PG8_STAGE(PG8_SA(1, 0), cA + kstep, vaC[0]); PG8_STAGE(PG8_SB(1, 1), cB + hstepB + kstep, voffB);
    PG8_WAIT_V(6); PG8_BAR;
    for (;;) {
        const bool has_next = S.next(ui + 1, nxt);
        const char* nA = cA; const char* nB = cB;
        if (has_next) { nA = S.a_base(nxt); nB = S.b_base(nxt);
#pragma unroll
            for (int h = 0; h < 2; ++h)
#pragma unroll
                for (int i = 0; i < 2; ++i) vaN[h][i] = S.a_voff(nxt, ui + 1, h, Rr[i], Cc[i]);
        } else {
#pragma unroll
            for (int h = 0; h < 2; ++h)
#pragma unroll
                for (int i = 0; i < 2; ++i) vaN[h][i] = vaC[h][i];
        }
#pragma unroll 1
        for (int t = 0; t < nt; t += 2) {
            const bool last = (t == nt - 2);
            const char* a1 = cA + (size_t)(t + 1) * kstep;
            const char* a2 = last ? nA : cA + (size_t)(t + 2) * kstep; const char* b2 = last ? nB : cB + (size_t)(t + 2) * kstep;
            const char* a3 = a2 + kstep; const char* b3 = b2 + kstep;
            unsigned va2[2][2];
#pragma unroll
            for (int h = 0; h < 2; ++h)
#pragma unroll
                for (int i = 0; i < 2; ++i) va2[h][i] = last ? vaN[h][i] : vaC[h][i];
            PG8_LDB(B0, 0, 0); PG8_LDB(B1, 0, 1); PG8_SCHED; PG8_LDA(At, 0, 0); PG8_STAGE(PG8_SA(1, 1), a1, vaC[1]);
            PG8_WAIT_V(8); PG8_WAIT_L(0); PG8_BAR; PG8_MMA(0, 0, At, B0); PG8_MMA(0, 1, At, B1); PG8_BAR; PG8_SCHED;
            PG8_LDA(At, 0, 1); PG8_STAGE(PG8_SB(0, 0), b2, voffB); PG8_STAGE(PG8_SB(0, 1), b2 + hstepB, voffB); PG8_STAGE(PG8_SA(0, 0), a2, va2[0]);
            PG8_WAIT_V(8); PG8_WAIT_L(0); PG8_BAR; PG8_MMA(1, 0, At, B0); PG8_MMA(1, 1, At, B1); PG8_BAR; PG8_SCHED;
            PG8_LDB(B0, 1, 0); PG8_LDB(B1, 1, 1); PG8_SCHED; PG8_LDA(At, 1, 0); PG8_STAGE(PG8_SA(0, 1), a2, va2[1]);
            PG8_WAIT_V(8); PG8_WAIT_L(0); PG8_BAR; PG8_MMA(0, 0, At, B0); PG8_MMA(0, 1, At, B1); PG8_BAR; PG8_SCHED;
            PG8_LDA(At, 1, 1); PG8_STAGE(PG8_SB(1, 0), b3, voffB); PG8_STAGE(PG8_SB(1, 1), b3 + hstepB, voffB); PG8_STAGE(PG8_SA(1, 0), a3, va2[0]);
            PG8_WAIT_V(8); PG8_WAIT_L(0); PG8_BAR; PG8_MMA(1, 0, At, B0); PG8_MMA(1, 1, At, B1); PG8_BAR; PG8_SCHED;
        }
        if constexpr (ALIGN_EPI) { if (wr == 0) PG8_BAR; }
        { int fr_ = fr, fq_ = fq; asm volatile("" : "+v"(fr_), "+v"(fq_)); E(acc, cur, ui, wr, wc, fr_, fq_); }
        if (!has_next) break;
#pragma unroll
        for (int a = 0; a < 2; ++a)
#pragma unroll
            for (int b = 0; b < 2; ++b)
#pragma unroll
                for (int m = 0; m < 4; ++m)
#pragma unroll
                    for (int n = 0; n < 2; ++n) acc[a][b][m][n] = (f32x4){0.f, 0.f, 0.f, 0.f};
        cur = nxt; cA = nA; cB = nB; ++ui;
#pragma unroll
        for (int h = 0; h < 2; ++h)
#pragma unroll
            for (int i = 0; i < 2; ++i) vaC[h][i] = vaN[h][i];
        if constexpr (ALIGN_EPI) { if (wr == 1) PG8_BAR; }
    }
    PG8_WAIT_V(0);
    if constexpr (!ALIGN_EPI) { if (wr == 0) PG8_BAR; }
    PG8_BAR;
#undef PG8_SA
#undef PG8_SB
#undef PG8_STAGE
#undef PG8_LDA
#undef PG8_LDB
#undef PG8_MMA
#undef PG8_WAIT_V
#undef PG8_WAIT_L
#undef PG8_BAR
#undef PG8_SCHED
}

struct DenseSched {
    const char* A; const char* Bt; int lda, ldb; int nM, nN, nwg, G, c;
    __device__ __forceinline__ void init(const void* A_, int lda_, const void* Bt_, int ldb_, int M, int N, int G_, int c_) {
        A = (const char*)A_; Bt = (const char*)Bt_; lda = lda_; ldb = ldb_; nM = M / BM; nN = N / BM; nwg = nM * nN; G = G_; c = c_; }
    __device__ __forceinline__ bool next(int i, Unit& u) const {
        const long L = (long)i * G + c; if (L >= nwg) return false;
        int wgid = (int)L; { const int q = nwg / 8, r = nwg % 8, xcd = wgid % 8, off = wgid / 8; wgid = (xcd < r ? xcd * (q + 1) : r * (q + 1) + (xcd - r) * q) + off; }
        const int nig = 8 * nN, gid = wgid / nig, fm = gid * 8, gsz = (nM - fm) < 8 ? (nM - fm) : 8;
        u.pm = fm + ((wgid % nig) % gsz); u.pn = (wgid % nig) / gsz; u.e = 0; u.mt = 0; return true;
    }
    __device__ __forceinline__ const char* a_base(const Unit& u) const { return A + (size_t)u.pm * BM * lda * 2; }
    __device__ __forceinline__ unsigned a_voff(const Unit&, int, int h, int R, int C) const { return (unsigned)((h * HALF + R) * lda + C) * 2u; }
    __device__ __forceinline__ const char* b_base(const Unit& u) const { return Bt + (size_t)u.pn * BM * ldb * 2; }
};
}
struct Args { const void* in[28]; float* out; unsigned char* ws; int ph_lo, ph_hi; };
struct Frame {
    LAS unsigned char* lds; volatile LAS unsigned* MISC; unsigned* ctl; unsigned char* ws;
    int tid, lane, wave, vcu, G;
};
#define WSP(T_, off) ((T_*)(F.ws + (off)))

__device__ __forceinline__ void transpose_item(const float* src, int src_ld, int k0, int n0, int nvalid, bf16_t* dst, int dst_ld, int drow0, LAS float* scr, int lane) {
    const int cl = lane & 31;
#pragma unroll 8
    for (int i = 0; i < 32; ++i) { const int kk = 2 * i + (lane >> 5); scr[kk * 33 + cl] = (cl < nvalid) ? src[(size_t)(k0 + kk) * src_ld + n0 + cl] : 0.f; }
    LDS_WAIT(); asm volatile("" ::: "memory");
    const int c = lane & 7;
#pragma unroll
    for (int j = 0; j < 4; ++j) { const int n = (lane >> 3) + 8 * j; const LAS float* s = scr + (8 * c) * 33 + n;
        u32x4 o; o.x = cvtpk(s[0 * 33], s[1 * 33]); o.y = cvtpk(s[2 * 33], s[3 * 33]); o.z = cvtpk(s[4 * 33], s[5 * 33]); o.w = cvtpk(s[6 * 33], s[7 * 33]);
        *(u32x4*)(dst + (size_t)(drow0 + n) * dst_ld + k0 + 8 * c) = o; }
    LDS_WAIT(); asm volatile("" ::: "memory");
}

__device__ __forceinline__ void pa_prologue(Frame& F, const Args& a) {
    const float* c_in = (const float*)a.in[1]; const int* pos = (const int*)a.in[2];
    const float* w_ada = (const float*)a.in[3]; const float* b_ada = (const float*)a.in[4];
    if ((int)blockIdx.x < 96) {
        LAS float* sc = (LAS float*)(F.lds);
        for (int idx = F.tid; idx < 32 * 1024; idx += 512) sc[idx] = siluf_(c_in[idx]);
        __syncthreads();
        for (int u = blockIdx.x; u < 96; u += F.G) {
            const int n = 64 * u + F.lane, b0 = 4 * F.wave;
            float acc0 = 0.f, acc1 = 0.f, acc2 = 0.f, acc3 = 0.f;
#pragma unroll 4
            for (int k = 0; k < 1024; ++k) { const float w = w_ada[(size_t)k * 6144 + n];
                acc0 += sc[(b0 + 0) * 1024 + k] * w; acc1 += sc[(b0 + 1) * 1024 + k] * w; acc2 += sc[(b0 + 2) * 1024 + k] * w; acc3 += sc[(b0 + 3) * 1024 + k] * w; }
            float* mod = WSP(float, WS_MOD); const float bb = b_ada[n];
            mod[(size_t)(b0 + 0) * 6144 + n] = acc0 + bb; mod[(size_t)(b0 + 1) * 6144 + n] = acc1 + bb; mod[(size_t)(b0 + 2) * 6144 + n] = acc2 + bb; mod[(size_t)(b0 + 3) * 6144 + n] = acc3 + bb;
        }
        __syncthreads();
    }
    {
        LAS float* scr = (LAS float*)(F.lds + F.wave * 16384);
        const int gw = F.vcu * 8 + F.wave, NGW = F.G * 8;
        constexpr int I_WIN = 16 * 144, I_UPA = 8 * 32, I_UPB = 6 * 32, I_OUT = 16 * 32, I_CW1 = 32 * 8, I_CW2 = 4 * 2, I_GU = 16 * 32, I_WD = 8 * 32;
        constexpr int NITEMS = I_WIN + I_UPA + I_UPB + I_OUT + 2 * I_CW1 + 2 * I_CW2 + NEXP * (I_GU + I_WD);
        for (int it = gw; it < NITEMS; it += NGW) {
            int r = it;
            if (r < I_WIN) { const int kb = r / 144, rb = r % 144, rho0 = 32 * rb, pn = rho0 >> 8, bj = (rho0 >> 7) & 1, wc = (rho0 >> 5) & 3, H = 4 * pn + wc;
                int nv = slot_valid(H) - 32 * bj; nv = nv < 0 ? 0 : (nv > 32 ? 32 : nv);
                transpose_item((const float*)a.in[7], IN_COLS, 64 * kb, slot_col0(H) + 32 * bj, nv, WSP(bf16_t, WS_WIN), 1024, rho0, scr, F.lane); continue; } r -= I_WIN;
            if (r < I_UPA) { const int kb = r / 32, rb = r % 32; transpose_item((const float*)a.in[18], 1024, 64 * kb, 32 * rb, 32, WSP(bf16_t, WS_WUPA), 512, 32 * rb, scr, F.lane); continue; } r -= I_UPA;
            if (r < I_UPB) { const int kb = r / 32, rb = r % 32; transpose_item((const float*)a.in[19], 1024, 64 * kb, 32 * rb, 32, WSP(bf16_t, WS_WUPB), 384, 32 * rb, scr, F.lane); continue; } r -= I_UPB;
            if (r < I_OUT) { const int kb = r / 32, rb = r % 32; transpose_item((const float*)a.in[20], 1024, 64 * kb, 32 * rb, 32, WSP(bf16_t, WS_WOUT), 1024, 32 * rb, scr, F.lane); continue; } r -= I_OUT;
            if (r < 2 * I_CW1) { const int kv = r / I_CW1, q = r % I_CW1, kb = q / 8, rb = q % 8;
                transpose_item((const float*)a.in[kv ? 14 : 11], 256, 64 * kb, 32 * rb, 32, WSP(bf16_t, WS_CW1) + (size_t)kv * 256 * 2048, 2048, 32 * rb, scr, F.lane); continue; } r -= 2 * I_CW1;
            if (r < 2 * I_CW2) { const int kv = r / I_CW2, q = r % I_CW2, kb = q / 2, rb = q % 2;
                transpose_item((const float*)a.in[kv ? 15 : 12], 64, 64 * kb, 32 * rb, 32, WSP(bf16_t, WS_CW2) + (size_t)kv * 64 * 256, 256, 32 * rb, scr, F.lane); continue; } r -= 2 * I_CW2;
            { const int e = r / (I_GU + I_WD); int q = r % (I_GU + I_WD);
              if (q < I_GU) { const int kb = q / 32, rb = q % 32, rho0 = 32 * rb, pn = rho0 >> 8, bj = (rho0 >> 7) & 1, y0 = rho0 & 127;
                  transpose_item((const float*)a.in[bj ? 26 : 25] + (size_t)e * 1024 * 512, 512, 64 * kb, 128 * pn + y0, 32, WSP(bf16_t, WS_WGU) + (size_t)e * 1024 * 1024, 1024, rho0, scr, F.lane); }
              else { q -= I_GU; const int kb = q / 32, rb = q % 32;
                  transpose_item((const float*)a.in[27] + (size_t)e * 512 * 1024, 1024, 64 * kb, 32 * rb, 32, WSP(bf16_t, WS_WD) + (size_t)e * 1024 * 512, 512, 32 * rb, scr, F.lane); } }
        }
    }
    {
        const int gt = F.vcu * 512 + F.tid, NGT = F.G * 512;
        float* cosT = WSP(float, WS_ROPE); float* sinT = cosT + (size_t)NT_TOK * 32;
        for (int idx = gt; idx < NT_TOK * 32; idx += NGT) { const int t = idx >> 5, f = idx & 31;
            const double inv = exp2(-(double)f * (13.287712379549449 / 32.0)); const double ang = (double)pos[t] * inv;
            double s, c; sincos(ang, &s, &c); cosT[idx] = (float)c; sinT[idx] = (float)s; }
        float* ccos = WSP(float, WS_CROPE); float* csin = ccos + 32 * 128 * 32;
        for (int idx = gt; idx < 32 * 128 * 32; idx += NGT) { const int f = idx & 31, n = (idx >> 5) & 127, b = idx >> 12;
            const int tt = 16 * n + 31; const int p = pos[b * SEQ + (tt < SEQ ? tt : SEQ - 1)];
            const double inv = exp2(-(double)f * (13.287712379549449 / 32.0)); const double ang = (double)p * inv;
            double s, c; sincos(ang, &s, &c); ccos[idx] = (float)c; csin[idx] = (float)s; }
        bf16_t* rhi = (bf16_t*)(F.ws + WS_SMALL + 65536); bf16_t* rlo = (bf16_t*)(F.ws + WS_SMALL + 196608);
        const float* w_group = (const float*)a.in[21]; const float* w_router = (const float*)a.in[23];
        for (int idx = gt; idx < 64 * 1024; idx += NGT) { const int c = idx >> 10, k = idx & 1023;
            float w = 0.f; if (c < 4) w = w_group[k * 4 + c]; else if (c < 36) { const int g = (c - 4) >> 3, e = (c - 4) & 7; w = w_router[((size_t)g * 1024 + k) * 8 + e]; }
            const unsigned hi = cvtpk(w, 0.f) & 0xffffu; const float lo = w - bf2f((unsigned short)hi);
            rhi[idx] = (bf16_t)hi; rlo[idx] = (bf16_t)(cvtpk(lo, 0.f) & 0xffffu); }
        float* bias = WSP(float, WS_SMALL);
        for (int idx = gt; idx < 16 * 512; idx += NGT) { const int ks = idx >> 9, kv = (idx >> 8) & 1, col = idx & 255; const float* pe = (const float*)a.in[kv ? 13 : 10]; const float* w1 = (const float*)a.in[kv ? 14 : 11];
            float s = 0.f;
#pragma unroll 8
            for (int i = 128 * ks; i < 128 * ks + 128; ++i) s += pe[i] * w1[(size_t)i * 256 + col];
            bias[idx] = s; }
        if (gt < NEXP) F.ctl[CW_CNT + 64 * gt] = 0u;
    }
}

__device__ __forceinline__ void pb_modnorm(Frame& F, const float* x, const float* g, const float* mod, int sh_off, int sc_off, bf16_t* out) {
    const int gw = F.vcu * 8 + F.wave, NGW = F.G * 8;
    for (int m = gw; m < NT_TOK; m += NGW) {
        const int b = m >> 11;
        const f32x4* xr = (const f32x4*)(x + (size_t)m * DM) + F.lane;
        f32x4 v[4]; float s = 0.f;
#pragma unroll
        for (int j = 0; j < 4; ++j) { v[j] = xr[64 * j]; s += (v[j].x * v[j].x + v[j].y * v[j].y) + (v[j].z * v[j].z + v[j].w * v[j].w); }
        const float rstd = 1.0f / sqrtf(wave_sum(s) * (1.f / DM) + EPS);
        const f32x4* gr = (const f32x4*)g + F.lane; const f32x4* scr = (const f32x4*)(mod + (size_t)b * 6144 + sc_off) + F.lane; const f32x4* shr = (const f32x4*)(mod + (size_t)b * 6144 + sh_off) + F.lane;
        u32x2* o8 = (u32x2*)(out + (size_t)m * DM) + F.lane;
#pragma unroll
        for (int j = 0; j < 4; ++j) { const f32x4 gg = gr[64 * j], sc = scr[64 * j], sh = shr[64 * j];
            const f32x4 y = (v[j] * rstd) * gg; const f32x4 h = y * (sc + 1.0f) + sh;
            u32x2 w; w.x = cvtpk(h.x, h.y); w.y = cvtpk(h.z, h.w); o8[64 * j] = w; }
    }
}
namespace pg8 {
struct ProjEpi {
    static constexpr bool PERM = true;
    unsigned char* ws; const float* cosT; const float* sinT; const float* nq; const float* nk; const float* dq; const float* dk;
    __device__ __forceinline__ void operator()(const f32x4 (&acc)[2][2][4][2], const Unit& u, int, int wr, int wc, int fr, int fq) const {
        const int H = __builtin_amdgcn_readfirstlane(4 * u.pn + wc);
        int type = 0; const float* gn = nq; float qs = 1.f;
        if (H < 8) { type = 1; gn = nq; qs = C2; }
        else if (H == 12 || H == 13 || H == 16 || H == 17) { type = 1; gn = nk; }
        else if (H >= 20 && H < 26) { type = 1; gn = dq; qs = C2; }
        else if (H >= 26 && H < 32) { type = 1; gn = dk; }
        else if (H >= 38 && H <= 70) type = 2;
        bf16_t* dst = (bf16_t*)(ws + slot_off(H));
        const int row0 = u.pm * BM + wr * 64 + fr;
        if (type == 1) {
            f32x4 g0[2], g1[2];
#pragma unroll
            for (int n = 0; n < 2; ++n) { g0[n] = *(const f32x4*)(gn + 8 * fq + 4 * n) * qs; g1[n] = *(const f32x4*)(gn + 32 + 8 * fq + 4 * n) * qs; }
#pragma unroll
            for (int ai = 0; ai < 2; ++ai)
#pragma unroll
                for (int m = 0; m < 4; ++m) {
                    const int tok = row0 + ai * HALF + m * 16;
                    float ss = 0.f;
#pragma unroll
                    for (int bj = 0; bj < 2; ++bj)
#pragma unroll
                        for (int n = 0; n < 2; ++n) { const f32x4 v = acc[ai][bj][m][n]; ss += (v[0] * v[0] + v[1] * v[1]) + (v[2] * v[2] + v[3] * v[3]); }
                    ss += __shfl_xor(ss, 16); ss += __shfl_xor(ss, 32);
                    const float rstd = 1.0f / sqrtf(ss * (1.f / 64.f) + EPS);
                    u32x4 w0, w1;
#pragma unroll
                    for (int n = 0; n < 2; ++n) {
                        const f32x4 cs = *(const f32x4*)(cosT + (size_t)tok * 32 + 8 * fq + 4 * n), sn = *(const f32x4*)(sinT + (size_t)tok * 32 + 8 * fq + 4 * n);
                        const f32x4 x1 = acc[ai][0][m][n] * rstd * g0[n], x2 = acc[ai][1][m][n] * rstd * g1[n];
                        const f32x4 o1 = x1 * cs - x2 * sn, o2 = x1 * sn + x2 * cs;
                        w0[2 * n] = cvtpk(o1[0], o1[1]); w0[2 * n + 1] = cvtpk(o1[2], o1[3]); w1[2 * n] = cvtpk(o2[0], o2[1]); w1[2 * n + 1] = cvtpk(o2[2], o2[3]);
                    }
                    bf16_t* rp = dst + (size_t)tok * 64 + 8 * fq;
                    *(u32x4*)rp = w0; *(u32x4*)(rp + 32) = w1;
                }
        } else {
#pragma unroll
            for (int ai = 0; ai < 2; ++ai)
#pragma unroll
                for (int m = 0; m < 4; ++m) {
                    const int tok = row0 + ai * HALF + m * 16;
                    bf16_t* rp = dst + (size_t)tok * 64 + 8 * fq;
#pragma unroll
                    for (int bj = 0; bj < 2; ++bj) { f32x4 v0 = acc[ai][bj][m][0], v1 = acc[ai][bj][m][1];
                        if (type == 2) {
#pragma unroll
                            for (int i = 0; i < 4; ++i) { v0[i] = sigmoidf_(v0[i]); v1[i] = sigmoidf_(v1[i]); } }
                        u32x4 w; w.x = cvtpk(v0[0], v0[1]); w.y = cvtpk(v0[2], v0[3]); w.z = cvtpk(v1[0], v1[1]); w.w = cvtpk(v1[2], v1[3]);
                        *(u32x4*)(rp + 32 * bj) = w; }
                }
        }
    }
};

template <bool ADD> struct UpEpi {
    static constexpr bool PERM = true;
    unsigned char* ws; bf16_t* Y; int gslot0;
    __device__ __forceinline__ void operator()(const f32x4 (&acc)[2][2][4][2], const Unit& u, int, int wr, int wc, int fr, int fq) const {
        const int row0 = u.pm * BM + wr * 64 + fr;
#pragma unroll
        for (int bj = 0; bj < 2; ++bj) {
            const int gs = __builtin_amdgcn_readfirstlane(gslot0 + 4 * u.pn + 2 * bj + (wc >> 1));
            const bf16_t* gp = (const bf16_t*)(ws + slot_off(gs)) + 32 * (wc & 1) + 8 * fq;
            const int col = u.pn * BM + bj * HALF + wc * 32 + 8 * fq;
#pragma unroll
            for (int ai = 0; ai < 2; ++ai)
#pragma unroll
                for (int m = 0; m < 4; ++m) {
                    const int tok = row0 + ai * HALF + m * 16;
                    const u32x4 g = *(const u32x4*)(gp + (size_t)tok * 64);
                    bf16_t* yp = Y + (size_t)tok * DM + col;
                    f32x4 v0 = acc[ai][bj][m][0], v1 = acc[ai][bj][m][1];
                    v0[0] *= bflo(g.x); v0[1] *= bfhi(g.x); v0[2] *= bflo(g.y); v0[3] *= bfhi(g.y); v1[0] *= bflo(g.z); v1[1] *= bfhi(g.z); v1[2] *= bflo(g.w); v1[3] *= bfhi(g.w);
                    if (ADD) { const u32x4 y = *(const u32x4*)yp;
                        v0[0] += bflo(y.x); v0[1] += bfhi(y.x); v0[2] += bflo(y.y); v0[3] += bfhi(y.y); v1[0] += bflo(y.z); v1[1] += bfhi(y.z); v1[2] += bflo(y.w); v1[3] += bfhi(y.w); }
                    u32x4 w; w.x = cvtpk(v0[0], v0[1]); w.y = cvtpk(v0[2], v0[3]); w.z = cvtpk(v1[0], v1[1]); w.w = cvtpk(v1[2], v1[3]);
                    *(u32x4*)yp = w;
                    if (m & 1) asm volatile("" ::: "memory");
                }
        }
    }
};

struct OutEpi {
    static constexpr bool PERM = false;
    const float* x; float* out; const float* mod; float* rowss;
    __device__ __forceinline__ void operator()(const f32x4 (&acc)[2][2][4][2], const Unit& u, int, int wr, int wc, int fr, int fq) const {
        const int row0 = u.pm * BM + wr * 64 + fr, col0 = u.pn * BM + wc * 32 + 4 * fq;
        const int b = (u.pm * BM) >> 11;
        const float* gt = mod + (size_t)b * 6144 + 2048 + col0;
        f32x4 gv[2][2];
#pragma unroll
        for (int bj = 0; bj < 2; ++bj)
#pragma unroll
            for (int n = 0; n < 2; ++n) gv[bj][n] = *(const f32x4*)(gt + bj * HALF + n * 16);
#pragma unroll
        for (int ai = 0; ai < 2; ++ai)
#pragma unroll
            for (int m = 0; m < 4; ++m) {
                const int tok = row0 + ai * HALF + m * 16; const size_t off = (size_t)tok * DM + col0; float ss = 0.f;
#pragma unroll
                for (int bj = 0; bj < 2; ++bj)
#pragma unroll
                    for (int n = 0; n < 2; ++n) { const f32x4 xv = *(const f32x4*)(x + off + bj * HALF + n * 16); const f32x4 o = xv + gv[bj][n] * acc[ai][bj][m][n];
                        ss += (o[0] * o[0] + o[1] * o[1]) + (o[2] * o[2] + o[3] * o[3]); *(f32x4*)(out + off + bj * HALF + n * 16) = o; }
                ss += __shfl_xor(ss, 16); ss += __shfl_xor(ss, 32);
                if (fq == 0) rowss[(size_t)tok * 16 + 4 * u.pn + wc] = ss;
            }
    }
};

struct CmpEpi {
    static constexpr bool PERM = true;
    const float* biasp; bf16_t* hid;
    __device__ __forceinline__ void operator()(const f32x4 (&acc)[2][2][4][2], const Unit& u, int, int wr, int wc, int fr, int fq) const {
        const int kv = u.pm >= 32 ? 1 : 0; const int row0 = u.pm * BM + wr * 64 + fr;
#pragma unroll
        for (int bj = 0; bj < 2; ++bj) {
            const int col = bj * HALF + wc * 32 + 8 * fq;
            f32x4 b0 = (f32x4){0.f, 0.f, 0.f, 0.f}, b1 = b0;
            for (int ks = 0; ks < 16; ++ks) { b0 += *(const f32x4*)(biasp + ks * 512 + kv * 256 + col); b1 += *(const f32x4*)(biasp + ks * 512 + kv * 256 + col + 4); }
#pragma unroll
            for (int ai = 0; ai < 2; ++ai)
#pragma unroll
                for (int m = 0; m < 4; ++m) {
                    const int row = row0 + ai * HALF + m * 16;
                    f32x4 v0 = acc[ai][bj][m][0] + b0, v1 = acc[ai][bj][m][1] + b1;
#pragma unroll
                    for (int i = 0; i < 4; ++i) { v0[i] = siluf_(v0[i]); v1[i] = siluf_(v1[i]); }
                    u32x4 w; w.x = cvtpk(v0[0], v0[1]); w.y = cvtpk(v0[2], v0[3]); w.z = cvtpk(v1[0], v1[1]); w.w = cvtpk(v1[2], v1[3]);
                    *(u32x4*)(hid + (size_t)row * 256 + col) = w;
                }
        }
    }
};
struct CmpSched {
    const char* A; const char* Bt; int ldb; int nwg_c, c;
    __device__ __forceinline__ bool next(int i, Unit& u) const { if (c < 0) return false; const int L = i * nwg_c + c; if (L >= 64) return false; u.pm = L; u.pn = 0; u.e = 0; u.mt = 0; return true; }
    __device__ __forceinline__ const char* a_base(const Unit& u) const { return A + (size_t)u.pm * BM * 1024 * 2; }
    __device__ __forceinline__ unsigned a_voff(const Unit&, int, int h, int R, int C) const { return (unsigned)((h * HALF + R) * 1024 + C) * 2u; }
    __device__ __forceinline__ const char* b_base(const Unit& u) const { return Bt + (u.pm >= 32 ? (size_t)256 * 2048 * 2 : 0); }
};
}
namespace att {
constexpr int A_KV = 0;
constexpr int A_WSF = 65536;
constexpr int A_OST = 67584;
constexpr int A_IMP = 100352;
constexpr int A_SEL = 133120;
constexpr float NEG_INF = -INFINITY;
constexpr float THR = 8.0f;
__device__ __forceinline__ int crow(int r, int hi) { return (r & 3) + 8 * (r >> 2) + 4 * hi; }
__device__ __forceinline__ void glds16(const void* gsrc, unsigned lds_dst) { unsigned keep;
    asm volatile("s_mov_b32 %0, m0\n\ts_mov_b32 m0, %2\n\ts_nop 0\n\tglobal_load_lds_dwordx4 %1, off\n\ts_mov_b32 m0, %0" : "=&s"(keep) : "v"(gsrc), "s"(lds_dst) : "memory"); }
#define ATT_WAIT_BAR(N) asm volatile("s_waitcnt vmcnt(" #N ") lgkmcnt(0)\n\ts_barrier" ::: "memory")
#define ATT_SBAR() __builtin_amdgcn_sched_barrier(0)

struct Ctx { LAS unsigned char* lds; int lane, r32, hi, wid; unsigned lds0; };
__device__ __forceinline__ int fresh(int v) { asm volatile("" : "+v"(v)); return v; }

__device__ __forceinline__ void qkt(f32x16& p0, f32x16& p1, const LAS unsigned char* Kslot, const bf16x8 (&qr)[4], int r32_, int hi_) {
    const int lq = fresh(r32_ + 32 * hi_); const int r32 = lq & 31, hi = lq >> 5;
    const LAS unsigned char* kb = Kslot + hi * 1024 + r32 * 16;
    const f32x16 z = {};
#pragma unroll
    for (int d0 = 0; d0 < 4; ++d0) {
        const bf16x8 b0 = *(const LAS bf16x8*)(kb + d0 * 2048);
        const bf16x8 b1 = *(const LAS bf16x8*)(kb + d0 * 2048 + 512);
        if (d0 == 0) { p0 = __builtin_amdgcn_mfma_f32_32x32x16_bf16(b0, qr[0], z, 0, 0, 0); p1 = __builtin_amdgcn_mfma_f32_32x32x16_bf16(b1, qr[0], z, 0, 0, 0); }
        else { p0 = __builtin_amdgcn_mfma_f32_32x32x16_bf16(b0, qr[d0], p0, 0, 0, 0); p1 = __builtin_amdgcn_mfma_f32_32x32x16_bf16(b1, qr[d0], p1, 0, 0, 0); } }
}
__device__ __forceinline__ void pv(f32x16 (&o)[2], int vb, bf16x8 pa0, bf16x8 pa1, bf16x8 pa2, bf16x8 pa3) {
#pragma unroll
    for (int d0 = 0; d0 < 2; ++d0) { s16x4 lo[4], hh[4];
#pragma unroll
        for (int ks = 0; ks < 4; ++ks) {
            asm volatile("ds_read_b64_tr_b16 %0,%1 offset:%c2" : "=&v"(lo[ks]) : "v"(vb), "i"(d0 * 4096 + ks * 1024) : "memory");
            asm volatile("ds_read_b64_tr_b16 %0,%1 offset:%c2" : "=&v"(hh[ks]) : "v"(vb), "i"(d0 * 4096 + ks * 1024 + 512) : "memory"); }
        asm volatile("s_waitcnt lgkmcnt(0)" ::: "memory"); ATT_SBAR();
#define ATT_PK(k) (bf16x8){lo[k][0], lo[k][1], lo[k][2], lo[k][3], hh[k][0], hh[k][1], hh[k][2], hh[k][3]}
        o[d0] = __builtin_amdgcn_mfma_f32_32x32x16_bf16(pa0, ATT_PK(0), o[d0], 0, 0, 0);
        o[d0] = __builtin_amdgcn_mfma_f32_32x32x16_bf16(pa1, ATT_PK(1), o[d0], 0, 0, 0);
        o[d0] = __builtin_amdgcn_mfma_f32_32x32x16_bf16(pa2, ATT_PK(2), o[d0], 0, 0, 0);
        o[d0] = __builtin_amdgcn_mfma_f32_32x32x16_bf16(pa3, ATT_PK(3), o[d0], 0, 0, 0);
#undef ATT_PK
    }
}
__device__ __forceinline__ float rowmax(const f32x16& p0, const f32x16& p1) {
    float a = fmaxf(p0[0], p1[0]);
#pragma unroll
    for (int r = 1; r < 16; ++r) a = fmaxf(a, fmaxf(p0[r], p1[r]));
    auto rr = __builtin_amdgcn_permlane32_swap(__float_as_uint(a), __float_as_uint(a), false, false);
    return fmaxf(__uint_as_float(rr[0]), __uint_as_float(rr[1]));
}
__device__ __forceinline__ float halfsum(float v) { auto rr = __builtin_amdgcn_permlane32_swap(__float_as_uint(v), __float_as_uint(v), false, false); return __uint_as_float(rr[0]) + __uint_as_float(rr[1]); }
#define ATT_PACK4(P, B) (u32x4){cvtpk(P[B], P[B + 1]), cvtpk(P[B + 2], P[B + 3]), cvtpk(P[B + 4], P[B + 5]), cvtpk(P[B + 6], P[B + 7])}
__device__ __forceinline__ void pv_tile(f32x16 (&o)[2], int vb, const f32x16& p0, const f32x16& p1) {
    const u32x4 w0 = ATT_PACK4(p0, 0), w1 = ATT_PACK4(p0, 8), w2 = ATT_PACK4(p1, 0), w3 = ATT_PACK4(p1, 8);
    pv(o, vb, __builtin_bit_cast(bf16x8, w0), __builtin_bit_cast(bf16x8, w1), __builtin_bit_cast(bf16x8, w2), __builtin_bit_cast(bf16x8, w3));
}
__device__ __forceinline__ void scale_rows(f32x16 (&o)[2], float f, const Ctx& C_) {
    Ctx C = C_; { const int l = fresh(C_.lane); C.r32 = l & 31; C.hi = l >> 5; }
    LAS float* wsf = (LAS float*)(C.lds + A_WSF) + C.wid * 64;
    if (C.hi == 0) wsf[C.r32] = f;
    asm volatile("s_waitcnt lgkmcnt(0)" ::: "memory");
#pragma unroll
    for (int g = 0; g < 4; ++g) { const f32x4 fv = *(const LAS f32x4*)(wsf + 8 * g + 4 * C.hi);
#pragma unroll
        for (int i = 0; i < 4; ++i) { o[0][4 * g + i] *= fv[i]; o[1][4 * g + i] *= fv[i]; } }
    asm volatile("s_waitcnt lgkmcnt(0)" ::: "memory");
}
__device__ __forceinline__ void axpy_rows(f32x16 (&acc)[2], const f32x16 (&o)[2], float f, const Ctx& C_) {
    Ctx C = C_; { const int l = fresh(C_.lane); C.r32 = l & 31; C.hi = l >> 5; }
    LAS float* wsf = (LAS float*)(C.lds + A_WSF) + C.wid * 64;
    if (C.hi == 0) wsf[C.r32] = f;
    asm volatile("s_waitcnt lgkmcnt(0)" ::: "memory");
#pragma unroll
    for (int g = 0; g < 4; ++g) { const f32x4 fv = *(const LAS f32x4*)(wsf + 8 * g + 4 * C.hi);
#pragma unroll
        for (int i = 0; i < 4; ++i) { acc[0][4 * g + i] += o[0][4 * g + i] * fv[i]; acc[1][4 * g + i] += o[1][4 * g + i] * fv[i]; } }
    asm volatile("s_waitcnt lgkmcnt(0)" ::: "memory");
}
struct SM { float m, l; f32x16 o[2]; };
__device__ __forceinline__ void sm_init(SM& s) { s.m = -1e30f; s.l = 0.f; s.o[0] = f32x16{}; s.o[1] = f32x16{}; }
__device__ __forceinline__ void sm_step(SM& s, f32x16& p0, f32x16& p1, int vb, const Ctx& C) {
    const float rm = rowmax(p0, p1);
    if (__any(rm > s.m + THR)) {
        const float mn = fmaxf(s.m, rm); const float f = __builtin_amdgcn_exp2f(s.m - mn);
        s.l *= f; s.m = mn; scale_rows(s.o, f, C);
    }
    float sum = 0.f;
#pragma unroll
    for (int r = 0; r < 16; ++r) { p0[r] = __builtin_amdgcn_exp2f(p0[r] - s.m); p1[r] = __builtin_amdgcn_exp2f(p1[r] - s.m); sum += p0[r] + p1[r]; }
    s.l += sum;
    pv_tile(s.o, vb, p0, p1);
}
template <int NS> __device__ __forceinline__ void dma_tile(const Ctx& C, const bf16_t* Kp, const bf16_t* Vp, long rs, int tile, int stage, int q) {
    const unsigned base = C.lds0 + (unsigned)((stage * 2 + q) * 16384);
    const long k0 = (long)tile * 64; const int lane = fresh(C.lane);
#pragma unroll
    for (int j = 0; j < NS; ++j) {
        const int pw = (NS == 1) ? C.wid : (2 * (C.wid & 3) + j);
        const bf16_t* ks = Kp + (k0 + lane) * rs + pw * 8;
        const bf16_t* vs = Vp + (k0 + 16 * (pw & 3) + (lane >> 2)) * rs + (pw >> 2) * 32 + (lane & 3) * 8;
        glds16(ks, (unsigned)__builtin_amdgcn_readfirstlane(base + pw * 1024));
        glds16(vs, (unsigned)__builtin_amdgcn_readfirstlane(base + 8192 + pw * 1024));
    }
}
template <int NS, class MaskF, class SkipF>
__device__ __forceinline__ void run_pass(const Ctx& C, SM& st, const bf16x8 (&qr)[4], const bf16_t* Kp, const bf16_t* Vp, long rs, int t_lo, int t_hi, int nsteps, MaskF mask, SkipF skip) {
    const int q = (NS == 1) ? 0 : (C.wid >> 2);
    if (t_lo < t_hi) dma_tile<NS>(C, Kp, Vp, rs, t_lo, 0, q);
    for (int step = 0; step < nsteps; ++step) {
        const int tile = t_lo + step; const bool act = tile < t_hi; const bool nact = (step + 1 < nsteps) && (tile + 1 < t_hi);
        if (nact) dma_tile<NS>(C, Kp, Vp, rs, tile + 1, (step + 1) & 1, q);
        if (nact) { if (NS == 1) ATT_WAIT_BAR(2); else ATT_WAIT_BAR(4); } else ATT_WAIT_BAR(0);
        if (act && !skip(tile)) {
            const int sb = ((step & 1) * 2 + q) * 16384;
            const int lv = fresh(C.lane); const int vlane = ((lv >> 4) & 1) * 32 + (lv & 3) * 8 + (4 * (lv >> 5) + ((lv & 15) >> 2)) * 64;
            f32x16 p0, p1; qkt(p0, p1, C.lds + sb, qr, C.r32, C.hi);
            mask(p0, p1, tile);
            sm_step(st, p0, p1, (int)C.lds0 + sb + 8192 + vlane, C);
        }
        ATT_WAIT_BAR(0);
    }
}
__device__ __forceinline__ void store_o(const f32x16 (&o)[2], bf16_t* Ow, long pitch, const Ctx& C_) {
    Ctx C = C_; { const int l = fresh(C_.lane); C.lane = l; C.r32 = l & 31; C.hi = l >> 5; }
    LAS bf16_t* stg = (LAS bf16_t*)(C.lds + A_OST) + C.wid * 2048;
#pragma unroll
    for (int r = 0; r < 16; ++r) { const int orow = crow(r, C.hi);
#pragma unroll
        for (int d0 = 0; d0 < 2; ++d0) stg[orow * 64 + d0 * 32 + C.r32] = (bf16_t)(cvtpk(o[d0][r], 0.f) & 0xffffu); }
    asm volatile("s_waitcnt lgkmcnt(0)" ::: "memory");
#pragma unroll
    for (int i = 0; i < 4; ++i) { const int row = i * 8 + (C.lane >> 3), ch = C.lane & 7; const u32x4 v = *(const LAS u32x4*)(stg + row * 64 + ch * 8); *(u32x4*)(Ow + (long)row * pitch + ch * 8) = v; }
    asm volatile("s_waitcnt lgkmcnt(0)" ::: "memory");
}
__device__ __forceinline__ void load_q(bf16x8 (&qr)[4], const bf16_t* Qrow, int hi) {
#pragma unroll
    for (int d0 = 0; d0 < 4; ++d0) qr[d0] = *(const bf16x8*)(Qrow + d0 * 16 + hi * 8);
}

__device__ __forceinline__ void dil_unit(const Ctx& C, unsigned char* ws, int u, bf16_t* obraw, float* lse) {
    const int gi = u >> 9, v = u & 511, hw = C.wid >> 2, w4 = C.wid & 3;
    const int b = v >> 4, j = (v >> 3) & 1;
    int ds, res, blk, L;
    if (gi == 0) { ds = 1; res = 0; blk = 2 * (v & 7) + hw; L = 2048; }
    else if (gi == 1) { ds = 4; res = (v >> 1) & 3; blk = 2 * (v & 1) + hw; L = 512; }
    else { ds = 16; res = 2 * (v & 7) + hw; blk = 0; L = 128; }
    const int h6 = gi * 2 + j;
    const size_t tokbase = (size_t)b * SEQ + res;
    const bf16_t* Qp = (const bf16_t*)(ws + slot_off(SL_QB + h6)) + tokbase * 64;
    const bf16_t* Kp = (const bf16_t*)(ws + slot_off(SL_KB + h6)) + tokbase * 64;
    const bf16_t* Vp = (const bf16_t*)(ws + slot_off(SL_VB + h6)) + tokbase * 64;
    const long rs = (long)ds * 64;
    int t_lo = 2 * blk - 2; if (t_lo < 0) t_lo = 0; int t_hi = 2 * blk + 2; if (t_hi > L / 64) t_hi = L / 64;
    const int nsteps = (gi == 2) ? 2 : 4;
    const int i0 = 128 * blk + 32 * w4, iq = i0 + C.r32;
    bf16x8 qr[4]; load_q(qr, Qp + (long)iq * rs, C.hi);
    SM st; sm_init(st);
    const int hi = C.hi;
    auto mask = [&](f32x16& p0, f32x16& p1, int tile) {
        const int lim = fresh(iq - 64 * tile - 4 * hi), lim2 = lim - 128;
#pragma unroll
        for (int r = 0; r < 16; ++r) { const int c = (r & 3) + 8 * (r >> 2);
            if (c > lim || c < lim2) p0[r] = NEG_INF;
            if (c + 32 > lim || c + 32 < lim2) p1[r] = NEG_INF; }
    };
    auto skip = [&](int tile) { return (64 * tile > i0 + 31) || (64 * tile + 63 < i0 - 128); };
    run_pass<2>(C, st, qr, Kp, Vp, rs, t_lo, t_hi, nsteps, mask, skip);
    const float lt = halfsum(st.l);
    const float inv = 1.0f / lt;
    scale_rows(st.o, inv, C);
    store_o(st.o, obraw + (tokbase + (size_t)i0 * ds) * 384 + h6 * 64, (long)ds * 384, C);
    if (C.hi == 0) lse[(tokbase + (size_t)iq * ds) * 8 + h6] = (st.m + __builtin_amdgcn_logf(lt)) * 0.6931471805599453f;
    ATT_WAIT_BAR(0);
}

__device__ __forceinline__ void nsa_unit(const Ctx& C, unsigned char* ws, int b, int hk, int blk, bf16_t* oa) {
    const int g = C.wid >> 1, head = hk * 4 + g, hi = C.hi;
    const int tq = 64 * blk + 32 * (C.wid & 1) + C.r32;
    const size_t tokbase = (size_t)b * SEQ;
    bf16x8 qr[4]; load_q(qr, (const bf16_t*)(ws + slot_off(SL_QA + head)) + (tokbase + tq) * 64, hi);
    const bf16_t* ga = (const bf16_t*)(ws + slot_off(SL_GA)) + (tokbase + tq) * 64;
    const float g_cmp = bf2f(ga[head]), g_slc = bf2f(ga[8 + head]), g_win = bf2f(ga[16 + head]);
    f32x16 ot[2]; ot[0] = f32x16{}; ot[1] = f32x16{};
    LAS float* imp = (LAS float*)(C.lds + A_IMP);
    LAS unsigned* sel = (LAS unsigned*)(C.lds + A_SEL);
    {
        const int pair = hk * 32 + b;
        const bf16_t* Kc = (const bf16_t*)(ws + WS_KC) + (size_t)pair * 128 * 64;
        const bf16_t* Vc = (const bf16_t*)(ws + WS_KC + MiB) + (size_t)pair * 128 * 64;
        const bool two = blk >= 16;
        dma_tile<1>(C, Kc, Vc, 64, 0, 0, 0);
        if (two) dma_tile<1>(C, Kc, Vc, 64, 1, 1, 0);
        ATT_WAIT_BAR(0);
        const int nlim = (tq - 31) >> 4;
        auto cmask = [&](f32x16& p0, f32x16& p1, int tile) {
            { const int lim = fresh(nlim - 64 * tile - 4 * hi);
#pragma unroll
              for (int r = 0; r < 16; ++r) { const int c = (r & 3) + 8 * (r >> 2); if (c > lim) p0[r] = NEG_INF; if (c + 32 > lim) p1[r] = NEG_INF; } } };
        float rm;
        { f32x16 s0, s1; qkt(s0, s1, C.lds + 0, qr, C.r32, hi); cmask(s0, s1, 0); rm = rowmax(s0, s1);
          if (two) { qkt(s0, s1, C.lds + 32768, qr, C.r32, hi); cmask(s0, s1, 1); rm = fmaxf(rm, rowmax(s0, s1)); } }
        const bool has = rm > -1e29f; if (!has) rm = 0.f;
        LAS float* irh; { unsigned a_ = (unsigned)(size_t)(imp + (g * 64 + 32 * (C.wid & 1) + C.r32) * 32 + hi); asm volatile("" : "+v"(a_)); irh = (LAS float*)(size_t)a_; }
        float sum = 0.f;
#pragma unroll
        for (int gq = 0; gq < 8; ++gq) irh[16 + 2 * gq] = 0.f;
        asm volatile("s_waitcnt lgkmcnt(0)" ::: "memory");
#pragma unroll
        for (int tile = 0; tile < 2; ++tile) {
            if (tile == 0 || two) {
                f32x16 s0, s1; qkt(s0, s1, C.lds + tile * 32768, qr, C.r32, hi); cmask(s0, s1, tile);
#pragma unroll
                for (int r = 0; r < 16; ++r) { s0[r] = __builtin_amdgcn_exp2f(s0[r] - rm); s1[r] = __builtin_amdgcn_exp2f(s1[r] - rm); sum += s0[r] + s1[r]; }
#pragma unroll
                for (int gq = 0; gq < 4; ++gq) { const float A0 = (s0[4 * gq] + s0[4 * gq + 1]) + (s0[4 * gq + 2] + 0.5f * s0[4 * gq + 3]), A1 = (s1[4 * gq] + s1[4 * gq + 1]) + (s1[4 * gq + 2] + 0.5f * s1[4 * gq + 3]);
                    if (tile == 0) { irh[2 * gq] = A0; irh[8 + 2 * gq] = A1; } else { irh[16 + 2 * gq] += A0; irh[24 + 2 * gq] += A1; } }
                asm volatile("s_waitcnt lgkmcnt(0)" ::: "memory");
#pragma unroll
                for (int gq = 0; gq < 4; ++gq) { const int j0 = 16 * tile + 2 * gq + 1, j1 = j0 + 8;
                    irh[j0] += 0.5f * s0[4 * gq + 3];
                    if (j1 < 31) irh[j1] += 0.5f * s1[4 * gq + 3]; else if (hi == 0) irh[j1] += 0.5f * s1[4 * gq + 3]; }
                asm volatile("s_waitcnt lgkmcnt(0)" ::: "memory");
                { const int lv = fresh(C.lane); const int vlane = ((lv >> 4) & 1) * 32 + (lv & 3) * 8 + (4 * (lv >> 5) + ((lv & 15) >> 2)) * 64;
                  pv_tile(ot, (int)C.lds0 + tile * 32768 + 8192 + vlane, s0, s1); }
            }
        }
        const float lt = halfsum(sum); const float inv = has ? 1.0f / lt : 0.f;
        if (hi == 0) ((LAS float*)(C.lds + A_SEL + 256))[g * 64 + 32 * (C.wid & 1) + C.r32] = inv;
        scale_rows(ot, g_cmp * inv, C);
        ATT_WAIT_BAR(0);
        if (C.wid == 0) {
            const int q = C.lane; unsigned m = 0u; const LAS float* nrm = (const LAS float*)(C.lds + A_SEL + 256);
            m |= 1u; m |= 1u << blk; if (blk >= 1) m |= 1u << (blk - 1);
            int need = 8 - __builtin_popcount(m);
            const int ncand = blk - 2;
            if (ncand > 0) {
                if (ncand <= need) { for (int jb = 1; jb <= blk - 2; ++jb) m |= 1u << jb; }
                else {
                    for (int it = 0; it < need; ++it) { float best = -1.f; int bj = 1;
                        for (int jb = 1; jb <= blk - 2; ++jb) { if (m & (1u << jb)) continue;
                            const float sc = (imp[(0 * 64 + q) * 32 + jb] * nrm[q] + imp[(1 * 64 + q) * 32 + jb] * nrm[64 + q]) + (imp[(2 * 64 + q) * 32 + jb] * nrm[128 + q] + imp[(3 * 64 + q) * 32 + jb] * nrm[192 + q]);
                            if (sc > best) { best = sc; bj = jb; } }
                        m |= 1u << bj; }
                }
            }
            sel[q] = m;
        }
        ATT_WAIT_BAR(0);
    }
    const unsigned mysel = sel[32 * (C.wid & 1) + C.r32];
    {
        const bf16_t* Kp = (const bf16_t*)(ws + slot_off(SL_KSLC + hk)) + tokbase * 64;
        const bf16_t* Vp = (const bf16_t*)(ws + slot_off(SL_VSLC + hk)) + tokbase * 64;
        SM st; sm_init(st);
        auto mask = [&](f32x16& p0, f32x16& p1, int tile) {
            if (!((mysel >> tile) & 1u)) {
#pragma unroll
                for (int r = 0; r < 16; ++r) { p0[r] = NEG_INF; p1[r] = NEG_INF; } }
            else if (tile == blk) { const int lim = fresh(tq - 64 * tile - 4 * hi);
#pragma unroll
                for (int r = 0; r < 16; ++r) { const int c = (r & 3) + 8 * (r >> 2); if (c > lim) p0[r] = NEG_INF; if (c + 32 > lim) p1[r] = NEG_INF; } }
        };
        auto skip = [&](int tile) { return !__any((mysel >> tile) & 1u); };
        run_pass<1>(C, st, qr, Kp, Vp, 64, 0, blk + 1, blk + 1, mask, skip);
        const float lt = halfsum(st.l);
        axpy_rows(ot, st.o, g_slc / lt, C);
    }
    {
        const bf16_t* Kp = (const bf16_t*)(ws + slot_off(SL_KWIN + hk)) + tokbase * 64;
        const bf16_t* Vp = (const bf16_t*)(ws + slot_off(SL_VWIN + hk)) + tokbase * 64;
        SM st; sm_init(st);
        const int t_lo = blk >= 8 ? blk - 8 : 0;
        auto mask = [&](f32x16& p0, f32x16& p1, int tile) {
            if (tile == blk || tile == blk - 8) { const int lim = fresh(tq - 64 * tile - 4 * hi), lim2 = lim - 512;
#pragma unroll
                for (int r = 0; r < 16; ++r) { const int c = (r & 3) + 8 * (r >> 2);
                    if (c > lim || c < lim2) p0[r] = NEG_INF; if (c + 32 > lim || c + 32 < lim2) p1[r] = NEG_INF; } }
        };
        auto skip = [&](int) { return false; };
        run_pass<1>(C, st, qr, Kp, Vp, 64, t_lo, blk + 1, blk + 1 - t_lo, mask, skip);
        const float lt = halfsum(st.l);
        axpy_rows(ot, st.o, g_win / lt, C);
    }
    store_o(ot, oa + (tokbase + 64 * blk + 32 * (C.wid & 1)) * 512 + head * 64, 512, C);
    ATT_WAIT_BAR(0);
}
}
__device__ __forceinline__ void pf4_router(Frame& F, const Args& a) {
    const float* x1 = a.out; const float* g2 = (const float*)a.in[6]; const float* mod = WSP(float, WS_MOD); const float* rowss = WSP(float, WS_ROWSS);
    const float* b_group = (const float*)a.in[22]; const float* b_router = (const float*)a.in[24];
    const bf16_t* rhi = (const bf16_t*)(F.ws + WS_SMALL + 65536); const bf16_t* rlo = (const bf16_t*)(F.ws + WS_SMALL + 196608);
    bf16_t* h2 = WSP(bf16_t, WS_H);
    int* pick_e = (int*)(F.ws + WS_PICK); int* pick_pos = (int*)(F.ws + WS_PICK + 524288); float* pick_w = (float*)(F.ws + WS_PICK + 1048576); int* list = WSP(int, WS_LIST);
    LAS float* lg = (LAS float*)(F.lds) + F.wave * (32 * 40);
    LAS int* lc = (LAS int*)(F.lds + 65536); LAS int* gb = lc + 32;
    const int r32 = F.lane & 31, hi = F.lane >> 5;
    const int NGW = F.G * 8, ntask = NT_TOK / 32, iters = (ntask + NGW - 1) / NGW;
    for (int it = 0; it < iters; ++it) {
        const int task = it * NGW + F.vcu * 8 + F.wave; const bool valid = task < ntask;
        if (F.tid < 32) lc[F.tid] = 0;
        __syncthreads();
        int e1 = 0, e2 = 0, p1 = 0, p2 = 0; float w1 = 0.f, w2 = 0.f; int row = 0;
        if (valid) {
            row = task * 32 + r32; const int b = row >> 11;
            float ss = 0.f; { const f32x4* rp = (const f32x4*)(rowss + (size_t)row * 16); const f32x4 s0 = rp[0], s1 = rp[1], s2 = rp[2], s3 = rp[3];
                ss = ((s0[0] + s0[1]) + (s0[2] + s0[3])) + ((s1[0] + s1[1]) + (s1[2] + s1[3])) + ((s2[0] + s2[1]) + (s2[2] + s2[3])) + ((s3[0] + s3[1]) + (s3[2] + s3[3])); }
            const float rstd = 1.0f / sqrtf(ss * (1.f / DM) + EPS);
            const float* xr = x1 + (size_t)row * DM + 8 * hi; const float* gp = g2 + 8 * hi; const float* scp = mod + (size_t)b * 6144 + 4096 + 8 * hi; const float* shp = mod + (size_t)b * 6144 + 3072 + 8 * hi;
            bf16_t* hp = h2 + (size_t)row * DM + 8 * hi;
            const bf16_t* wh0 = rhi + (size_t)r32 * 1024 + 8 * hi; const bf16_t* wl0 = rlo + (size_t)r32 * 1024 + 8 * hi;
            f32x16 acc0 = {}, acc1 = {};
#pragma unroll 2
            for (int s = 0; s < 64; ++s) {
                const f32x4 xa = *(const f32x4*)(xr + 16 * s), xb = *(const f32x4*)(xr + 16 * s + 4);
                const f32x4 ga = *(const f32x4*)(gp + 16 * s), gbv = *(const f32x4*)(gp + 16 * s + 4);
                const f32x4 sa = *(const f32x4*)(scp + 16 * s), sb = *(const f32x4*)(scp + 16 * s + 4);
                const f32x4 ha = *(const f32x4*)(shp + 16 * s), hb = *(const f32x4*)(shp + 16 * s + 4);
                const f32x4 va = (xa * rstd) * ga * (sa + 1.0f) + ha, vb = (xb * rstd) * gbv * (sb + 1.0f) + hb;
                u32x4 whi; whi.x = cvtpk(va[0], va[1]); whi.y = cvtpk(va[2], va[3]); whi.z = cvtpk(vb[0], vb[1]); whi.w = cvtpk(vb[2], vb[3]);
                *(u32x4*)(hp + 16 * s) = whi;
                u32x4 wlo; wlo.x = cvtpk(va[0] - bflo(whi.x), va[1] - bfhi(whi.x)); wlo.y = cvtpk(va[2] - bflo(whi.y), va[3] - bfhi(whi.y));
                wlo.z = cvtpk(vb[0] - bflo(whi.z), vb[1] - bfhi(whi.z)); wlo.w = cvtpk(vb[2] - bflo(whi.w), vb[3] - bfhi(whi.w));
                const bf16x8 Bh = __builtin_bit_cast(bf16x8, whi), Bl = __builtin_bit_cast(bf16x8, wlo);
                const bf16x8 Ah0 = *(const bf16x8*)(wh0 + 16 * s), Al0 = *(const bf16x8*)(wl0 + 16 * s);
                const bf16x8 Ah1 = *(const bf16x8*)(wh0 + 32 * 1024 + 16 * s), Al1 = *(const bf16x8*)(wl0 + 32 * 1024 + 16 * s);
                acc0 = __builtin_amdgcn_mfma_f32_32x32x16_bf16(Ah0, Bh, acc0, 0, 0, 0); acc0 = __builtin_amdgcn_mfma_f32_32x32x16_bf16(Ah0, Bl, acc0, 0, 0, 0); acc0 = __builtin_amdgcn_mfma_f32_32x32x16_bf16(Al0, Bh, acc0, 0, 0, 0);
                acc1 = __builtin_amdgcn_mfma_f32_32x32x16_bf16(Ah1, Bh, acc1, 0, 0, 0); acc1 = __builtin_amdgcn_mfma_f32_32x32x16_bf16(Ah1, Bl, acc1, 0, 0, 0); acc1 = __builtin_amdgcn_mfma_f32_32x32x16_bf16(Al1, Bh, acc1, 0, 0, 0);
            }
            LAS float* lr = lg + r32 * 40;
#pragma unroll
            for (int gq = 0; gq < 4; ++gq) *(LAS f32x4*)(lr + 8 * gq + 4 * hi) = (f32x4){acc0[4 * gq], acc0[4 * gq + 1], acc0[4 * gq + 2], acc0[4 * gq + 3]};
            if (hi == 0) *(LAS f32x4*)(lr + 32) = (f32x4){acc1[0], acc1[1], acc1[2], acc1[3]};
            asm volatile("s_waitcnt lgkmcnt(0)" ::: "memory");
            if (hi == 0) {
                float gl[4];
#pragma unroll
                for (int i = 0; i < 4; ++i) gl[i] = lr[i] + b_group[i];
                int gi = 0; float gm = gl[0];
#pragma unroll
                for (int i = 1; i < 4; ++i) if (gl[i] > gm) { gm = gl[i]; gi = i; }
                float gsum = 0.f;
#pragma unroll
                for (int i = 0; i < 4; ++i) gsum += __expf(gl[i] - gm);
                const float gw = 1.0f / gsum;
                float el[8];
#pragma unroll
                for (int i = 0; i < 8; ++i) el[i] = lr[4 + 8 * gi + i] + b_router[gi * 8 + i];
                int i1 = 0; float v1 = el[0];
#pragma unroll
                for (int i = 1; i < 8; ++i) if (el[i] > v1) { v1 = el[i]; i1 = i; }
                int i2 = -1; float v2 = -INFINITY;
#pragma unroll
                for (int i = 0; i < 8; ++i) if (i != i1 && el[i] > v2) { v2 = el[i]; i2 = i; }
                const float pa = 1.0f / (1.0f + __expf(v2 - v1));
                w1 = gw * pa; w2 = gw * (1.0f - pa); e1 = gi * 8 + i1; e2 = gi * 8 + i2;
                p1 = __hip_atomic_fetch_add((int*)(lc + e1), 1, __ATOMIC_RELAXED, __HIP_MEMORY_SCOPE_WORKGROUP);
                p2 = __hip_atomic_fetch_add((int*)(lc + e2), 1, __ATOMIC_RELAXED, __HIP_MEMORY_SCOPE_WORKGROUP);
            }
        }
        __syncthreads();
        if (F.tid < 32) { const int c = lc[F.tid]; gb[F.tid] = c ? (int)__hip_atomic_fetch_add(F.ctl + CW_CNT + 64 * F.tid, (unsigned)c, RLX_AGENT) : 0; }
        __syncthreads();
        if (valid && hi == 0) {
            p1 += gb[e1]; p2 += gb[e2];
            pick_e[row * 2] = e1; pick_e[row * 2 + 1] = e2; pick_pos[row * 2] = p1; pick_pos[row * 2 + 1] = p2; pick_w[row * 2] = w1; pick_w[row * 2 + 1] = w2;
            list[(size_t)e1 * NT_TOK + p1] = row; list[(size_t)e2 * NT_TOK + p2] = row;
        }
        __syncthreads();
    }
}

__device__ __forceinline__ void moe_tables(Frame& F) {
    LAS int* cnt = (LAS int*)(F.lds + LDS_EXP); LAS int* pre = cnt + 32;
    if (F.tid < 32) cnt[F.tid] = (int)__hip_atomic_load(F.ctl + CW_CNT + 64 * F.tid, RLX_AGENT);
    __syncthreads();
    if (F.tid == 0) { int s = 0; for (int e = 0; e < 32; ++e) { pre[e] = s; s += (cnt[e] + 255) >> 8; } pre[32] = s; }
    __syncthreads();
}
namespace pg8 {
struct MoeSched {
    const char* A; const char* Bt; int lda, ldb; size_t bstride; bool gather; LAS unsigned char* lds; int G, c;
    __device__ __forceinline__ bool next(int i, Unit& u) const {
        const LAS int* pre = (const LAS int*)(lds + LDS_EXP) + 32;
        const int L = i * G + c; if (L >= 4 * pre[32]) return false;
        const int mtg = L >> 2; int e = 0;
#pragma unroll 1
        for (int k = 1; k < 32; ++k) if (pre[k] <= mtg) e = k;
        u.pm = mtg; u.pn = L & 3; u.e = e; u.mt = mtg - pre[e]; return true;
    }
    __device__ __forceinline__ const char* a_base(const Unit& u) const { return gather ? A : A + (size_t)u.pm * BM * lda * 2; }
    __device__ __forceinline__ unsigned a_voff(const Unit&, int ui, int h, int R, int C) const {
        if (gather) { const int tok = ((const LAS int*)(lds + LDS_TOK))[ui * 256 + h * HALF + R]; return (unsigned)(tok * lda + C) * 2u; }
        return (unsigned)((h * HALF + R) * lda + C) * 2u; }
    __device__ __forceinline__ const char* b_base(const Unit& u) const { return Bt + (size_t)u.e * bstride + (size_t)u.pn * BM * ldb * 2; }
};
struct GuEpi {
    static constexpr bool PERM = true;
    bf16_t* hid;
    __device__ __forceinline__ void operator()(const f32x4 (&acc)[2][2][4][2], const Unit& u, int, int wr, int wc, int fr, int fq) const {
        const int row0 = u.pm * BM + wr * 64 + fr, col = u.pn * HALF + wc * 32 + 8 * fq;
#pragma unroll
        for (int ai = 0; ai < 2; ++ai)
#pragma unroll
            for (int m = 0; m < 4; ++m) {
                f32x4 v0, v1;
#pragma unroll
                for (int i = 0; i < 4; ++i) { v0[i] = siluf_(acc[ai][0][m][0][i]) * acc[ai][1][m][0][i]; v1[i] = siluf_(acc[ai][0][m][1][i]) * acc[ai][1][m][1][i]; }
                u32x4 w; w.x = cvtpk(v0[0], v0[1]); w.y = cvtpk(v0[2], v0[3]); w.z = cvtpk(v1[0], v1[1]); w.w = cvtpk(v1[2], v1[3]);
                *(u32x4*)(hid + (size_t)(row0 + ai * HALF + m * 16) * EFF + col) = w;
            }
    }
};
struct YEpi {
    static constexpr bool PERM = true;
    bf16_t* Y;
    __device__ __forceinline__ void operator()(const f32x4 (&acc)[2][2][4][2], const Unit& u, int, int wr, int wc, int fr, int fq) const {
        const int row0 = u.pm * BM + wr * 64 + fr, col0 = u.pn * BM + wc * 32 + 8 * fq;
#pragma unroll
        for (int ai = 0; ai < 2; ++ai)
#pragma unroll
            for (int m = 0; m < 4; ++m)
#pragma unroll
                for (int bj = 0; bj < 2; ++bj) { const f32x4 v0 = acc[ai][bj][m][0], v1 = acc[ai][bj][m][1];
                    u32x4 w; w.x = cvtpk(v0[0], v0[1]); w.y = cvtpk(v0[2], v0[3]); w.z = cvtpk(v1[0], v1[1]); w.w = cvtpk(v1[2], v1[3]);
                    *(u32x4*)(Y + (size_t)(row0 + ai * HALF + m * 16) * DM + col0 + bj * HALF) = w; }
    }
};
}

__device__ __forceinline__ void moe_fill_tokens(Frame& F, const pg8::MoeSched& S) {
    const LAS int* cnt = (const LAS int*)(F.lds + LDS_EXP); LAS int* tokt = (LAS int*)(F.lds + LDS_TOK); const int* list = WSP(int, WS_LIST);
    pg8::Unit u;
    for (int i = 0; i < 12 && S.next(i, u); ++i) {
        if (F.tid < 256) { const int idx = u.mt * 256 + F.tid; tokt[i * 256 + F.tid] = list[(size_t)u.e * NT_TOK + (idx < cnt[u.e] ? idx : 0)]; }
    }
    __syncthreads();
}

__device__ __forceinline__ void pi_combine(Frame& F, const Args& a) {
    const LAS int* pre = (const LAS int*)(F.lds + LDS_EXP) + 32;
    const int* pick_e = (const int*)(F.ws + WS_PICK); const int* pick_pos = (const int*)(F.ws + WS_PICK + 524288); const float* pick_w = (const float*)(F.ws + WS_PICK + 1048576);
    const bf16_t* Y = WSP(bf16_t, WS_R1); const float* mod = WSP(float, WS_MOD); float* out = a.out;
    const int gw = F.vcu * 8 + F.wave, NGW = F.G * 8;
    for (int m = gw; m < NT_TOK; m += NGW) {
        const int b = m >> 11;
        const int e0 = pick_e[2 * m], e1 = pick_e[2 * m + 1]; const float w0 = pick_w[2 * m], w1 = pick_w[2 * m + 1];
        const size_t s0 = (size_t)pre[e0] * 256 + pick_pos[2 * m], s1 = (size_t)pre[e1] * 256 + pick_pos[2 * m + 1];
        const u32x2* y0 = (const u32x2*)(Y + s0 * DM) + F.lane; const u32x2* y1 = (const u32x2*)(Y + s1 * DM) + F.lane;
        f32x4* xr = (f32x4*)(out + (size_t)m * DM) + F.lane; const f32x4* gt = (const f32x4*)(mod + (size_t)b * 6144 + 5120) + F.lane;
#pragma unroll
        for (int j = 0; j < 4; ++j) { const u32x2 a0 = y0[64 * j], a1 = y1[64 * j]; const f32x4 g = gt[64 * j]; f32x4 x = xr[64 * j];
            x[0] += g[0] * (w0 * bflo(a0.x) + w1 * bflo(a1.x)); x[1] += g[1] * (w0 * bfhi(a0.x) + w1 * bfhi(a1.x));
            x[2] += g[2] * (w0 * bflo(a0.y) + w1 * bflo(a1.y)); x[3] += g[3] * (w0 * bfhi(a0.y) + w1 * bfhi(a1.y)); xr[64 * j] = x; }
    }
}
#ifndef MK_MODE
#define MK_MODE 2
#endif
constexpr int NPHASE = 12;

__device__ __forceinline__ void pd_compress_stage2(Frame& F, const Args& a, int pm) {
    const int r32 = F.lane & 31, hi = F.lane >> 5, kv = pm >= 32 ? 1 : 0;
    const bf16_t* w2t = WSP(bf16_t, WS_CW2) + (size_t)kv * 64 * 256;
    const int rowg = 256 * pm + 32 * F.wave + r32;
    const bf16_t* hp = WSP(bf16_t, WS_CHID) + (size_t)rowg * 256 + 8 * hi;
    f32x16 acc0 = {}, acc1 = {};
#pragma unroll 4
    for (int s = 0; s < 16; ++s) {
        const bf16x8 B = *(const bf16x8*)(hp + 16 * s);
        const bf16x8 A0 = *(const bf16x8*)(w2t + (size_t)r32 * 256 + 16 * s + 8 * hi), A1 = *(const bf16x8*)(w2t + (size_t)(32 + r32) * 256 + 16 * s + 8 * hi);
        acc0 = __builtin_amdgcn_mfma_f32_32x32x16_bf16(A0, B, acc0, 0, 0, 0); acc1 = __builtin_amdgcn_mfma_f32_32x32x16_bf16(A1, B, acc1, 0, 0, 0);
    }
    const int mrow = rowg & 8191;
    bf16_t* dst = (bf16_t*)(F.ws + WS_KC + (kv ? MiB : 0)) + (size_t)mrow * 64;
    if (kv == 0) {
        float ss = 0.f;
#pragma unroll
        for (int r = 0; r < 16; ++r) ss += acc0[r] * acc0[r] + acc1[r] * acc1[r];
        ss = att::halfsum(ss);
        const float rstd = 1.0f / sqrtf(ss * (1.f / 64.f) + EPS);
        const float* nk = (const float*)a.in[9];
        const int b = (mrow >> 7) & 31, n = mrow & 127;
        const float* cc = WSP(float, WS_CROPE) + ((size_t)b * 128 + n) * 32; const float* sn = cc + 32 * 128 * 32;
#pragma unroll
        for (int gq = 0; gq < 4; ++gq) { const int d = 8 * gq + 4 * hi;
            const f32x4 g1 = *(const f32x4*)(nk + d), g2 = *(const f32x4*)(nk + 32 + d), c4 = *(const f32x4*)(cc + d), s4 = *(const f32x4*)(sn + d);
            f32x4 x1, x2;
#pragma unroll
            for (int i = 0; i < 4; ++i) { x1[i] = acc0[4 * gq + i] * rstd * g1[i]; x2[i] = acc1[4 * gq + i] * rstd * g2[i]; }
            const f32x4 o1 = x1 * c4 - x2 * s4, o2 = x1 * s4 + x2 * c4;
            u32x2 w1, w2; w1.x = cvtpk(o1[0], o1[1]); w1.y = cvtpk(o1[2], o1[3]); w2.x = cvtpk(o2[0], o2[1]); w2.y = cvtpk(o2[2], o2[3]);
            *(u32x2*)(dst + d) = w1; *(u32x2*)(dst + 32 + d) = w2; }
    } else {
#pragma unroll
        for (int gq = 0; gq < 4; ++gq) { const int d = 8 * gq + 4 * hi;
            u32x2 w1, w2; w1.x = cvtpk(acc0[4 * gq], acc0[4 * gq + 1]); w1.y = cvtpk(acc0[4 * gq + 2], acc0[4 * gq + 3]); w2.x = cvtpk(acc1[4 * gq], acc1[4 * gq + 1]); w2.y = cvtpk(acc1[4 * gq + 2], acc1[4 * gq + 3]);
            *(u32x2*)(dst + d) = w1; *(u32x2*)(dst + 32 + d) = w2; }
    }
}

__device__ __forceinline__ void pf1_scale_ob(Frame& F) {
    const float* lse = WSP(float, WS_LSE); const unsigned* src = (const unsigned*)(F.ws + WS_H + 64 * MiB); unsigned* dst = (unsigned*)(F.ws + WS_R1);
    const int gw = F.vcu * 8 + F.wave, NGW = F.G * 8, j = F.lane >> 5;
    for (int m = gw; m < NT_TOK; m += NGW) {
        const float l0 = lse[(size_t)m * 8 + j], l1 = lse[(size_t)m * 8 + 2 + j], l2 = lse[(size_t)m * 8 + 4 + j];
        const float mx = fmaxf(l0, fmaxf(l1, l2)); const float e0 = __expf(l0 - mx), e1 = __expf(l1 - mx), e2 = __expf(l2 - mx); const float inv = 1.0f / (e0 + e1 + e2);
        const float al[3] = {e0 * inv, e1 * inv, e2 * inv};
#pragma unroll
        for (int gi = 0; gi < 3; ++gi) { const unsigned w = src[(size_t)m * 192 + gi * 64 + F.lane]; dst[(size_t)m * 192 + gi * 64 + F.lane] = cvtpk(bflo(w) * al[gi], bfhi(w) * al[gi]); }
    }
}

__global__ void __launch_bounds__(512, 2) mk_fwd(Args args) {
    extern __shared__ __attribute__((aligned(16))) unsigned char lds_raw[];
    Frame F;
    F.lds = (LAS unsigned char*)lds_raw;
    F.MISC = (volatile LAS unsigned*)(F.lds + LDS_MISC);
    F.tid = threadIdx.x; F.lane = F.tid & 63; F.wave = __builtin_amdgcn_readfirstlane(F.tid >> 6);
    F.G = gridDim.x; { const int bx = blockIdx.x; F.vcu = (F.G % 8 == 0) ? (bx % 8) * (F.G / 8) + bx / 8 : bx; }
    F.ws = args.ws; F.ctl = (unsigned*)(args.ws + WS_CTL);
    if (F.tid < 64) ((LAS unsigned*)(F.lds + LDS_MISC))[F.tid] = 0u;
    __syncthreads();
#if MK_MODE == 1
    cg::grid_group grid = cg::this_grid();
#define GRID_BAR() grid.sync()
#elif MK_MODE == 2
    XcdBarrier bar = xcd_barrier_post(F.ctl + CW_BAR, F.MISC + 8);
#define GRID_BAR() xcd_barrier(bar)
#else
#define GRID_BAR() do {} while (0)
#endif
    const int lo = args.ph_lo, hi = args.ph_hi;
#ifndef PH_MASK
#define PH_MASK 0xfff
#endif
#define IN(k) (((PH_MASK >> (k)) & 1) && lo <= (k) && (k) < hi)
#define SEAM(k) do { if (IN(k) && IN((k) + 1)) GRID_BAR(); } while (0)

    if (IN(0)) { pa_prologue(F, args); } SEAM(0);
    if (IN(1)) { pb_modnorm(F, (const float*)args.in[0], (const float*)args.in[5], WSP(float, WS_MOD), 0, 1024, WSP(bf16_t, WS_H)); } SEAM(1);
    if (IN(2)) {
        pg8::DenseSched S; S.init(WSP(bf16_t, WS_H), 1024, WSP(bf16_t, WS_WIN), 1024, NT_TOK, NPROJ, F.G, (int)blockIdx.x);
        pg8::ProjEpi E{F.ws, WSP(float, WS_ROPE), WSP(float, WS_ROPE) + (size_t)NT_TOK * 32, (const float*)args.in[8], (const float*)args.in[9], (const float*)args.in[16], (const float*)args.in[17]};
        pg8::gemm_phase<pg8::ProjEpi, pg8::DenseSched>(F.lds, 1024, S, E);
    } SEAM(2);
    if (IN(3)) {
        const int ncw = F.G >= 128 ? 64 : (F.G > 1 ? F.G / 2 : 1);
        if ((int)blockIdx.x < ncw) {
            pg8::CmpSched S{(const char*)(F.ws + slot_off(SL_KCMP)), (const char*)(F.ws + WS_CW1), 2048, ncw, (int)blockIdx.x};
            pg8::CmpEpi E{WSP(float, WS_SMALL), WSP(bf16_t, WS_CHID)};
            pg8::gemm_phase<pg8::CmpEpi, pg8::CmpSched>(F.lds, 2048, S, E);
            VM_WAIT(); __syncthreads();
            pg8::Unit u; for (int i = 0; S.next(i, u); ++i) pd_compress_stage2(F, args, u.pm);
        }
        if ((int)blockIdx.x >= ncw || F.G == 1) {
            att::Ctx C; C.lds = F.lds; C.lane = F.lane; C.r32 = F.lane & 31; C.hi = F.lane >> 5; C.wid = F.wave; C.lds0 = (unsigned)(size_t)F.lds;
            const int nd = F.G == 1 ? 1 : F.G - ncw, c = F.G == 1 ? 0 : (int)blockIdx.x - ncw;
            for (int u = c; u < 1536; u += nd) att::dil_unit(C, F.ws, u, (bf16_t*)(F.ws + WS_H + 64 * MiB), WSP(float, WS_LSE));
        }
    } SEAM(3);
    if (IN(4)) {
        att::Ctx C; C.lds = F.lds; C.lane = F.lane; C.r32 = F.lane & 31; C.hi = F.lane >> 5; C.wid = F.wave; C.lds0 = (unsigned)(size_t)F.lds;
        for (int v = F.vcu; v < 256; v += F.G) {
            const int bh = v >> 2, k = v & 3, b = bh >> 1, hk = bh & 1;
            for (int i = 0; i < 8; ++i) { const int blk = (i & 1) ? (8 * (i >> 1) + 7 - k) : (8 * (i >> 1) + k); att::nsa_unit(C, F.ws, b, hk, 31 - blk, WSP(bf16_t, WS_H)); }
        }
    } SEAM(4);
    if (IN(5)) {
        pf1_scale_ob(F);
        pg8::DenseSched S; S.init(WSP(bf16_t, WS_H), 512, WSP(bf16_t, WS_WUPA), 512, NT_TOK, DM, F.G, (int)blockIdx.x);
        pg8::UpEpi<false> E{F.ws, WSP(bf16_t, WS_Y), SL_GMA};
        pg8::gemm_phase<pg8::UpEpi<false>, pg8::DenseSched>(F.lds, 512, S, E);
    } SEAM(5);
    if (IN(6)) {
        pg8::DenseSched S; S.init(WSP(bf16_t, WS_R1), 384, WSP(bf16_t, WS_WUPB), 384, NT_TOK, DM, F.G, (int)blockIdx.x);
        pg8::UpEpi<true> E{F.ws, WSP(bf16_t, WS_Y), SL_GMB};
        pg8::gemm_phase<pg8::UpEpi<true>, pg8::DenseSched>(F.lds, 384, S, E);
    } SEAM(6);
    if (IN(7)) {
        pg8::DenseSched S; S.init(WSP(bf16_t, WS_Y), 1024, WSP(bf16_t, WS_WOUT), 1024, NT_TOK, DM, F.G, (int)blockIdx.x);
        pg8::OutEpi E{(const float*)args.in[0], args.out, WSP(float, WS_MOD), WSP(float, WS_ROWSS)};
        pg8::gemm_phase<pg8::OutEpi, pg8::DenseSched>(F.lds, 1024, S, E);
    } SEAM(7);
    if (IN(8)) { pf4_router(F, args); } SEAM(8);
    if (IN(9)) {
        moe_tables(F);
        pg8::MoeSched S{(const char*)(F.ws + WS_H), (const char*)(F.ws + WS_WGU), 1024, 1024, (size_t)1024 * 1024 * 2, true, F.lds, F.G, F.vcu};
        moe_fill_tokens(F, S);
        pg8::GuEpi E{WSP(bf16_t, WS_R2)};
        pg8::gemm_phase<pg8::GuEpi, pg8::MoeSched>(F.lds, 1024, S, E);
    } SEAM(9);
    if (IN(10)) {
        moe_tables(F);
        pg8::MoeSched S{(const char*)(F.ws + WS_R2), (const char*)(F.ws + WS_WD), 512, 512, (size_t)1024 * 512 * 2, false, F.lds, F.G, F.vcu};
        pg8::YEpi E{WSP(bf16_t, WS_R1)};
        pg8::gemm_phase<pg8::YEpi, pg8::MoeSched>(F.lds, 512, S, E);
    } SEAM(10);
    if (IN(11)) { moe_tables(F); pi_combine(F, args); }
#undef IN
#undef SEAM
}

extern "C" void kernel_launch(void* const* d_in, const int* in_sizes, int n_in, void* d_out, int out_size, void* d_ws, size_t ws_size, hipStream_t stream) {
    static int grid = 0;
    if (grid == 0) {
        if (n_in != 28 || in_sizes[0] != NT_TOK * DM || out_size != NT_TOK * DM || ws_size < WS_END) {
            fprintf(stderr, "kernel_launch: shape/workspace mismatch (n_in %d, in0 %d, out %d, ws %zu, need %zu)\n", n_in, n_in > 0 ? in_sizes[0] : -1, out_size, ws_size, (size_t)WS_END); grid = -1; return; }
        int dev = 0, cus = 0, per_cu = 0;
        hipGetDevice(&dev); hipDeviceGetAttribute(&cus, hipDeviceAttributeMultiprocessorCount, dev);
        if (hipFuncSetAttribute((const void*)mk_fwd, hipFuncAttributeMaxDynamicSharedMemorySize, LDS_BYTES) != hipSuccess) { fprintf(stderr, "kernel_launch: hipFuncSetAttribute failed\n"); grid = -1; return; }
        if (hipOccupancyMaxActiveBlocksPerMultiprocessor(&per_cu, (const void*)mk_fwd, 512, LDS_BYTES) != hipSuccess || per_cu < 1) { fprintf(stderr, "kernel_launch: occupancy query says %d blocks per CU\n", per_cu); per_cu = 1; }
        (void)hipGetLastError();
        grid = cus;
        fprintf(stderr, "kernel_launch: %d CUs, occupancy %d, grid %d\n", cus, per_cu, grid);
    }
    if (grid < 0) return;
    hipMemsetAsync((char*)d_ws + WS_CTL, 0, CTL_ZERO_BYTES, stream);
    Args a{};
    for (int i = 0; i < 28; ++i) a.in[i] = d_in[i];
    a.out = (float*)d_out; a.ws = (unsigned char*)d_ws;
#if MK_MODE == 0
    for (int p = 0; p < NPHASE; ++p) { a.ph_lo = p; a.ph_hi = p + 1; hipLaunchKernelGGL(mk_fwd, dim3(grid), dim3(512), LDS_BYTES, stream, a); }
#elif MK_MODE == 1
    a.ph_lo = 0; a.ph_hi = NPHASE;
    void* kargs[] = {&a};
    hipError_t e = hipLaunchCooperativeKernel((const void*)mk_fwd, dim3(grid), dim3(512), kargs, LDS_BYTES, stream);
    if (e != hipSuccess) fprintf(stderr, "cooperative launch failed: %s (grid %d)\n", hipGetErrorString(e), grid);
#else
    a.ph_lo = 0; a.ph_hi = NPHASE;
    hipLaunchKernelGGL(mk_fwd, dim3(grid), dim3(512), LDS_BYTES, stream, a);
#endif
}
```

```cpp
#include <hip/hip_runtime.h>
#include <hip/hip_cooperative_groups.h>
#include <cstdio>
#include <cstdint>
#include <cmath>
namespace cg = cooperative_groups;

#ifndef PC_BF16
#define PC_FP8 1
#endif
#ifndef NSA_MERGED_PASSES
#define NSA_SPLIT_PASSES 1
#endif
#ifndef X1_AS_F32
#define X1_BF16 1
#endif
#ifndef PF3_BF16
#define PF3_FP8 1
#endif
#define LAS __attribute__((address_space(3)))
#define GAS __attribute__((address_space(1)))
typedef unsigned short bf16_t;
typedef short bf16x8 __attribute__((ext_vector_type(8)));
typedef short s16x4 __attribute__((ext_vector_type(4)));
typedef float f32x2 __attribute__((ext_vector_type(2)));
typedef float f32x4 __attribute__((ext_vector_type(4)));
typedef float f32x16 __attribute__((ext_vector_type(16)));
typedef unsigned u32x2 __attribute__((ext_vector_type(2)));
typedef unsigned u32x4 __attribute__((ext_vector_type(4)));
typedef __bf16 bf16x2_t __attribute__((ext_vector_type(2)));

constexpr int NB = 32, SEQ = 2048, NT_TOK = NB * SEQ, DM = 1024;
constexpr int IN_COLS = 4504, NSLOT = 72, NPROJ = NSLOT * 64;
constexpr int NEXP = 32, EFF = 512;
constexpr float EPS = 1e-6f;
constexpr float C2 = 0.125f * 1.4426950408889634f;
constexpr int SL_QA = 0, SL_KCMP = 8, SL_VCMP = 10, SL_KSLC = 12, SL_VSLC = 14, SL_KWIN = 16, SL_VWIN = 18, SL_QB = 20, SL_KB = 26, SL_VB = 32, SL_GMA = 38, SL_GMB = 54, SL_GA = 70;

constexpr size_t MiB = 1u << 20;
constexpr size_t WS_CTL = 0, CTL_ZERO_BYTES = 256 * 1024;
constexpr size_t WS_MOD = 1 * MiB;
constexpr size_t WS_SMALL = 2 * MiB;
constexpr size_t WS_ROPE = 3 * MiB;
constexpr size_t WS_CROPE = 19 * MiB;
constexpr size_t WS_WIN = 20 * MiB;
constexpr size_t WS_WUPA = 29 * MiB;
constexpr size_t WS_WUPB = 30 * MiB;
constexpr size_t WS_WOUT = 31 * MiB;
constexpr size_t WS_CW1 = 33 * MiB;
constexpr size_t WS_CW2 = 35 * MiB;
constexpr size_t WS_WGU = 36 * MiB;
constexpr size_t WS_WD = 100 * MiB;
constexpr size_t WS_KC = 132 * MiB;
constexpr size_t WS_CHID = 134 * MiB;
constexpr size_t WS_LSE = 142 * MiB;
constexpr size_t WS_ROWSS = 144 * MiB;
constexpr size_t WS_PICK = 148 * MiB;
constexpr size_t WS_LIST = 150 * MiB;
constexpr size_t WS_H = 160 * MiB;
constexpr size_t WS_Y = 288 * MiB;
constexpr size_t WS_R1 = 416 * MiB;
constexpr size_t WS_R2 = 720 * MiB;
constexpr size_t WS_END = 992 * MiB;
constexpr size_t SLOT_BYTES = (size_t)NT_TOK * 64 * 2;
__host__ __device__ __forceinline__ size_t slot_off(int s) { return s < 38 ? WS_R1 + (size_t)s * SLOT_BYTES : WS_R2 + (size_t)(s - 38) * SLOT_BYTES; }
constexpr int CW_BAR = 4096;
constexpr int CW_CNT = 16384;

constexpr int LDS_BYTES = 163840;
constexpr int LDS_STAGE = 0;
constexpr int LDS_X = 131072;
constexpr int LDS_MISC = LDS_BYTES - 256;
constexpr int LDS_TOK = 135168;
constexpr int LDS_EXP = 147456;

__device__ __forceinline__ int lane_now() { int l; asm volatile("v_mbcnt_lo_u32_b32 %0, -1, 0\n\tv_mbcnt_hi_u32_b32 %0, -1, %0" : "=v"(l)); return l; }
#define RLX_AGENT __ATOMIC_RELAXED, __HIP_MEMORY_SCOPE_AGENT
#define LDS_WAIT() asm volatile("s_waitcnt lgkmcnt(0)" ::: "memory")
#define VM_WAIT() asm volatile("s_waitcnt vmcnt(0)" ::: "memory")
__device__ __forceinline__ unsigned cvtpk(float lo, float hi) { f32x2 v = {lo, hi}; bf16x2_t b = __builtin_convertvector(v, bf16x2_t); return __builtin_bit_cast(unsigned, b); }
__device__ __forceinline__ unsigned pk4_fp8(float a, float b, float c, float d) { int w = 0; w = __builtin_amdgcn_cvt_pk_fp8_f32(a, b, w, false); w = __builtin_amdgcn_cvt_pk_fp8_f32(c, d, w, true); return (unsigned)w; }
__device__ __forceinline__ float clamp448(float x) { return __builtin_amdgcn_fmed3f(x, -448.f, 448.f); }
__device__ __forceinline__ float bf2f(unsigned short h) { return __uint_as_float(((unsigned)h) << 16); }
__device__ __forceinline__ float bflo(unsigned w) { return __uint_as_float(w << 16); }
__device__ __forceinline__ float bfhi(unsigned w) { return __uint_as_float(w & 0xffff0000u); }
__device__ __forceinline__ float wave_sum(float v) {
    v += __uint_as_float(__builtin_amdgcn_update_dpp(0u, __float_as_uint(v), 0xB1, 0xf, 0xf, true));
    v += __uint_as_float(__builtin_amdgcn_update_dpp(0u, __float_as_uint(v), 0x4E, 0xf, 0xf, true));
    v += __uint_as_float(__builtin_amdgcn_update_dpp(0u, __float_as_uint(v), 0x141, 0xf, 0xf, true));
    v += __uint_as_float(__builtin_amdgcn_update_dpp(0u, __float_as_uint(v), 0x140, 0xf, 0xf, true));
    v += __uint_as_float(__builtin_amdgcn_update_dpp(0u, __float_as_uint(v), 0x142, 0xa, 0xf, false));
    v += __uint_as_float(__builtin_amdgcn_update_dpp(0u, __float_as_uint(v), 0x143, 0xc, 0xf, false));
    return __uint_as_float(__builtin_amdgcn_readlane(__float_as_uint(v), 63));
}
__device__ __forceinline__ float sigmoidf_(float x) { return __builtin_amdgcn_rcpf(1.0f + __builtin_amdgcn_exp2f(-1.4426950408889634f * x)); }
__device__ __forceinline__ float siluf_(float x) { return x * __builtin_amdgcn_rcpf(1.0f + __builtin_amdgcn_exp2f(-1.4426950408889634f * x)); }
__host__ __device__ __forceinline__ int slot_col0(int H) { return H < 8 ? 64 * H : H < 20 ? 512 + 64 * (H - 8) : H < 38 ? 1304 + 64 * (H - 20) : H < 70 ? 2456 + 64 * (H - 38) : H == 70 ? 1280 : 0; }
__host__ __device__ __forceinline__ int slot_valid(int H) { return H < 70 ? 64 : H == 70 ? 24 : 0; }

#define XB_TMO      128
#define XB_XCNT(j)  (256  + 64 * (j))
#define XB_XSUB(j)  (1280 + 64 * (j))
#define XB_XGEN(j)  (2304 + 64 * (j))
#define XB_TOP      3328
#define XB_TOPGEN   3392
#define XCD_BAR_WORDS 3456
#define XB_SPIN_CAP (1u << 22)
__device__ __forceinline__ unsigned xb_ld(unsigned* p)              { return __hip_atomic_load(p, __ATOMIC_RELAXED, __HIP_MEMORY_SCOPE_AGENT); }
__device__ __forceinline__ unsigned xb_add(unsigned* p, unsigned v) { return __hip_atomic_fetch_add(p, v, __ATOMIC_RELAXED, __HIP_MEMORY_SCOPE_AGENT); }
__device__ __forceinline__ unsigned xb_xcc_id() { return (unsigned)__builtin_amdgcn_s_getreg((3 << 11) | 20) & 0xFu; }
#define XB_SPIN(cond, bar) do { unsigned _sp = 0; while (cond) { __builtin_amdgcn_s_sleep(1); \
    if ((++_sp & 255u) == 0u) { if (xb_ld(&(bar)[XB_TMO])) break; if (_sp > XB_SPIN_CAP) { atomicAdd(&(bar)[XB_TMO], 1u); break; } } } } while (0)
struct XcdBarrier { unsigned* bar; unsigned x; volatile LAS unsigned* st; int wave; };
__device__ __forceinline__ XcdBarrier xcd_barrier_post(unsigned* bar, volatile LAS unsigned* st, int wave) {
    XcdBarrier b; b.bar = bar; b.x = xb_xcc_id(); b.st = st; b.wave = wave;
    if (wave == 0 && lane_now() == 0) (void)xb_add(&bar[XB_XCNT(b.x)], 1u);
    return b;
}
__device__ __forceinline__ void xcd_barrier_complete(unsigned* bar, unsigned x, unsigned& nloc, unsigned& nx) {
    const unsigned G = gridDim.x * gridDim.y * gridDim.z;
    unsigned sum, cnt, mine, sp = 0u;
    for (;;) {
        sum = 0u; cnt = 0u; mine = 0u;
#pragma unroll
        for (unsigned j = 0; j < 16; ++j) { const unsigned c = xb_ld(&bar[XB_XCNT(j)]); sum += c; cnt += (c > 0u) ? 1u : 0u; mine = (j == x) ? c : mine; }
        if (sum == G) break;
        __builtin_amdgcn_s_sleep(1);
        if ((++sp & 255u) == 0u) { if (xb_ld(&bar[XB_TMO])) break; if (sp > XB_SPIN_CAP) { atomicAdd(&bar[XB_TMO], 1u); break; } }
    }
    nloc = mine > 0u ? mine : 1u; nx = cnt > 0u ? cnt : 1u;
}
__device__ __forceinline__ void xcd_barrier(const XcdBarrier& b) {
    asm volatile("s_waitcnt vmcnt(0)" ::: "memory");
    __syncthreads();
    if (b.wave == 0 && lane_now() == 0) {
        unsigned* bar = b.bar;
        __builtin_amdgcn_s_waitcnt(0);
        unsigned nloc = b.st[0], nx = b.st[1];
        if (nloc == 0u) { xcd_barrier_complete(bar, b.x, nloc, nx); b.st[0] = nloc; b.st[1] = nx; }
        const unsigned old = xb_add(&bar[XB_XSUB(b.x)], 1u);
        const unsigned gen = old / nloc;
        if (old + 1u == (gen + 1u) * nloc) {
            __builtin_amdgcn_fence(__ATOMIC_RELEASE, "agent");
            asm volatile("s_waitcnt vmcnt(0)" ::: "memory");
            const unsigned og = xb_add(&bar[XB_TOP], 1u);
            const unsigned tg = og / nx;
            if (og + 1u == (tg + 1u) * nx) xb_add(&bar[XB_TOPGEN], 1u);
            else XB_SPIN(xb_ld(&bar[XB_TOPGEN]) == tg, bar);
            __builtin_amdgcn_fence(__ATOMIC_ACQUIRE, "agent");
            xb_add(&bar[XB_XGEN(b.x)], 1u);
            asm volatile("s_waitcnt vmcnt(0)" ::: "memory");
        } else {
            XB_SPIN(xb_ld(&bar[XB_XGEN(b.x)]) == gen, bar);
            __builtin_amdgcn_fence(__ATOMIC_ACQUIRE, "agent");
            asm volatile("s_waitcnt vmcnt(0)" ::: "memory");
        }
    }
    __syncthreads();
}
namespace pg8 {
constexpr int BM = 256, BK = 64, HALF = 128, HTB = HALF * BK * 2, STAGE_BYTES = 8 * HTB;
__host__ __device__ __forceinline__ int lds_byte(int r, int c) { const int st = (r >> 4) * 2 + (c >> 5), rr = r & 15, cc = c & 31, ob = rr * 64 + cc * 2; return st * 1024 + (ob ^ (((ob >> 9) & 1) << 5)); }
__host__ __device__ __forceinline__ void stage_rc(int b, int& R, int& C) { const int st = b / 1024, sb = b % 1024, swz = sb ^ (((sb >> 9) & 1) << 5); R = (st >> 1) * 16 + swz / 64; C = (st & 1) * 32 + (swz % 64) / 2; }
__host__ __device__ __forceinline__ int perm32(int rho) { const int n = rho >> 4, i = rho & 15; return 8 * (i >> 2) + 4 * n + (i & 3); }

typedef int v4i_t __attribute__((ext_vector_type(4)));
typedef int v8i_t __attribute__((ext_vector_type(8)));
struct Unit { int pm, pn, e, mt; };

template <int N> __device__ __forceinline__ void waitv_n() {
    static_assert(N == 8 || N == 16 || N == 24 || N == 40, "add the immediate");
    if constexpr (N == 8) asm volatile("s_waitcnt vmcnt(8)" ::: "memory");
    else if constexpr (N == 16) asm volatile("s_waitcnt vmcnt(16)" ::: "memory");
    else if constexpr (N == 24) asm volatile("s_waitcnt vmcnt(24)" ::: "memory");
    else asm volatile("s_waitcnt vmcnt(40)" ::: "memory");
}
template <class Epi, class Sched, bool ALIGN_EPI = true, bool FP8 = false>
__device__ __forceinline__ void gemm_phase(LAS unsigned char* lds, const int wid, const int K, const Sched& S, const Epi& E) {
    const int lane = lane_now(), tid = wid * 64 + lane, wr = wid >> 2, wc = wid & 3, fr = lane & 15, fq = lane >> 4;
    const int nt = K / BK;
    int Rr[2], Cc[2]; unsigned voffB[2];
#pragma unroll
    for (int i = 0; i < 2; ++i) { stage_rc(tid * 16 + i * 8192, Rr[i], Cc[i]); const int Rb = Epi::PERM ? ((Rr[i] & ~31) + perm32(Rr[i] & 31)) : Rr[i];
        voffB[i] = (unsigned)(Rb * S.ldb + Cc[i]) * 2u; }
    const size_t kstep = (size_t)(BK * 2);
    const size_t hstepB = (size_t)HALF * S.ldb * 2;
    const unsigned ldsw = (unsigned)wid * 1024u;
    const int aoff = lds_byte(wr * 64 + fr, fq * 8), boff = lds_byte(wc * 32 + fr, fq * 8);
#define PG8_SA(b, h) (((b) * 2 + (h)) * HTB)
#define PG8_SB(b, h) ((4 + (b) * 2 + (h)) * HTB)
#ifdef PROBE_SKIP
#define PG8_SK(bit) (E.noepi && (PROBE_SKIP & (bit)))
#else
#define PG8_SK(bit) false
#endif
#define PG8_STAGE(bufoff, gbase, voff) do { if (!PG8_SK(1)) _Pragma("unroll") for (int _i = 0; _i < 2; ++_i) \
        __builtin_amdgcn_global_load_lds((const unsigned*)((const char*)(gbase) + (voff)[_i]), (LAS unsigned*)(lds + (bufoff) + ldsw + _i * 8192), 16, 0, 0); } while (0)
#define PG8_LDA(dst, b, h) do { if (PG8_SK(2)) {} else if constexpr (FP8) { _Pragma("unroll") for (int m = 0; m < 4; ++m) { const v4i_t lo_ = *(const LAS v4i_t*)(lds + PG8_SA(b, h) + aoff + m * 2048), hi_ = *(const LAS v4i_t*)(lds + PG8_SA(b, h) + aoff + m * 2048 + 1024); \
            dst##8[m] = __builtin_shufflevector(lo_, hi_, 0, 1, 2, 3, 4, 5, 6, 7); } } \
        else { _Pragma("unroll") for (int m = 0; m < 4; ++m) _Pragma("unroll") for (int k = 0; k < 2; ++k) dst[m][k] = *(const LAS bf16x8*)(lds + PG8_SA(b, h) + aoff + m * 2048 + k * 1024); } } while (0)
#define PG8_LDB(dst, b, h) do { if (PG8_SK(2)) {} else if constexpr (FP8) { _Pragma("unroll") for (int n = 0; n < 2; ++n) { const v4i_t lo_ = *(const LAS v4i_t*)(lds + PG8_SB(b, h) + boff + n * 2048), hi_ = *(const LAS v4i_t*)(lds + PG8_SB(b, h) + boff + n * 2048 + 1024); \
            dst##8[n] = __builtin_shufflevector(lo_, hi_, 0, 1, 2, 3, 4, 5, 6, 7); } } \
        else { _Pragma("unroll") for (int n = 0; n < 2; ++n) _Pragma("unroll") for (int k = 0; k < 2; ++k) dst[n][k] = *(const LAS bf16x8*)(lds + PG8_SB(b, h) + boff + n * 2048 + k * 1024); } } while (0)
#ifdef PROBE_HALF
#define PG8_SKIP(ai) (E.noepi && (ai) >= PROBE_HALF)
#else
#define PG8_SKIP(ai) false
#endif
#define PG8_MMA(ai, bj, At, Bt) do { __builtin_amdgcn_s_setprio(1); \
        if (PG8_SKIP(ai)) {} else if constexpr (FP8) { _Pragma("unroll") for (int m = 0; m < 4; ++m) _Pragma("unroll") for (int n = 0; n < 2; ++n) \
            asm volatile("v_mfma_f32_16x16x128_f8f6f4 %0, %1, %2, %0" : "+v"(acc[ai][bj][m][n]) : "v"(Bt##8[n]), "v"(At##8[m])); } \
        else { _Pragma("unroll") for (int m = 0; m < 4; ++m) _Pragma("unroll") for (int n = 0; n < 2; ++n) _Pragma("unroll") for (int k = 0; k < 2; ++k) \
            acc[ai][bj][m][n] = __builtin_amdgcn_mfma_f32_16x16x32_bf16(Bt[n][k], At[m][k], acc[ai][bj][m][n], 0, 0, 0); } \
        __builtin_amdgcn_s_setprio(0); } while (0)
#define PG8_MMA0(ai, bj, At, Bt) do { __builtin_amdgcn_s_setprio(1); \
        _Pragma("unroll") for (int m = 0; m < 4; ++m) _Pragma("unroll") for (int n = 0; n < 2; ++n) \
            asm volatile("v_mfma_f32_16x16x128_f8f6f4 %0, %1, %2, 0" : "=&v"(acc[ai][bj][m][n]) : "v"(Bt##8[n]), "v"(At##8[m])); \
        __builtin_amdgcn_s_setprio(0); } while (0)
#define PG8_WAIT_V(n) asm volatile("s_waitcnt vmcnt(" #n ")" ::: "memory")
#ifndef WV_A
#define WV_A 8
#define WV_B 8
#endif
#define PG8_STR2(x) #x
#define PG8_STR(x) PG8_STR2(x)
#define PG8_WAIT_V_A asm volatile("s_waitcnt vmcnt(" PG8_STR(WV_A) ")" ::: "memory")
#define PG8_WAIT_V_B asm volatile("s_waitcnt vmcnt(" PG8_STR(WV_B) ")" ::: "memory")
#ifdef PG8_RELAX_FIRST
#define PG8_WAIT_V_FIRST do { if (FP8 && Epi::NSTORE > 0 && t == 0 && ui > 0) waitv_n<8 + (Epi::NSTORE > 0 ? Epi::NSTORE : 0)>(); else PG8_WAIT_V_A; } while (0)
#else
#define PG8_WAIT_V_FIRST PG8_WAIT_V_A
#endif
#define PG8_WAIT_L(n) asm volatile("s_waitcnt lgkmcnt(" #n ")" ::: "memory")
#define PG8_BAR __builtin_amdgcn_s_barrier()
#define PG8_SCHED __builtin_amdgcn_sched_barrier(0)
    Unit cur, nxt; int ui = 0;
    if (!S.next(0, cur)) return;
    if constexpr (Epi::DEPHASE > 1) {
        const unsigned slot = (unsigned)S.dephase_id() % Epi::DEPHASE;
        const unsigned long long t0 = __builtin_amdgcn_s_memrealtime(), dl = (unsigned long long)(slot * (unsigned)Epi::DEPHASE_TICKS) / Epi::DEPHASE;
        while (__builtin_amdgcn_s_memrealtime() - t0 < dl) __builtin_amdgcn_s_sleep(8);
    }
    f32x4 acc[2][2][4][2];
    if constexpr (!FP8) {
#pragma unroll
    for (int a = 0; a < 2; ++a)
#pragma unroll
        for (int b = 0; b < 2; ++b)
#pragma unroll
            for (int m = 0; m < 4; ++m)
#pragma unroll
                for (int n = 0; n < 2; ++n) acc[a][b][m][n] = (f32x4){0.f, 0.f, 0.f, 0.f};
    }
    bf16x8 At[4][2], B0[2][2], B1[2][2]; v8i_t At8[4], B08[2], B18[2];
#ifdef PROBE_SKIP
    for (int m = 0; m < 4; ++m) At8[m] = (v8i_t){0,0,0,0,0,0,0,0}; for (int n = 0; n < 2; ++n) { B08[n] = At8[0]; B18[n] = At8[0]; }
#endif
    unsigned vaC[2][2], vaN[2][2];
#pragma unroll
    for (int h = 0; h < 2; ++h)
#pragma unroll
        for (int i = 0; i < 2; ++i) vaC[h][i] = S.a_voff(cur, 0, h, Rr[i], Cc[i]);
    const char* cA = S.a_base(cur); const char* cB = S.b_base(cur);
    PG8_STAGE(PG8_SB(0, 0), cB, voffB); PG8_STAGE(PG8_SB(0, 1), cB + hstepB, voffB); PG8_STAGE(PG8_SA(0, 0), cA, vaC[0]); PG8_STAGE(PG8_SA(0, 1), cA, vaC[1]);
    if (wr == 1) PG8_BAR;
    PG8_WAIT_V(2); PG8_BAR;
    PG8_STAGE(PG8_SB(1, 0), cB + kstep, voffB); PG8_STAGE(PG8_SA(1, 0), cA + kstep, vaC[0]); PG8_STAGE(PG8_SB(1, 1), cB + hstepB + kstep, voffB);
    PG8_WAIT_V(6); PG8_BAR;
    for (;;) {
        const bool has_next = S.next(ui + 1, nxt);
        const char* nA = cA; const char* nB = cB;
        if (has_next) { nA = S.a_base(nxt); nB = S.b_base(nxt);
#pragma unroll
            for (int h = 0; h < 2; ++h)
#pragma unroll
                for (int i = 0; i < 2; ++i) vaN[h][i] = S.a_voff(nxt, ui + 1, h, Rr[i], Cc[i]);
        } else {
#pragma unroll
            for (int h = 0; h < 2; ++h)
#pragma unroll
                for (int i = 0; i < 2; ++i) vaN[h][i] = vaC[h][i];
        }
#pragma unroll 1
        for (int t = 0; t < nt; t += 2) {
            const bool last = (t == nt - 2);
            const char* a1 = cA + (size_t)(t + 1) * kstep;
            const char* a2 = last ? nA : cA + (size_t)(t + 2) * kstep; const char* b2 = last ? nB : cB + (size_t)(t + 2) * kstep;
            const char* a3 = a2 + kstep; const char* b3 = b2 + kstep;
            unsigned va2[2][2];
#pragma unroll
            for (int h = 0; h < 2; ++h)
#pragma unroll
                for (int i = 0; i < 2; ++i) va2[h][i] = last ? vaN[h][i] : vaC[h][i];
            PG8_LDB(B0, 0, 0); PG8_LDB(B1, 0, 1); PG8_SCHED; PG8_LDA(At, 0, 0); PG8_STAGE(PG8_SA(1, 1), a1, vaC[1]);
            PG8_WAIT_V_FIRST; PG8_WAIT_L(0); PG8_BAR; if (FP8 && t == 0) { PG8_MMA0(0, 0, At, B0); PG8_MMA0(0, 1, At, B1); } else { PG8_MMA(0, 0, At, B0); PG8_MMA(0, 1, At, B1); } PG8_BAR; PG8_SCHED;
            PG8_LDA(At, 0, 1); PG8_STAGE(PG8_SB(0, 0), b2, voffB); PG8_STAGE(PG8_SB(0, 1), b2 + hstepB, voffB); PG8_STAGE(PG8_SA(0, 0), a2, va2[0]);
            PG8_WAIT_V_FIRST; PG8_WAIT_L(0); PG8_BAR; if (FP8 && t == 0) { PG8_MMA0(1, 0, At, B0); PG8_MMA0(1, 1, At, B1); } else { PG8_MMA(1, 0, At, B0); PG8_MMA(1, 1, At, B1); } PG8_BAR; PG8_SCHED;
            PG8_LDB(B0, 1, 0); PG8_LDB(B1, 1, 1); PG8_SCHED; PG8_LDA(At, 1, 0); PG8_STAGE(PG8_SA(0, 1), a2, va2[1]);
            PG8_WAIT_V_A; PG8_WAIT_L(0); PG8_BAR; PG8_MMA(0, 0, At, B0); PG8_MMA(0, 1, At, B1); PG8_BAR; PG8_SCHED;
            PG8_LDA(At, 1, 1); PG8_STAGE(PG8_SB(1, 0), b3, voffB); PG8_STAGE(PG8_SB(1, 1), b3 + hstepB, voffB); PG8_STAGE(PG8_SA(1, 0), a3, va2[0]);
            PG8_WAIT_V_B; PG8_WAIT_L(0); PG8_BAR; PG8_MMA(1, 0, At, B0); PG8_MMA(1, 1, At, B1); PG8_BAR; PG8_SCHED;
            if constexpr (Epi::MIDK > 0) { if (t + 2 == Epi::MIDK) {
                if constexpr (FP8) asm volatile("s_nop 15\n\ts_nop 15" ::: "memory");
                int fr_ = fr, fq_ = fq; asm volatile("" : "+v"(fr_), "+v"(fq_)); E.mid(acc, cur, wr, wc, fr_, fq_); } }
        }
        if constexpr (ALIGN_EPI) { if (wr == 0) PG8_BAR; }
        if constexpr (FP8) asm volatile("s_nop 15\n\ts_nop 15" ::: "memory");
#ifdef PROBE_NOEPI
        if (!E.noepi)
#endif
        { int fr_ = fr, fq_ = fq; asm volatile("" : "+v"(fr_), "+v"(fq_)); E(acc, cur, ui, wr, wc, fr_, fq_); }
        if (!has_next) break;
        if constexpr (!FP8) {
#pragma unroll
        for (int a = 0; a < 2; ++a)
#pragma unroll
            for (int b = 0; b < 2; ++b)
#pragma unroll
                for (int m = 0; m < 4; ++m)
#pragma unroll
                    for (int n = 0; n < 2; ++n) acc[a][b][m][n] = (f32x4){0.f, 0.f, 0.f, 0.f};
        }
        cur = nxt; cA = nA; cB = nB; ++ui;
#pragma unroll
        for (int h = 0; h < 2; ++h)
#pragma unroll
            for (int i = 0; i < 2; ++i) vaC[h][i] = vaN[h][i];
        if constexpr (ALIGN_EPI) { if (wr == 1) PG8_BAR; }
    }
    PG8_WAIT_V(0);
    if constexpr (!ALIGN_EPI) { if (wr == 0) PG8_BAR; }
    PG8_BAR;
#undef PG8_SA
#undef PG8_SB
#undef PG8_STAGE
#undef PG8_LDA
#undef PG8_LDB
#undef PG8_MMA
#undef PG8_MMA0
#undef PG8_WAIT_V
#undef PG8_WAIT_V_A
#undef PG8_WAIT_V_B
#undef PG8_WAIT_V_FIRST
#undef PG8_WAIT_L
#undef PG8_BAR
#undef PG8_SCHED
}

struct DenseSched {
    const char* A; const char* Bt; int lda, ldb; int nM, nN, nwg, G, c; bool hot = false;
    __device__ __forceinline__ void init(const void* A_, int lda_, const void* Bt_, int ldb_, int M, int N, int G_, int c_) {
        A = (const char*)A_; Bt = (const char*)Bt_; lda = lda_; ldb = ldb_; nM = M / BM; nN = N / BM; nwg = nM * nN; G = G_; c = c_; }
    __device__ __forceinline__ bool next(int i, Unit& u) const {
        const long L = (long)i * G + c; if (L >= nwg) return false;
        int wgid = (int)L; { const int q = nwg / 8, r = nwg % 8, xcd = wgid % 8, off = wgid / 8; wgid = (xcd < r ? xcd * (q + 1) : r * (q + 1) + (xcd - r) * q) + off; }
#ifndef DENSE_WGM
#define DENSE_WGM 8
#endif
        const int nig = DENSE_WGM * nN, gid = wgid / nig, fm = gid * DENSE_WGM, gsz = (nM - fm) < DENSE_WGM ? (nM - fm) : DENSE_WGM;
        u.pm = fm + ((wgid % nig) % gsz); u.pn = (wgid % nig) / gsz; u.e = 0; u.mt = 0; return true;
    }
#ifdef PROBE_HOT
    __device__ __forceinline__ const char* a_base(const Unit& u) const { return A + (size_t)(hot ? (c & 63) : u.pm) * BM * lda * 2; }
    __device__ __forceinline__ const char* b_base(const Unit& u) const { return Bt + (size_t)(hot ? (c & 15) : u.pn) * BM * ldb * 2; }
#else
    __device__ __forceinline__ const char* a_base(const Unit& u) const { return A + (size_t)u.pm * BM * lda * 2; }
    __device__ __forceinline__ const char* b_base(const Unit& u) const { return Bt + (size_t)u.pn * BM * ldb * 2; }
#endif
    __device__ __forceinline__ unsigned a_voff(const Unit&, int, int h, int R, int C) const { return (unsigned)((h * HALF + R) * lda + C) * 2u; }
    __device__ __forceinline__ int dephase_id() const { return c >> 3; }
};
}
struct Args { const void* in[28]; float* out; unsigned char* ws; int ph_lo, ph_hi; };
struct Frame {
    LAS unsigned char* lds; volatile LAS unsigned* MISC; unsigned* ctl; unsigned char* ws;
    int wave, vcu, G;
};
#define F_LANE() lane_now()
#define F_TID() (F.wave * 64 + lane_now())
#define WSP(T_, off) ((T_*)(F.ws + (off)))

__device__ __forceinline__ void transpose_item(const float* src, int src_ld, int k0, int n0, int nvalid, bf16_t* dst, int dst_ld, int drow0, LAS float* scr, int lane) {
    const int cl = lane & 31;
    float tv[32];
#pragma unroll
    for (int i = 0; i < 32; ++i) { const int kk = 2 * i + (lane >> 5); tv[i] = (cl < nvalid) ? src[(size_t)(k0 + kk) * src_ld + n0 + cl] : 0.f; }
#pragma unroll
    for (int i = 0; i < 32; ++i) { const int kk = 2 * i + (lane >> 5); scr[kk * 33 + cl] = tv[i]; }
    LDS_WAIT(); asm volatile("" ::: "memory");
    const int c = lane & 7;
#pragma unroll
    for (int j = 0; j < 4; ++j) { const int n = (lane >> 3) + 8 * j; const LAS float* s = scr + (8 * c) * 33 + n;
        u32x4 o; o.x = cvtpk(s[0 * 33], s[1 * 33]); o.y = cvtpk(s[2 * 33], s[3 * 33]); o.z = cvtpk(s[4 * 33], s[5 * 33]); o.w = cvtpk(s[6 * 33], s[7 * 33]);
        *(u32x4*)(dst + (size_t)(drow0 + n) * dst_ld + k0 + 8 * c) = o; }
    LDS_WAIT(); asm volatile("" ::: "memory");
}

__device__ __forceinline__ void transpose_item_fp8(const float* src, int src_ld, int k0, int n0, float sc, unsigned char* dst, int dst_ld, int drow0, LAS float* scr, int lane) {
    const int cl = lane & 31;
    float tv[32];
#pragma unroll
    for (int i = 0; i < 32; ++i) { const int kk = 2 * i + (lane >> 5); tv[i] = src[(size_t)(k0 + kk) * src_ld + n0 + cl] * sc; }
#pragma unroll
    for (int i = 0; i < 32; ++i) { const int kk = 2 * i + (lane >> 5); scr[kk * 33 + cl] = tv[i]; }
    LDS_WAIT(); asm volatile("" ::: "memory");
    const int c = lane & 7;
#pragma unroll
    for (int j = 0; j < 4; ++j) { const int n = (lane >> 3) + 8 * j; const LAS float* s = scr + (8 * c) * 33 + n;
        u32x2 o; o.x = pk4_fp8(s[0 * 33], s[1 * 33], s[2 * 33], s[3 * 33]); o.y = pk4_fp8(s[4 * 33], s[5 * 33], s[6 * 33], s[7 * 33]);
        *(u32x2*)(dst + (size_t)(drow0 + n) * dst_ld + k0 + 8 * c) = o; }
    LDS_WAIT(); asm volatile("" ::: "memory");
}
__device__ __forceinline__ void transpose_item_fp8v(const float* src, int src_ld, int k0, int n0, int nvalid, float sc, unsigned char* dst, int dst_ld, int drow0, LAS float* scr, int lane) {
    const int cl = lane & 31;
    float tv[32];
#pragma unroll
    for (int i = 0; i < 32; ++i) { const int kk = 2 * i + (lane >> 5); tv[i] = (cl < nvalid) ? src[(size_t)(k0 + kk) * src_ld + n0 + cl] * sc : 0.f; }
#pragma unroll
    for (int i = 0; i < 32; ++i) { const int kk = 2 * i + (lane >> 5); scr[kk * 33 + cl] = tv[i]; }
    LDS_WAIT(); asm volatile("" ::: "memory");
    const int c = lane & 7;
#pragma unroll
    for (int j = 0; j < 4; ++j) { const int n = (lane >> 3) + 8 * j; const LAS float* s = scr + (8 * c) * 33 + n;
        u32x2 o; o.x = pk4_fp8(s[0 * 33], s[1 * 33], s[2 * 33], s[3 * 33]); o.y = pk4_fp8(s[4 * 33], s[5 * 33], s[6 * 33], s[7 * 33]);
        *(u32x2*)(dst + (size_t)(drow0 + n) * dst_ld + k0 + 8 * c) = o; }
    LDS_WAIT(); asm volatile("" ::: "memory");
}
__device__ __forceinline__ void pa_prologue(Frame& F, const Args& a) {
    const float* c_in = (const float*)a.in[1]; const int* pos = (const int*)a.in[2];
    const float* w_ada = (const float*)a.in[3]; const float* b_ada = (const float*)a.in[4];
    {
        constexpr int MU = 256, MC = 24;
        LAS float* sc = (LAS float*)(F.lds);
        if ((int)blockIdx.x < MU) { for (int idx = F_TID(); idx < 32 * 1024; idx += 512) { const int k = idx >> 5, b = idx & 31; sc[idx] = siluf_(c_in[b * 1024 + k]); } }
        __syncthreads();
        for (int u = blockIdx.x; u < MU; u += F.G) {
            const int ln = F_LANE(); const bool on = ln < MC; const int n = MC * u + (on ? ln : 0);
            float acc[32];
#pragma unroll
            for (int b = 0; b < 32; ++b) acc[b] = 0.f;
            const float* wp = w_ada + (size_t)(128 * F.wave) * 6144 + n;
            const LAS float* sp = sc + (128 * F.wave) * 32;
#pragma unroll 1
            for (int k0 = 0; k0 < 128; k0 += 16) {
                float wv[16];
#pragma unroll
                for (int j = 0; j < 16; ++j) wv[j] = wp[(size_t)(k0 + j) * 6144];
#pragma unroll
                for (int j = 0; j < 16; ++j)
#pragma unroll
                    for (int b4 = 0; b4 < 8; ++b4) { const f32x4 s = *(const LAS f32x4*)(sp + (k0 + j) * 32 + 4 * b4);
                        acc[4 * b4] += s[0] * wv[j]; acc[4 * b4 + 1] += s[1] * wv[j]; acc[4 * b4 + 2] += s[2] * wv[j]; acc[4 * b4 + 3] += s[3] * wv[j]; }
            }
            __syncthreads();
            LAS float* red = (LAS float*)(F.lds);
#pragma unroll
            for (int b = 0; b < 32; ++b) red[(F.wave * 32 + b) * 64 + ln] = acc[b];
            __syncthreads();
            float* mod = WSP(float, WS_MOD);
            for (int o = F_TID(); o < 32 * MC; o += 512) { const int b = o / MC, col = o % MC; float s = b_ada[MC * u + col];
#pragma unroll
                for (int w = 0; w < 8; ++w) s += red[(w * 32 + b) * 64 + col];
                mod[(size_t)b * 6144 + MC * u + col] = s; }
            __syncthreads();
            if (u + F.G < MU) { for (int idx = F_TID(); idx < 32 * 1024; idx += 512) { const int k = idx >> 5, b = idx & 31; sc[idx] = siluf_(c_in[b * 1024 + k]); } __syncthreads(); }
        }
    }
#if defined(PROBE_PA) && PROBE_PA == 2
    for (int rep_ = 0; rep_ < 2; ++rep_)
#endif
    {
        LAS float* scr = (LAS float*)(F.lds + F.wave * 16384);
        const int gw = F.vcu * 8 + F.wave, NGW = F.G * 8, lane = F_LANE();
        constexpr int I_WIN = 16 * 144, I_UPA = 8 * 32, I_UPB = 6 * 32, I_OUT = 16 * 32, I_CW1 = 32 * 8, I_CW2 = 4 * 2, I_GU = 16 * 32, I_WD = 8 * 32;
        constexpr int NITEMS = I_WIN + I_UPA + I_UPB + I_OUT + 2 * I_CW1 + 2 * I_CW2 + NEXP * (I_GU + I_WD);
        struct TItem { const float* src; unsigned char* dst; int src_ld, k0, n0, nvalid, dst_ld, drow0, esz; float sc; };
        auto decode = [&](int r) -> TItem {
            TItem d; d.nvalid = 32; d.sc = 64.f; d.esz = 1;
            if (r < I_WIN) { const int kb = r / 144, rb = r % 144, rho0 = 32 * rb, pn = rho0 >> 8, bj = (rho0 >> 7) & 1, wc = (rho0 >> 5) & 3, H = 4 * pn + wc;
                int nv = slot_valid(H) - 32 * bj; nv = nv < 0 ? 0 : (nv > 32 ? 32 : nv);
                d.src = (const float*)a.in[7]; d.src_ld = IN_COLS; d.k0 = 64 * kb; d.n0 = slot_col0(H) + 32 * bj; d.nvalid = nv;
                if (H >= SL_GMA && H < SL_GA) { const int q = (H - SL_GMA) & 15; d.n0 = slot_col0(H < SL_GMB ? SL_GMA : SL_GMB) + 256 * (q >> 2) + 128 * bj + 32 * (q & 3); }
                d.dst = F.ws + WS_WIN; d.dst_ld = 1024; d.drow0 = rho0; return d; } r -= I_WIN;
            if (r < I_UPA) { const int kb = r / 32, rb = r % 32; d.src = (const float*)a.in[18]; d.src_ld = 1024; d.k0 = 64 * kb; d.n0 = 32 * rb; d.dst = F.ws + WS_WUPA; d.dst_ld = 1024; d.drow0 = 32 * rb; return d; } r -= I_UPA;
            if (r < I_UPB) { const int kb = r / 32, rb = r % 32; d.src = (const float*)a.in[19]; d.src_ld = 1024; d.k0 = 64 * kb; d.n0 = 32 * rb; d.dst = F.ws + WS_WUPA + 512; d.dst_ld = 1024; d.drow0 = 32 * rb; return d; } r -= I_UPB;
            if (r < I_OUT) { const int kb = r / 32, rb = r % 32; d.src = (const float*)a.in[20]; d.src_ld = 1024; d.k0 = 64 * kb; d.n0 = 32 * rb; d.dst = F.ws + WS_WOUT; d.dst_ld = 1024; d.drow0 = 32 * rb; return d; } r -= I_OUT;
            if (r < 2 * I_CW1) { const int kv = r / I_CW1, q = r % I_CW1, kb = q / 8, rb = q % 8; d.esz = 2; d.sc = 1.f;
                d.src = (const float*)a.in[kv ? 14 : 11]; d.src_ld = 256; d.k0 = 64 * kb; d.n0 = 32 * rb; d.dst = F.ws + WS_CW1 + (size_t)kv * 256 * 2048 * 2; d.dst_ld = 2048; d.drow0 = 32 * rb; return d; } r -= 2 * I_CW1;
            if (r < 2 * I_CW2) { const int kv = r / I_CW2, q = r % I_CW2, kb = q / 2, rb = q % 2; d.esz = 2; d.sc = 1.f;
                d.src = (const float*)a.in[kv ? 15 : 12]; d.src_ld = 64; d.k0 = 64 * kb; d.n0 = 32 * rb; d.dst = F.ws + WS_CW2 + (size_t)kv * 64 * 256 * 2; d.dst_ld = 256; d.drow0 = 32 * rb; return d; } r -= 2 * I_CW2;
            const int e = r / (I_GU + I_WD); int q = r % (I_GU + I_WD);
            if (q < I_GU) { const int kb = q / 32, rb = q % 32, rho0 = 32 * rb, pn = rho0 >> 8, bj = (rho0 >> 7) & 1, y0 = rho0 & 127;
                d.src = (const float*)a.in[bj ? 26 : 25] + (size_t)e * 1024 * 512; d.src_ld = 512; d.k0 = 64 * kb; d.n0 = 128 * pn + y0; d.dst = F.ws + WS_WGU + (size_t)e * 1024 * 1024; d.dst_ld = 1024; d.drow0 = rho0; return d; }
            q -= I_GU; { const int kb = q / 32, rb = q % 32;
                d.src = (const float*)a.in[27] + (size_t)e * 512 * 1024; d.src_ld = 1024; d.k0 = 64 * kb; d.n0 = 32 * rb; d.dst = F.ws + WS_WD + (size_t)e * 1024 * 512; d.dst_ld = 512; d.drow0 = 32 * rb; return d; }
        };
        auto iload = [&](const TItem& d, float (&tv)[32]) { const int cl = lane & 31;
#pragma unroll
            for (int i = 0; i < 32; ++i) { const int kk = 2 * i + (lane >> 5); tv[i] = d.src[(size_t)(d.k0 + kk) * d.src_ld + d.n0 + cl]; } };
        auto istore = [&](const TItem& d, const float (&tv)[32]) { const int cl = lane & 31;
#pragma unroll
            for (int i = 0; i < 32; ++i) { const int kk = 2 * i + (lane >> 5); scr[kk * 33 + cl] = (cl < d.nvalid) ? tv[i] * d.sc : 0.f; }
            LDS_WAIT(); asm volatile("" ::: "memory");
            const int c = lane & 7;
#pragma unroll
            for (int j = 0; j < 4; ++j) { const int n = (lane >> 3) + 8 * j; const LAS float* s = scr + (8 * c) * 33 + n;
                unsigned char* dp = d.dst + ((size_t)(d.drow0 + n) * d.dst_ld + d.k0 + 8 * c) * d.esz;
                if (d.esz == 1) { u32x2 o; o.x = pk4_fp8(s[0 * 33], s[1 * 33], s[2 * 33], s[3 * 33]); o.y = pk4_fp8(s[4 * 33], s[5 * 33], s[6 * 33], s[7 * 33]); *(u32x2*)dp = o; }
                else { u32x4 o; o.x = cvtpk(s[0 * 33], s[1 * 33]); o.y = cvtpk(s[2 * 33], s[3 * 33]); o.z = cvtpk(s[4 * 33], s[5 * 33]); o.w = cvtpk(s[6 * 33], s[7 * 33]); *(u32x4*)dp = o; } }
            LDS_WAIT(); asm volatile("" ::: "memory"); };
        float ta[32], tb[32]; TItem da, db;
        int it = gw;
        if (it < NITEMS) { da = decode(it); iload(da, ta); }
#pragma unroll 1
        for (; it < NITEMS; it += 2 * NGW) {
            const bool hb = it + NGW < NITEMS; if (hb) { db = decode(it + NGW); iload(db, tb); }
            istore(da, ta);
            const bool ha = it + 2 * NGW < NITEMS; if (ha) { da = decode(it + 2 * NGW); iload(da, ta); }
            if (hb) istore(db, tb);
        }
    }
#if defined(PROBE_PA) && PROBE_PA == 3
    for (int rep_ = 0; rep_ < 2; ++rep_)
#endif
    {
        const int gt = F.vcu * 512 + F_TID(), NGT = F.G * 512;
        const double inv_rev = exp2(-(double)(gt & 31) * (13.287712379549449 / 32.0)) * 0.15915494309189535;
        float* ccos = WSP(float, WS_CROPE); float* csin = ccos + 32 * 128 * 32;
        for (int idx = gt; idx < 32 * 128 * 32; idx += NGT) { const int n = (idx >> 5) & 127, b = idx >> 12;
            const int tt = 16 * n + 31; const int p = pos[b * SEQ + (tt < SEQ ? tt : SEQ - 1)];
            const double rv = (double)p * inv_rev; const float fr = (float)(rv - rint(rv));
            ccos[idx] = __builtin_amdgcn_cosf(fr); csin[idx] = __builtin_amdgcn_sinf(fr); }
        bf16_t* rhi = (bf16_t*)(F.ws + WS_SMALL + 65536); bf16_t* rlo = (bf16_t*)(F.ws + WS_SMALL + 196608);
        const float* w_group = (const float*)a.in[21]; const float* w_router = (const float*)a.in[23];
        for (int idx = gt; idx < 64 * 1024; idx += NGT) { const int c = idx >> 10, k = idx & 1023;
            float w = 0.f; if (c < 4) w = w_group[k * 4 + c]; else if (c < 36) { const int g = (c - 4) >> 3, e = (c - 4) & 7; w = w_router[((size_t)g * 1024 + k) * 8 + e]; }
            const unsigned hi = cvtpk(w, 0.f) & 0xffffu; const float lo = w - bf2f((unsigned short)hi);
            rhi[idx] = (bf16_t)hi; rlo[idx] = (bf16_t)(cvtpk(lo, 0.f) & 0xffffu); }
        float* bias = WSP(float, WS_SMALL);
        for (int idx = gt; idx < 16 * 512; idx += NGT) { const int ks = idx >> 9, kv = (idx >> 8) & 1, col = idx & 255; const float* pe = (const float*)a.in[kv ? 13 : 10]; const float* w1 = (const float*)a.in[kv ? 14 : 11];
            float s = 0.f;
#pragma unroll 8
            for (int i = 128 * ks; i < 128 * ks + 128; ++i) s += pe[i] * w1[(size_t)i * 256 + col];
            bias[idx] = s; }
        for (int idx = gt; idx < 1024 * 32; idx += NGT) ((unsigned*)(F.ws + WS_WUPA))[(idx >> 5) * 256 + 224 + (idx & 31)] = 0u;
        if (gt < NEXP) F.ctl[CW_CNT + 64 * gt] = 0u;
    }
}

__device__ __forceinline__ void pb_modnorm(Frame& F, const float* x, const float* g, const float* mod, int sh_off, int sc_off, bf16_t* out, const float* g2) {
    const int gw = F.vcu * 8 + F.wave, NGW = F.G * 8;
    { float* a2 = WSP(float, WS_SMALL + 524288); for (int idx = F.vcu * 512 + F_TID(); idx < 32 * 1024; idx += F.G * 512) { const int b = idx >> 10, k = idx & 1023; a2[idx] = g2[k] * (1.0f + mod[(size_t)b * 6144 + 4096 + k]); } }
    const int ln = F_LANE();
#define PB_LOAD(V, M) do { const f32x4* xr_ = (const f32x4*)(x + (size_t)(M) * DM) + ln; _Pragma("unroll") for (int j = 0; j < 4; ++j) V[j] = xr_[64 * j]; } while (0)
#define PB_ROW(V, M) do { float s = 0.f; \
        _Pragma("unroll") for (int j = 0; j < 4; ++j) s += (V[j].x * V[j].x + V[j].y * V[j].y) + (V[j].z * V[j].z + V[j].w * V[j].w); \
        const float rstd = __builtin_amdgcn_rsqf(wave_sum(s) * (1.f / DM) + EPS); \
        unsigned* o4 = (unsigned*)((unsigned char*)out + (size_t)(M) * DM) + ln; \
        _Pragma("unroll") for (int j = 0; j < 4; ++j) { const f32x4 h = (V[j] * rstd) * ca[j] + cb[j]; o4[64 * j] = pk4_fp8(h.x, h.y, h.z, h.w); } } while (0)
#pragma unroll 1
    for (int blk = gw; blk < NT_TOK / 32; blk += NGW) {
        const int m0 = blk * 32, b = m0 >> 11;
        f32x4 ca[4], cb[4];
        { const f32x4* gr = (const f32x4*)g + ln; const f32x4* scr = (const f32x4*)(mod + (size_t)b * 6144 + sc_off) + ln; const f32x4* shr = (const f32x4*)(mod + (size_t)b * 6144 + sh_off) + ln;
#pragma unroll
          for (int j = 0; j < 4; ++j) { ca[j] = gr[64 * j] * (scr[64 * j] + 1.0f); cb[j] = shr[64 * j]; } }
        f32x4 va[4], vb[4];
        PB_LOAD(va, m0);
#pragma unroll 1
        for (int i = 0; i < 32; i += 2) {
            PB_LOAD(vb, m0 + i + 1);
            PB_ROW(va, m0 + i);
            if (i + 2 < 32) PB_LOAD(va, m0 + i + 2);
            PB_ROW(vb, m0 + i + 1);
        }
    }
#undef PB_ROW
#undef PB_LOAD
}
namespace pg8 {
#ifndef PC_DEPHASE
#define PC_DEPHASE 1
#define PC_DEPHASE_TICKS 0
#endif
struct ProjEpi {
    static constexpr bool PERM = true; static constexpr int MIDK = 0, DEPHASE = PC_DEPHASE, DEPHASE_TICKS = PC_DEPHASE_TICKS;
#ifdef PROBE_NOEPI
    static constexpr int NSTORE = 0;
#else
    static constexpr int NSTORE = 8;
#endif
    unsigned char* ws; const int* pos; const float* cosT; const float* sinT; const float* nq; const float* nk; const float* dq; const float* dk; bool noepi; bool hotst = false;
    static __device__ __forceinline__ float xsum(float x) {
        float y = x; asm("s_nop 1\n\tv_permlane16_swap_b32 %0, %1" : "+v"(x), "+v"(y)); x += y;
        y = x; asm("s_nop 1\n\tv_permlane32_swap_b32 %0, %1" : "+v"(x), "+v"(y)); return x + y; }
    __device__ __forceinline__ void operator()(const f32x4 (&acc)[2][2][4][2], const Unit& u, int, int wr, int wc, int fr, int fq) const {
#ifdef PC_FP8
        constexpr float SC = 0.015625f;
#else
        constexpr float SC = 1.0f;
#endif
        const int H = __builtin_amdgcn_readfirstlane(4 * u.pn + wc);
        int type = 0; const float* gn = nq; float qs = 1.f;
        if (H < 8) { type = 1; gn = nq; qs = C2; }
        else if (H == 12 || H == 13 || H == 16 || H == 17) { type = 1; gn = nk; }
        else if (H >= 20 && H < 26) { type = 1; gn = dq; qs = C2; }
        else if (H >= 26 && H < 32) { type = 1; gn = dk; }
        else if (H >= 38 && H <= 70) type = 2;
        bf16_t* dst = (bf16_t*)(ws + slot_off(H));
#ifdef PROBE_HOTST
        const int row0 = hotst ? (int)blockIdx.x * 256 + wr * 64 + fr : u.pm * BM + wr * 64 + fr;
        if (hotst) dst = (bf16_t*)(ws + WS_Y) + (size_t)wc * 65536 * 64;
#else
        const int row0 = u.pm * BM + wr * 64 + fr;
#endif
        if (type == 1) {
            f32x4 g0[2], g1[2], ir[2];
#pragma unroll
            for (int n = 0; n < 2; ++n) { g0[n] = *(const f32x4*)(gn + 8 * fq + 4 * n) * qs; g1[n] = *(const f32x4*)(gn + 32 + 8 * fq + 4 * n) * qs;
#pragma unroll
                for (int i = 0; i < 4; ++i) ir[n][i] = __builtin_amdgcn_exp2f(-(float)(8 * fq + 4 * n + i) * 0.41524101186092033f - 2.651496129472319f); }
            float pf[8], rs[8];
#pragma unroll
            for (int j = 0; j < 8; ++j) pf[j] = (float)pos[row0 + (j >> 2) * HALF + (j & 3) * 16];
#pragma unroll
            for (int j = 0; j < 8; ++j) { const int ai = j >> 2, m = j & 3;
                f32x4 q = acc[ai][0][m][0] * acc[ai][0][m][0]; q += acc[ai][0][m][1] * acc[ai][0][m][1]; q += acc[ai][1][m][0] * acc[ai][1][m][0]; q += acc[ai][1][m][1] * acc[ai][1][m][1];
                rs[j] = (q[0] + q[1]) + (q[2] + q[3]); }
#ifdef PC_XSUM_SWAP
#pragma unroll
            for (int j = 0; j < 8; ++j) rs[j] = xsum(rs[j]);
#else
            { float t[8];
#pragma unroll
                for (int j = 0; j < 8; ++j) t[j] = __shfl_xor(rs[j], 16);
#pragma unroll
                for (int j = 0; j < 8; ++j) rs[j] += t[j];
#pragma unroll
                for (int j = 0; j < 8; ++j) t[j] = __shfl_xor(rs[j], 32);
#pragma unroll
                for (int j = 0; j < 8; ++j) rs[j] += t[j]; }
#endif
#pragma unroll
            for (int j = 0; j < 8; ++j) rs[j] = SC * __builtin_amdgcn_rsqf(rs[j] * (SC * SC / 64.f) + EPS);
#pragma unroll
            for (int j = 0; j < 8; ++j) { const int ai = j >> 2, m = j & 3;
                const int tok = row0 + ai * HALF + m * 16;
                u32x4 w0, w1;
#pragma unroll
                for (int n = 0; n < 2; ++n) {
                    const f32x4 rv = ir[n] * pf[j];
                    f32x4 cs, sn;
#pragma unroll
                    for (int i = 0; i < 4; ++i) { const float fr2 = __builtin_amdgcn_fractf(rv[i]); cs[i] = __builtin_amdgcn_cosf(fr2); sn[i] = __builtin_amdgcn_sinf(fr2); }
                    const f32x4 x1 = acc[ai][0][m][n] * (g0[n] * rs[j]), x2 = acc[ai][1][m][n] * (g1[n] * rs[j]);
                    const f32x4 o1 = x1 * cs - x2 * sn, o2 = x1 * sn + x2 * cs;
                    w0[2 * n] = cvtpk(o1[0], o1[1]); w0[2 * n + 1] = cvtpk(o1[2], o1[3]); w1[2 * n] = cvtpk(o2[0], o2[1]); w1[2 * n + 1] = cvtpk(o2[2], o2[3]);
                }
                bf16_t* rp = dst + (size_t)tok * 64 + 8 * fq;
                *(u32x4*)rp = w0; *(u32x4*)(rp + 32) = w1;
            }
        } else if (type == 2 && H < SL_GA) {
            unsigned char* dst8 = (unsigned char*)dst;
#pragma unroll
            for (int ai = 0; ai < 2; ++ai)
#pragma unroll
                for (int m = 0; m < 4; ++m) {
                    const int tok = row0 + ai * HALF + m * 16;
                    u32x4 w;
#pragma unroll
                    for (int bj = 0; bj < 2; ++bj)
#pragma unroll
                        for (int n = 0; n < 2; ++n) { const f32x4 t = acc[ai][bj][m][n] * (-1.4426950408889634f * SC); f32x4 e, g;
#pragma unroll
                            for (int i = 0; i < 4; ++i) e[i] = __builtin_amdgcn_exp2f(t[i]);
                            e += 1.0f;
#pragma unroll
                            for (int i = 0; i < 4; ++i) g[i] = __builtin_amdgcn_rcpf(e[i]);
                            const float g0 = g[0] * 255.0f + 8388608.0f, g1 = g[1] * 255.0f + 8388608.0f, g2 = g[2] * 255.0f + 8388608.0f, g3 = g[3] * 255.0f + 8388608.0f;
                            const unsigned u0 = __builtin_bit_cast(unsigned, g0), u1 = __builtin_bit_cast(unsigned, g1), u2 = __builtin_bit_cast(unsigned, g2), u3 = __builtin_bit_cast(unsigned, g3);
                            w[2 * bj + n] = (u0 & 0xffu) | (u1 << 8) | (u2 << 16) | (u3 << 24); }
                    *(u32x4*)(dst8 + (size_t)tok * 64 + 16 * fq) = w;
                }
        } else if (type == 2) {
#pragma unroll
            for (int ai = 0; ai < 2; ++ai)
#pragma unroll
                for (int m = 0; m < 4; ++m) {
                    const int tok = row0 + ai * HALF + m * 16;
                    bf16_t* rp = dst + (size_t)tok * 64 + 8 * fq;
#pragma unroll
                    for (int bj = 0; bj < 2; ++bj) { f32x4 v[2];
#pragma unroll
                        for (int n = 0; n < 2; ++n) { const f32x4 t = acc[ai][bj][m][n] * (-1.4426950408889634f * SC); f32x4 e;
#pragma unroll
                            for (int i = 0; i < 4; ++i) e[i] = __builtin_amdgcn_exp2f(t[i]);
                            e += 1.0f;
#pragma unroll
                            for (int i = 0; i < 4; ++i) v[n][i] = __builtin_amdgcn_rcpf(e[i]); }
                        u32x4 w; w.x = cvtpk(v[0][0], v[0][1]); w.y = cvtpk(v[0][2], v[0][3]); w.z = cvtpk(v[1][0], v[1][1]); w.w = cvtpk(v[1][2], v[1][3]);
                        *(u32x4*)(rp + 32 * bj) = w; }
                }
        } else {
#pragma unroll
            for (int ai = 0; ai < 2; ++ai)
#pragma unroll
                for (int m = 0; m < 4; ++m) {
                    const int tok = row0 + ai * HALF + m * 16;
                    bf16_t* rp = dst + (size_t)tok * 64 + 8 * fq;
#pragma unroll
                    for (int bj = 0; bj < 2; ++bj) { const f32x4 v0 = acc[ai][bj][m][0] * SC, v1 = acc[ai][bj][m][1] * SC;
                        u32x4 w; w.x = cvtpk(v0[0], v0[1]); w.y = cvtpk(v0[2], v0[3]); w.z = cvtpk(v1[0], v1[1]); w.w = cvtpk(v1[2], v1[3]);
                        *(u32x4*)(rp + 32 * bj) = w; }
                }
        }
    }
};

template <bool ADD> struct UpEpi {
    static constexpr bool PERM = true, noepi = false; static constexpr int MIDK = 0, DEPHASE = 1, DEPHASE_TICKS = 0, NSTORE = 0;
    unsigned char* ws; bf16_t* Y; int gslot0; unsigned char* Y8;
    __device__ __forceinline__ void operator()(const f32x4 (&acc)[2][2][4][2], const Unit& u, int, int wr, int wc, int fr, int fq) const {
        const int row0 = u.pm * BM + wr * 64 + fr;
#pragma unroll
        for (int bj = 0; bj < 2; ++bj) {
            const int gs = __builtin_amdgcn_readfirstlane(gslot0 + 4 * u.pn + 2 * bj + (wc >> 1));
            const bf16_t* gp = (const bf16_t*)(ws + slot_off(gs)) + 32 * (wc & 1) + 8 * fq;
            const int col = u.pn * BM + bj * HALF + wc * 32 + 8 * fq;
#pragma unroll
            for (int ai = 0; ai < 2; ++ai) {
                u32x4 gg[4], yy[4];
#pragma unroll
                for (int m = 0; m < 4; ++m) { const int tok = row0 + ai * HALF + m * 16; gg[m] = *(const u32x4*)(gp + (size_t)tok * 64); if (ADD) yy[m] = *(const u32x4*)(Y + (size_t)tok * DM + col); }
#pragma unroll
                for (int m = 0; m < 4; ++m) {
                    const int tok = row0 + ai * HALF + m * 16;
                    const u32x4 g = gg[m];
                    bf16_t* yp = Y + (size_t)tok * DM + col;
                    f32x4 v0 = acc[ai][bj][m][0], v1 = acc[ai][bj][m][1];
                    v0[0] *= bflo(g.x); v0[1] *= bfhi(g.x); v0[2] *= bflo(g.y); v0[3] *= bfhi(g.y); v1[0] *= bflo(g.z); v1[1] *= bfhi(g.z); v1[2] *= bflo(g.w); v1[3] *= bfhi(g.w);
                    if (ADD) { const u32x4 y = yy[m];
                        v0[0] += bflo(y.x); v0[1] += bfhi(y.x); v0[2] += bflo(y.y); v0[3] += bfhi(y.y); v1[0] += bflo(y.z); v1[1] += bfhi(y.z); v1[2] += bflo(y.w); v1[3] += bfhi(y.w); }
                    if (ADD && Y8) { u32x2 w8; w8.x = pk4_fp8(v0[0] * 16.f, v0[1] * 16.f, v0[2] * 16.f, v0[3] * 16.f); w8.y = pk4_fp8(v1[0] * 16.f, v1[1] * 16.f, v1[2] * 16.f, v1[3] * 16.f); *(u32x2*)(Y8 + (size_t)tok * DM + col) = w8; }
                    else { u32x4 w; w.x = cvtpk(v0[0], v0[1]); w.y = cvtpk(v0[2], v0[3]); w.z = cvtpk(v1[0], v1[1]); w.w = cvtpk(v1[2], v1[3]); *(u32x4*)yp = w; }
                }
                asm volatile("" ::: "memory");
            }
            asm volatile("" ::: "memory");
        }
    }
};

struct Up2Epi {
    static constexpr bool PERM = true, noepi = false; static constexpr int MIDK = 4, DEPHASE = 1, DEPHASE_TICKS = 0, NSTORE = 16;
    unsigned char* ws; unsigned char* Y8;
    static __device__ __forceinline__ unsigned fixz(unsigned x) { return x | ((((x - 0x01010101u) & ~x) & 0x80808080u) >> 7); }
    static __device__ __forceinline__ f32x4 ub4(unsigned x) { return (f32x4){(float)(x & 0xffu), (float)((x >> 8) & 0xffu), (float)((x >> 16) & 0xffu), (float)(x >> 24)}; }
    __device__ __forceinline__ void mid(f32x4 (&acc)[2][2][4][2], const Unit& u, int wr, int wc, int fr, int fq) const {
        const int row0 = u.pm * BM + wr * 64 + fr;
        const int sa = __builtin_amdgcn_readfirstlane(SL_GMA + 4 * u.pn + wc);
        const unsigned char* ga = ws + slot_off(sa) + 16 * fq;
        const unsigned char* gb = ws + slot_off(sa + (SL_GMB - SL_GMA)) + 16 * fq;
#pragma unroll
        for (int ai = 0; ai < 2; ++ai) {
            u32x4 xa[4], xb[4];
#pragma unroll
            for (int m = 0; m < 4; ++m) { const int tok = row0 + ai * HALF + m * 16; xa[m] = *(const u32x4*)(ga + (size_t)tok * 64); xb[m] = *(const u32x4*)(gb + (size_t)tok * 64); }
#pragma unroll
            for (int m = 0; m < 4; ++m)
#pragma unroll
                for (int bj = 0; bj < 2; ++bj)
#pragma unroll
                    for (int n = 0; n < 2; ++n) { const f32x4 a = ub4(xa[m][2 * bj + n]), b = ub4(fixz(xb[m][2 * bj + n])); f32x4 r;
#pragma unroll
                        for (int i = 0; i < 4; ++i) r[i] = __builtin_amdgcn_rcpf(b[i]);
                        acc[ai][bj][m][n] *= a * r; }
            asm volatile("" ::: "memory");
        }
    }
    __device__ __forceinline__ void operator()(const f32x4 (&acc)[2][2][4][2], const Unit& u, int, int wr, int wc, int fr, int fq) const {
        const int row0 = u.pm * BM + wr * 64 + fr;
        const int sb = __builtin_amdgcn_readfirstlane(SL_GMB + 4 * u.pn + wc);
        const unsigned char* gb = ws + slot_off(sb) + 16 * fq;
        u32x4 xb[8];
#pragma unroll
        for (int j = 0; j < 8; ++j) xb[j] = *(const u32x4*)(gb + (size_t)(row0 + (j >> 2) * HALF + (j & 3) * 16) * 64);
#pragma unroll
        for (int j = 0; j < 8; ++j) { const int ai = j >> 2, m = j & 3;
            const int tok = row0 + ai * HALF + m * 16; const float s = 1.0f / (64.0f * 255.0f);
#pragma unroll
            for (int bj = 0; bj < 2; ++bj) {
                const int col = u.pn * BM + bj * HALF + wc * 32 + 8 * fq;
                const f32x4 v0 = acc[ai][bj][m][0] * s * ub4(fixz(xb[j][2 * bj])), v1 = acc[ai][bj][m][1] * s * ub4(fixz(xb[j][2 * bj + 1]));
                u32x2 w8; w8.x = pk4_fp8(v0[0], v0[1], v0[2], v0[3]); w8.y = pk4_fp8(v1[0], v1[1], v1[2], v1[3]);
                *(u32x2*)(Y8 + (size_t)tok * DM + col) = w8;
            }
        }
    }
};

#ifndef OUT_DEPHASE
#define OUT_DEPHASE 1
#endif
struct OutEpi {
    static constexpr bool PERM = false, noepi = false; static constexpr int MIDK = 0, DEPHASE = OUT_DEPHASE, DEPHASE_TICKS = 3400, NSTORE = 32;
    const float* x; float* out; const float* mod; float* rowss; float asc;
    __device__ __forceinline__ void operator()(const f32x4 (&acc)[2][2][4][2], const Unit& u, int, int wr, int wc, int fr, int fq) const {
        const int row0 = u.pm * BM + wr * 64 + fr, col0 = u.pn * BM + wc * 32 + 4 * fq;
        const int b = (u.pm * BM) >> 11;
        const float* gt = mod + (size_t)b * 6144 + 2048 + col0;
        f32x4 gv[2][2];
#pragma unroll
        for (int bj = 0; bj < 2; ++bj)
#pragma unroll
            for (int n = 0; n < 2; ++n) gv[bj][n] = *(const f32x4*)(gt + bj * HALF + n * 16) * asc;
#pragma unroll
        for (int ai = 0; ai < 2; ++ai) {
            f32x4 xv[4][2][2];
#pragma unroll
            for (int m = 0; m < 4; ++m) { const size_t off = (size_t)(row0 + ai * HALF + m * 16) * DM + col0;
#pragma unroll
                for (int bj = 0; bj < 2; ++bj)
#pragma unroll
                    for (int n = 0; n < 2; ++n) xv[m][bj][n] = *(const f32x4*)(x + off + bj * HALF + n * 16); }
#pragma unroll
            for (int m = 0; m < 4; ++m) {
                const int tok = row0 + ai * HALF + m * 16; const size_t off = (size_t)tok * DM + col0; float ss = 0.f;
#pragma unroll
                for (int bj = 0; bj < 2; ++bj)
#pragma unroll
                    for (int n = 0; n < 2; ++n) { const f32x4 o = xv[m][bj][n] + gv[bj][n] * acc[ai][bj][m][n];
                        ss += (o[0] * o[0] + o[1] * o[1]) + (o[2] * o[2] + o[3] * o[3]);
#ifdef X1_BF16
                        { u32x2 w; w.x = cvtpk(o[0], o[1]); w.y = cvtpk(o[2], o[3]); *(u32x2*)((bf16_t*)out + off + bj * HALF + n * 16) = w; }
#else
                        *(f32x4*)(out + off + bj * HALF + n * 16) = o;
#endif
                    }
                ss += __shfl_xor(ss, 16); ss += __shfl_xor(ss, 32);
                if (fq == 0) rowss[(size_t)tok * 16 + 4 * u.pn + wc] = ss;
            }
            asm volatile("" ::: "memory");
        }
    }
};

struct CmpEpi {
    static constexpr bool PERM = true, noepi = false; static constexpr int MIDK = 0, DEPHASE = 1, DEPHASE_TICKS = 0, NSTORE = 0;
    const float* biasp; bf16_t* hid;
    __device__ __forceinline__ void operator()(const f32x4 (&acc)[2][2][4][2], const Unit& u, int, int wr, int wc, int fr, int fq) const {
        const int kv = u.pm >= 32 ? 1 : 0; const int row0 = u.pm * BM + wr * 64 + fr;
#pragma unroll
        for (int bj = 0; bj < 2; ++bj) {
            const int col = bj * HALF + wc * 32 + 8 * fq;
            f32x4 b0 = (f32x4){0.f, 0.f, 0.f, 0.f}, b1 = b0;
            for (int ks = 0; ks < 16; ++ks) { b0 += *(const f32x4*)(biasp + ks * 512 + kv * 256 + col); b1 += *(const f32x4*)(biasp + ks * 512 + kv * 256 + col + 4); }
#pragma unroll
            for (int ai = 0; ai < 2; ++ai)
#pragma unroll
                for (int m = 0; m < 4; ++m) {
                    const int row = row0 + ai * HALF + m * 16;
                    f32x4 v0 = acc[ai][bj][m][0] + b0, v1 = acc[ai][bj][m][1] + b1;
#pragma unroll
                    for (int i = 0; i < 4; ++i) { v0[i] = siluf_(v0[i]); v1[i] = siluf_(v1[i]); }
                    u32x4 w; w.x = cvtpk(v0[0], v0[1]); w.y = cvtpk(v0[2], v0[3]); w.z = cvtpk(v1[0], v1[1]); w.w = cvtpk(v1[2], v1[3]);
                    *(u32x4*)(hid + (size_t)row * 256 + col) = w;
                }
        }
    }
};
struct CmpSched {
    const char* A; const char* Bt; int ldb; int nwg_c, c;
    __device__ __forceinline__ bool next(int i, Unit& u) const { if (c < 0) return false; const int L = i * nwg_c + c; if (L >= 64) return false; u.pm = L; u.pn = 0; u.e = 0; u.mt = 0; return true; }
    __device__ __forceinline__ const char* a_base(const Unit& u) const { return A + (size_t)u.pm * BM * 1024 * 2; }
    __device__ __forceinline__ unsigned a_voff(const Unit&, int, int h, int R, int C) const { return (unsigned)((h * HALF + R) * 1024 + C) * 2u; }
    __device__ __forceinline__ const char* b_base(const Unit& u) const { return Bt + (u.pm >= 32 ? (size_t)256 * 2048 * 2 : 0); }
    __device__ __forceinline__ int dephase_id() const { return 0; }
};
}
namespace att {
constexpr int A_KV = 0;
constexpr int A_IMP = 49152;
constexpr int A_SEL = 83968;
constexpr int A_WSF = 98304;
constexpr int A_OST = 100352;
constexpr float NEG_INF = -INFINITY;
constexpr float THR = 8.0f;
__device__ __forceinline__ int crow(int r, int hi) { return (r & 3) + 8 * (r >> 2) + 4 * hi; }
__device__ __forceinline__ void glds16(const void* gsrc, unsigned lds_dst) { unsigned keep;
    asm volatile("s_mov_b32 %0, m0\n\ts_mov_b32 m0, %2\n\ts_nop 0\n\tglobal_load_lds_dwordx4 %1, off\n\ts_mov_b32 m0, %0" : "=&s"(keep) : "v"(gsrc), "s"(lds_dst) : "memory"); }
#define ATT_WAIT_BAR(N) asm volatile("s_waitcnt vmcnt(" #N ") lgkmcnt(0)\n\ts_barrier" ::: "memory")
#define ATT_SBAR() __builtin_amdgcn_sched_barrier(0)

struct Ctx { LAS unsigned char* lds; int lane, r32, hi, wid; unsigned lds0; };
__device__ __forceinline__ int fresh(int v) { asm volatile("" : "+v"(v)); return v; }

__device__ __forceinline__ void qkt(f32x16& p0, f32x16& p1, const LAS unsigned char* Kslot, const bf16x8 (&qr)[4], int lane_) {
    const int lq = lane_now(); const int r32 = lq & 31, hi = lq >> 5;
    const LAS unsigned char* kb = Kslot + hi * 1024 + r32 * 16;
    const f32x16 z = {};
#pragma unroll
    for (int d0 = 0; d0 < 4; ++d0) {
        const bf16x8 b0 = *(const LAS bf16x8*)(kb + d0 * 2048);
        const bf16x8 b1 = *(const LAS bf16x8*)(kb + d0 * 2048 + 512);
        if (d0 == 0) { p0 = __builtin_amdgcn_mfma_f32_32x32x16_bf16(b0, qr[0], z, 0, 0, 0); p1 = __builtin_amdgcn_mfma_f32_32x32x16_bf16(b1, qr[0], z, 0, 0, 0); }
        else { p0 = __builtin_amdgcn_mfma_f32_32x32x16_bf16(b0, qr[d0], p0, 0, 0, 0); p1 = __builtin_amdgcn_mfma_f32_32x32x16_bf16(b1, qr[d0], p1, 0, 0, 0); } }
}
__device__ __forceinline__ void pv(f32x16 (&o)[2], int vb, bf16x8 pa0, bf16x8 pa1, bf16x8 pa2, bf16x8 pa3) {
#pragma unroll
    for (int d0 = 0; d0 < 2; ++d0) { s16x4 lo[4], hh[4];
#pragma unroll
        for (int ks = 0; ks < 4; ++ks) {
            asm volatile("ds_read_b64_tr_b16 %0,%1 offset:%c2" : "=&v"(lo[ks]) : "v"(vb), "i"(d0 * 4096 + ks * 1024) : "memory");
            asm volatile("ds_read_b64_tr_b16 %0,%1 offset:%c2" : "=&v"(hh[ks]) : "v"(vb), "i"(d0 * 4096 + ks * 1024 + 512) : "memory"); }
        asm volatile("s_waitcnt lgkmcnt(0)" ::: "memory"); ATT_SBAR();
#define ATT_PK(k) (bf16x8){lo[k][0], lo[k][1], lo[k][2], lo[k][3], hh[k][0], hh[k][1], hh[k][2], hh[k][3]}
        o[d0] = __builtin_amdgcn_mfma_f32_32x32x16_bf16(pa0, ATT_PK(0), o[d0], 0, 0, 0);
        o[d0] = __builtin_amdgcn_mfma_f32_32x32x16_bf16(pa1, ATT_PK(1), o[d0], 0, 0, 0);
        o[d0] = __builtin_amdgcn_mfma_f32_32x32x16_bf16(pa2, ATT_PK(2), o[d0], 0, 0, 0);
        o[d0] = __builtin_amdgcn_mfma_f32_32x32x16_bf16(pa3, ATT_PK(3), o[d0], 0, 0, 0);
#undef ATT_PK
    }
}
__device__ __forceinline__ float max3f(float a, float b, float c) { float r; asm("v_max3_f32 %0, %1, %2, %3" : "=v"(r) : "v"(a), "v"(b), "v"(c)); return r; }
__device__ __forceinline__ float max2f(float a, float b) { float r; asm("v_max_f32_e32 %0, %1, %2" : "=v"(r) : "v"(a), "v"(b)); return r; }
__device__ __forceinline__ float rowmax3(const f32x16& p0, const f32x16& p1) {
    float a = max3f(p0[0], p0[1], p1[0]), b = max3f(p0[2], p0[3], p1[1]); a = max3f(a, p1[2], p1[3]);
#pragma unroll
    for (int r = 4; r < 16; r += 4) { a = max3f(a, p0[r], p0[r + 1]); b = max3f(b, p0[r + 2], p0[r + 3]); a = max3f(a, p1[r], p1[r + 1]); b = max3f(b, p1[r + 2], p1[r + 3]); }
    const float m = max2f(a, b);
    auto rr = __builtin_amdgcn_permlane32_swap(__float_as_uint(m), __float_as_uint(m), false, false);
    return max2f(__uint_as_float(rr[0]), __uint_as_float(rr[1]));
}

__device__ __forceinline__ float rowmax(const f32x16& p0, const f32x16& p1) { return rowmax3(p0, p1); }
__device__ __forceinline__ float halfsum(float v) { auto rr = __builtin_amdgcn_permlane32_swap(__float_as_uint(v), __float_as_uint(v), false, false); return __uint_as_float(rr[0]) + __uint_as_float(rr[1]); }
#define ATT_PACK4(P, B) (u32x4){cvtpk(P[B], P[B + 1]), cvtpk(P[B + 2], P[B + 3]), cvtpk(P[B + 4], P[B + 5]), cvtpk(P[B + 6], P[B + 7])}
__device__ __forceinline__ void pv_tile(f32x16 (&o)[2], int vb, const f32x16& p0, const f32x16& p1) {
    const u32x4 w0 = ATT_PACK4(p0, 0), w1 = ATT_PACK4(p0, 8), w2 = ATT_PACK4(p1, 0), w3 = ATT_PACK4(p1, 8);
    pv(o, vb, __builtin_bit_cast(bf16x8, w0), __builtin_bit_cast(bf16x8, w1), __builtin_bit_cast(bf16x8, w2), __builtin_bit_cast(bf16x8, w3));
}
__device__ __forceinline__ void scale_rows(f32x16 (&o)[2], float f, const Ctx& C_) {
    Ctx C = C_; { const int l = lane_now(); C.r32 = l & 31; C.hi = l >> 5; }
    LAS float* wsf = (LAS float*)(C.lds + A_WSF) + C.wid * 64;
    if (C.hi == 0) wsf[C.r32] = f;
    asm volatile("s_waitcnt lgkmcnt(0)" ::: "memory");
#pragma unroll
    for (int g = 0; g < 4; ++g) { const f32x4 fv = *(const LAS f32x4*)(wsf + 8 * g + 4 * C.hi);
#pragma unroll
        for (int i = 0; i < 4; ++i) { o[0][4 * g + i] *= fv[i]; o[1][4 * g + i] *= fv[i]; } }
    asm volatile("s_waitcnt lgkmcnt(0)" ::: "memory");
}
__device__ __forceinline__ void axpy_rows(f32x16 (&acc)[2], const f32x16 (&o)[2], float f, const Ctx& C_) {
    Ctx C = C_; { const int l = lane_now(); C.r32 = l & 31; C.hi = l >> 5; }
    LAS float* wsf = (LAS float*)(C.lds + A_WSF) + C.wid * 64;
    if (C.hi == 0) wsf[C.r32] = f;
    asm volatile("s_waitcnt lgkmcnt(0)" ::: "memory");
#pragma unroll
    for (int g = 0; g < 4; ++g) { const f32x4 fv = *(const LAS f32x4*)(wsf + 8 * g + 4 * C.hi);
#pragma unroll
        for (int i = 0; i < 4; ++i) { acc[0][4 * g + i] += o[0][4 * g + i] * fv[i]; acc[1][4 * g + i] += o[1][4 * g + i] * fv[i]; } }
    asm volatile("s_waitcnt lgkmcnt(0)" ::: "memory");
}
struct SM { float m, l; f32x16 o[2]; };
__device__ __forceinline__ void sm_init(SM& s) { s.m = -1e30f; s.l = 0.f; s.o[0] = f32x16{}; s.o[1] = f32x16{}; }
__device__ __forceinline__ void sm_part1(SM& s, f32x16& p0, f32x16& p1, u32x4& w0, u32x4& w1, u32x4& w2, u32x4& w3, const Ctx& C) {
    const float rm = rowmax(p0, p1);
    if (__any(rm > s.m + THR)) {
        const float mn = fmaxf(s.m, rm); const float f = __builtin_amdgcn_exp2f(s.m - mn);
        s.l *= f; s.m = mn; scale_rows(s.o, f, C);
    }
    float sum = 0.f;
#pragma unroll
    for (int r = 0; r < 16; ++r) { p0[r] = __builtin_amdgcn_exp2f(p0[r] - s.m); p1[r] = __builtin_amdgcn_exp2f(p1[r] - s.m); sum += p0[r] + p1[r]; }
    s.l += sum;
    w0 = ATT_PACK4(p0, 0); w1 = ATT_PACK4(p0, 8); w2 = ATT_PACK4(p1, 0); w3 = ATT_PACK4(p1, 8);
}
template <int NS> __device__ __forceinline__ void dma_tile(const Ctx& C, const bf16_t* Kp, const bf16_t* Vp, long rs, int tile, int stage, int q, int base_off = 0) {
    const unsigned base = C.lds0 + (unsigned)(base_off + (stage * NS + q) * 16384);
    const long k0 = (long)tile * 64; const int lane = lane_now();
#pragma unroll
    for (int j = 0; j < NS; ++j) {
        const int pw = (NS == 1) ? C.wid : (2 * (C.wid & 3) + j);
        const bf16_t* ks = Kp + (k0 + lane) * rs + pw * 8;
        const bf16_t* vs = Vp + (k0 + 16 * (pw & 3) + (lane >> 2)) * rs + (pw >> 2) * 32 + (lane & 3) * 8;
        glds16(ks, (unsigned)__builtin_amdgcn_readfirstlane(base + pw * 1024));
        glds16(vs, (unsigned)__builtin_amdgcn_readfirstlane(base + 8192 + pw * 1024));
    }
}
template <int NS> __device__ __forceinline__ void wait_bar_tiles(int allowed) {
    if (allowed <= 0) ATT_WAIT_BAR(0);
    else if (allowed == 1) { if (NS == 1) ATT_WAIT_BAR(2); else ATT_WAIT_BAR(4); }
    else { if (NS == 1) ATT_WAIT_BAR(4); else ATT_WAIT_BAR(8); }
}
template <int NS, class MaskF, class SkipF>
__device__ __forceinline__ void run_pass(const Ctx& C, SM& st, const bf16x8 (&qr)[4], const bf16_t* Kp, const bf16_t* Vp, long rs, int t_lo, int t_hi, int nsteps, MaskF mask, SkipF skip) {
    const int q = (NS == 1) ? 0 : (C.wid >> 2);
    const int nvalid = t_hi - t_lo;
#pragma unroll
    for (int s = 0; s < 2; ++s) if (s < nvalid) dma_tile<NS>(C, Kp, Vp, rs, t_lo + s, s, q);
#pragma unroll 1
    for (int s = 0; s < nsteps; ++s) {
        wait_bar_tiles<NS>((s + 1 < nvalid) ? 1 : 0);
        if (s + 2 < nvalid) dma_tile<NS>(C, Kp, Vp, rs, t_lo + s + 2, (s + 2) % 3, q);
        if (s < nvalid && !skip(t_lo + s)) {
            const int sb = ((s % 3) * NS + q) * 16384;
            f32x16 p0, p1; qkt(p0, p1, C.lds + sb, qr, C.lane);
            mask(p0, p1, t_lo + s);
            u32x4 w0, w1, w2, w3; sm_part1(st, p0, p1, w0, w1, w2, w3, C);
            const int lv = lane_now(); const int vlane = ((lv >> 4) & 1) * 32 + (lv & 3) * 8 + (4 * (lv >> 5) + ((lv & 15) >> 2)) * 64;
            pv(st.o, (int)C.lds0 + sb + 8192 + vlane, __builtin_bit_cast(bf16x8, w0), __builtin_bit_cast(bf16x8, w1), __builtin_bit_cast(bf16x8, w2), __builtin_bit_cast(bf16x8, w3));
        }
    }
    ATT_WAIT_BAR(0);
}
__device__ __forceinline__ void store_o(const f32x16 (&o)[2], bf16_t* Ow, long pitch, const Ctx& C_) {
    Ctx C = C_; { const int l = lane_now(); C.lane = l; C.r32 = l & 31; C.hi = l >> 5; }
    LAS bf16_t* stg = (LAS bf16_t*)(C.lds + A_OST) + C.wid * 2048;
#pragma unroll
    for (int r = 0; r < 16; ++r) { const int orow = crow(r, C.hi);
#pragma unroll
        for (int d0 = 0; d0 < 2; ++d0) stg[orow * 64 + d0 * 32 + C.r32] = (bf16_t)(cvtpk(o[d0][r], 0.f) & 0xffffu); }
    asm volatile("s_waitcnt lgkmcnt(0)" ::: "memory");
#pragma unroll
    for (int i = 0; i < 4; ++i) { const int row = i * 8 + (C.lane >> 3), ch = C.lane & 7; const u32x4 v = *(const LAS u32x4*)(stg + row * 64 + ch * 8); *(u32x4*)(Ow + (long)row * pitch + ch * 8) = v; }
    asm volatile("s_waitcnt lgkmcnt(0)" ::: "memory");
}
__device__ __forceinline__ void load_q(bf16x8 (&qr)[4], const bf16_t* Qrow, int hi) {
#pragma unroll
    for (int d0 = 0; d0 < 4; ++d0) qr[d0] = *(const bf16x8*)(Qrow + d0 * 16 + hi * 8);
}

}
namespace att {
constexpr int F_K = 0, F_V = 24576, F_SLOT = 8192;
typedef LAS const char* lds_cptr;
typedef short v4i16_t __attribute__((ext_vector_type(4)));
__device__ __forceinline__ float fadd_s(float a, float b) { float r; asm("v_add_f32_e32 %0, %1, %2" : "=v"(r) : "v"(a), "v"(b)); return r; }
__device__ __forceinline__ float fsub_s(float a, float b) { float r; asm("v_sub_f32_e32 %0, %1, %2" : "=v"(r) : "v"(a), "v"(b)); return r; }
__device__ __forceinline__ void kload8(bf16x8* kf, lds_cptr kp) {
    kf[0] = *(const LAS bf16x8*)(kp);        kf[1] = *(const LAS bf16x8*)(kp + 512);
    kf[2] = *(const LAS bf16x8*)(kp + 2048); kf[3] = *(const LAS bf16x8*)(kp + 2560);
    kf[4] = *(const LAS bf16x8*)(kp + 4096); kf[5] = *(const LAS bf16x8*)(kp + 4608);
    kf[6] = *(const LAS bf16x8*)(kp + 6144); kf[7] = *(const LAS bf16x8*)(kp + 6656);
}
__device__ __forceinline__ void kload2(bf16x8* kf, lds_cptr kp, int j) { kf[2 * j] = *(const LAS bf16x8*)(kp + j * 2048); kf[2 * j + 1] = *(const LAS bf16x8*)(kp + j * 2048 + 512); }
__device__ __forceinline__ s16x4 vtr(lds_cptr p) { return __builtin_bit_cast(s16x4, __builtin_amdgcn_ds_read_tr16_b64_v4i16((LAS v4i16_t*)p)); }
__device__ __forceinline__ void fast_prefetch(const Ctx& C, const bf16_t* Kp, const bf16_t* Vp, int t_lo, int ntr) {
    const int lane = lane_now(); const int wid = C.wid;
    const bf16_t* ksrc = Kp + ((long)t_lo * 64 + lane) * 64 + wid * 8;
    const bf16_t* vsrc = Vp + ((long)t_lo * 64 + 16 * (wid & 3) + (lane >> 2)) * 64 + (wid >> 2) * 32 + (lane & 3) * 8;
    const unsigned kdst = C.lds0 + F_K + wid * 1024, vdst = C.lds0 + F_V + wid * 1024;
    glds16(ksrc, (unsigned)__builtin_amdgcn_readfirstlane(kdst)); glds16(vsrc, (unsigned)__builtin_amdgcn_readfirstlane(vdst));
    glds16(ksrc + (long)((1 < ntr) ? 1 : (ntr - 1)) * 4096, (unsigned)__builtin_amdgcn_readfirstlane(kdst + F_SLOT));
    glds16(ksrc + (long)((2 < ntr) ? 2 : (ntr - 1)) * 4096, (unsigned)__builtin_amdgcn_readfirstlane(kdst + 2 * F_SLOT));
}
__device__ __forceinline__ void fast_prefetch2(const Ctx& C, const bf16_t* Kp1, const bf16_t* Vp1, int n1, const bf16_t* Kp2, int t_lo2, int n2) {
    const int lane = lane_now(); const int wid = C.wid;
    const int koff = lane * 64 + wid * 8, voff = (16 * (wid & 3) + (lane >> 2)) * 64 + (wid >> 2) * 32 + (lane & 3) * 8;
    const unsigned kdst = C.lds0 + F_K + wid * 1024, vdst = C.lds0 + F_V + wid * 1024;
    const bf16_t* K2b = Kp2 + (long)t_lo2 * 4096;
    glds16(Kp1 + koff, (unsigned)__builtin_amdgcn_readfirstlane(kdst)); glds16(Vp1 + voff, (unsigned)__builtin_amdgcn_readfirstlane(vdst));
#pragma unroll
    for (int t = 1; t < 3; ++t) { const bool s2 = t >= n1; const int idx = s2 ? ((t - n1 < n2) ? (t - n1) : (n2 - 1)) : t;
        glds16((s2 ? K2b : Kp1) + (long)idx * 4096 + koff, (unsigned)__builtin_amdgcn_readfirstlane(kdst + t * F_SLOT)); }
}
template <int THRL, bool PRE, class MaskF>
__device__ __forceinline__ void fast_pass(const Ctx& C, const bf16x8 (&qr)[4], const bf16_t* Kp, const bf16_t* Vp, int t_lo, int ntr, MaskF mask, f32x16 (&o)[2], float& l_out) {
    const int lane = lane_now(), r32 = lane & 31, hi = lane >> 5; const int wid = C.wid;
    const unsigned lds0 = C.lds0;
    LAS float* wsf = (LAS float*)(C.lds + A_WSF) + wid * 64;
    int NT = ntr; if (NT < 4) NT = 4;
    const bf16_t* ksrc = Kp + ((long)t_lo * 64 + lane) * 64 + wid * 8;
    const bf16_t* vsrc = Vp + ((long)t_lo * 64 + 16 * (wid & 3) + (lane >> 2)) * 64 + (wid >> 2) * 32 + (lane & 3) * 8;
    const unsigned kdst = lds0 + F_K + wid * 1024, vdst = lds0 + F_V + wid * 1024;
#define FP_TSRC(t) ((long)(((t) < ntr) ? (t) : (ntr - 1)) * 4096)
#define DMA_K(t, slot) glds16(ksrc + FP_TSRC(t), (unsigned)__builtin_amdgcn_readfirstlane(kdst + (slot)))
#define DMA_V(t, slot) glds16(vsrc + FP_TSRC(t), (unsigned)__builtin_amdgcn_readfirstlane(vdst + (slot)))
    const int vb0 = (int)(lds0 + F_V) + ((lane >> 4) & 1) * 32 + (lane & 3) * 8 + (4 * hi + ((lane & 15) >> 2)) * 64;
    bf16x8 kf[8];
    const lds_cptr shm3 = (lds_cptr)C.lds; const lds_cptr kp0 = shm3 + F_K + hi * 1024 + r32 * 16; const lds_cptr vp0 = shm3 + F_V + ((lane >> 4) & 1) * 32 + (lane & 3) * 8 + (4 * hi + ((lane & 15) >> 2)) * 64;
    if (!PRE) { DMA_K(0, 0); DMA_V(0, 0); DMA_K(1, F_SLOT); }
    float mhat = 0.f, l_reg = 0.f; o[0] = f32x16{}; o[1] = f32x16{}; f32x16 negm; { float z_ = 0.f; asm volatile("" : "+v"(z_));
#pragma unroll
      for (int r = 0; r < 16; ++r) negm[r] = z_; }
#define CMASK(P0, P1, t) mask(P0, P1, (t))
    bool resc = false;
#define START(P0, P1) do { const float rm = rowmax3(P0, P1); resc = false; \
    { const float dl = rm; mhat = fadd_s(mhat, dl); \
      _Pragma("unroll") for (int r = 0; r < 16; ++r) { P0[r] = fsub_s(P0[r], dl); P1[r] = fsub_s(P1[r], dl); } \
      _Pragma("unroll") for (int r = 0; r < 16; ++r) negm[r] = -mhat; asm volatile("" : "+v"(negm)); } \
    _Pragma("unroll") for (int r = 0; r < 16; ++r) P0[r] = __builtin_amdgcn_exp2f(P0[r]); } while (0)
#define RESC() do { if (resc) { asm volatile("s_waitcnt lgkmcnt(0)" ::: "memory"); \
      _Pragma("unroll") for (int d_ = 0; d_ < 2; ++d_) _Pragma("unroll") for (int r = 0; r < 16; ++r) o[d_][r] *= wsf[crow(r, hi)]; } } while (0)
    f32x16 pA0, pA1, pB0, pB1;
    int sl_prev = 0, sl_cur = 0, sl_next = F_SLOT;
#define ROT() do { sl_prev = sl_cur; sl_cur = sl_next; sl_next = (sl_next == 2 * F_SLOT) ? 0 : sl_next + F_SLOT; } while (0)
    if (!PRE) DMA_K(2, 2 * F_SLOT);
    ATT_WAIT_BAR(3);
    { const LAS unsigned char* kb = C.lds + F_K + hi * 1024 + r32 * 16;
#pragma unroll
      for (int d0 = 0; d0 < 4; ++d0) { const bf16x8 b0 = *(const LAS bf16x8*)(kb + d0 * 2048); const bf16x8 b1 = *(const LAS bf16x8*)(kb + d0 * 2048 + 512);
          if (d0 == 0) { pA0 = __builtin_amdgcn_mfma_f32_32x32x16_bf16(b0, qr[0], negm, 0, 0, 0); pA1 = __builtin_amdgcn_mfma_f32_32x32x16_bf16(b1, qr[0], negm, 0, 0, 0); }
          else { pA0 = __builtin_amdgcn_mfma_f32_32x32x16_bf16(b0, qr[d0], pA0, 0, 0, 0); pA1 = __builtin_amdgcn_mfma_f32_32x32x16_bf16(b1, qr[d0], pA1, 0, 0, 0); } } }
    CMASK(pA0, pA1, 0);
    asm volatile("s_nop 15\n\ts_nop 7" : "+v"(pA0), "+v"(pA1));
    START(pA0, pA1);
#pragma unroll
    for (int r = 0; r < 16; ++r) pA1[r] = __builtin_amdgcn_exp2f(pA1[r]);
    ATT_WAIT_BAR(0);
    DMA_K(3, 0); DMA_V(1, F_SLOT);
    ROT();
    kload8(kf, kp0 + sl_cur);
    ATT_WAIT_BAR(2);
    s16x4 vlo[8], vhi[8]; u32x4 pw0, pw1, pw2, pw3;
#define PKW(P, B) cvtpk(P[B], P[B + 1])
#define PAF(k) __builtin_bit_cast(bf16x8, pw##k)
#define VFR(i) (bf16x8){vlo[i][0], vlo[i][1], vlo[i][2], vlo[i][3], vhi[i][0], vhi[i][1], vhi[i][2], vhi[i][3]}
#define PIN(x) asm volatile("" : "+v"(x))
#define MX3(a, b, c) __builtin_fmaxf(__builtin_fmaxf((a), (b)), (c))
#define GAPA(MF, A0, A1, A2, A3, W0, W1, PW) do { MF; sacc += A0; sacc += A1; sacc += A2; sacc += A3; PIN(sacc); W0; W1; PIN(PW); ATT_SBAR(); } while (0)
#define EX(v) __builtin_amdgcn_exp2f(v)
#define GAPB(MF, X, B) do { MF; X[B] = EX(X[B]); X[B + 1] = EX(X[B + 1]); X[B + 2] = EX(X[B + 2]); X[B + 3] = EX(X[B + 3]); PIN(X); ATT_SBAR(); } while (0)
#define VRD(i) do { vlo[i] = vtr(vp_ + (((i) >> 2) * 4096 + ((i) & 3) * 1024)); vhi[i] = vtr(vp_ + (((i) >> 2) * 4096 + ((i) & 3) * 1024 + 512)); } while (0)
#define KRD(G, j) do { if (G) { kload2(kf, kp0 + sl_next, j); ATT_SBAR(); } } while (0)
#define STEP(C0, C1, P0, P1, t, GK, GV, GL) do { ATT_SBAR(); \
    const lds_cptr vp_ = vp0 + sl_prev; \
    VRD(0); ATT_SBAR(); float sacc = (P0[0] + P0[1]); \
    GAPA(C0 = __builtin_amdgcn_mfma_f32_32x32x16_bf16(kf[0], qr[0], negm, 0, 0, 0), P0[2], P0[3], P0[4], P0[5],     pw0[0] = PKW(P0, 0), pw0[1] = PKW(P0, 2), pw0); \
    VRD(4); ATT_SBAR(); GAPA(C1 = __builtin_amdgcn_mfma_f32_32x32x16_bf16(kf[1], qr[0], negm, 0, 0, 0), P0[6], P0[7], P0[8], P0[9],     pw0[2] = PKW(P0, 4), pw0[3] = PKW(P0, 6), pw0); \
    VRD(1); ATT_SBAR(); GAPA(C0 = __builtin_amdgcn_mfma_f32_32x32x16_bf16(kf[2], qr[1], C0, 0, 0, 0),   P0[10], P0[11], P0[12], P0[13], pw1[0] = PKW(P0, 8), pw1[1] = PKW(P0, 10), pw1); \
    VRD(5); ATT_SBAR(); GAPA(C1 = __builtin_amdgcn_mfma_f32_32x32x16_bf16(kf[3], qr[1], C1, 0, 0, 0),   P0[14], P0[15], P1[0], P1[1],   pw1[2] = PKW(P0, 12), pw1[3] = PKW(P0, 14), pw1); \
    VRD(2); ATT_SBAR(); GAPA(C0 = __builtin_amdgcn_mfma_f32_32x32x16_bf16(kf[4], qr[2], C0, 0, 0, 0),   P1[2], P1[3], P1[4], P1[5],     pw2[0] = PKW(P1, 0), pw2[1] = PKW(P1, 2), pw2); \
    VRD(6); ATT_SBAR(); GAPA(C1 = __builtin_amdgcn_mfma_f32_32x32x16_bf16(kf[5], qr[2], C1, 0, 0, 0),   P1[6], P1[7], P1[8], P1[9],     pw2[2] = PKW(P1, 4), pw2[3] = PKW(P1, 6), pw2); \
    VRD(3); ATT_SBAR(); GAPA(C0 = __builtin_amdgcn_mfma_f32_32x32x16_bf16(kf[6], qr[3], C0, 0, 0, 0),   P1[10], P1[11], P1[12], P1[13], pw3[0] = PKW(P1, 8), pw3[1] = PKW(P1, 10), pw3); \
    VRD(7); ATT_SBAR(); GAPA(C1 = __builtin_amdgcn_mfma_f32_32x32x16_bf16(kf[7], qr[3], C1, 0, 0, 0),   P1[14], P1[15], 0.f, 0.f,       pw3[2] = PKW(P1, 12), pw3[3] = PKW(P1, 14), pw3); \
    l_reg += sacc; \
    if (GK) { DMA_K((t) + 3, sl_cur); } if (GV) { DMA_V((t) + 1, sl_next); } \
    CMASK(C0, C1, t); \
    { float a = MX3(C0[0], C0[1], C1[0]), b = MX3(C0[2], C0[3], C1[1]); a = MX3(a, C1[2], C1[3]); \
      _Pragma("unroll") for (int r = 4; r < 16; r += 4) { a = MX3(a, C0[r], C0[r + 1]); b = MX3(b, C0[r + 2], C0[r + 3]); a = MX3(a, C1[r], C1[r + 1]); b = MX3(b, C1[r + 2], C1[r + 3]); } \
      float rm = __builtin_fmaxf(a, b); { auto rr = __builtin_amdgcn_permlane32_swap(__float_as_uint(rm), __float_as_uint(rm), false, false); rm = __builtin_fmaxf(__uint_as_float(rr[0]), __uint_as_float(rr[1])); } \
      resc = false; \
      if (__builtin_expect(__any(rm > (float)THRL), 0)) { const float dl = __builtin_fmaxf(rm, 0.f); mhat += dl; \
        _Pragma("unroll") for (int r = 0; r < 16; ++r) { C0[r] -= dl; C1[r] -= dl; } \
        _Pragma("unroll") for (int r = 0; r < 16; ++r) negm[r] = -mhat; asm volatile("" : "+v"(negm)); \
        const float f = __builtin_amdgcn_exp2f(-dl); l_reg *= f; if (hi == 0) wsf[r32] = f; resc = true; } } \
    ATT_SBAR(); \
    GAPB(o[0] = __builtin_amdgcn_mfma_f32_32x32x16_bf16(PAF(0), VFR(0), o[0], 0, 0, 0), C0, 0); \
    GAPB(o[1] = __builtin_amdgcn_mfma_f32_32x32x16_bf16(PAF(0), VFR(4), o[1], 0, 0, 0), C0, 4); \
    KRD(GL, 0); GAPB(o[0] = __builtin_amdgcn_mfma_f32_32x32x16_bf16(PAF(1), VFR(1), o[0], 0, 0, 0), C0, 8); \
    KRD(GL, 1); GAPB(o[1] = __builtin_amdgcn_mfma_f32_32x32x16_bf16(PAF(1), VFR(5), o[1], 0, 0, 0), C0, 12); \
    KRD(GL, 2); GAPB(o[0] = __builtin_amdgcn_mfma_f32_32x32x16_bf16(PAF(2), VFR(2), o[0], 0, 0, 0), C1, 0); \
    KRD(GL, 3); GAPB(o[1] = __builtin_amdgcn_mfma_f32_32x32x16_bf16(PAF(2), VFR(6), o[1], 0, 0, 0), C1, 4); \
    GAPB(o[0] = __builtin_amdgcn_mfma_f32_32x32x16_bf16(PAF(3), VFR(3), o[0], 0, 0, 0), C1, 8); \
    GAPB(o[1] = __builtin_amdgcn_mfma_f32_32x32x16_bf16(PAF(3), VFR(7), o[1], 0, 0, 0), C1, 12); \
    } while (0)
    int t = 1;
    for (; t + 5 < NT; t += 2) {
        STEP(pB0, pB1, pA0, pA1, t, true, true, true);     ATT_WAIT_BAR(2); RESC(); ROT();
        STEP(pA0, pA1, pB0, pB1, t + 1, true, true, true); ATT_WAIT_BAR(2); RESC(); ROT();
    }
#define ENDW(tt) do { if ((tt) + 3 < NT) { ATT_WAIT_BAR(2); } else if ((tt) + 2 < NT) { ATT_WAIT_BAR(1); } else { ATT_WAIT_BAR(0); } } while (0)
    for (; t + 1 < NT; t += 2) {
        STEP(pB0, pB1, pA0, pA1, t, (t + 3 < NT), (t + 1 < NT), (t + 1 < NT));         ENDW(t);     RESC(); ROT();
        STEP(pA0, pA1, pB0, pB1, t + 1, (t + 4 < NT), (t + 2 < NT), (t + 2 < NT));     ENDW(t + 1); RESC(); ROT();
    }
#define DRAIN(X0, X1, SL) do { float sacc = X0[0] + X0[1]; \
      _Pragma("unroll") for (int r = 2; r < 16; ++r) sacc += X0[r]; \
      _Pragma("unroll") for (int r = 0; r < 16; ++r) sacc += X1[r]; \
      l_reg += sacc; \
      pw0 = (u32x4){PKW(X0, 0), PKW(X0, 2), PKW(X0, 4), PKW(X0, 6)}; pw1 = (u32x4){PKW(X0, 8), PKW(X0, 10), PKW(X0, 12), PKW(X0, 14)}; \
      pw2 = (u32x4){PKW(X1, 0), PKW(X1, 2), PKW(X1, 4), PKW(X1, 6)}; pw3 = (u32x4){PKW(X1, 8), PKW(X1, 10), PKW(X1, 12), PKW(X1, 14)}; \
      ATT_SBAR(); pv(o, vb0 + (SL), PAF(0), PAF(1), PAF(2), PAF(3)); } while (0)
    if (NT & 1) { DRAIN(pA0, pA1, sl_prev); }
    else { STEP(pB0, pB1, pA0, pA1, NT - 1, false, false, false); RESC(); DRAIN(pB0, pB1, sl_cur); }
#undef DRAIN
    l_out = l_reg;
    ATT_WAIT_BAR(0);
#undef FP_TSRC
#undef DMA_K
#undef DMA_V
#undef CMASK
#undef START
#undef RESC
#undef ROT
#undef PKW
#undef PAF
#undef VFR
#undef PIN
#undef MX3
#undef GAPA
#undef GAPB
#undef EX
#undef VRD
#undef KRD
#undef STEP
#undef ENDW
}

template <bool ADD> __device__ __forceinline__ void acc_rows(const f32x16 (&o)[2], float f, const Ctx& C_) {
    const int l = lane_now(), r32 = l & 31, hi = l >> 5;
    LAS float* wsf = (LAS float*)(C_.lds + A_WSF) + C_.wid * 64;
    if (hi == 0) wsf[r32] = f;
    asm volatile("s_waitcnt lgkmcnt(0)" ::: "memory");
    LAS float* lo = (LAS float*)(C_.lds + A_IMP + C_.wid * 4096) + 4 * hi * 64 + r32;
    LAS float* hp = (LAS float*)(C_.lds + A_OST + C_.wid * 4096) + 4 * hi * 64 + r32;
#pragma unroll
    for (int g = 0; g < 4; ++g) { const f32x4 fv = *(const LAS f32x4*)(wsf + 8 * g + 4 * hi);
#pragma unroll
        for (int i = 0; i < 4; ++i)
#pragma unroll
            for (int d0 = 0; d0 < 2; ++d0) { LAS float* p = ((g < 2) ? lo : hp) + ((i + 8 * (g & 1)) * 64 + 32 * d0);
                const float v = o[d0][4 * g + i] * fv[i]; if (ADD) *p += v; else *p = v; } }
    asm volatile("s_waitcnt lgkmcnt(0)" ::: "memory");
}
__device__ __forceinline__ void acc_flush(unsigned char* Ow, long pitch, const Ctx& C_) {
    const int l = lane_now();
#pragma unroll
    for (int i = 0; i < 4; ++i) { const int row = i * 8 + (l >> 3), ch = l & 7;
        const LAS float* p = (const LAS float*)(C_.lds + (row < 16 ? A_IMP : A_OST) + C_.wid * 4096) + (row & 15) * 64 + ch * 8;
        const f32x4 a = *(const LAS f32x4*)p * 16.f, b = *(const LAS f32x4*)(p + 4) * 16.f;
        u32x2 w; w.x = pk4_fp8(a[0], a[1], a[2], a[3]); w.y = pk4_fp8(b[0], b[1], b[2], b[3]);
        *(u32x2*)(Ow + (long)row * pitch + ch * 8) = w; }
    asm volatile("s_waitcnt lgkmcnt(0)" ::: "memory");
}
template <int THRL, bool PRE, class MaskF1, class MaskF2>
__device__ __forceinline__ void fast_pass2(const Ctx& C, const bf16x8 (&qr)[4], const bf16_t* Kp1, const bf16_t* Vp1, int n1, MaskF1 mask1, float g1,
                                           const bf16_t* Kp2, const bf16_t* Vp2, int t_lo2, int n2, MaskF2 mask2, float g2) {
    f32x16 o[2];
    const int lane = lane_now(), r32 = lane & 31, hi = lane >> 5; const int wid = C.wid;
    const unsigned lds0 = C.lds0;
    LAS float* wsf = (LAS float*)(C.lds + A_WSF) + wid * 64;
    int NT = (n1 + n2 + 1) & ~1; if (NT < 4) NT = 4;
    const int koff = lane * 64 + wid * 8, voff = (16 * (wid & 3) + (lane >> 2)) * 64 + (wid >> 2) * 32 + (lane & 3) * 8;
    const bf16_t* K2b = Kp2 + (long)t_lo2 * 4096; const bf16_t* V2b = Vp2 + (long)t_lo2 * 4096;
    const unsigned kdst = lds0 + F_K + wid * 1024, vdst = lds0 + F_V + wid * 1024;
#define FP_SEG2(t) ((t) >= n1)
#define FP_TIDX(t) (FP_SEG2(t) ? ((((t) - n1) < n2) ? ((t) - n1) : (n2 - 1)) : (t))
#define DMA_K(t, slot) glds16((FP_SEG2(t) ? K2b : Kp1) + (long)FP_TIDX(t) * 4096 + koff, (unsigned)__builtin_amdgcn_readfirstlane(kdst + (slot)))
#define DMA_V(t, slot) glds16((FP_SEG2(t) ? V2b : Vp1) + (long)FP_TIDX(t) * 4096 + voff, (unsigned)__builtin_amdgcn_readfirstlane(vdst + (slot)))
    const int vb0 = (int)(lds0 + F_V) + ((lane >> 4) & 1) * 32 + (lane & 3) * 8 + (4 * hi + ((lane & 15) >> 2)) * 64;
    bf16x8 kf[8];
    const lds_cptr shm3 = (lds_cptr)C.lds; const lds_cptr kp0 = shm3 + F_K + hi * 1024 + r32 * 16; const lds_cptr vp0 = shm3 + F_V + ((lane >> 4) & 1) * 32 + (lane & 3) * 8 + (4 * hi + ((lane & 15) >> 2)) * 64;
    if (!PRE) { DMA_K(0, 0); DMA_V(0, 0); DMA_K(1, F_SLOT); }
    float mhat = 0.f, l_reg = 0.f; o[0] = f32x16{}; o[1] = f32x16{}; const f32x16 zc = {};
#define CMASK(P0, P1, t) do { if ((t) < n1) mask1(P0, P1, (t)); else mask2(P0, P1, (t) - n1); } while (0)
    bool resc = false;
#define START(P0, P1) do { const float rm = rowmax3(P0, P1); resc = false; \
    { const float dl = rm; mhat = fadd_s(mhat, dl); \
      _Pragma("unroll") for (int r = 0; r < 16; ++r) { P0[r] = fsub_s(P0[r], dl); P1[r] = fsub_s(P1[r], dl); } \
      } \
    _Pragma("unroll") for (int r = 0; r < 16; ++r) P0[r] = __builtin_amdgcn_exp2f(P0[r]); } while (0)
#define RESC() do { if (resc) { asm volatile("s_waitcnt lgkmcnt(0)" ::: "memory"); \
      _Pragma("unroll") for (int d_ = 0; d_ < 2; ++d_) _Pragma("unroll") for (int r = 0; r < 16; ++r) o[d_][r] *= wsf[crow(r, hi)]; } } while (0)
    f32x16 pA0, pA1, pB0, pB1;
    int sl_prev = 0, sl_cur = 0, sl_next = F_SLOT;
#define SEAM_FIN(t) do { if ((t) == n1) { acc_rows<true>(o, g1 / halfsum(l_reg), C); o[0] = f32x16{}; o[1] = f32x16{}; l_reg = 0.f; } } while (0)
#define ROT() do { sl_prev = sl_cur; sl_cur = sl_next; sl_next = (sl_next == 2 * F_SLOT) ? 0 : sl_next + F_SLOT; } while (0)
    if (!PRE) DMA_K(2, 2 * F_SLOT);
    ATT_WAIT_BAR(3);
    { const LAS unsigned char* kb = C.lds + F_K + hi * 1024 + r32 * 16;
#pragma unroll
      for (int d0 = 0; d0 < 4; ++d0) { const bf16x8 b0 = *(const LAS bf16x8*)(kb + d0 * 2048); const bf16x8 b1 = *(const LAS bf16x8*)(kb + d0 * 2048 + 512);
          if (d0 == 0) { pA0 = __builtin_amdgcn_mfma_f32_32x32x16_bf16(b0, qr[0], zc, 0, 0, 0); pA1 = __builtin_amdgcn_mfma_f32_32x32x16_bf16(b1, qr[0], zc, 0, 0, 0); }
          else { pA0 = __builtin_amdgcn_mfma_f32_32x32x16_bf16(b0, qr[d0], pA0, 0, 0, 0); pA1 = __builtin_amdgcn_mfma_f32_32x32x16_bf16(b1, qr[d0], pA1, 0, 0, 0); } } }
    CMASK(pA0, pA1, 0);
    asm volatile("s_nop 15\n\ts_nop 7" : "+v"(pA0), "+v"(pA1));
    START(pA0, pA1);
#pragma unroll
    for (int r = 0; r < 16; ++r) pA1[r] = __builtin_amdgcn_exp2f(pA1[r]);
    ATT_WAIT_BAR(0);
    DMA_K(3, 0); DMA_V(1, F_SLOT);
    ROT();
    kload8(kf, kp0 + sl_cur);
    ATT_WAIT_BAR(2);
    s16x4 vlo[8], vhi[8]; u32x4 pw0, pw1, pw2, pw3;
#define PKW(P, B) cvtpk(P[B], P[B + 1])
#define PAF(k) __builtin_bit_cast(bf16x8, pw##k)
#define VFR(i) (bf16x8){vlo[i][0], vlo[i][1], vlo[i][2], vlo[i][3], vhi[i][0], vhi[i][1], vhi[i][2], vhi[i][3]}
#define PIN(x) asm volatile("" : "+v"(x))
#define MX3(a, b, c) __builtin_fmaxf(__builtin_fmaxf((a), (b)), (c))
#define GAPA(MF, A0, A1, A2, A3, W0, W1, PW) do { MF; sacc += A0; sacc += A1; sacc += A2; sacc += A3; PIN(sacc); W0; W1; PIN(PW); ATT_SBAR(); } while (0)
#define EX(v) __builtin_amdgcn_exp2f(v)
#define GAPB(MF, X, B) do { MF; X[B] = EX(X[B]); X[B + 1] = EX(X[B + 1]); X[B + 2] = EX(X[B + 2]); X[B + 3] = EX(X[B + 3]); PIN(X); ATT_SBAR(); } while (0)
#define VRD(i) do { vlo[i] = vtr(vp_ + (((i) >> 2) * 4096 + ((i) & 3) * 1024)); vhi[i] = vtr(vp_ + (((i) >> 2) * 4096 + ((i) & 3) * 1024 + 512)); } while (0)
#define KRD(G, j) do { if (G) { kload2(kf, kp0 + sl_next, j); ATT_SBAR(); } } while (0)
#define STEP(C0, C1, P0, P1, t, GK, GV, GL) do { ATT_SBAR(); \
    const lds_cptr vp_ = vp0 + sl_prev; \
    VRD(0); ATT_SBAR(); float sacc = (P0[0] + P0[1]); \
    GAPA(C0 = __builtin_amdgcn_mfma_f32_32x32x16_bf16(kf[0], qr[0], zc, 0, 0, 0), P0[2], P0[3], P0[4], P0[5],     pw0[0] = PKW(P0, 0), pw0[1] = PKW(P0, 2), pw0); \
    VRD(4); ATT_SBAR(); GAPA(C1 = __builtin_amdgcn_mfma_f32_32x32x16_bf16(kf[1], qr[0], zc, 0, 0, 0), P0[6], P0[7], P0[8], P0[9],     pw0[2] = PKW(P0, 4), pw0[3] = PKW(P0, 6), pw0); \
    VRD(1); ATT_SBAR(); GAPA(C0 = __builtin_amdgcn_mfma_f32_32x32x16_bf16(kf[2], qr[1], C0, 0, 0, 0),   P0[10], P0[11], P0[12], P0[13], pw1[0] = PKW(P0, 8), pw1[1] = PKW(P0, 10), pw1); \
    VRD(5); ATT_SBAR(); GAPA(C1 = __builtin_amdgcn_mfma_f32_32x32x16_bf16(kf[3], qr[1], C1, 0, 0, 0),   P0[14], P0[15], P1[0], P1[1],   pw1[2] = PKW(P0, 12), pw1[3] = PKW(P0, 14), pw1); \
    VRD(2); ATT_SBAR(); GAPA(C0 = __builtin_amdgcn_mfma_f32_32x32x16_bf16(kf[4], qr[2], C0, 0, 0, 0),   P1[2], P1[3], P1[4], P1[5],     pw2[0] = PKW(P1, 0), pw2[1] = PKW(P1, 2), pw2); \
    VRD(6); ATT_SBAR(); GAPA(C1 = __builtin_amdgcn_mfma_f32_32x32x16_bf16(kf[5], qr[2], C1, 0, 0, 0),   P1[6], P1[7], P1[8], P1[9],     pw2[2] = PKW(P1, 4), pw2[3] = PKW(P1, 6), pw2); \
    VRD(3); ATT_SBAR(); GAPA(C0 = __builtin_amdgcn_mfma_f32_32x32x16_bf16(kf[6], qr[3], C0, 0, 0, 0),   P1[10], P1[11], P1[12], P1[13], pw3[0] = PKW(P1, 8), pw3[1] = PKW(P1, 10), pw3); \
    VRD(7); ATT_SBAR(); GAPA(C1 = __builtin_amdgcn_mfma_f32_32x32x16_bf16(kf[7], qr[3], C1, 0, 0, 0),   P1[14], P1[15], 0.f, 0.f,       pw3[2] = PKW(P1, 12), pw3[3] = PKW(P1, 14), pw3); \
    l_reg += sacc; \
    if (GK) { DMA_K((t) + 3, sl_cur); } if (GV) { DMA_V((t) + 1, sl_next); } \
    _Pragma("unroll") for (int r = 0; r < 16; ++r) { C0[r] -= mhat; C1[r] -= mhat; } \
    CMASK(C0, C1, t); \
    { float a = MX3(C0[0], C0[1], C1[0]), b = MX3(C0[2], C0[3], C1[1]); a = MX3(a, C1[2], C1[3]); \
      _Pragma("unroll") for (int r = 4; r < 16; r += 4) { a = MX3(a, C0[r], C0[r + 1]); b = MX3(b, C0[r + 2], C0[r + 3]); a = MX3(a, C1[r], C1[r + 1]); b = MX3(b, C1[r + 2], C1[r + 3]); } \
      float rm = __builtin_fmaxf(a, b); { auto rr = __builtin_amdgcn_permlane32_swap(__float_as_uint(rm), __float_as_uint(rm), false, false); rm = __builtin_fmaxf(__uint_as_float(rr[0]), __uint_as_float(rr[1])); } \
      resc = false; \
      if ((t) == n1) { const float dl = rm; mhat += dl;                        \
        _Pragma("unroll") for (int r = 0; r < 16; ++r) { C0[r] -= dl; C1[r] -= dl; } \
        } \
      else if (__builtin_expect(__any(rm > (float)THRL), 0)) { const float dl = __builtin_fmaxf(rm, 0.f); mhat += dl; \
        _Pragma("unroll") for (int r = 0; r < 16; ++r) { C0[r] -= dl; C1[r] -= dl; } \
        const float f = __builtin_amdgcn_exp2f(-dl); l_reg *= f; if (hi == 0) wsf[r32] = f; resc = true; } } \
    ATT_SBAR(); \
    GAPB(o[0] = __builtin_amdgcn_mfma_f32_32x32x16_bf16(PAF(0), VFR(0), o[0], 0, 0, 0), C0, 0); \
    GAPB(o[1] = __builtin_amdgcn_mfma_f32_32x32x16_bf16(PAF(0), VFR(4), o[1], 0, 0, 0), C0, 4); \
    KRD(GL, 0); GAPB(o[0] = __builtin_amdgcn_mfma_f32_32x32x16_bf16(PAF(1), VFR(1), o[0], 0, 0, 0), C0, 8); \
    KRD(GL, 1); GAPB(o[1] = __builtin_amdgcn_mfma_f32_32x32x16_bf16(PAF(1), VFR(5), o[1], 0, 0, 0), C0, 12); \
    KRD(GL, 2); GAPB(o[0] = __builtin_amdgcn_mfma_f32_32x32x16_bf16(PAF(2), VFR(2), o[0], 0, 0, 0), C1, 0); \
    KRD(GL, 3); GAPB(o[1] = __builtin_amdgcn_mfma_f32_32x32x16_bf16(PAF(2), VFR(6), o[1], 0, 0, 0), C1, 4); \
    GAPB(o[0] = __builtin_amdgcn_mfma_f32_32x32x16_bf16(PAF(3), VFR(3), o[0], 0, 0, 0), C1, 8); \
    GAPB(o[1] = __builtin_amdgcn_mfma_f32_32x32x16_bf16(PAF(3), VFR(7), o[1], 0, 0, 0), C1, 12); \
    } while (0)
    int t = 1;
    for (; t + 5 < NT; t += 2) {
        STEP(pB0, pB1, pA0, pA1, t, true, true, true);     ATT_WAIT_BAR(2); RESC(); SEAM_FIN(t); ROT();
        STEP(pA0, pA1, pB0, pB1, t + 1, true, true, true); ATT_WAIT_BAR(2); RESC(); SEAM_FIN(t + 1); ROT();
    }
#define ENDW(tt) do { if ((tt) + 3 < NT) { ATT_WAIT_BAR(2); } else if ((tt) + 2 < NT) { ATT_WAIT_BAR(1); } else { ATT_WAIT_BAR(0); } } while (0)
    for (; t + 1 < NT; t += 2) {
        STEP(pB0, pB1, pA0, pA1, t, (t + 3 < NT), (t + 1 < NT), (t + 1 < NT));         ENDW(t);     RESC(); SEAM_FIN(t); ROT();
        STEP(pA0, pA1, pB0, pB1, t + 1, (t + 4 < NT), (t + 2 < NT), (t + 2 < NT));     ENDW(t + 1); RESC(); SEAM_FIN(t + 1); ROT();
    }
    STEP(pB0, pB1, pA0, pA1, NT - 1, false, false, false); RESC(); SEAM_FIN(NT - 1);
    { float sacc = pB0[0] + pB0[1];
#pragma unroll
      for (int r = 2; r < 16; ++r) sacc += pB0[r];
#pragma unroll
      for (int r = 0; r < 16; ++r) sacc += pB1[r];
      l_reg += sacc;
      pw0 = (u32x4){PKW(pB0, 0), PKW(pB0, 2), PKW(pB0, 4), PKW(pB0, 6)}; pw1 = (u32x4){PKW(pB0, 8), PKW(pB0, 10), PKW(pB0, 12), PKW(pB0, 14)};
      pw2 = (u32x4){PKW(pB1, 0), PKW(pB1, 2), PKW(pB1, 4), PKW(pB1, 6)}; pw3 = (u32x4){PKW(pB1, 8), PKW(pB1, 10), PKW(pB1, 12), PKW(pB1, 14)};
      ATT_SBAR(); pv(o, vb0 + sl_cur, PAF(0), PAF(1), PAF(2), PAF(3)); }
    acc_rows<true>(o, g2 / halfsum(l_reg), C);
    ATT_WAIT_BAR(0);
#undef FP_SEG2
#undef FP_TIDX
#undef SEAM_FIN
#undef DMA_K
#undef DMA_V
#undef CMASK
#undef START
#undef RESC
#undef ROT
#undef PKW
#undef PAF
#undef VFR
#undef PIN
#undef MX3
#undef GAPA
#undef GAPB
#undef EX
#undef VRD
#undef KRD
#undef STEP
#undef ENDW
}

}
namespace att {
template <int CTRL> __device__ __forceinline__ float dppf(float v) { return __uint_as_float(__builtin_amdgcn_update_dpp(0u, __float_as_uint(v), CTRL, 0xf, 0xf, true)); }
template <class T> __device__ __forceinline__ T* fresh_ptr(T* p) { asm volatile("" : "+v"(p)); return p; }
__device__ __forceinline__ void dil_unit(const Ctx& C, unsigned char* ws, int u, bf16_t* obraw, float* lse) {
    const int gi = u >> 9, v = u & 511, hw = C.wid >> 2, w4 = C.wid & 3;
    const int b = v >> 4, j = (v >> 3) & 1;
    int ds, res, blk, L;
    if (gi == 0) { ds = 1; res = 0; blk = 2 * (v & 7) + hw; L = 2048; }
    else if (gi == 1) { ds = 4; res = (v >> 1) & 3; blk = 2 * (v & 1) + hw; L = 512; }
    else { ds = 16; res = 2 * (v & 7) + hw; blk = 0; L = 128; }
    const int h6 = gi * 2 + j;
    const size_t tokbase = (size_t)b * SEQ + res;
    const bf16_t* Qp = (const bf16_t*)(ws + slot_off(SL_QB + h6)) + tokbase * 64;
    const bf16_t* Kp = (const bf16_t*)(ws + slot_off(SL_KB + h6)) + tokbase * 64;
    const bf16_t* Vp = (const bf16_t*)(ws + slot_off(SL_VB + h6)) + tokbase * 64;
    const long rs = (long)ds * 64;
    int t_lo = 2 * blk - 2; if (t_lo < 0) t_lo = 0; int t_hi = 2 * blk + 2; if (t_hi > L / 64) t_hi = L / 64;
    const int nsteps = (gi == 2) ? 2 : 4;
    const int l0_ = lane_now(); const int hi = l0_ >> 5;
    const int i0 = 128 * blk + 32 * w4, iq = i0 + (l0_ & 31);
    bf16x8 qr[4]; load_q(qr, Qp + (long)iq * rs, hi);
    SM st; sm_init(st);
    auto mask = [&](f32x16& p0, f32x16& p1, int tile) {
        const int lim = fresh(iq - 64 * tile - 4 * hi), lim2 = lim - 128;
#pragma unroll
        for (int r = 0; r < 16; ++r) { const int c = (r & 3) + 8 * (r >> 2);
            if (c > lim || c < lim2) p0[r] = NEG_INF;
            if (c + 32 > lim || c + 32 < lim2) p1[r] = NEG_INF; }
    };
    auto skip = [&](int tile) { return (64 * tile > i0 + 31) || (64 * tile + 63 < i0 - 128); };
    run_pass<2>(C, st, qr, Kp, Vp, rs, t_lo, t_hi, nsteps, mask, skip);
    const float lt = halfsum(st.l);
    const float inv = 1.0f / lt;
    scale_rows(st.o, inv, C);
    store_o(st.o, obraw + (tokbase + (size_t)i0 * ds) * 384 + h6 * 64, (long)ds * 384, C);
    if ((lane_now() >> 5) == 0) lse[(tokbase + (size_t)iq * ds) * 8 + h6] = (st.m + __builtin_amdgcn_logf(lt)) * 0.6931471805599453f;
    ATT_WAIT_BAR(0);
}

__device__ __forceinline__ void nsa_unit(const Ctx& C, unsigned char* ws, int b, int hk, int blk, unsigned char* oa) {
    const int g = C.wid >> 1, head = hk * 4 + g;
    const size_t tokbase = (size_t)b * SEQ;
    const bf16_t* qbase = (const bf16_t*)(ws + slot_off(SL_QA + head)) + (tokbase + 64 * blk + 32 * (C.wid & 1)) * 64;
    const bf16_t* gabase = (const bf16_t*)(ws + slot_off(SL_GA)) + (tokbase + 64 * blk + 32 * (C.wid & 1)) * 64;
#define NSA_LANE_STATE() const int l_ = lane_now(); const int r32_ = l_ & 31, hi = l_ >> 5; const int tq = 64 * blk + 32 * (C.wid & 1) + r32_; \
    const bf16_t* qrow = qbase + r32_ * 64; const bf16_t* ga = gabase + r32_ * 64
#ifndef PROBE_ZERO
#define PROBE_ZERO 0
#endif
    f32x16 ot[2]; ot[0] = f32x16{}; ot[1] = f32x16{};
    LAS float* imp = (LAS float*)(C.lds + A_IMP);
    LAS unsigned* sel = (LAS unsigned*)(C.lds + A_SEL);
#if defined(PROBE_DUP) && PROBE_DUP == 1
    for (int rep_ = 0; rep_ < 2; ++rep_)
#endif
    {
        ot[0] = f32x16{}; ot[1] = f32x16{};
        NSA_LANE_STATE();
        bf16x8 qr[4]; load_q(qr, qrow, hi);
        const float g_cmp = (PROBE_ZERO & 1) ? 0.f : bf2f(ga[head]);
        const int pair = hk * 32 + b;
        const bf16_t* Kc = (const bf16_t*)(ws + WS_KC) + (size_t)pair * 128 * 64;
        const bf16_t* Vc = (const bf16_t*)(ws + WS_KC + MiB) + (size_t)pair * 128 * 64;
        const bool two = blk >= 16;
#ifndef NSA_SPLIT_PASSES
        fast_prefetch2(C, (const bf16_t*)(ws + slot_off(SL_KSLC + hk)) + tokbase * 64, (const bf16_t*)(ws + slot_off(SL_VSLC + hk)) + tokbase * 64, blk + 1,
                       (const bf16_t*)(ws + slot_off(SL_KWIN + hk)) + tokbase * 64, blk >= 8 ? blk - 8 : 0, blk >= 8 ? 9 : blk + 1);
#else
        fast_prefetch(C, (const bf16_t*)(ws + slot_off(SL_KSLC + hk)) + tokbase * 64, (const bf16_t*)(ws + slot_off(SL_VSLC + hk)) + tokbase * 64, 0, blk + 1);
#endif
        dma_tile<1>(C, Kc, Vc, 64, 0, 0, 0, A_OST);
        if (two) dma_tile<1>(C, Kc, Vc, 64, 1, 1, 0, A_OST);
        ATT_WAIT_BAR(0);
        const int nlim = (tq - 31) >> 4;
        auto cmask = [&](f32x16& p0, f32x16& p1, int tile) {
            { const int lim = fresh(nlim - 64 * tile - 4 * hi);
#pragma unroll
              for (int r = 0; r < 16; ++r) { const int c = (r & 3) + 8 * (r >> 2); if (c > lim) p0[r] = NEG_INF; if (c + 32 > lim) p1[r] = NEG_INF; } } };
        float rm;
        { f32x16 s0, s1; qkt(s0, s1, C.lds + A_OST, qr, C.lane); cmask(s0, s1, 0); rm = rowmax(s0, s1);
          if (two) { qkt(s0, s1, C.lds + A_OST + 16384, qr, C.lane); cmask(s0, s1, 1); rm = fmaxf(rm, rowmax(s0, s1)); } }
        const bool has = rm > -1e29f; if (!has) rm = 0.f;
        LAS float* irh; { unsigned a_ = (unsigned)(size_t)(imp + (g * 64 + 32 * (C.wid & 1) + r32_) * 33 + hi); asm volatile("" : "+v"(a_)); irh = (LAS float*)(size_t)a_; }
        float sum = 0.f;
#pragma unroll
        for (int gq = 0; gq < 8; ++gq) irh[16 + 2 * gq] = 0.f;
        asm volatile("s_waitcnt lgkmcnt(0)" ::: "memory");
#pragma unroll
        for (int tile = 0; tile < 2; ++tile) {
            if (tile == 0 || two) {
                f32x16 s0, s1; qkt(s0, s1, C.lds + A_OST + tile * 16384, qr, C.lane); cmask(s0, s1, tile);
#pragma unroll
                for (int r = 0; r < 16; ++r) { s0[r] = __builtin_amdgcn_exp2f(s0[r] - rm); s1[r] = __builtin_amdgcn_exp2f(s1[r] - rm); sum += s0[r] + s1[r]; }
#pragma unroll
                for (int gq = 0; gq < 4; ++gq) { const float A0 = (s0[4 * gq] + s0[4 * gq + 1]) + (s0[4 * gq + 2] + 0.5f * s0[4 * gq + 3]), A1 = (s1[4 * gq] + s1[4 * gq + 1]) + (s1[4 * gq + 2] + 0.5f * s1[4 * gq + 3]);
                    if (tile == 0) { irh[2 * gq] = A0; irh[8 + 2 * gq] = A1; } else { irh[16 + 2 * gq] += A0; irh[24 + 2 * gq] += A1; } }
                asm volatile("s_waitcnt lgkmcnt(0)" ::: "memory");
#pragma unroll
                for (int gq = 0; gq < 4; ++gq) { const int j0 = 16 * tile + 2 * gq + 1, j1 = j0 + 8;
                    irh[j0] += 0.5f * s0[4 * gq + 3];
                    if (j1 < 31) irh[j1] += 0.5f * s1[4 * gq + 3]; else if (hi == 0) irh[j1] += 0.5f * s1[4 * gq + 3]; }
                asm volatile("s_waitcnt lgkmcnt(0)" ::: "memory");
                { const int lv = lane_now(); const int vlane = ((lv >> 4) & 1) * 32 + (lv & 3) * 8 + (4 * (lv >> 5) + ((lv & 15) >> 2)) * 64;
                  pv_tile(ot, (int)C.lds0 + A_OST + tile * 16384 + 8192 + vlane, s0, s1); }
            }
        }
        const float lt = halfsum(sum); const float inv = has ? 1.0f / lt : 0.f;
        if (hi == 0) ((LAS float*)(C.lds + A_SEL + 256))[g * 64 + 32 * (C.wid & 1) + (lane_now() & 31)] = inv;
        scale_rows(ot, g_cmp * inv, C);
        ATT_WAIT_BAR(0);
        {
            const int l_ = lane_now(); const int jb = l_ & 31, hf = l_ >> 5;
            const LAS float* nrm = (const LAS float*)(C.lds + A_SEL + 256);
            unsigned m0 = 1u | (1u << blk); if (blk >= 1) m0 |= 1u << (blk - 1);
            const int need = 8 - __builtin_popcount(m0), ncand = blk - 2;
            const bool cand = (jb >= 1) && (jb <= blk - 2);
#pragma unroll 1
            for (int it = 0; it < 4; ++it) {
                const int q = C.wid * 8 + 2 * it + hf; unsigned m = m0;
                if (ncand > 0) {
                    if (ncand <= need) { m |= ((1u << (blk - 1)) - 1u) & ~1u; }
                    else {
                        float sc = (imp[(0 * 64 + q) * 33 + jb] * nrm[q] + imp[(1 * 64 + q) * 33 + jb] * nrm[64 + q]) + (imp[(2 * 64 + q) * 33 + jb] * nrm[128 + q] + imp[(3 * 64 + q) * 33 + jb] * nrm[192 + q]);
#ifdef PROBE_SELINV
                        sc = 1e30f - sc;
#endif
                        if (!cand) sc = -1.f;
                        for (int r = 0; r < need; ++r) {
                            float mx = sc;
                            mx = fmaxf(mx, dppf<0xB1>(mx)); mx = fmaxf(mx, dppf<0x4E>(mx)); mx = fmaxf(mx, dppf<0x141>(mx)); mx = fmaxf(mx, dppf<0x140>(mx));
                            { const float up = __uint_as_float(__builtin_amdgcn_update_dpp(__float_as_uint(mx), __float_as_uint(mx), 0x142, 0xa, 0xf, false));
                              const float m2 = fmaxf(mx, up);
                              const float m31 = __uint_as_float(__builtin_amdgcn_readlane(__float_as_uint(m2), 31)), m63 = __uint_as_float(__builtin_amdgcn_readlane(__float_as_uint(m2), 63));
                              mx = hf ? m63 : m31; }
                            const unsigned long long bal = __ballot(sc == mx && sc >= 0.f);
                            const unsigned bm = hf ? (unsigned)(bal >> 32) : (unsigned)bal;
                            const int w = __ffs(bm) - 1;
                            if (w >= 0) { m |= 1u << w; if (jb == w) sc = -1.f; }
                        }
                    }
                }
                if (jb == 0) sel[q] = m;
            }
        }
        ATT_WAIT_BAR(0);
    }
    const unsigned mysel = sel[32 * (C.wid & 1) + (lane_now() & 31)];
    acc_rows<false>(ot, 1.0f, C);
#ifndef NSA_SPLIT_PASSES
    {
        const bf16_t* Kp1 = (const bf16_t*)(ws + slot_off(SL_KSLC + hk)) + tokbase * 64; const bf16_t* Vp1 = (const bf16_t*)(ws + slot_off(SL_VSLC + hk)) + tokbase * 64;
        const bf16_t* Kp2 = (const bf16_t*)(ws + slot_off(SL_KWIN + hk)) + tokbase * 64; const bf16_t* Vp2 = (const bf16_t*)(ws + slot_off(SL_VWIN + hk)) + tokbase * 64;
        const int n1 = blk + 1, t_lo2 = blk >= 8 ? blk - 8 : 0, n2 = blk + 1 - t_lo2;
        NSA_LANE_STATE();
        bf16x8 qr[4]; load_q(qr, qrow, hi);
        const float g_slc = (PROBE_ZERO & 2) ? 0.f : bf2f(ga[8 + head]), g_win = (PROBE_ZERO & 4) ? 0.f : bf2f(ga[16 + head]);
        auto mask1 = [&](f32x16& p0, f32x16& p1, int t) {
            const bool on = ((mysel >> t) & 1u);
            if (!__all(on) || t == blk) {
                if (!on) {
#pragma unroll
                    for (int r = 0; r < 16; ++r) { p0[r] = NEG_INF; p1[r] = NEG_INF; } }
                else if (t == blk) { const int lim = fresh(tq - 64 * t - 4 * hi);
#pragma unroll
                    for (int r = 0; r < 16; ++r) { const int c = (r & 3) + 8 * (r >> 2); if (c > lim) p0[r] = NEG_INF; if (c + 32 > lim) p1[r] = NEG_INF; } }
            }
        };
        auto mask2 = [&](f32x16& p0, f32x16& p1, int t) {
            if (t >= n2) {
#pragma unroll
                for (int r = 0; r < 16; ++r) { p0[r] = NEG_INF; p1[r] = NEG_INF; } }
            else if (t == n2 - 1 || (t == 0 && blk >= 8)) { const int lim = fresh(tq - 64 * (t_lo2 + t) - 4 * hi), lim2 = lim - 512;
#pragma unroll
                for (int r = 0; r < 16; ++r) { const int c = (r & 3) + 8 * (r >> 2);
                    if (c > lim || c < lim2) p0[r] = NEG_INF; if (c + 32 > lim || c + 32 < lim2) p1[r] = NEG_INF; } }
        };
        fast_pass2<8, true>(C, qr, Kp1, Vp1, n1, mask1, g_slc, Kp2, Vp2, t_lo2, n2, mask2, g_win);
    }
#else
    {
        const bf16_t* Kp = (const bf16_t*)(ws + slot_off(SL_KSLC + hk)) + tokbase * 64;
        const bf16_t* Vp = (const bf16_t*)(ws + slot_off(SL_VSLC + hk)) + tokbase * 64;
        const int ntr = blk + 1;
        NSA_LANE_STATE();
        bf16x8 qr[4]; load_q(qr, qrow, hi);
        const float g_slc = (PROBE_ZERO & 2) ? 0.f : bf2f(ga[8 + head]);
        auto mask = [&](f32x16& p0, f32x16& p1, int t) {
            const bool on = (t < ntr) && ((mysel >> t) & 1u);
            if (!__all(on) || t == blk) {
                if (!on) {
#pragma unroll
                    for (int r = 0; r < 16; ++r) { p0[r] = NEG_INF; p1[r] = NEG_INF; } }
                else if (t == blk) { const int lim = fresh(tq - 64 * t - 4 * hi);
#pragma unroll
                    for (int r = 0; r < 16; ++r) { const int c = (r & 3) + 8 * (r >> 2); if (c > lim) p0[r] = NEG_INF; if (c + 32 > lim) p1[r] = NEG_INF; } }
            }
        };
        f32x16 o[2]; float l;
        fast_pass<8, true>(C, qr, Kp, Vp, 0, ntr, mask, o, l);
        acc_rows<true>(o, g_slc * __builtin_amdgcn_rcpf(halfsum(l)), C);
#if defined(PROBE_DUP) && PROBE_DUP == 2
        fast_pass<8, false>(C, qr, Kp, Vp, 0, ntr, mask, o, l);
        acc_rows<true>(o, 0.f * halfsum(l), C);
#endif
    }
    {
        const bf16_t* Kp = (const bf16_t*)(ws + slot_off(SL_KWIN + hk)) + tokbase * 64;
        const bf16_t* Vp = (const bf16_t*)(ws + slot_off(SL_VWIN + hk)) + tokbase * 64;
        const int t_lo = blk >= 8 ? blk - 8 : 0, ntr = blk + 1 - t_lo;
        NSA_LANE_STATE();
        bf16x8 qr[4]; load_q(qr, qrow, hi);
        const float g_win = (PROBE_ZERO & 4) ? 0.f : bf2f(ga[16 + head]);
        auto mask = [&](f32x16& p0, f32x16& p1, int t) {
            if (t >= ntr) {
#pragma unroll
                for (int r = 0; r < 16; ++r) { p0[r] = NEG_INF; p1[r] = NEG_INF; } }
            else if (t == ntr - 1 || (t == 0 && blk >= 8)) { const int lim = fresh(tq - 64 * (t_lo + t) - 4 * hi), lim2 = lim - 512;
#pragma unroll
                for (int r = 0; r < 16; ++r) { const int c = (r & 3) + 8 * (r >> 2);
                    if (c > lim || c < lim2) p0[r] = NEG_INF; if (c + 32 > lim || c + 32 < lim2) p1[r] = NEG_INF; } }
        };
        f32x16 o[2]; float l;
        fast_pass<8, false>(C, qr, Kp, Vp, t_lo, ntr, mask, o, l);
        acc_rows<true>(o, g_win * __builtin_amdgcn_rcpf(halfsum(l)), C);
#if defined(PROBE_DUP) && PROBE_DUP == 3
        fast_pass<8, false>(C, qr, Kp, Vp, t_lo, ntr, mask, o, l);
        acc_rows<true>(o, 0.f * halfsum(l), C);
#endif
    }
#endif
    acc_flush(oa + (tokbase + 64 * blk + 32 * (C.wid & 1)) * 1024 + head * 64, 1024, C);
    ATT_WAIT_BAR(0);
}
}
__device__ __forceinline__ void pf4_router(Frame& F, const Args& a, const bool dry = false) {
#ifdef X1_BF16
    const bf16_t* x1 = WSP(bf16_t, WS_Y);
#else
    const float* x1 = a.out;
#endif
    const float* mod = WSP(float, WS_MOD); const float* rowss = WSP(float, WS_ROWSS);
    const float* b_group = (const float*)a.in[22]; const float* b_router = (const float*)a.in[24];
    const bf16_t* rhi = (const bf16_t*)(F.ws + WS_SMALL + 65536); const bf16_t* rlo = (const bf16_t*)(F.ws + WS_SMALL + 196608);
    unsigned char* h2 = WSP(unsigned char, WS_H);
    int* pick_e = (int*)(F.ws + WS_PICK); int* pick_pos = (int*)(F.ws + WS_PICK + 524288); float* pick_w = (float*)(F.ws + WS_PICK + 1048576); int* list = WSP(int, WS_LIST);
    LAS unsigned char* wch = F.lds; LAS float* mv = (LAS float*)(F.lds + 67584);
    LAS float* lg = (LAS float*)(F.lds + 75776) + F.wave * (32 * 40);
    LAS int* lc = (LAS int*)(F.lds + 116736); LAS int* gb = lc + 32;
    const int r32 = F_LANE() & 31, hi = F_LANE() >> 5;
    const int NGW = F.G * 8, ntask = NT_TOK / 32, iters = (ntask + NGW - 1) / NGW;
    for (int it = 0; it < iters; ++it) {
        const int task = it * NGW + F.vcu * 8 + F.wave; const bool valid = task < ntask;
        if (F_TID() < 32) lc[F_TID()] = 0;
        __syncthreads();
        int e1 = 0, e2 = 0, p1 = 0, p2 = 0; float w1 = 0.f, w2 = 0.f; int row = 0;
        f32x16 acc0 = {}, acc1 = {};
        {
            row = (valid ? task : 0) * 32 + r32; const int b = row >> 11;
            float ss = 0.f; { const f32x4* rp = (const f32x4*)(rowss + (size_t)row * 16); const f32x4 s0 = rp[0], s1 = rp[1], s2 = rp[2], s3 = rp[3];
                ss = ((s0[0] + s0[1]) + (s0[2] + s0[3])) + ((s1[0] + s1[1]) + (s1[2] + s1[3])) + ((s2[0] + s2[1]) + (s2[2] + s2[3])) + ((s3[0] + s3[1]) + (s3[2] + s3[3])); }
            const float rstd = __builtin_amdgcn_rsqf(ss * (1.f / DM) + EPS);
            unsigned char* hp = h2 + (size_t)row * DM + 8 * hi;
#ifdef X1_BF16
            const bf16_t* xr = x1 + (size_t)row * DM + 8 * hi;
            u32x4 xq[4];
#pragma unroll
            for (int j = 0; j < 4; ++j) xq[j] = *(const u32x4*)(xr + 16 * j);
#else
            const float* xr = x1 + (size_t)row * DM + 8 * hi;
            f32x4 xq[4][2];
#pragma unroll
            for (int j = 0; j < 4; ++j) { xq[j][0] = *(const f32x4*)(xr + 16 * j); xq[j][1] = *(const f32x4*)(xr + 16 * j + 4); }
#endif
            { const int t_ = F_TID(); const float* a2 = WSP(float, WS_SMALL + 524288) + (size_t)b * 1024; const float* s2 = mod + (size_t)b * 6144 + 3072;
              for (int i = t_; i < 2048; i += 512) mv[i] = (i < 1024) ? a2[i] : s2[i - 1024]; }
            const LAS unsigned char* wrd = wch + r32 * 528 + 16 * hi; const LAS float* mrd = mv + 8 * hi;
#pragma unroll 1
            for (int c = 0; c < 4; ++c) {
                __syncthreads();
                { const int t_ = F_TID();
#pragma unroll
                  for (int p = 0; p < 8; ++p) { const int piece = t_ + 512 * p, mat = piece >> 11, q = piece & 2047, col = q >> 5, kk = (q & 31) * 8;
                      const u32x4 v = *(const u32x4*)((mat ? rlo : rhi) + (size_t)col * 1024 + 256 * c + kk);
                      *(LAS u32x4*)(wch + mat * 33792 + col * 528 + kk * 2) = v; } }
                __syncthreads();
                if (valid) {
#pragma unroll 1
                for (int s4 = 0; s4 < 16; s4 += 4) {
#pragma unroll
                    for (int j = 0; j < 4; ++j) {
                        const int sl = s4 + j, s = 16 * c + sl;
#ifdef X1_BF16
                        const u32x4 xw = xq[j]; const f32x4 xa = {bflo(xw.x), bfhi(xw.x), bflo(xw.y), bfhi(xw.y)}, xb = {bflo(xw.z), bfhi(xw.z), bflo(xw.w), bfhi(xw.w)};
                        if (s + 4 < 64) xq[j] = *(const u32x4*)(xr + 16 * (s + 4));
#else
                        const f32x4 xa = xq[j][0], xb = xq[j][1];
                        if (s + 4 < 64) { xq[j][0] = *(const f32x4*)(xr + 16 * (s + 4)); xq[j][1] = *(const f32x4*)(xr + 16 * (s + 4) + 4); }
#endif
                        const f32x4 ca0 = *(const LAS f32x4*)(mrd + 16 * s), ca1 = *(const LAS f32x4*)(mrd + 16 * s + 4), ch0 = *(const LAS f32x4*)(mrd + 1024 + 16 * s), ch1 = *(const LAS f32x4*)(mrd + 1024 + 16 * s + 4);
                        const bf16x8 Ah0 = *(const LAS bf16x8*)(wrd + 32 * sl), Al0 = *(const LAS bf16x8*)(wrd + 33792 + 32 * sl);
                        const bf16x8 Ah1 = *(const LAS bf16x8*)(wrd + 32 * 528 + 32 * sl), Al1 = *(const LAS bf16x8*)(wrd + 33792 + 32 * 528 + 32 * sl);
                        const f32x4 va = (xa * rstd) * ca0 + ch0, vb = (xb * rstd) * ca1 + ch1;
                        { u32x2 w8; w8.x = pk4_fp8(va[0], va[1], va[2], va[3]); w8.y = pk4_fp8(vb[0], vb[1], vb[2], vb[3]); *(u32x2*)(hp + 16 * s) = w8; }
                        u32x4 whi; whi.x = cvtpk(va[0], va[1]); whi.y = cvtpk(va[2], va[3]); whi.z = cvtpk(vb[0], vb[1]); whi.w = cvtpk(vb[2], vb[3]);
                        u32x4 wlo; wlo.x = cvtpk(va[0] - bflo(whi.x), va[1] - bfhi(whi.x)); wlo.y = cvtpk(va[2] - bflo(whi.y), va[3] - bfhi(whi.y));
                        wlo.z = cvtpk(vb[0] - bflo(whi.z), vb[1] - bfhi(whi.z)); wlo.w = cvtpk(vb[2] - bflo(whi.w), vb[3] - bfhi(whi.w));
                        const bf16x8 Bh = __builtin_bit_cast(bf16x8, whi), Bl = __builtin_bit_cast(bf16x8, wlo);
                        acc0 = __builtin_amdgcn_mfma_f32_32x32x16_bf16(Ah0, Bh, acc0, 0, 0, 0); acc0 = __builtin_amdgcn_mfma_f32_32x32x16_bf16(Ah0, Bl, acc0, 0, 0, 0); acc0 = __builtin_amdgcn_mfma_f32_32x32x16_bf16(Al0, Bh, acc0, 0, 0, 0);
                        acc1 = __builtin_amdgcn_mfma_f32_32x32x16_bf16(Ah1, Bh, acc1, 0, 0, 0); acc1 = __builtin_amdgcn_mfma_f32_32x32x16_bf16(Ah1, Bl, acc1, 0, 0, 0); acc1 = __builtin_amdgcn_mfma_f32_32x32x16_bf16(Al1, Bh, acc1, 0, 0, 0);
                    }
                }
                }
            }
        }
        if (valid) {
            LAS float* lr = lg + r32 * 40;
#pragma unroll
            for (int gq = 0; gq < 4; ++gq) *(LAS f32x4*)(lr + 8 * gq + 4 * hi) = (f32x4){acc0[4 * gq], acc0[4 * gq + 1], acc0[4 * gq + 2], acc0[4 * gq + 3]};
            if (hi == 0) *(LAS f32x4*)(lr + 32) = (f32x4){acc1[0], acc1[1], acc1[2], acc1[3]};
            asm volatile("s_waitcnt lgkmcnt(0)" ::: "memory");
            if (hi == 0) {
                float gl[4];
#pragma unroll
                for (int i = 0; i < 4; ++i) gl[i] = lr[i] + b_group[i];
                int gi = 0; float gm = gl[0];
#pragma unroll
                for (int i = 1; i < 4; ++i) if (gl[i] > gm) { gm = gl[i]; gi = i; }
                float gsum = 0.f;
#pragma unroll
                for (int i = 0; i < 4; ++i) gsum += __expf(gl[i] - gm);
                const float gw = 1.0f / gsum;
                float el[8];
#pragma unroll
                for (int i = 0; i < 8; ++i) el[i] = lr[4 + 8 * gi + i] + b_router[gi * 8 + i];
                int i1 = 0; float v1 = el[0];
#pragma unroll
                for (int i = 1; i < 8; ++i) if (el[i] > v1) { v1 = el[i]; i1 = i; }
                int i2 = -1; float v2 = -INFINITY;
#pragma unroll
                for (int i = 0; i < 8; ++i) if (i != i1 && el[i] > v2) { v2 = el[i]; i2 = i; }
                const float pa = 1.0f / (1.0f + __expf(v2 - v1));
                w1 = gw * pa; w2 = gw * (1.0f - pa); e1 = gi * 8 + i1; e2 = gi * 8 + i2;
                p1 = __hip_atomic_fetch_add((int*)(lc + e1), 1, __ATOMIC_RELAXED, __HIP_MEMORY_SCOPE_WORKGROUP);
                p2 = __hip_atomic_fetch_add((int*)(lc + e2), 1, __ATOMIC_RELAXED, __HIP_MEMORY_SCOPE_WORKGROUP);
            }
        }
        __syncthreads();
        if (!dry && F_TID() < 32) { const int c = lc[F_TID()]; gb[F_TID()] = c ? (int)__hip_atomic_fetch_add(F.ctl + CW_CNT + 64 * F_TID(), (unsigned)c, RLX_AGENT) : 0; }
        __syncthreads();
        if (!dry && valid && hi == 0) {
            p1 += gb[e1]; p2 += gb[e2];
            pick_e[row * 2] = e1; pick_e[row * 2 + 1] = e2; pick_pos[row * 2] = p1; pick_pos[row * 2 + 1] = p2; pick_w[row * 2] = w1; pick_w[row * 2 + 1] = w2;
            list[(size_t)e1 * NT_TOK + p1] = row; list[(size_t)e2 * NT_TOK + p2] = row;
        }
        __syncthreads();
    }
}

__device__ __forceinline__ void moe_tables(Frame& F) {
    LAS int* cnt = (LAS int*)(F.lds + LDS_EXP); LAS int* pre = cnt + 32;
    if (F_TID() < 32) cnt[F_TID()] = (int)__hip_atomic_load(F.ctl + CW_CNT + 64 * F_TID(), RLX_AGENT);
    __syncthreads();
    if (F_TID() == 0) { int s = 0; for (int e = 0; e < 32; ++e) { pre[e] = s; s += (cnt[e] + 255) >> 8; } pre[32] = s; }
    __syncthreads();
}
namespace pg8 {
struct MoeSched {
    const char* A; const char* Bt; int lda, ldb; size_t bstride; bool gather; LAS unsigned char* lds; int G, c;
    __device__ __forceinline__ bool next(int i, Unit& u) const {
        const LAS int* pre = (const LAS int*)(lds + LDS_EXP) + 32;
        const int L = i * G + c; if (L >= 4 * pre[32]) return false;
        const int mtg = L >> 2;
        const int pk = pre[lane_now() & 31];
        const int e = __builtin_popcount((unsigned)__ballot(pk <= mtg)) - 1;
        u.pm = mtg; u.pn = L & 3; u.e = e; u.mt = mtg - pre[e]; return true;
    }
    __device__ __forceinline__ const char* a_base(const Unit& u) const { return gather ? A : A + (size_t)u.pm * BM * lda * 2; }
    __device__ __forceinline__ unsigned a_voff(const Unit&, int ui, int h, int R, int C) const {
        if (gather) { const int tok = ((const LAS int*)(lds + LDS_TOK))[ui * 256 + h * HALF + R]; return (unsigned)(tok * lda + C) * 2u; }
        return (unsigned)((h * HALF + R) * lda + C) * 2u; }
    __device__ __forceinline__ const char* b_base(const Unit& u) const { return Bt + (size_t)u.e * bstride + (size_t)u.pn * BM * ldb * 2; }
    __device__ __forceinline__ int dephase_id() const { return c; }
};
struct GuEpi {
    static constexpr bool PERM = true, noepi = false; static constexpr int MIDK = 0, DEPHASE = 1, DEPHASE_TICKS = 0, NSTORE = 8;
    unsigned char* hid;
    __device__ __forceinline__ void operator()(const f32x4 (&acc)[2][2][4][2], const Unit& u, int, int wr, int wc, int fr, int fq) const {
        const int row0 = u.pm * BM + wr * 64 + fr, col = u.pn * HALF + wc * 32 + 8 * fq;
#pragma unroll
        for (int ai = 0; ai < 2; ++ai)
#pragma unroll
            for (int m = 0; m < 4; ++m) {
                f32x4 v0, v1;
#pragma unroll
                for (int i = 0; i < 4; ++i) { v0[i] = clamp448(siluf_(acc[ai][0][m][0][i] * 0.015625f) * acc[ai][1][m][0][i] * 0.125f); v1[i] = clamp448(siluf_(acc[ai][0][m][1][i] * 0.015625f) * acc[ai][1][m][1][i] * 0.125f); }
                u32x2 w; w.x = pk4_fp8(v0[0], v0[1], v0[2], v0[3]); w.y = pk4_fp8(v1[0], v1[1], v1[2], v1[3]);
                *(u32x2*)(hid + (size_t)(row0 + ai * HALF + m * 16) * EFF + col) = w;
            }
    }
};
struct YEpi {
    static constexpr bool PERM = true, noepi = false; static constexpr int MIDK = 0, DEPHASE = 1, DEPHASE_TICKS = 0;
#ifdef PROBE_NOSTORE
    static constexpr int NSTORE = 0;
#else
    static constexpr int NSTORE = 16;
#endif
    unsigned char* Y; float osc; bool nostore;
    __device__ __forceinline__ void operator()(const f32x4 (&acc)[2][2][4][2], const Unit& u, int, int wr, int wc, int fr, int fq) const {
        const int row0 = u.pm * BM + wr * 64 + fr, col0 = u.pn * BM + wc * 32 + 8 * fq;
#pragma unroll
        for (int ai = 0; ai < 2; ++ai)
#pragma unroll
            for (int m = 0; m < 4; ++m)
#pragma unroll
                for (int bj = 0; bj < 2; ++bj) { const f32x4 v0 = acc[ai][bj][m][0] * osc, v1 = acc[ai][bj][m][1] * osc;
                    u32x2 w; w.x = pk4_fp8(clamp448(v0[0]), clamp448(v0[1]), clamp448(v0[2]), clamp448(v0[3])); w.y = pk4_fp8(clamp448(v1[0]), clamp448(v1[1]), clamp448(v1[2]), clamp448(v1[3]));
                    if (!nostore) *(u32x2*)(Y + (size_t)(row0 + ai * HALF + m * 16) * DM + col0 + bj * HALF) = w; else asm volatile("" :: "v"(w)); }
    }
};
}

__device__ __forceinline__ void moe_fill_tokens(Frame& F, const pg8::MoeSched& S) {
    const LAS int* cnt = (const LAS int*)(F.lds + LDS_EXP); LAS int* tokt = (LAS int*)(F.lds + LDS_TOK); const int* list = WSP(int, WS_LIST);
    pg8::Unit u;
    for (int i = 0; i < 12 && S.next(i, u); ++i) {
        if (F_TID() < 256) { const int idx = u.mt * 256 + F_TID(); tokt[i * 256 + F_TID()] = list[(size_t)u.e * NT_TOK + (idx < cnt[u.e] ? idx : 0)]; }
    }
    __syncthreads();
}

__device__ __forceinline__ void pi_combine(Frame& F, const Args& a, const float wsc = 1.0f) {
    const LAS int* pre = (const LAS int*)(F.lds + LDS_EXP) + 32;
    const int* pick_e = (const int*)(F.ws + WS_PICK); const int* pick_pos = (const int*)(F.ws + WS_PICK + 524288); const float* pick_w = (const float*)(F.ws + WS_PICK + 1048576);
    const unsigned char* Y = WSP(unsigned char, WS_R1); const float* mod = WSP(float, WS_MOD); float* out = a.out;
    const int gw = F.vcu * 8 + F.wave, NGW = F.G * 8, ln = F_LANE();
    struct Pk { int e0, e1, p0, p1; float w0, w1; };
#ifdef X1_BF16
    const bf16_t* x1b = WSP(bf16_t, WS_Y);
    struct Dat { unsigned a0[4], a1[4]; u32x2 x[4]; float w0, w1; };
#else
    struct Dat { unsigned a0[4], a1[4]; f32x4 x[4]; float w0, w1; };
#endif
    auto ldpk = [&](int r) { Pk k; k.e0 = pick_e[2 * r]; k.e1 = pick_e[2 * r + 1]; k.p0 = pick_pos[2 * r]; k.p1 = pick_pos[2 * r + 1]; k.w0 = pick_w[2 * r]; k.w1 = pick_w[2 * r + 1]; return k; };
    auto lddat = [&](int r, const Pk& k) { Dat d; d.w0 = k.w0 * wsc * 0.0625f; d.w1 = k.w1 * wsc * 0.0625f;
        const size_t s0 = (size_t)pre[k.e0] * 256 + k.p0, s1 = (size_t)pre[k.e1] * 256 + k.p1;
        const unsigned* y0 = (const unsigned*)(Y + s0 * DM) + ln; const unsigned* y1 = (const unsigned*)(Y + s1 * DM) + ln;
#ifdef X1_BF16
        const u32x2* xr = (const u32x2*)(x1b + (size_t)r * DM) + ln;
#else
        const f32x4* xr = (const f32x4*)(out + (size_t)r * DM) + ln;
#endif
#pragma unroll
        for (int j = 0; j < 4; ++j) { d.a0[j] = y0[64 * j]; d.a1[j] = y1[64 * j]; d.x[j] = xr[64 * j]; }
        return d; };
    f32x4 gtv[4];
    auto fin = [&](int r, const Dat& d) { f32x4* xw = (f32x4*)(out + (size_t)r * DM) + ln;
#pragma unroll
        for (int j = 0; j < 4; ++j) { const f32x4 g = gtv[j];
#ifdef X1_BF16
            f32x4 x = {bflo(d.x[j].x), bfhi(d.x[j].x), bflo(d.x[j].y), bfhi(d.x[j].y)};
#else
            f32x4 x = d.x[j];
#endif
            const f32x2 p0 = __builtin_amdgcn_cvt_pk_f32_fp8(d.a0[j], false), p1 = __builtin_amdgcn_cvt_pk_f32_fp8(d.a0[j], true), q0 = __builtin_amdgcn_cvt_pk_f32_fp8(d.a1[j], false), q1 = __builtin_amdgcn_cvt_pk_f32_fp8(d.a1[j], true);
            x[0] += g[0] * (d.w0 * p0[0] + d.w1 * q0[0]); x[1] += g[1] * (d.w0 * p0[1] + d.w1 * q0[1]);
            x[2] += g[2] * (d.w0 * p1[0] + d.w1 * q1[0]); x[3] += g[3] * (d.w0 * p1[1] + d.w1 * q1[1]); xw[64 * j] = x; } };
#pragma unroll 1
    for (int blk = gw; blk < NT_TOK / 32; blk += NGW) {
        const int m0 = blk * 32, b = m0 >> 11, m1 = m0 + 32;
        { const f32x4* gt = (const f32x4*)(mod + (size_t)b * 6144 + 5120) + ln;
#pragma unroll
          for (int j = 0; j < 4; ++j) gtv[j] = gt[64 * j]; }
        int r0 = m0;
        Pk k1 = ldpk(r0); Dat d0 = lddat(r0, k1);
        Pk k2 = ldpk(r0 + 1);
#pragma unroll 1
        for (; r0 < m1; ++r0) {
            const int r1 = r0 + 1, r2 = r0 + 2;
            Dat d1 = d0; if (r1 < m1) d1 = lddat(r1, k2);
            if (r2 < m1) k2 = ldpk(r2);
            fin(r0, d0);
            d0 = d1;
        }
    }
}
#ifndef MK_MODE
#define MK_MODE 2
#endif
constexpr int NPHASE = 12;
#ifndef REP_MASK
#define REP_MASK 0
#endif
#define REPS(k) (((REP_MASK >> (k)) & 1) ? 2 : 1)

__device__ __forceinline__ void pd_compress_stage2(Frame& F, const Args& a, int pm) {
    const int r32 = F_LANE() & 31, hi = F_LANE() >> 5, kv = pm >= 32 ? 1 : 0;
    const bf16_t* w2t = WSP(bf16_t, WS_CW2) + (size_t)kv * 64 * 256;
    const int rowg = 256 * pm + 32 * F.wave + r32;
    const bf16_t* hp = WSP(bf16_t, WS_CHID) + (size_t)rowg * 256 + 8 * hi;
    f32x16 acc0 = {}, acc1 = {};
#pragma unroll 4
    for (int s = 0; s < 16; ++s) {
        const bf16x8 B = *(const bf16x8*)(hp + 16 * s);
        const bf16x8 A0 = *(const bf16x8*)(w2t + (size_t)r32 * 256 + 16 * s + 8 * hi), A1 = *(const bf16x8*)(w2t + (size_t)(32 + r32) * 256 + 16 * s + 8 * hi);
        acc0 = __builtin_amdgcn_mfma_f32_32x32x16_bf16(A0, B, acc0, 0, 0, 0); acc1 = __builtin_amdgcn_mfma_f32_32x32x16_bf16(A1, B, acc1, 0, 0, 0);
    }
    const int mrow = rowg & 8191;
    bf16_t* dst = (bf16_t*)(F.ws + WS_KC + (kv ? MiB : 0)) + (size_t)mrow * 64;
    if (kv == 0) {
        float ss = 0.f;
#pragma unroll
        for (int r = 0; r < 16; ++r) ss += acc0[r] * acc0[r] + acc1[r] * acc1[r];
        ss = att::halfsum(ss);
        const float rstd = __builtin_amdgcn_rsqf(ss * (1.f / 64.f) + EPS);
        const float* nk = (const float*)a.in[9];
        const int b = (mrow >> 7) & 31, n = mrow & 127;
        const float* cc = WSP(float, WS_CROPE) + ((size_t)b * 128 + n) * 32; const float* sn = cc + 32 * 128 * 32;
#pragma unroll
        for (int gq = 0; gq < 4; ++gq) { const int d = 8 * gq + 4 * hi;
            const f32x4 g1 = *(const f32x4*)(nk + d), g2 = *(const f32x4*)(nk + 32 + d), c4 = *(const f32x4*)(cc + d), s4 = *(const f32x4*)(sn + d);
            f32x4 x1, x2;
#pragma unroll
            for (int i = 0; i < 4; ++i) { x1[i] = acc0[4 * gq + i] * rstd * g1[i]; x2[i] = acc1[4 * gq + i] * rstd * g2[i]; }
            const f32x4 o1 = x1 * c4 - x2 * s4, o2 = x1 * s4 + x2 * c4;
            u32x2 w1, w2; w1.x = cvtpk(o1[0], o1[1]); w1.y = cvtpk(o1[2], o1[3]); w2.x = cvtpk(o2[0], o2[1]); w2.y = cvtpk(o2[2], o2[3]);
            *(u32x2*)(dst + d) = w1; *(u32x2*)(dst + 32 + d) = w2; }
    } else {
#pragma unroll
        for (int gq = 0; gq < 4; ++gq) { const int d = 8 * gq + 4 * hi;
            u32x2 w1, w2; w1.x = cvtpk(acc0[4 * gq], acc0[4 * gq + 1]); w1.y = cvtpk(acc0[4 * gq + 2], acc0[4 * gq + 3]); w2.x = cvtpk(acc1[4 * gq], acc1[4 * gq + 1]); w2.y = cvtpk(acc1[4 * gq + 2], acc1[4 * gq + 3]);
            *(u32x2*)(dst + d) = w1; *(u32x2*)(dst + 32 + d) = w2; }
    }
}

__device__ __forceinline__ void pf1_scale_ob(Frame& F) {
    const float* lse = WSP(float, WS_LSE); const u32x2* src = (const u32x2*)(F.ws + WS_H + 64 * MiB); unsigned* dst = (unsigned*)(F.ws + WS_Y);
    const int gw = F.vcu * 8 + F.wave, NGW = F.G * 8, l = F_LANE();
    for (int m = gw; m < NT_TOK; m += NGW) {
        const int j = (l & 31) >> 4;
        const float l0 = lse[(size_t)m * 8 + j], l1 = lse[(size_t)m * 8 + 2 + j], l2 = lse[(size_t)m * 8 + 4 + j];
        const float mx = fmaxf(l0, fmaxf(l1, l2)); const float e0 = __expf(l0 - mx), e1 = __expf(l1 - mx), e2 = __expf(l2 - mx); const float inv = 16.0f * __builtin_amdgcn_rcpf(e0 + e1 + e2);
        const float al[3] = {(PROBE_ZERO & 8) ? 0.f : e0 * inv, (PROBE_ZERO & 8) ? 0.f : e1 * inv, (PROBE_ZERO & 8) ? 0.f : e2 * inv};
        if (l < 32) {
#pragma unroll
            for (int gi = 0; gi < 3; ++gi) { const u32x2 w = src[(size_t)m * 96 + gi * 32 + l]; dst[(size_t)m * 256 + 128 + gi * 32 + l] = pk4_fp8(bflo(w.x) * al[gi], bfhi(w.x) * al[gi], bflo(w.y) * al[gi], bfhi(w.y) * al[gi]); }
        } else dst[(size_t)m * 256 + 224 + (l - 32)] = 0u;
    }
}

__global__ void __launch_bounds__(512, 2) mk_fwd(Args args) {
    extern __shared__ __attribute__((aligned(16))) unsigned char lds_raw[];
    Frame F;
    F.lds = (LAS unsigned char*)lds_raw;
    F.MISC = (volatile LAS unsigned*)(F.lds + LDS_MISC);
    F.wave = __builtin_amdgcn_readfirstlane(threadIdx.x >> 6);
    F.G = gridDim.x; { const int bx = blockIdx.x; F.vcu = (F.G % 8 == 0) ? (bx % 8) * (F.G / 8) + bx / 8 : bx; }
    F.ws = args.ws; F.ctl = (unsigned*)(args.ws + WS_CTL);
    if (F_TID() < 64) ((LAS unsigned*)(F.lds + LDS_MISC))[F_TID()] = 0u;
    __syncthreads();
#if MK_MODE == 1
    cg::grid_group grid = cg::this_grid();
#define GRID_BAR() grid.sync()
#elif MK_MODE == 2
    XcdBarrier bar = xcd_barrier_post(F.ctl + CW_BAR, F.MISC + 8, F.wave);
#define GRID_BAR() xcd_barrier(bar)
#else
#define GRID_BAR() do {} while (0)
#endif
    int lo = args.ph_lo, hi = args.ph_hi; if (hi == 100 || hi == 102) { lo = 2; hi = 3; } if (hi == 101) { lo = 10; hi = 11; }
#ifndef PH_MASK
#define PH_MASK 0xfff
#endif
#define IN(k) (((PH_MASK >> (k)) & 1) && lo <= (k) && (k) < hi)
#ifdef PROBE_DBLBAR
#define SEAM(k) do { if (IN(k) && ((k) + 1 < hi)) { GRID_BAR(); GRID_BAR(); } } while (0)
#else
#define SEAM(k) do { if (IN(k) && ((k) + 1 < hi)) GRID_BAR(); } while (0)
#endif


    if (IN(0)) { pa_prologue(F, args); } SEAM(0);
    if (IN(1)) { pb_modnorm(F, (const float*)args.in[0], (const float*)args.in[5], WSP(float, WS_MOD), 0, 1024, WSP(bf16_t, WS_H), (const float*)args.in[6]); } SEAM(1);
    if (IN(2)) {
#ifdef PC_FP8
        pg8::DenseSched S; S.init(WSP(bf16_t, WS_H), 512, WSP(bf16_t, WS_WIN), 512, NT_TOK, NPROJ, F.G, (int)blockIdx.x);
#ifdef PROBE_HOT
        S.hot = args.ph_hi == 100;
#endif
#else
        pg8::DenseSched S; S.init(WSP(bf16_t, WS_H), 1024, WSP(bf16_t, WS_WIN), 1024, NT_TOK, NPROJ, F.G, (int)blockIdx.x);
#endif
        pg8::ProjEpi E{F.ws, (const int*)args.in[2], WSP(float, WS_ROPE), WSP(float, WS_ROPE) + (size_t)NT_TOK * 32, (const float*)args.in[8], (const float*)args.in[9], (const float*)args.in[16], (const float*)args.in[17], args.ph_hi == 100, args.ph_hi == 102};
#ifdef PC_FP8
        pg8::gemm_phase<pg8::ProjEpi, pg8::DenseSched, true, true>(F.lds, F.wave, 512, S, E);
#else
        pg8::gemm_phase<pg8::ProjEpi, pg8::DenseSched>(F.lds, F.wave, 1024, S, E);
#endif
    } SEAM(2);
    if (IN(3)) {
        const int ncw = F.G >= 128 ? 64 : (F.G > 1 ? F.G / 2 : 1);
        if ((int)blockIdx.x < ncw) {
            pg8::CmpSched S{(const char*)(F.ws + slot_off(SL_KCMP)), (const char*)(F.ws + WS_CW1), 2048, ncw, (int)blockIdx.x};
            pg8::CmpEpi E{WSP(float, WS_SMALL), WSP(bf16_t, WS_CHID)};
            pg8::gemm_phase<pg8::CmpEpi, pg8::CmpSched>(F.lds, F.wave, 2048, S, E);
            VM_WAIT(); __syncthreads();
            pg8::Unit u; for (int i = 0; S.next(i, u); ++i) pd_compress_stage2(F, args, u.pm);
        }
        if ((int)blockIdx.x >= ncw || F.G == 1) {
            att::Ctx C; C.lds = F.lds; C.lane = 0; C.r32 = 0; C.hi = 0; C.wid = F.wave; C.lds0 = (unsigned)(size_t)F.lds;
            const int nd = F.G == 1 ? 1 : F.G - ncw, c = F.G == 1 ? 0 : (int)blockIdx.x - ncw;
            for (int u = c; u < 1536; u += nd) att::dil_unit(C, F.ws, u, (bf16_t*)(F.ws + WS_H + 64 * MiB), WSP(float, WS_LSE));
        }
    } SEAM(3);
    if (IN(4)) {
        att::Ctx C; C.lds = F.lds; C.lane = 0; C.r32 = 0; C.hi = 0; C.wid = F.wave; C.lds0 = (unsigned)(size_t)F.lds;
        for (int v = F.vcu; v < 256; v += F.G) {
            const int bh = v >> 2, k = v & 3, b = bh >> 1, hk = bh & 1;
            for (int i = 0; i < 8; ++i) { const int blk = (i & 1) ? (8 * (i >> 1) + 7 - k) : (8 * (i >> 1) + k); att::nsa_unit(C, F.ws, b, hk, 31 - blk, F.ws + WS_Y); }
        }
        pf1_scale_ob(F);
    } SEAM(4);
    if (IN(5)) {
        pg8::DenseSched S; S.init(F.ws + WS_Y, 512, F.ws + WS_WUPA, 512, NT_TOK, DM, F.G, (int)blockIdx.x);
        pg8::Up2Epi E{F.ws, F.ws + WS_R1 + 64 * MiB};
        pg8::gemm_phase<pg8::Up2Epi, pg8::DenseSched, true, true>(F.lds, F.wave, 512, S, E);
    } SEAM(5);
    if (IN(7)) {
#ifdef PF3_FP8
        pg8::DenseSched S; S.init(F.ws + WS_R1 + 64 * MiB, 512, WSP(bf16_t, WS_WOUT), 512, NT_TOK, DM, F.G, (int)blockIdx.x);
#ifdef X1_BF16
        pg8::OutEpi E{(const float*)args.in[0], WSP(float, WS_Y), WSP(float, WS_MOD), WSP(float, WS_ROWSS), 1.0f / (16.f * 64.f)};
#else
        pg8::OutEpi E{(const float*)args.in[0], args.out, WSP(float, WS_MOD), WSP(float, WS_ROWSS), 1.0f / (16.f * 64.f)};
#endif
        pg8::gemm_phase<pg8::OutEpi, pg8::DenseSched, true, true>(F.lds, F.wave, 512, S, E);
#else
        pg8::DenseSched S; S.init(WSP(bf16_t, WS_Y), 1024, WSP(bf16_t, WS_WOUT), 1024, NT_TOK, DM, F.G, (int)blockIdx.x);
        pg8::OutEpi E{(const float*)args.in[0], args.out, WSP(float, WS_MOD), WSP(float, WS_ROWSS), 1.0f};
        pg8::gemm_phase<pg8::OutEpi, pg8::DenseSched>(F.lds, F.wave, 1024, S, E);
#endif
    } SEAM(7);
    if (IN(8)) { pf4_router(F, args);
#if defined(PROBE_DRY) && PROBE_DRY == 8
        GRID_BAR(); pf4_router(F, args, true);
#endif
    } SEAM(8);
    if (IN(9)) {
        moe_tables(F);
        pg8::MoeSched S{(const char*)(F.ws + WS_H), (const char*)(F.ws + WS_WGU), 512, 512, (size_t)1024 * 1024, true, F.lds, F.G, F.vcu};
        moe_fill_tokens(F, S);
        pg8::GuEpi E{WSP(unsigned char, WS_R2)};
        pg8::gemm_phase<pg8::GuEpi, pg8::MoeSched, true, true>(F.lds, F.wave, 512, S, E);
    } SEAM(9);
    if (IN(10)) {
        moe_tables(F);
        pg8::MoeSched S{(const char*)(F.ws + WS_R2), (const char*)(F.ws + WS_WD), 256, 256, (size_t)1024 * 512, false, F.lds, F.G, F.vcu};
        pg8::YEpi E{F.ws + WS_R1, 16.0f / (8.0f * 64.0f), args.ph_hi == 101};
#ifndef PH_ALIGN
#define PH_ALIGN true
#endif
        pg8::gemm_phase<pg8::YEpi, pg8::MoeSched, PH_ALIGN, true>(F.lds, F.wave, 256, S, E);
    } SEAM(10);
    if (IN(11)) { moe_tables(F); pi_combine(F, args);
#if defined(PROBE_DRY) && PROBE_DRY == 11
        GRID_BAR(); pi_combine(F, args, 0.0f);
#endif
    }
#undef IN
#undef SEAM
}

#ifdef PROBE_MFMA
__global__ void __launch_bounds__(512, 2) probe_mfma(float* sink, int iters) {
    typedef int v8i __attribute__((ext_vector_type(8)));
    const unsigned lane = threadIdx.x;
    v8i a[4], b[4];
    for (int i = 0; i < 4; ++i) for (int j = 0; j < 8; ++j) { unsigned h = lane * 2654435761u + i * 40503u + j * 9973u; h ^= h >> 13; h *= 0x5bd1e995u; h ^= h >> 15; a[i][j] = (int)(h & 0xbfbfbfbfu); h *= 0x9e3779b1u; h ^= h >> 11; b[i][j] = (int)(h & 0xbfbfbfbfu); }
    f32x4 acc[16];
    for (int i = 0; i < 16; ++i) acc[i] = (f32x4){0.f, 0.f, 0.f, 0.f};
#pragma unroll 1
    for (int it = 0; it < iters; ++it) {
#if PROBE_MFMA == 1
#pragma unroll
        for (int i = 0; i < 16; ++i) asm volatile("v_mfma_f32_16x16x128_f8f6f4 %0, %1, %2, %0" : "+v"(acc[i]) : "v"(a[i & 3]), "v"(b[i >> 2]));
#else
#pragma unroll
        for (int i = 0; i < 16; ++i) { bf16x8 x0, x1, y0, y1;
            for (int j = 0; j < 4; ++j) { ((int*)&x0)[j] = a[i & 3][j] & 0x3fff3fff; ((int*)&x1)[j] = a[i & 3][4 + j] & 0x3fff3fff; ((int*)&y0)[j] = b[i >> 2][j] & 0x3fff3fff; ((int*)&y1)[j] = b[i >> 2][4 + j] & 0x3fff3fff; }
            asm volatile("v_mfma_f32_16x16x32_bf16 %0, %1, %2, %0\n\tv_mfma_f32_16x16x32_bf16 %0, %3, %4, %0" : "+v"(acc[i]) : "v"(x0), "v"(y0), "v"(x1), "v"(y1)); }
#endif
    }
    asm volatile("s_nop 15\n\ts_nop 15" ::: "memory");
    float sum = 0.f; for (int i = 0; i < 16; ++i) sum += acc[i][0] + acc[i][1] + acc[i][2] + acc[i][3];
    if (sum == 12345.678f) sink[0] = sum;
}
#endif
extern "C" void kernel_launch(void* const* d_in, const int* in_sizes, int n_in, void* d_out, int out_size, void* d_ws, size_t ws_size, hipStream_t stream) {
    static int grid = 0;
    if (grid == 0) {
        if (n_in != 28 || in_sizes[0] != NT_TOK * DM || out_size != NT_TOK * DM || ws_size < WS_END) {
            fprintf(stderr, "kernel_launch: shape/workspace mismatch (n_in %d, in0 %d, out %d, ws %zu, need %zu)\n", n_in, n_in > 0 ? in_sizes[0] : -1, out_size, ws_size, (size_t)WS_END); grid = -1; return; }
        int dev = 0, cus = 0, per_cu = 0;
        hipGetDevice(&dev); hipDeviceGetAttribute(&cus, hipDeviceAttributeMultiprocessorCount, dev);
        if (hipFuncSetAttribute((const void*)mk_fwd, hipFuncAttributeMaxDynamicSharedMemorySize, LDS_BYTES) != hipSuccess) { fprintf(stderr, "kernel_launch: hipFuncSetAttribute failed\n"); grid = -1; return; }
        if (hipOccupancyMaxActiveBlocksPerMultiprocessor(&per_cu, (const void*)mk_fwd, 512, LDS_BYTES) != hipSuccess || per_cu < 1) { fprintf(stderr, "kernel_launch: occupancy query says %d blocks per CU\n", per_cu); per_cu = 1; }
        (void)hipGetLastError();
        grid = cus;
        fprintf(stderr, "kernel_launch: %d CUs, occupancy %d, grid %d\n", cus, per_cu, grid);
    }
    if (grid < 0) return;
    hipMemsetAsync((char*)d_ws + WS_CTL, 0, CTL_ZERO_BYTES, stream);
    Args a{};
    for (int i = 0; i < 28; ++i) a.in[i] = d_in[i];
    a.out = (float*)d_out; a.ws = (unsigned char*)d_ws;
#if MK_MODE == 0
#ifdef PROBE_NOSTORE
    for (int p = 0; p < NPHASE; ++p) { a.ph_lo = p; a.ph_hi = p + 1; hipLaunchKernelGGL(mk_fwd, dim3(grid), dim3(512), LDS_BYTES, stream, a);
        if (p == 10) { a.ph_lo = 10; a.ph_hi = 101; hipLaunchKernelGGL(mk_fwd, dim3(grid), dim3(512), LDS_BYTES, stream, a); } }
    if (0)
#endif
#ifdef PROBE_NOEPI
    for (int p = 0; p < NPHASE; ++p) { a.ph_lo = p; a.ph_hi = p + 1; hipLaunchKernelGGL(mk_fwd, dim3(grid), dim3(512), LDS_BYTES, stream, a);
        if (p == 2) { a.ph_lo = 2; a.ph_hi = PROBE_NOEPI == 2 ? 102 : 100; hipLaunchKernelGGL(mk_fwd, dim3(grid), dim3(512), LDS_BYTES, stream, a); } }
    if (0)
#endif
    for (int p = 0; p < NPHASE; ++p) for (int r = 0; r < REPS(p); ++r) { a.ph_lo = p; a.ph_hi = p + 1; hipLaunchKernelGGL(mk_fwd, dim3(grid), dim3(512), LDS_BYTES, stream, a); }
#ifdef PROBE_MFMA
    hipFuncSetAttribute((const void*)probe_mfma, hipFuncAttributeMaxDynamicSharedMemorySize, LDS_BYTES);
    hipLaunchKernelGGL(probe_mfma, dim3(grid), dim3(512), LDS_BYTES, stream, (float*)((char*)d_ws + WS_CTL), PROBE_ITERS);
#endif
#elif MK_MODE == 1
    a.ph_lo = 0; a.ph_hi = NPHASE;
    void* kargs[] = {&a};
    hipError_t e = hipLaunchCooperativeKernel((const void*)mk_fwd, dim3(grid), dim3(512), kargs, LDS_BYTES, stream);
    if (e != hipSuccess) fprintf(stderr, "cooperative launch failed: %s (grid %d)\n", hipGetErrorString(e), grid);
#else
    a.ph_lo = 0; a.ph_hi = NPHASE;
    hipLaunchKernelGGL(mk_fwd, dim3(grid), dim3(512), LDS_BYTES, stream, a);
#endif
}
```

```cpp
#include <hip/hip_runtime.h>
#include <hip/hip_cooperative_groups.h>
#include <cstdio>
#include <cstdint>
#include <cmath>
namespace cg = cooperative_groups;

#ifndef PC_BF16
#define PC_FP8 1
#endif
#ifndef NSA_MERGED_PASSES
#define NSA_SPLIT_PASSES 1
#endif
#ifndef X1_AS_F32
#define X1_BF16 1
#endif
#ifndef PF3_BF16
#define PF3_FP8 1
#endif
#define LAS __attribute__((address_space(3)))
#define GAS __attribute__((address_space(1)))
typedef unsigned short bf16_t;
typedef short bf16x8 __attribute__((ext_vector_type(8)));
typedef short s16x4 __attribute__((ext_vector_type(4)));
typedef float f32x2 __attribute__((ext_vector_type(2)));
typedef float f32x4 __attribute__((ext_vector_type(4)));
typedef float f32x16 __attribute__((ext_vector_type(16)));
typedef unsigned u32x2 __attribute__((ext_vector_type(2)));
typedef unsigned u32x4 __attribute__((ext_vector_type(4)));
typedef __bf16 bf16x2_t __attribute__((ext_vector_type(2)));

constexpr int NB = 32, SEQ = 2048, NT_TOK = NB * SEQ, DM = 1024;
constexpr int IN_COLS = 4504, NSLOT = 72, NPROJ = NSLOT * 64;
constexpr int NEXP = 32, EFF = 512;
constexpr float EPS = 1e-6f;
constexpr float C2 = 0.125f * 1.4426950408889634f;
constexpr int SL_QA = 0, SL_KCMP = 8, SL_VCMP = 10, SL_KSLC = 12, SL_VSLC = 14, SL_KWIN = 16, SL_VWIN = 18, SL_QB = 20, SL_KB = 26, SL_VB = 32, SL_GMA = 38, SL_GMB = 54, SL_GA = 70;

constexpr size_t MiB = 1u << 20;
constexpr size_t WS_CTL = 0, CTL_ZERO_BYTES = 256 * 1024;
constexpr size_t WS_MOD = 1 * MiB;
constexpr size_t WS_SMALL = 2 * MiB;
constexpr size_t WS_ROPE = 3 * MiB;
constexpr size_t WS_CROPE = 19 * MiB;
constexpr size_t WS_WIN = 20 * MiB;
constexpr size_t WS_WUPA = 29 * MiB;
constexpr size_t WS_WUPB = 30 * MiB;
constexpr size_t WS_WOUT = 31 * MiB;
constexpr size_t WS_CW1 = 33 * MiB;
constexpr size_t WS_CW2 = 35 * MiB;
constexpr size_t WS_WGU = 36 * MiB;
constexpr size_t WS_WD = 100 * MiB;
constexpr size_t WS_KC = 132 * MiB;
constexpr size_t WS_CHID = 134 * MiB;
constexpr size_t WS_LSE = 142 * MiB;
constexpr size_t WS_ROWSS = 144 * MiB;
constexpr size_t WS_PICK = 148 * MiB;
constexpr size_t WS_LIST = 150 * MiB;
constexpr size_t WS_H = 160 * MiB;
constexpr size_t WS_Y = 288 * MiB;
constexpr size_t WS_R1 = 416 * MiB;
constexpr size_t WS_R2 = 720 * MiB;
constexpr size_t WS_END = 992 * MiB;
constexpr size_t SLOT_BYTES = (size_t)NT_TOK * 64 * 2;
__host__ __device__ __forceinline__ size_t slot_off(int s) { return s < 38 ? WS_R1 + (size_t)s * SLOT_BYTES : WS_R2 + (size_t)(s - 38) * SLOT_BYTES; }
constexpr int CW_BAR = 4096;
constexpr int CW_CNT = 16384;

constexpr int LDS_BYTES = 163840;
constexpr int LDS_STAGE = 0;
constexpr int LDS_X = 131072;
constexpr int LDS_MISC = LDS_BYTES - 256;
constexpr int LDS_TOK = 135168;
constexpr int LDS_EXP = 147456;

__device__ __forceinline__ int lane_now() { int l; asm volatile("v_mbcnt_lo_u32_b32 %0, -1, 0\n\tv_mbcnt_hi_u32_b32 %0, -1, %0" : "=v"(l)); return l; }
#define RLX_AGENT __ATOMIC_RELAXED, __HIP_MEMORY_SCOPE_AGENT
#define LDS_WAIT() asm volatile("s_waitcnt lgkmcnt(0)" ::: "memory")
#define VM_WAIT() asm volatile("s_waitcnt vmcnt(0)" ::: "memory")
__device__ __forceinline__ unsigned cvtpk(float lo, float hi) { f32x2 v = {lo, hi}; bf16x2_t b = __builtin_convertvector(v, bf16x2_t); return __builtin_bit_cast(unsigned, b); }
__device__ __forceinline__ unsigned pk4_fp8(float a, float b, float c, float d) { int w = 0; w = __builtin_amdgcn_cvt_pk_fp8_f32(a, b, w, false); w = __builtin_amdgcn_cvt_pk_fp8_f32(c, d, w, true); return (unsigned)w; }
__device__ __forceinline__ float clamp448(float x) { return __builtin_amdgcn_fmed3f(x, -448.f, 448.f); }
__device__ __forceinline__ float bf2f(unsigned short h) { return __uint_as_float(((unsigned)h) << 16); }
__device__ __forceinline__ float bflo(unsigned w) { return __uint_as_float(w << 16); }
__device__ __forceinline__ float bfhi(unsigned w) { return __uint_as_float(w & 0xffff0000u); }
__device__ __forceinline__ float wave_sum(float v) {
    v += __uint_as_float(__builtin_amdgcn_update_dpp(0u, __float_as_uint(v), 0xB1, 0xf, 0xf, true));
    v += __uint_as_float(__builtin_amdgcn_update_dpp(0u, __float_as_uint(v), 0x4E, 0xf, 0xf, true));
    v += __uint_as_float(__builtin_amdgcn_update_dpp(0u, __float_as_uint(v), 0x141, 0xf, 0xf, true));
    v += __uint_as_float(__builtin_amdgcn_update_dpp(0u, __float_as_uint(v), 0x140, 0xf, 0xf, true));
    v += __uint_as_float(__builtin_amdgcn_update_dpp(0u, __float_as_uint(v), 0x142, 0xa, 0xf, false));
    v += __uint_as_float(__builtin_amdgcn_update_dpp(0u, __float_as_uint(v), 0x143, 0xc, 0xf, false));
    return __uint_as_float(__builtin_amdgcn_readlane(__float_as_uint(v), 63));
}
__device__ __forceinline__ float sigmoidf_(float x) { return __builtin_amdgcn_rcpf(1.0f + __builtin_amdgcn_exp2f(-1.4426950408889634f * x)); }
__device__ __forceinline__ float siluf_(float x) { return x * __builtin_amdgcn_rcpf(1.0f + __builtin_amdgcn_exp2f(-1.4426950408889634f * x)); }
__host__ __device__ __forceinline__ int slot_col0(int H) { return H < 8 ? 64 * H : H < 20 ? 512 + 64 * (H - 8) : H < 38 ? 1304 + 64 * (H - 20) : H < 70 ? 2456 + 64 * (H - 38) : H == 70 ? 1280 : 0; }
__host__ __device__ __forceinline__ int slot_valid(int H) { return H < 70 ? 64 : H == 70 ? 24 : 0; }

#define XB_TMO      128
#define XB_XCNT(j)  (256  + 64 * (j))
#define XB_XSUB(j)  (1280 + 64 * (j))
#define XB_XGEN(j)  (2304 + 64 * (j))
#define XB_TOP      3328
#define XB_TOPGEN   3392
#define XCD_BAR_WORDS 3456
#define XB_SPIN_CAP (1u << 22)
__device__ __forceinline__ unsigned xb_ld(unsigned* p)              { return __hip_atomic_load(p, __ATOMIC_RELAXED, __HIP_MEMORY_SCOPE_AGENT); }
__device__ __forceinline__ unsigned xb_add(unsigned* p, unsigned v) { return __hip_atomic_fetch_add(p, v, __ATOMIC_RELAXED, __HIP_MEMORY_SCOPE_AGENT); }
__device__ __forceinline__ unsigned xb_xcc_id() { return (unsigned)__builtin_amdgcn_s_getreg((3 << 11) | 20) & 0xFu; }
#define XB_SPIN(cond, bar) do { unsigned _sp = 0; while (cond) { __builtin_amdgcn_s_sleep(1); \
    if ((++_sp & 255u) == 0u) { if (xb_ld(&(bar)[XB_TMO])) break; if (_sp > XB_SPIN_CAP) { atomicAdd(&(bar)[XB_TMO], 1u); break; } } } } while (0)
struct XcdBarrier { unsigned* bar; unsigned x; volatile LAS unsigned* st; int wave; };
__device__ __forceinline__ XcdBarrier xcd_barrier_post(unsigned* bar, volatile LAS unsigned* st, int wave) {
    XcdBarrier b; b.bar = bar; b.x = xb_xcc_id(); b.st = st; b.wave = wave;
    if (wave == 0 && lane_now() == 0) (void)xb_add(&bar[XB_XCNT(b.x)], 1u);
    return b;
}
__device__ __forceinline__ void xcd_barrier_complete(unsigned* bar, unsigned x, unsigned& nloc, unsigned& nx) {
    const unsigned G = gridDim.x * gridDim.y * gridDim.z;
    unsigned sum, cnt, mine, sp = 0u;
    for (;;) {
        sum = 0u; cnt = 0u; mine = 0u;
#pragma unroll
        for (unsigned j = 0; j < 16; ++j) { const unsigned c = xb_ld(&bar[XB_XCNT(j)]); sum += c; cnt += (c > 0u) ? 1u : 0u; mine = (j == x) ? c : mine; }
        if (sum == G) break;
        __builtin_amdgcn_s_sleep(1);
        if ((++sp & 255u) == 0u) { if (xb_ld(&bar[XB_TMO])) break; if (sp > XB_SPIN_CAP) { atomicAdd(&bar[XB_TMO], 1u); break; } }
    }
    nloc = mine > 0u ? mine : 1u; nx = cnt > 0u ? cnt : 1u;
}
__device__ __forceinline__ void xcd_barrier(const XcdBarrier& b) {
    asm volatile("s_waitcnt vmcnt(0)" ::: "memory");
    __syncthreads();
    if (b.wave == 0 && lane_now() == 0) {
        unsigned* bar = b.bar;
        __builtin_amdgcn_s_waitcnt(0);
        unsigned nloc = b.st[0], nx = b.st[1];
        if (nloc == 0u) { xcd_barrier_complete(bar, b.x, nloc, nx); b.st[0] = nloc; b.st[1] = nx; }
        const unsigned old = xb_add(&bar[XB_XSUB(b.x)], 1u);
        const unsigned gen = old / nloc;
        if (old + 1u == (gen + 1u) * nloc) {
            __builtin_amdgcn_fence(__ATOMIC_RELEASE, "agent");
            asm volatile("s_waitcnt vmcnt(0)" ::: "memory");
            const unsigned og = xb_add(&bar[XB_TOP], 1u);
            const unsigned tg = og / nx;
            if (og + 1u == (tg + 1u) * nx) xb_add(&bar[XB_TOPGEN], 1u);
            else XB_SPIN(xb_ld(&bar[XB_TOPGEN]) == tg, bar);
            __builtin_amdgcn_fence(__ATOMIC_ACQUIRE, "agent");
            xb_add(&bar[XB_XGEN(b.x)], 1u);
            asm volatile("s_waitcnt vmcnt(0)" ::: "memory");
        } else {
            XB_SPIN(xb_ld(&bar[XB_XGEN(b.x)]) == gen, bar);
            __builtin_amdgcn_fence(__ATOMIC_ACQUIRE, "agent");
            asm volatile("s_waitcnt vmcnt(0)" ::: "memory");
        }
    }
    __syncthreads();
}
namespace pg8 {
constexpr int BM = 256, BK = 64, HALF = 128, HTB = HALF * BK * 2, STAGE_BYTES = 8 * HTB;
__host__ __device__ __forceinline__ int lds_byte(int r, int c) { const int st = (r >> 4) * 2 + (c >> 5), rr = r & 15, cc = c & 31, ob = rr * 64 + cc * 2; return st * 1024 + (ob ^ (((ob >> 9) & 1) << 5)); }
__host__ __device__ __forceinline__ void stage_rc(int b, int& R, int& C) { const int st = b / 1024, sb = b % 1024, swz = sb ^ (((sb >> 9) & 1) << 5); R = (st >> 1) * 16 + swz / 64; C = (st & 1) * 32 + (swz % 64) / 2; }
__host__ __device__ __forceinline__ int perm32(int rho) { const int n = rho >> 4, i = rho & 15; return 8 * (i >> 2) + 4 * n + (i & 3); }

typedef int v4i_t __attribute__((ext_vector_type(4)));
typedef int v8i_t __attribute__((ext_vector_type(8)));
struct Unit { int pm, pn, e, mt; };

template <int N> __device__ __forceinline__ void waitv_n() {
    static_assert(N == 8 || N == 16 || N == 24 || N == 40, "add the immediate");
    if constexpr (N == 8) asm volatile("s_waitcnt vmcnt(8)" ::: "memory");
    else if constexpr (N == 16) asm volatile("s_waitcnt vmcnt(16)" ::: "memory");
    else if constexpr (N == 24) asm volatile("s_waitcnt vmcnt(24)" ::: "memory");
    else asm volatile("s_waitcnt vmcnt(40)" ::: "memory");
}
template <class Epi, class Sched, bool ALIGN_EPI = true, bool FP8 = false>
__device__ __forceinline__ void gemm_phase(LAS unsigned char* lds, const int wid, const int K, const Sched& S, const Epi& E) {
    const int lane = lane_now(), tid = wid * 64 + lane, wr = wid >> 2, wc = wid & 3, fr = lane & 15, fq = lane >> 4;
    const int nt = K / BK;
    int Rr[2], Cc[2]; unsigned voffB[2];
#pragma unroll
    for (int i = 0; i < 2; ++i) { stage_rc(tid * 16 + i * 8192, Rr[i], Cc[i]); const int Rb = Epi::PERM ? ((Rr[i] & ~31) + perm32(Rr[i] & 31)) : Rr[i];
        voffB[i] = (unsigned)(Rb * S.ldb + Cc[i]) * 2u; }
    const size_t kstep = (size_t)(BK * 2);
    const size_t hstepB = (size_t)HALF * S.ldb * 2;
    const unsigned ldsw = (unsigned)wid * 1024u;
    const int aoff = lds_byte(wr * 64 + fr, fq * 8), boff = lds_byte(wc * 32 + fr, fq * 8);
#define PG8_SA(b, h) (((b) * 2 + (h)) * HTB)
#define PG8_SB(b, h) ((4 + (b) * 2 + (h)) * HTB)
#ifdef PROBE_SKIP
#define PG8_SK(bit) (E.noepi && (PROBE_SKIP & (bit)))
#else
#define PG8_SK(bit) false
#endif
#define PG8_STAGE(bufoff, gbase, voff) do { if (!PG8_SK(1)) _Pragma("unroll") for (int _i = 0; _i < 2; ++_i) \
        __builtin_amdgcn_global_load_lds((const unsigned*)((const char*)(gbase) + (voff)[_i]), (LAS unsigned*)(lds + (bufoff) + ldsw + _i * 8192), 16, 0, 0); } while (0)
#define PG8_LDA(dst, b, h) do { if (PG8_SK(2)) {} else if constexpr (FP8) { _Pragma("unroll") for (int m = 0; m < 4; ++m) { const v4i_t lo_ = *(const LAS v4i_t*)(lds + PG8_SA(b, h) + aoff + m * 2048), hi_ = *(const LAS v4i_t*)(lds + PG8_SA(b, h) + aoff + m * 2048 + 1024); \
            dst##8[m] = __builtin_shufflevector(lo_, hi_, 0, 1, 2, 3, 4, 5, 6, 7); } } \
        else { _Pragma("unroll") for (int m = 0; m < 4; ++m) _Pragma("unroll") for (int k = 0; k < 2; ++k) dst[m][k] = *(const LAS bf16x8*)(lds + PG8_SA(b, h) + aoff + m * 2048 + k * 1024); } } while (0)
#define PG8_LDB(dst, b, h) do { if (PG8_SK(2)) {} else if constexpr (FP8) { _Pragma("unroll") for (int n = 0; n < 2; ++n) { const v4i_t lo_ = *(const LAS v4i_t*)(lds + PG8_SB(b, h) + boff + n * 2048), hi_ = *(const LAS v4i_t*)(lds + PG8_SB(b, h) + boff + n * 2048 + 1024); \
            dst##8[n] = __builtin_shufflevector(lo_, hi_, 0, 1, 2, 3, 4, 5, 6, 7); } } \
        else { _Pragma("unroll") for (int n = 0; n < 2; ++n) _Pragma("unroll") for (int k = 0; k < 2; ++k) dst[n][k] = *(const LAS bf16x8*)(lds + PG8_SB(b, h) + boff + n * 2048 + k * 1024); } } while (0)
#ifdef PROBE_HALF
#define PG8_SKIP(ai) (E.noepi && (ai) >= PROBE_HALF)
#else
#define PG8_SKIP(ai) false
#endif
#define PG8_MMA(ai, bj, At, Bt) do { __builtin_amdgcn_s_setprio(1); \
        if (PG8_SKIP(ai)) {} else if constexpr (FP8) { _Pragma("unroll") for (int m = 0; m < 4; ++m) _Pragma("unroll") for (int n = 0; n < 2; ++n) \
            asm volatile("v_mfma_f32_16x16x128_f8f6f4 %0, %1, %2, %0" : "+v"(acc[ai][bj][m][n]) : "v"(Bt##8[n]), "v"(At##8[m])); } \
        else { _Pragma("unroll") for (int m = 0; m < 4; ++m) _Pragma("unroll") for (int n = 0; n < 2; ++n) _Pragma("unroll") for (int k = 0; k < 2; ++k) \
            acc[ai][bj][m][n] = __builtin_amdgcn_mfma_f32_16x16x32_bf16(Bt[n][k], At[m][k], acc[ai][bj][m][n], 0, 0, 0); } \
        __builtin_amdgcn_s_setprio(0); } while (0)
#define PG8_MMA0(ai, bj, At, Bt) do { __builtin_amdgcn_s_setprio(1); \
        _Pragma("unroll") for (int m = 0; m < 4; ++m) _Pragma("unroll") for (int n = 0; n < 2; ++n) \
            asm volatile("v_mfma_f32_16x16x128_f8f6f4 %0, %1, %2, 0" : "=&v"(acc[ai][bj][m][n]) : "v"(Bt##8[n]), "v"(At##8[m])); \
        __builtin_amdgcn_s_setprio(0); } while (0)
#define PG8_WAIT_V(n) asm volatile("s_waitcnt vmcnt(" #n ")" ::: "memory")
#ifndef WV_A
#define WV_A 8
#define WV_B 8
#endif
#define PG8_STR2(x) #x
#define PG8_STR(x) PG8_STR2(x)
#define PG8_WAIT_V_A asm volatile("s_waitcnt vmcnt(" PG8_STR(WV_A) ")" ::: "memory")
#define PG8_WAIT_V_B asm volatile("s_waitcnt vmcnt(" PG8_STR(WV_B) ")" ::: "memory")
#ifdef PG8_RELAX_FIRST
#define PG8_WAIT_V_FIRST do { if (FP8 && Epi::NSTORE > 0 && t == 0 && ui > 0) waitv_n<8 + (Epi::NSTORE > 0 ? Epi::NSTORE : 0)>(); else PG8_WAIT_V_A; } while (0)
#else
#define PG8_WAIT_V_FIRST PG8_WAIT_V_A
#endif
#define PG8_WAIT_L(n) asm volatile("s_waitcnt lgkmcnt(" #n ")" ::: "memory")
#define PG8_BAR __builtin_amdgcn_s_barrier()
#define PG8_SCHED __builtin_amdgcn_sched_barrier(0)
    Unit cur, nxt; int ui = 0;
    if (!S.next(0, cur)) return;
    if constexpr (Epi::DEPHASE > 1) {
        const unsigned slot = (unsigned)S.dephase_id() % Epi::DEPHASE;
        const unsigned long long t0 = __builtin_amdgcn_s_memrealtime(), dl = (unsigned long long)(slot * (unsigned)Epi::DEPHASE_TICKS) / Epi::DEPHASE;
        while (__builtin_amdgcn_s_memrealtime() - t0 < dl) __builtin_amdgcn_s_sleep(8);
    }
    f32x4 acc[2][2][4][2];
    if constexpr (!FP8) {
#pragma unroll
    for (int a = 0; a < 2; ++a)
#pragma unroll
        for (int b = 0; b < 2; ++b)
#pragma unroll
            for (int m = 0; m < 4; ++m)
#pragma unroll
                for (int n = 0; n < 2; ++n) acc[a][b][m][n] = (f32x4){0.f, 0.f, 0.f, 0.f};
    }
    bf16x8 At[4][2], B0[2][2], B1[2][2]; v8i_t At8[4], B08[2], B18[2];
#ifdef PROBE_SKIP
    for (int m = 0; m < 4; ++m) At8[m] = (v8i_t){0,0,0,0,0,0,0,0}; for (int n = 0; n < 2; ++n) { B08[n] = At8[0]; B18[n] = At8[0]; }
#endif
    unsigned vaC[2][2], vaN[2][2];
#pragma unroll
    for (int h = 0; h < 2; ++h)
#pragma unroll
        for (int i = 0; i < 2; ++i) vaC[h][i] = S.a_voff(cur, 0, h, Rr[i], Cc[i]);
    const char* cA = S.a_base(cur); const char* cB = S.b_base(cur);
    PG8_STAGE(PG8_SB(0, 0), cB, voffB); PG8_STAGE(PG8_SB(0, 1), cB + hstepB, voffB); PG8_STAGE(PG8_SA(0, 0), cA, vaC[0]); PG8_STAGE(PG8_SA(0, 1), cA, vaC[1]);
    if (wr == 1) PG8_BAR;
    PG8_WAIT_V(2); PG8_BAR;
    PG8_STAGE(PG8_SB(1, 0), cB + kstep, voffB); PG8_STAGE(PG8_SA(1, 0), cA + kstep, vaC[0]); PG8_STAGE(PG8_SB(1, 1), cB + hstepB + kstep, voffB);
    PG8_WAIT_V(6); PG8_BAR;
    for (;;) {
        const bool has_next = S.next(ui + 1, nxt);
        const char* nA = cA; const char* nB = cB;
        if (has_next) { nA = S.a_base(nxt); nB = S.b_base(nxt);
#pragma unroll
            for (int h = 0; h < 2; ++h)
#pragma unroll
                for (int i = 0; i < 2; ++i) vaN[h][i] = S.a_voff(nxt, ui + 1, h, Rr[i], Cc[i]);
        } else {
#pragma unroll
            for (int h = 0; h < 2; ++h)
#pragma unroll
                for (int i = 0; i < 2; ++i) vaN[h][i] = vaC[h][i];
        }
#pragma unroll 1
        for (int t = 0; t < nt; t += 2) {
            const bool last = (t == nt - 2);
            const char* a1 = cA + (size_t)(t + 1) * kstep;
            const char* a2 = last ? nA : cA + (size_t)(t + 2) * kstep; const char* b2 = last ? nB : cB + (size_t)(t + 2) * kstep;
            const char* a3 = a2 + kstep; const char* b3 = b2 + kstep;
            unsigned va2[2][2];
#pragma unroll
            for (int h = 0; h < 2; ++h)
#pragma unroll
                for (int i = 0; i < 2; ++i) va2[h][i] = last ? vaN[h][i] : vaC[h][i];
            PG8_LDB(B0, 0, 0); PG8_LDB(B1, 0, 1); PG8_SCHED; PG8_LDA(At, 0, 0); PG8_STAGE(PG8_SA(1, 1), a1, vaC[1]);
            PG8_WAIT_V_FIRST; PG8_WAIT_L(0); PG8_BAR; if (FP8 && t == 0) { PG8_MMA0(0, 0, At, B0); PG8_MMA0(0, 1, At, B1); } else { PG8_MMA(0, 0, At, B0); PG8_MMA(0, 1, At, B1); } PG8_BAR; PG8_SCHED;
            PG8_LDA(At, 0, 1); PG8_STAGE(PG8_SB(0, 0), b2, voffB); PG8_STAGE(PG8_SB(0, 1), b2 + hstepB, voffB); PG8_STAGE(PG8_SA(0, 0), a2, va2[0]);
            PG8_WAIT_V_FIRST; PG8_WAIT_L(0); PG8_BAR; if (FP8 && t == 0) { PG8_MMA0(1, 0, At, B0); PG8_MMA0(1, 1, At, B1); } else { PG8_MMA(1, 0, At, B0); PG8_MMA(1, 1, At, B1); } PG8_BAR; PG8_SCHED;
            PG8_LDB(B0, 1, 0); PG8_LDB(B1, 1, 1); PG8_SCHED; PG8_LDA(At, 1, 0); PG8_STAGE(PG8_SA(0, 1), a2, va2[1]);
            PG8_WAIT_V_A; PG8_WAIT_L(0); PG8_BAR; PG8_MMA(0, 0, At, B0); PG8_MMA(0, 1, At, B1); PG8_BAR; PG8_SCHED;
            PG8_LDA(At, 1, 1); PG8_STAGE(PG8_SB(1, 0), b3, voffB); PG8_STAGE(PG8_SB(1, 1), b3 + hstepB, voffB); PG8_STAGE(PG8_SA(1, 0), a3, va2[0]);
            PG8_WAIT_V_B; PG8_WAIT_L(0); PG8_BAR; PG8_MMA(1, 0, At, B0); PG8_MMA(1, 1, At, B1); PG8_BAR; PG8_SCHED;
            if constexpr (Epi::MIDK > 0) { if (t + 2 == Epi::MIDK) {
                if constexpr (FP8) asm volatile("s_nop 15\n\ts_nop 15" ::: "memory");
                int fr_ = fr, fq_ = fq; asm volatile("" : "+v"(fr_), "+v"(fq_)); E.mid(acc, cur, wr, wc, fr_, fq_); } }
        }
        if constexpr (ALIGN_EPI) { if (wr == 0) PG8_BAR; }
        if constexpr (FP8) asm volatile("s_nop 15\n\ts_nop 15" ::: "memory");
#ifdef PROBE_NOEPI
        if (!E.noepi)
#endif
        { int fr_ = fr, fq_ = fq; asm volatile("" : "+v"(fr_), "+v"(fq_)); E(acc, cur, ui, wr, wc, fr_, fq_); }
        if (!has_next) break;
        if constexpr (!FP8) {
#pragma unroll
        for (int a = 0; a < 2; ++a)
#pragma unroll
            for (int b = 0; b < 2; ++b)
#pragma unroll
                for (int m = 0; m < 4; ++m)
#pragma unroll
                    for (int n = 0; n < 2; ++n) acc[a][b][m][n] = (f32x4){0.f, 0.f, 0.f, 0.f};
        }
        cur = nxt; cA = nA; cB = nB; ++ui;
#pragma unroll
        for (int h = 0; h < 2; ++h)
#pragma unroll
            for (int i = 0; i < 2; ++i) vaC[h][i] = vaN[h][i];
        if constexpr (ALIGN_EPI) { if (wr == 1) PG8_BAR; }
    }
    PG8_WAIT_V(0);
    if constexpr (!ALIGN_EPI) { if (wr == 0) PG8_BAR; }
    PG8_BAR;
#undef PG8_SA
#undef PG8_SB
#undef PG8_STAGE
#undef PG8_LDA
#undef PG8_LDB
#undef PG8_MMA
#undef PG8_MMA0
#undef PG8_WAIT_V
#undef PG8_WAIT_V_A
#undef PG8_WAIT_V_B
#undef PG8_WAIT_V_FIRST
#undef PG8_WAIT_L
#undef PG8_BAR
#undef PG8_SCHED
}

struct DenseSched {
    const char* A; const char* Bt; int lda, ldb; int nM, nN, nwg, G, c; bool hot = false;
    __device__ __forceinline__ void init(const void* A_, int lda_, const void* Bt_, int ldb_, int M, int N, int G_, int c_) {
        A = (const char*)A_; Bt = (const char*)Bt_; lda = lda_; ldb = ldb_; nM = M / BM; nN = N / BM; nwg = nM * nN; G = G_; c = c_; }
    __device__ __forceinline__ bool next(int i, Unit& u) const {
        const long L = (long)i * G + c; if (L >= nwg) return false;
        int wgid = (int)L; { const int q = nwg / 8, r = nwg % 8, xcd = wgid % 8, off = wgid / 8; wgid = (xcd < r ? xcd * (q + 1) : r * (q + 1) + (xcd - r) * q) + off; }
#ifndef DENSE_WGM
#define DENSE_WGM 8
#endif
        const int nig = DENSE_WGM * nN, gid = wgid / nig, fm = gid * DENSE_WGM, gsz = (nM - fm) < DENSE_WGM ? (nM - fm) : DENSE_WGM;
        u.pm = fm + ((wgid % nig) % gsz); u.pn = (wgid % nig) / gsz; u.e = 0; u.mt = 0; return true;
    }
#ifdef PROBE_HOT
    __device__ __forceinline__ const char* a_base(const Unit& u) const { return A + (size_t)(hot ? (c & 63) : u.pm) * BM * lda * 2; }
    __device__ __forceinline__ const char* b_base(const Unit& u) const { return Bt + (size_t)(hot ? (c & 15) : u.pn) * BM * ldb * 2; }
#else
    __device__ __forceinline__ const char* a_base(const Unit& u) const { return A + (size_t)u.pm * BM * lda * 2; }
    __device__ __forceinline__ const char* b_base(const Unit& u) const { return Bt + (size_t)u.pn * BM * ldb * 2; }
#endif
    __device__ __forceinline__ unsigned a_voff(const Unit&, int, int h, int R, int C) const { return (unsigned)((h * HALF + R) * lda + C) * 2u; }
    __device__ __forceinline__ int dephase_id() const { return c >> 3; }
};
}
struct Args { const void* in[28]; float* out; unsigned char* ws; int ph_lo, ph_hi; };
struct Frame {
    LAS unsigned char* lds; volatile LAS unsigned* MISC; unsigned* ctl; unsigned char* ws;
    int wave, vcu, G;
};
#define F_LANE() lane_now()
#define F_TID() (F.wave * 64 + lane_now())
#define WSP(T_, off) ((T_*)(F.ws + (off)))

__device__ __forceinline__ void transpose_item(const float* src, int src_ld, int k0, int n0, int nvalid, bf16_t* dst, int dst_ld, int drow0, LAS float* scr, int lane) {
    const int cl = lane & 31;
    float tv[32];
#pragma unroll
    for (int i = 0; i < 32; ++i) { const int kk = 2 * i + (lane >> 5); tv[i] = (cl < nvalid) ? src[(size_t)(k0 + kk) * src_ld + n0 + cl] : 0.f; }
#pragma unroll
    for (int i = 0; i < 32; ++i) { const int kk = 2 * i + (lane >> 5); scr[kk * 33 + cl] = tv[i]; }
    LDS_WAIT(); asm volatile("" ::: "memory");
    const int c = lane & 7;
#pragma unroll
    for (int j = 0; j < 4; ++j) { const int n = (lane >> 3) + 8 * j; const LAS float* s = scr + (8 * c) * 33 + n;
        u32x4 o; o.x = cvtpk(s[0 * 33], s[1 * 33]); o.y = cvtpk(s[2 * 33], s[3 * 33]); o.z = cvtpk(s[4 * 33], s[5 * 33]); o.w = cvtpk(s[6 * 33], s[7 * 33]);
        *(u32x4*)(dst + (size_t)(drow0 + n) * dst_ld + k0 + 8 * c) = o; }
    LDS_WAIT(); asm volatile("" ::: "memory");
}

__device__ __forceinline__ void transpose_item_fp8(const float* src, int src_ld, int k0, int n0, float sc, unsigned char* dst, int dst_ld, int drow0, LAS float* scr, int lane) {
    const int cl = lane & 31;
    float tv[32];
#pragma unroll
    for (int i = 0; i < 32; ++i) { const int kk = 2 * i + (lane >> 5); tv[i] = src[(size_t)(k0 + kk) * src_ld + n0 + cl] * sc; }
#pragma unroll
    for (int i = 0; i < 32; ++i) { const int kk = 2 * i + (lane >> 5); scr[kk * 33 + cl] = tv[i]; }
    LDS_WAIT(); asm volatile("" ::: "memory");
    const int c = lane & 7;
#pragma unroll
    for (int j = 0; j < 4; ++j) { const int n = (lane >> 3) + 8 * j; const LAS float* s = scr + (8 * c) * 33 + n;
        u32x2 o; o.x = pk4_fp8(s[0 * 33], s[1 * 33], s[2 * 33], s[3 * 33]); o.y = pk4_fp8(s[4 * 33], s[5 * 33], s[6 * 33], s[7 * 33]);
        *(u32x2*)(dst + (size_t)(drow0 + n) * dst_ld + k0 + 8 * c) = o; }
    LDS_WAIT(); asm volatile("" ::: "memory");
}
__device__ __forceinline__ void transpose_item_fp8v(const float* src, int src_ld, int k0, int n0, int nvalid, float sc, unsigned char* dst, int dst_ld, int drow0, LAS float* scr, int lane) {
    const int cl = lane & 31;
    float tv[32];
#pragma unroll
    for (int i = 0; i < 32; ++i) { const int kk = 2 * i + (lane >> 5); tv[i] = (cl < nvalid) ? src[(size_t)(k0 + kk) * src_ld + n0 + cl] * sc : 0.f; }
#pragma unroll
    for (int i = 0; i < 32; ++i) { const int kk = 2 * i + (lane >> 5); scr[kk * 33 + cl] = tv[i]; }
    LDS_WAIT(); asm volatile("" ::: "memory");
    const int c = lane & 7;
#pragma unroll
    for (int j = 0; j < 4; ++j) { const int n = (lane >> 3) + 8 * j; const LAS float* s = scr + (8 * c) * 33 + n;
        u32x2 o; o.x = pk4_fp8(s[0 * 33], s[1 * 33], s[2 * 33], s[3 * 33]); o.y = pk4_fp8(s[4 * 33], s[5 * 33], s[6 * 33], s[7 * 33]);
        *(u32x2*)(dst + (size_t)(drow0 + n) * dst_ld + k0 + 8 * c) = o; }
    LDS_WAIT(); asm volatile("" ::: "memory");
}
__device__ __forceinline__ void pa_prologue(Frame& F, const Args& a) {
    const float* c_in = (const float*)a.in[1]; const int* pos = (const int*)a.in[2];
    const float* w_ada = (const float*)a.in[3]; const float* b_ada = (const float*)a.in[4];
    {
        constexpr int MU = 256, MC = 24;
        LAS float* sc = (LAS float*)(F.lds);
        if ((int)blockIdx.x < MU) { for (int idx = F_TID(); idx < 32 * 1024; idx += 512) { const int k = idx >> 5, b = idx & 31; sc[idx] = siluf_(c_in[b * 1024 + k]); } }
        __syncthreads();
        for (int u = blockIdx.x; u < MU; u += F.G) {
            const int ln = F_LANE(); const bool on = ln < MC; const int n = MC * u + (on ? ln : 0);
            float acc[32];
#pragma unroll
            for (int b = 0; b < 32; ++b) acc[b] = 0.f;
            const float* wp = w_ada + (size_t)(128 * F.wave) * 6144 + n;
            const LAS float* sp = sc + (128 * F.wave) * 32;
            {
                float wv[128];
#pragma unroll
                for (int j = 0; j < 128; ++j) wv[j] = wp[(size_t)j * 6144];
                __builtin_amdgcn_sched_barrier(0);
#pragma unroll
                for (int j = 0; j < 128; ++j)
#pragma unroll
                    for (int b4 = 0; b4 < 8; ++b4) { const f32x4 s = *(const LAS f32x4*)(sp + j * 32 + 4 * b4);
                        acc[4 * b4] += s[0] * wv[j]; acc[4 * b4 + 1] += s[1] * wv[j]; acc[4 * b4 + 2] += s[2] * wv[j]; acc[4 * b4 + 3] += s[3] * wv[j]; }
            }
            __syncthreads();
            LAS float* red = (LAS float*)(F.lds);
#pragma unroll
            for (int b = 0; b < 32; ++b) red[(F.wave * 32 + b) * 64 + ln] = acc[b];
            __syncthreads();
            float* mod = WSP(float, WS_MOD);
            for (int o = F_TID(); o < 32 * MC; o += 512) { const int b = o / MC, col = o % MC; float s = b_ada[MC * u + col];
#pragma unroll
                for (int w = 0; w < 8; ++w) s += red[(w * 32 + b) * 64 + col];
                mod[(size_t)b * 6144 + MC * u + col] = s; }
            __syncthreads();
            if (u + F.G < MU) { for (int idx = F_TID(); idx < 32 * 1024; idx += 512) { const int k = idx >> 5, b = idx & 31; sc[idx] = siluf_(c_in[b * 1024 + k]); } __syncthreads(); }
        }
    }
#if defined(PROBE_PA) && PROBE_PA == 2
    for (int rep_ = 0; rep_ < 2; ++rep_)
#endif
    {
        LAS float* scr = (LAS float*)(F.lds + F.wave * 16384);
        const int gw = F.vcu * 8 + F.wave, NGW = F.G * 8, lane = F_LANE();
        constexpr int I_WIN = 16 * 144, I_UPA = 8 * 32, I_UPB = 6 * 32, I_OUT = 16 * 32, I_CW1 = 32 * 8, I_CW2 = 4 * 2, I_GU = 16 * 32, I_WD = 8 * 32;
        constexpr int NITEMS = I_WIN + I_UPA + I_UPB + I_OUT + 2 * I_CW1 + 2 * I_CW2 + NEXP * (I_GU + I_WD);
        struct TItem { const float* src; unsigned char* dst; int src_ld, k0, n0, nvalid, dst_ld, drow0, esz; float sc; };
        auto decode = [&](int r) -> TItem {
            TItem d; d.nvalid = 32; d.sc = 64.f; d.esz = 1;
            if (r < I_WIN) { const int kb = r / 144, rb = r % 144, rho0 = 32 * rb, pn = rho0 >> 8, bj = (rho0 >> 7) & 1, wc = (rho0 >> 5) & 3, H = 4 * pn + wc;
                int nv = slot_valid(H) - 32 * bj; nv = nv < 0 ? 0 : (nv > 32 ? 32 : nv);
                d.src = (const float*)a.in[7]; d.src_ld = IN_COLS; d.k0 = 64 * kb; d.n0 = slot_col0(H) + 32 * bj; d.nvalid = nv;
                if (H >= SL_GMA && H < SL_GA) { const int q = (H - SL_GMA) & 15; d.n0 = slot_col0(H < SL_GMB ? SL_GMA : SL_GMB) + 256 * (q >> 2) + 128 * bj + 32 * (q & 3); }
                d.dst = F.ws + WS_WIN; d.dst_ld = 1024; d.drow0 = rho0; return d; } r -= I_WIN;
            if (r < I_UPA) { const int kb = r / 32, rb = r % 32; d.src = (const float*)a.in[18]; d.src_ld = 1024; d.k0 = 64 * kb; d.n0 = 32 * rb; d.dst = F.ws + WS_WUPA; d.dst_ld = 1024; d.drow0 = 32 * rb; return d; } r -= I_UPA;
            if (r < I_UPB) { const int kb = r / 32, rb = r % 32; d.src = (const float*)a.in[19]; d.src_ld = 1024; d.k0 = 64 * kb; d.n0 = 32 * rb; d.dst = F.ws + WS_WUPA + 512; d.dst_ld = 1024; d.drow0 = 32 * rb; return d; } r -= I_UPB;
            if (r < I_OUT) { const int kb = r / 32, rb = r % 32; d.src = (const float*)a.in[20]; d.src_ld = 1024; d.k0 = 64 * kb; d.n0 = 32 * rb; d.dst = F.ws + WS_WOUT; d.dst_ld = 1024; d.drow0 = 32 * rb; return d; } r -= I_OUT;
            if (r < 2 * I_CW1) { const int kv = r / I_CW1, q = r % I_CW1, kb = q / 8, rb = q % 8; d.esz = 2; d.sc = 1.f;
                d.src = (const float*)a.in[kv ? 14 : 11]; d.src_ld = 256; d.k0 = 64 * kb; d.n0 = 32 * rb; d.dst = F.ws + WS_CW1 + (size_t)kv * 256 * 2048 * 2; d.dst_ld = 2048; d.drow0 = 32 * rb; return d; } r -= 2 * I_CW1;
            if (r < 2 * I_CW2) { const int kv = r / I_CW2, q = r % I_CW2, kb = q / 2, rb = q % 2; d.esz = 2; d.sc = 1.f;
                d.src = (const float*)a.in[kv ? 15 : 12]; d.src_ld = 64; d.k0 = 64 * kb; d.n0 = 32 * rb; d.dst = F.ws + WS_CW2 + (size_t)kv * 64 * 256 * 2; d.dst_ld = 256; d.drow0 = 32 * rb; return d; } r -= 2 * I_CW2;
            const int e = r / (I_GU + I_WD); int q = r % (I_GU + I_WD);
            if (q < I_GU) { const int kb = q / 32, rb = q % 32, rho0 = 32 * rb, pn = rho0 >> 8, bj = (rho0 >> 7) & 1, y0 = rho0 & 127;
                d.src = (const float*)a.in[bj ? 26 : 25] + (size_t)e * 1024 * 512; d.src_ld = 512; d.k0 = 64 * kb; d.n0 = 128 * pn + y0; d.dst = F.ws + WS_WGU + (size_t)e * 1024 * 1024; d.dst_ld = 1024; d.drow0 = rho0; return d; }
            q -= I_GU; { const int kb = q / 32, rb = q % 32;
                d.src = (const float*)a.in[27] + (size_t)e * 512 * 1024; d.src_ld = 1024; d.k0 = 64 * kb; d.n0 = 32 * rb; d.dst = F.ws + WS_WD + (size_t)e * 1024 * 512; d.dst_ld = 512; d.drow0 = 32 * rb; return d; }
        };
        auto iload = [&](const TItem& d, float (&tv)[32]) { const int cl = lane & 31;
#pragma unroll
            for (int i = 0; i < 32; ++i) { const int kk = 2 * i + (lane >> 5); tv[i] = d.src[(size_t)(d.k0 + kk) * d.src_ld + d.n0 + cl]; } };
        auto istore = [&](const TItem& d, const float (&tv)[32]) { const int cl = lane & 31;
#pragma unroll
            for (int i = 0; i < 32; ++i) { const int kk = 2 * i + (lane >> 5); scr[kk * 33 + cl] = (cl < d.nvalid) ? tv[i] * d.sc : 0.f; }
            LDS_WAIT(); asm volatile("" ::: "memory");
            const int c = lane & 7;
#pragma unroll
            for (int j = 0; j < 4; ++j) { const int n = (lane >> 3) + 8 * j; const LAS float* s = scr + (8 * c) * 33 + n;
                unsigned char* dp = d.dst + ((size_t)(d.drow0 + n) * d.dst_ld + d.k0 + 8 * c) * d.esz;
                if (d.esz == 1) { u32x2 o; o.x = pk4_fp8(s[0 * 33], s[1 * 33], s[2 * 33], s[3 * 33]); o.y = pk4_fp8(s[4 * 33], s[5 * 33], s[6 * 33], s[7 * 33]); *(u32x2*)dp = o; }
                else { u32x4 o; o.x = cvtpk(s[0 * 33], s[1 * 33]); o.y = cvtpk(s[2 * 33], s[3 * 33]); o.z = cvtpk(s[4 * 33], s[5 * 33]); o.w = cvtpk(s[6 * 33], s[7 * 33]); *(u32x4*)dp = o; } }
            LDS_WAIT(); asm volatile("" ::: "memory"); };
        float ta[32], tb[32]; TItem da, db;
        int it = gw;
        if (it < NITEMS) { da = decode(it); iload(da, ta); }
#pragma unroll 1
        for (; it < NITEMS; it += 2 * NGW) {
            const bool hb = it + NGW < NITEMS; if (hb) { db = decode(it + NGW); iload(db, tb); }
            istore(da, ta);
            const bool ha = it + 2 * NGW < NITEMS; if (ha) { da = decode(it + 2 * NGW); iload(da, ta); }
            if (hb) istore(db, tb);
        }
    }
#if defined(PROBE_PA) && PROBE_PA == 3
    for (int rep_ = 0; rep_ < 2; ++rep_)
#endif
    {
        const int gt = F.vcu * 512 + F_TID(), NGT = F.G * 512;
        const double inv_rev = exp2(-(double)(gt & 31) * (13.287712379549449 / 32.0)) * 0.15915494309189535;
        float* ccos = WSP(float, WS_CROPE); float* csin = ccos + 32 * 128 * 32;
        for (int idx = gt; idx < 32 * 128 * 32; idx += NGT) { const int n = (idx >> 5) & 127, b = idx >> 12;
            const int tt = 16 * n + 31; const int p = pos[b * SEQ + (tt < SEQ ? tt : SEQ - 1)];
            const double rv = (double)p * inv_rev; const float fr = (float)(rv - rint(rv));
            ccos[idx] = __builtin_amdgcn_cosf(fr); csin[idx] = __builtin_amdgcn_sinf(fr); }
        bf16_t* rhi = (bf16_t*)(F.ws + WS_SMALL + 65536); bf16_t* rlo = (bf16_t*)(F.ws + WS_SMALL + 196608);
        const float* w_group = (const float*)a.in[21]; const float* w_router = (const float*)a.in[23];
        for (int idx = gt; idx < 64 * 1024; idx += NGT) { const int c = idx >> 10, k = idx & 1023;
            float w = 0.f; if (c < 4) w = w_group[k * 4 + c]; else if (c < 36) { const int g = (c - 4) >> 3, e = (c - 4) & 7; w = w_router[((size_t)g * 1024 + k) * 8 + e]; }
            const unsigned hi = cvtpk(w, 0.f) & 0xffffu; const float lo = w - bf2f((unsigned short)hi);
            rhi[idx] = (bf16_t)hi; rlo[idx] = (bf16_t)(cvtpk(lo, 0.f) & 0xffffu); }
        float* bias = WSP(float, WS_SMALL);
        for (int idx = gt; idx < 16 * 512; idx += NGT) { const int ks = idx >> 9, kv = (idx >> 8) & 1, col = idx & 255; const float* pe = (const float*)a.in[kv ? 13 : 10]; const float* w1 = (const float*)a.in[kv ? 14 : 11];
            float s = 0.f;
#pragma unroll 8
            for (int i = 128 * ks; i < 128 * ks + 128; ++i) s += pe[i] * w1[(size_t)i * 256 + col];
            bias[idx] = s; }
        for (int idx = gt; idx < 1024 * 32; idx += NGT) ((unsigned*)(F.ws + WS_WUPA))[(idx >> 5) * 256 + 224 + (idx & 31)] = 0u;
        if (gt < NEXP) F.ctl[CW_CNT + 64 * gt] = 0u;
    }
}

__device__ __forceinline__ void pb_modnorm(Frame& F, const float* x, const float* g, const float* mod, int sh_off, int sc_off, bf16_t* out, const float* g2) {
    const int gw = F.vcu * 8 + F.wave, NGW = F.G * 8;
    { float* a2 = WSP(float, WS_SMALL + 524288); for (int idx = F.vcu * 512 + F_TID(); idx < 32 * 1024; idx += F.G * 512) { const int b = idx >> 10, k = idx & 1023; a2[idx] = g2[k] * (1.0f + mod[(size_t)b * 6144 + 4096 + k]); } }
    const int ln = F_LANE();
#define PB_LOAD(V, M) do { const f32x4* xr_ = (const f32x4*)(x + (size_t)(M) * DM) + ln; _Pragma("unroll") for (int j = 0; j < 4; ++j) V[j] = xr_[64 * j]; } while (0)
#define PB_ROW(V, M) do { float s = 0.f; \
        _Pragma("unroll") for (int j = 0; j < 4; ++j) s += (V[j].x * V[j].x + V[j].y * V[j].y) + (V[j].z * V[j].z + V[j].w * V[j].w); \
        const float rstd = __builtin_amdgcn_rsqf(wave_sum(s) * (1.f / DM) + EPS); \
        unsigned* o4 = (unsigned*)((unsigned char*)out + (size_t)(M) * DM) + ln; \
        _Pragma("unroll") for (int j = 0; j < 4; ++j) { const f32x4 h = (V[j] * rstd) * ca[j] + cb[j]; o4[64 * j] = pk4_fp8(h.x, h.y, h.z, h.w); } } while (0)
#pragma unroll 1
    for (int blk = gw; blk < NT_TOK / 32; blk += NGW) {
        const int m0 = blk * 32, b = m0 >> 11;
        f32x4 ca[4], cb[4];
        { const f32x4* gr = (const f32x4*)g + ln; const f32x4* scr = (const f32x4*)(mod + (size_t)b * 6144 + sc_off) + ln; const f32x4* shr = (const f32x4*)(mod + (size_t)b * 6144 + sh_off) + ln;
#pragma unroll
          for (int j = 0; j < 4; ++j) { ca[j] = gr[64 * j] * (scr[64 * j] + 1.0f); cb[j] = shr[64 * j]; } }
        f32x4 va[4], vb[4];
        PB_LOAD(va, m0);
#pragma unroll 1
        for (int i = 0; i < 32; i += 2) {
            PB_LOAD(vb, m0 + i + 1);
            PB_ROW(va, m0 + i);
            if (i + 2 < 32) PB_LOAD(va, m0 + i + 2);
            PB_ROW(vb, m0 + i + 1);
        }
    }
#undef PB_ROW
#undef PB_LOAD
}
namespace pg8 {
#ifndef PC_DEPHASE
#define PC_DEPHASE 1
#define PC_DEPHASE_TICKS 0
#endif
struct ProjEpi {
    static constexpr bool PERM = true; static constexpr int MIDK = 0, DEPHASE = PC_DEPHASE, DEPHASE_TICKS = PC_DEPHASE_TICKS;
#ifdef PROBE_NOEPI
    static constexpr int NSTORE = 0;
#else
    static constexpr int NSTORE = 8;
#endif
    unsigned char* ws; const int* pos; const float* cosT; const float* sinT; const float* nq; const float* nk; const float* dq; const float* dk; bool noepi; bool hotst = false;
    static __device__ __forceinline__ float xsum(float x) {
        float y = x; asm("s_nop 1\n\tv_permlane16_swap_b32 %0, %1" : "+v"(x), "+v"(y)); x += y;
        y = x; asm("s_nop 1\n\tv_permlane32_swap_b32 %0, %1" : "+v"(x), "+v"(y)); return x + y; }
    __device__ __forceinline__ void operator()(const f32x4 (&acc)[2][2][4][2], const Unit& u, int, int wr, int wc, int fr, int fq) const {
#ifdef PC_FP8
        constexpr float SC = 0.015625f;
#else
        constexpr float SC = 1.0f;
#endif
        const int H = __builtin_amdgcn_readfirstlane(4 * u.pn + wc);
        int type = 0; const float* gn = nq; float qs = 1.f;
        if (H < 8) { type = 1; gn = nq; qs = C2; }
        else if (H == 12 || H == 13 || H == 16 || H == 17) { type = 1; gn = nk; }
        else if (H >= 20 && H < 26) { type = 1; gn = dq; qs = C2; }
        else if (H >= 26 && H < 32) { type = 1; gn = dk; }
        else if (H >= 38 && H <= 70) type = 2;
        bf16_t* dst = (bf16_t*)(ws + slot_off(H));
#ifdef PROBE_HOTST
        const int row0 = hotst ? (int)blockIdx.x * 256 + wr * 64 + fr : u.pm * BM + wr * 64 + fr;
        if (hotst) dst = (bf16_t*)(ws + WS_Y) + (size_t)wc * 65536 * 64;
#else
        const int row0 = u.pm * BM + wr * 64 + fr;
#endif
        if (type == 1) {
            f32x4 g0[2], g1[2], ir[2];
#pragma unroll
            for (int n = 0; n < 2; ++n) { g0[n] = *(const f32x4*)(gn + 8 * fq + 4 * n) * qs; g1[n] = *(const f32x4*)(gn + 32 + 8 * fq + 4 * n) * qs;
#pragma unroll
                for (int i = 0; i < 4; ++i) ir[n][i] = __builtin_amdgcn_exp2f(-(float)(8 * fq + 4 * n + i) * 0.41524101186092033f - 2.651496129472319f); }
            float pf[8], rs[8];
#pragma unroll
            for (int j = 0; j < 8; ++j) pf[j] = (float)pos[row0 + (j >> 2) * HALF + (j & 3) * 16];
#pragma unroll
            for (int j = 0; j < 8; ++j) { const int ai = j >> 2, m = j & 3;
                f32x4 q = acc[ai][0][m][0] * acc[ai][0][m][0]; q += acc[ai][0][m][1] * acc[ai][0][m][1]; q += acc[ai][1][m][0] * acc[ai][1][m][0]; q += acc[ai][1][m][1] * acc[ai][1][m][1];
                rs[j] = (q[0] + q[1]) + (q[2] + q[3]); }
#ifdef PC_XSUM_SWAP
#pragma unroll
            for (int j = 0; j < 8; ++j) rs[j] = xsum(rs[j]);
#else
            { float t[8];
#pragma unroll
                for (int j = 0; j < 8; ++j) t[j] = __shfl_xor(rs[j], 16);
#pragma unroll
                for (int j = 0; j < 8; ++j) rs[j] += t[j];
#pragma unroll
                for (int j = 0; j < 8; ++j) t[j] = __shfl_xor(rs[j], 32);
#pragma unroll
                for (int j = 0; j < 8; ++j) rs[j] += t[j]; }
#endif
#pragma unroll
            for (int j = 0; j < 8; ++j) rs[j] = SC * __builtin_amdgcn_rsqf(rs[j] * (SC * SC / 64.f) + EPS);
#pragma unroll
            for (int j = 0; j < 8; ++j) { const int ai = j >> 2, m = j & 3;
                const int tok = row0 + ai * HALF + m * 16;
                u32x4 w0, w1;
#pragma unroll
                for (int n = 0; n < 2; ++n) {
                    const f32x4 rv = ir[n] * pf[j];
                    f32x4 cs, sn;
#pragma unroll
                    for (int i = 0; i < 4; ++i) { const float fr2 = __builtin_amdgcn_fractf(rv[i]); cs[i] = __builtin_amdgcn_cosf(fr2); sn[i] = __builtin_amdgcn_sinf(fr2); }
                    const f32x4 x1 = acc[ai][0][m][n] * (g0[n] * rs[j]), x2 = acc[ai][1][m][n] * (g1[n] * rs[j]);
                    const f32x4 o1 = x1 * cs - x2 * sn, o2 = x1 * sn + x2 * cs;
                    w0[2 * n] = cvtpk(o1[0], o1[1]); w0[2 * n + 1] = cvtpk(o1[2], o1[3]); w1[2 * n] = cvtpk(o2[0], o2[1]); w1[2 * n + 1] = cvtpk(o2[2], o2[3]);
                }
                bf16_t* rp = dst + (size_t)tok * 64 + 8 * fq;
                *(u32x4*)rp = w0; *(u32x4*)(rp + 32) = w1;
            }
        } else if (type == 2 && H < SL_GA) {
            unsigned char* dst8 = (unsigned char*)dst;
#pragma unroll
            for (int ai = 0; ai < 2; ++ai)
#pragma unroll
                for (int m = 0; m < 4; ++m) {
                    const int tok = row0 + ai * HALF + m * 16;
                    u32x4 w;
#pragma unroll
                    for (int bj = 0; bj < 2; ++bj)
#pragma unroll
                        for (int n = 0; n < 2; ++n) { const f32x4 t = acc[ai][bj][m][n] * (-1.4426950408889634f * SC); f32x4 e, g;
#pragma unroll
                            for (int i = 0; i < 4; ++i) e[i] = __builtin_amdgcn_exp2f(t[i]);
                            e += 1.0f;
#pragma unroll
                            for (int i = 0; i < 4; ++i) g[i] = __builtin_amdgcn_rcpf(e[i]);
                            const float g0 = g[0] * 255.0f + 8388608.0f, g1 = g[1] * 255.0f + 8388608.0f, g2 = g[2] * 255.0f + 8388608.0f, g3 = g[3] * 255.0f + 8388608.0f;
                            const unsigned u0 = __builtin_bit_cast(unsigned, g0), u1 = __builtin_bit_cast(unsigned, g1), u2 = __builtin_bit_cast(unsigned, g2), u3 = __builtin_bit_cast(unsigned, g3);
                            w[2 * bj + n] = (u0 & 0xffu) | (u1 << 8) | (u2 << 16) | (u3 << 24); }
                    *(u32x4*)(dst8 + (size_t)tok * 64 + 16 * fq) = w;
                }
        } else if (type == 2) {
#pragma unroll
            for (int ai = 0; ai < 2; ++ai)
#pragma unroll
                for (int m = 0; m < 4; ++m) {
                    const int tok = row0 + ai * HALF + m * 16;
                    bf16_t* rp = dst + (size_t)tok * 64 + 8 * fq;
#pragma unroll
                    for (int bj = 0; bj < 2; ++bj) { f32x4 v[2];
#pragma unroll
                        for (int n = 0; n < 2; ++n) { const f32x4 t = acc[ai][bj][m][n] * (-1.4426950408889634f * SC); f32x4 e;
#pragma unroll
                            for (int i = 0; i < 4; ++i) e[i] = __builtin_amdgcn_exp2f(t[i]);
                            e += 1.0f;
#pragma unroll
                            for (int i = 0; i < 4; ++i) v[n][i] = __builtin_amdgcn_rcpf(e[i]); }
                        u32x4 w; w.x = cvtpk(v[0][0], v[0][1]); w.y = cvtpk(v[0][2], v[0][3]); w.z = cvtpk(v[1][0], v[1][1]); w.w = cvtpk(v[1][2], v[1][3]);
                        *(u32x4*)(rp + 32 * bj) = w; }
                }
        } else {
#pragma unroll
            for (int ai = 0; ai < 2; ++ai)
#pragma unroll
                for (int m = 0; m < 4; ++m) {
                    const int tok = row0 + ai * HALF + m * 16;
                    bf16_t* rp = dst + (size_t)tok * 64 + 8 * fq;
#pragma unroll
                    for (int bj = 0; bj < 2; ++bj) { const f32x4 v0 = acc[ai][bj][m][0] * SC, v1 = acc[ai][bj][m][1] * SC;
                        u32x4 w; w.x = cvtpk(v0[0], v0[1]); w.y = cvtpk(v0[2], v0[3]); w.z = cvtpk(v1[0], v1[1]); w.w = cvtpk(v1[2], v1[3]);
                        *(u32x4*)(rp + 32 * bj) = w; }
                }
        }
    }
};

template <bool ADD> struct UpEpi {
    static constexpr bool PERM = true, noepi = false; static constexpr int MIDK = 0, DEPHASE = 1, DEPHASE_TICKS = 0, NSTORE = 0;
    unsigned char* ws; bf16_t* Y; int gslot0; unsigned char* Y8;
    __device__ __forceinline__ void operator()(const f32x4 (&acc)[2][2][4][2], const Unit& u, int, int wr, int wc, int fr, int fq) const {
        const int row0 = u.pm * BM + wr * 64 + fr;
#pragma unroll
        for (int bj = 0; bj < 2; ++bj) {
            const int gs = __builtin_amdgcn_readfirstlane(gslot0 + 4 * u.pn + 2 * bj + (wc >> 1));
            const bf16_t* gp = (const bf16_t*)(ws + slot_off(gs)) + 32 * (wc & 1) + 8 * fq;
            const int col = u.pn * BM + bj * HALF + wc * 32 + 8 * fq;
#pragma unroll
            for (int ai = 0; ai < 2; ++ai) {
                u32x4 gg[4], yy[4];
#pragma unroll
                for (int m = 0; m < 4; ++m) { const int tok = row0 + ai * HALF + m * 16; gg[m] = *(const u32x4*)(gp + (size_t)tok * 64); if (ADD) yy[m] = *(const u32x4*)(Y + (size_t)tok * DM + col); }
#pragma unroll
                for (int m = 0; m < 4; ++m) {
                    const int tok = row0 + ai * HALF + m * 16;
                    const u32x4 g = gg[m];
                    bf16_t* yp = Y + (size_t)tok * DM + col;
                    f32x4 v0 = acc[ai][bj][m][0], v1 = acc[ai][bj][m][1];
                    v0[0] *= bflo(g.x); v0[1] *= bfhi(g.x); v0[2] *= bflo(g.y); v0[3] *= bfhi(g.y); v1[0] *= bflo(g.z); v1[1] *= bfhi(g.z); v1[2] *= bflo(g.w); v1[3] *= bfhi(g.w);
                    if (ADD) { const u32x4 y = yy[m];
                        v0[0] += bflo(y.x); v0[1] += bfhi(y.x); v0[2] += bflo(y.y); v0[3] += bfhi(y.y); v1[0] += bflo(y.z); v1[1] += bfhi(y.z); v1[2] += bflo(y.w); v1[3] += bfhi(y.w); }
                    if (ADD && Y8) { u32x2 w8; w8.x = pk4_fp8(v0[0] * 16.f, v0[1] * 16.f, v0[2] * 16.f, v0[3] * 16.f); w8.y = pk4_fp8(v1[0] * 16.f, v1[1] * 16.f, v1[2] * 16.f, v1[3] * 16.f); *(u32x2*)(Y8 + (size_t)tok * DM + col) = w8; }
                    else { u32x4 w; w.x = cvtpk(v0[0], v0[1]); w.y = cvtpk(v0[2], v0[3]); w.z = cvtpk(v1[0], v1[1]); w.w = cvtpk(v1[2], v1[3]); *(u32x4*)yp = w; }
                }
                asm volatile("" ::: "memory");
            }
            asm volatile("" ::: "memory");
        }
    }
};

struct Up2Epi {
    static constexpr bool PERM = true, noepi = false; static constexpr int MIDK = 4, DEPHASE = 1, DEPHASE_TICKS = 0, NSTORE = 16;
    unsigned char* ws; unsigned char* Y8;
    static __device__ __forceinline__ unsigned fixz(unsigned x) { return x | ((((x - 0x01010101u) & ~x) & 0x80808080u) >> 7); }
    static __device__ __forceinline__ f32x4 ub4(unsigned x) { return (f32x4){(float)(x & 0xffu), (float)((x >> 8) & 0xffu), (float)((x >> 16) & 0xffu), (float)(x >> 24)}; }
    __device__ __forceinline__ void mid(f32x4 (&acc)[2][2][4][2], const Unit& u, int wr, int wc, int fr, int fq) const {
        const int row0 = u.pm * BM + wr * 64 + fr;
        const int sa = __builtin_amdgcn_readfirstlane(SL_GMA + 4 * u.pn + wc);
        const unsigned char* ga = ws + slot_off(sa) + 16 * fq;
        const unsigned char* gb = ws + slot_off(sa + (SL_GMB - SL_GMA)) + 16 * fq;
#pragma unroll
        for (int ai = 0; ai < 2; ++ai) {
            u32x4 xa[4], xb[4];
#pragma unroll
            for (int m = 0; m < 4; ++m) { const int tok = row0 + ai * HALF + m * 16; xa[m] = *(const u32x4*)(ga + (size_t)tok * 64); xb[m] = *(const u32x4*)(gb + (size_t)tok * 64); }
#pragma unroll
            for (int m = 0; m < 4; ++m)
#pragma unroll
                for (int bj = 0; bj < 2; ++bj)
#pragma unroll
                    for (int n = 0; n < 2; ++n) { const f32x4 a = ub4(xa[m][2 * bj + n]), b = ub4(fixz(xb[m][2 * bj + n])); f32x4 r;
#pragma unroll
                        for (int i = 0; i < 4; ++i) r[i] = __builtin_amdgcn_rcpf(b[i]);
                        acc[ai][bj][m][n] *= a * r; }
            asm volatile("" ::: "memory");
        }
    }
    __device__ __forceinline__ void operator()(const f32x4 (&acc)[2][2][4][2], const Unit& u, int, int wr, int wc, int fr, int fq) const {
        const int row0 = u.pm * BM + wr * 64 + fr;
        const int sb = __builtin_amdgcn_readfirstlane(SL_GMB + 4 * u.pn + wc);
        const unsigned char* gb = ws + slot_off(sb) + 16 * fq;
        u32x4 xb[8];
#pragma unroll
        for (int j = 0; j < 8; ++j) xb[j] = *(const u32x4*)(gb + (size_t)(row0 + (j >> 2) * HALF + (j & 3) * 16) * 64);
#pragma unroll
        for (int j = 0; j < 8; ++j) { const int ai = j >> 2, m = j & 3;
            const int tok = row0 + ai * HALF + m * 16; const float s = 1.0f / (64.0f * 255.0f);
#pragma unroll
            for (int bj = 0; bj < 2; ++bj) {
                const int col = u.pn * BM + bj * HALF + wc * 32 + 8 * fq;
                const f32x4 v0 = acc[ai][bj][m][0] * s * ub4(fixz(xb[j][2 * bj])), v1 = acc[ai][bj][m][1] * s * ub4(fixz(xb[j][2 * bj + 1]));
                u32x2 w8; w8.x = pk4_fp8(v0[0], v0[1], v0[2], v0[3]); w8.y = pk4_fp8(v1[0], v1[1], v1[2], v1[3]);
                *(u32x2*)(Y8 + (size_t)tok * DM + col) = w8;
            }
        }
    }
};

#ifndef OUT_DEPHASE
#define OUT_DEPHASE 1
#endif
struct OutEpi {
    static constexpr bool PERM = false, noepi = false; static constexpr int MIDK = 0, DEPHASE = OUT_DEPHASE, DEPHASE_TICKS = 3400, NSTORE = 32;
    const float* x; float* out; const float* mod; float* rowss; float asc;
    __device__ __forceinline__ void operator()(const f32x4 (&acc)[2][2][4][2], const Unit& u, int, int wr, int wc, int fr, int fq) const {
        const int row0 = u.pm * BM + wr * 64 + fr, col0 = u.pn * BM + wc * 32 + 4 * fq;
        const int b = (u.pm * BM) >> 11;
        const float* gt = mod + (size_t)b * 6144 + 2048 + col0;
        f32x4 gv[2][2];
#pragma unroll
        for (int bj = 0; bj < 2; ++bj)
#pragma unroll
            for (int n = 0; n < 2; ++n) gv[bj][n] = *(const f32x4*)(gt + bj * HALF + n * 16) * asc;
#pragma unroll
        for (int ai = 0; ai < 2; ++ai) {
            f32x4 xv[4][2][2];
#pragma unroll
            for (int m = 0; m < 4; ++m) { const size_t off = (size_t)(row0 + ai * HALF + m * 16) * DM + col0;
#pragma unroll
                for (int bj = 0; bj < 2; ++bj)
#pragma unroll
                    for (int n = 0; n < 2; ++n) xv[m][bj][n] = *(const f32x4*)(x + off + bj * HALF + n * 16); }
#pragma unroll
            for (int m = 0; m < 4; ++m) {
                const int tok = row0 + ai * HALF + m * 16; const size_t off = (size_t)tok * DM + col0; float ss = 0.f;
#pragma unroll
                for (int bj = 0; bj < 2; ++bj)
#pragma unroll
                    for (int n = 0; n < 2; ++n) { const f32x4 o = xv[m][bj][n] + gv[bj][n] * acc[ai][bj][m][n];
                        ss += (o[0] * o[0] + o[1] * o[1]) + (o[2] * o[2] + o[3] * o[3]);
#ifdef X1_BF16
                        { u32x2 w; w.x = cvtpk(o[0], o[1]); w.y = cvtpk(o[2], o[3]); *(u32x2*)((bf16_t*)out + off + bj * HALF + n * 16) = w; }
#else
                        *(f32x4*)(out + off + bj * HALF + n * 16) = o;
#endif
                    }
                ss += __shfl_xor(ss, 16); ss += __shfl_xor(ss, 32);
                if (fq == 0) rowss[(size_t)tok * 16 + 4 * u.pn + wc] = ss;
            }
            asm volatile("" ::: "memory");
        }
    }
};

struct CmpEpi {
    static constexpr bool PERM = true, noepi = false; static constexpr int MIDK = 0, DEPHASE = 1, DEPHASE_TICKS = 0, NSTORE = 0;
    const float* biasp; bf16_t* hid;
    __device__ __forceinline__ void operator()(const f32x4 (&acc)[2][2][4][2], const Unit& u, int, int wr, int wc, int fr, int fq) const {
        const int kv = u.pm >= 32 ? 1 : 0; const int row0 = u.pm * BM + wr * 64 + fr;
#pragma unroll
        for (int bj = 0; bj < 2; ++bj) {
            const int col = bj * HALF + wc * 32 + 8 * fq;
            f32x4 b0 = (f32x4){0.f, 0.f, 0.f, 0.f}, b1 = b0;
            for (int ks = 0; ks < 16; ++ks) { b0 += *(const f32x4*)(biasp + ks * 512 + kv * 256 + col); b1 += *(const f32x4*)(biasp + ks * 512 + kv * 256 + col + 4); }
#pragma unroll
            for (int ai = 0; ai < 2; ++ai)
#pragma unroll
                for (int m = 0; m < 4; ++m) {
                    const int row = row0 + ai * HALF + m * 16;
                    f32x4 v0 = acc[ai][bj][m][0] + b0, v1 = acc[ai][bj][m][1] + b1;
#pragma unroll
                    for (int i = 0; i < 4; ++i) { v0[i] = siluf_(v0[i]); v1[i] = siluf_(v1[i]); }
                    u32x4 w; w.x = cvtpk(v0[0], v0[1]); w.y = cvtpk(v0[2], v0[3]); w.z = cvtpk(v1[0], v1[1]); w.w = cvtpk(v1[2], v1[3]);
                    *(u32x4*)(hid + (size_t)row * 256 + col) = w;
                }
        }
    }
};
struct CmpSched {
    const char* A; const char* Bt; int ldb; int nwg_c, c;
    __device__ __forceinline__ bool next(int i, Unit& u) const { if (c < 0) return false; const int L = i * nwg_c + c; if (L >= 64) return false; u.pm = L; u.pn = 0; u.e = 0; u.mt = 0; return true; }
    __device__ __forceinline__ const char* a_base(const Unit& u) const { return A + (size_t)u.pm * BM * 1024 * 2; }
    __device__ __forceinline__ unsigned a_voff(const Unit&, int, int h, int R, int C) const { return (unsigned)((h * HALF + R) * 1024 + C) * 2u; }
    __device__ __forceinline__ const char* b_base(const Unit& u) const { return Bt + (u.pm >= 32 ? (size_t)256 * 2048 * 2 : 0); }
    __device__ __forceinline__ int dephase_id() const { return 0; }
};
}
namespace att {
constexpr int A_KV = 0;
constexpr int A_IMP = 49152;
constexpr int A_SEL = 83968;
constexpr int A_WSF = 98304;
constexpr int A_OST = 100352;
constexpr float NEG_INF = -INFINITY;
constexpr float THR = 8.0f;
__device__ __forceinline__ int crow(int r, int hi) { return (r & 3) + 8 * (r >> 2) + 4 * hi; }
__device__ __forceinline__ void glds16(const void* gsrc, unsigned lds_dst) { unsigned keep;
    asm volatile("s_mov_b32 %0, m0\n\ts_mov_b32 m0, %2\n\ts_nop 0\n\tglobal_load_lds_dwordx4 %1, off\n\ts_mov_b32 m0, %0" : "=&s"(keep) : "v"(gsrc), "s"(lds_dst) : "memory"); }
#define ATT_WAIT_BAR(N) asm volatile("s_waitcnt vmcnt(" #N ") lgkmcnt(0)\n\ts_barrier" ::: "memory")
#define ATT_SBAR() __builtin_amdgcn_sched_barrier(0)

struct Ctx { LAS unsigned char* lds; int lane, r32, hi, wid; unsigned lds0; };
__device__ __forceinline__ int fresh(int v) { asm volatile("" : "+v"(v)); return v; }

__device__ __forceinline__ void qkt(f32x16& p0, f32x16& p1, const LAS unsigned char* Kslot, const bf16x8 (&qr)[4], int lane_) {
    const int lq = lane_now(); const int r32 = lq & 31, hi = lq >> 5;
    const LAS unsigned char* kb = Kslot + hi * 1024 + r32 * 16;
    const f32x16 z = {};
#pragma unroll
    for (int d0 = 0; d0 < 4; ++d0) {
        const bf16x8 b0 = *(const LAS bf16x8*)(kb + d0 * 2048);
        const bf16x8 b1 = *(const LAS bf16x8*)(kb + d0 * 2048 + 512);
        if (d0 == 0) { p0 = __builtin_amdgcn_mfma_f32_32x32x16_bf16(b0, qr[0], z, 0, 0, 0); p1 = __builtin_amdgcn_mfma_f32_32x32x16_bf16(b1, qr[0], z, 0, 0, 0); }
        else { p0 = __builtin_amdgcn_mfma_f32_32x32x16_bf16(b0, qr[d0], p0, 0, 0, 0); p1 = __builtin_amdgcn_mfma_f32_32x32x16_bf16(b1, qr[d0], p1, 0, 0, 0); } }
}
__device__ __forceinline__ void pv(f32x16 (&o)[2], int vb, bf16x8 pa0, bf16x8 pa1, bf16x8 pa2, bf16x8 pa3) {
#pragma unroll
    for (int d0 = 0; d0 < 2; ++d0) { s16x4 lo[4], hh[4];
#pragma unroll
        for (int ks = 0; ks < 4; ++ks) {
            asm volatile("ds_read_b64_tr_b16 %0,%1 offset:%c2" : "=&v"(lo[ks]) : "v"(vb), "i"(d0 * 4096 + ks * 1024) : "memory");
            asm volatile("ds_read_b64_tr_b16 %0,%1 offset:%c2" : "=&v"(hh[ks]) : "v"(vb), "i"(d0 * 4096 + ks * 1024 + 512) : "memory"); }
        asm volatile("s_waitcnt lgkmcnt(0)" ::: "memory"); ATT_SBAR();
#define ATT_PK(k) (bf16x8){lo[k][0], lo[k][1], lo[k][2], lo[k][3], hh[k][0], hh[k][1], hh[k][2], hh[k][3]}
        o[d0] = __builtin_amdgcn_mfma_f32_32x32x16_bf16(pa0, ATT_PK(0), o[d0], 0, 0, 0);
        o[d0] = __builtin_amdgcn_mfma_f32_32x32x16_bf16(pa1, ATT_PK(1), o[d0], 0, 0, 0);
        o[d0] = __builtin_amdgcn_mfma_f32_32x32x16_bf16(pa2, ATT_PK(2), o[d0], 0, 0, 0);
        o[d0] = __builtin_amdgcn_mfma_f32_32x32x16_bf16(pa3, ATT_PK(3), o[d0], 0, 0, 0);
#undef ATT_PK
    }
}
__device__ __forceinline__ float max3f(float a, float b, float c) { float r; asm("v_max3_f32 %0, %1, %2, %3" : "=v"(r) : "v"(a), "v"(b), "v"(c)); return r; }
__device__ __forceinline__ float max2f(float a, float b) { float r; asm("v_max_f32_e32 %0, %1, %2" : "=v"(r) : "v"(a), "v"(b)); return r; }
__device__ __forceinline__ float rowmax3(const f32x16& p0, const f32x16& p1) {
    float a = max3f(p0[0], p0[1], p1[0]), b = max3f(p0[2], p0[3], p1[1]); a = max3f(a, p1[2], p1[3]);
#pragma unroll
    for (int r = 4; r < 16; r += 4) { a = max3f(a, p0[r], p0[r + 1]); b = max3f(b, p0[r + 2], p0[r + 3]); a = max3f(a, p1[r], p1[r + 1]); b = max3f(b, p1[r + 2], p1[r + 3]); }
    const float m = max2f(a, b);
    auto rr = __builtin_amdgcn_permlane32_swap(__float_as_uint(m), __float_as_uint(m), false, false);
    return max2f(__uint_as_float(rr[0]), __uint_as_float(rr[1]));
}

__device__ __forceinline__ float rowmax(const f32x16& p0, const f32x16& p1) { return rowmax3(p0, p1); }
__device__ __forceinline__ float halfsum(float v) { auto rr = __builtin_amdgcn_permlane32_swap(__float_as_uint(v), __float_as_uint(v), false, false); return __uint_as_float(rr[0]) + __uint_as_float(rr[1]); }
#define ATT_PACK4(P, B) (u32x4){cvtpk(P[B], P[B + 1]), cvtpk(P[B + 2], P[B + 3]), cvtpk(P[B + 4], P[B + 5]), cvtpk(P[B + 6], P[B + 7])}
__device__ __forceinline__ void pv_tile(f32x16 (&o)[2], int vb, const f32x16& p0, const f32x16& p1) {
    const u32x4 w0 = ATT_PACK4(p0, 0), w1 = ATT_PACK4(p0, 8), w2 = ATT_PACK4(p1, 0), w3 = ATT_PACK4(p1, 8);
    pv(o, vb, __builtin_bit_cast(bf16x8, w0), __builtin_bit_cast(bf16x8, w1), __builtin_bit_cast(bf16x8, w2), __builtin_bit_cast(bf16x8, w3));
}
__device__ __forceinline__ void scale_rows(f32x16 (&o)[2], float f, const Ctx& C_) {
    Ctx C = C_; { const int l = lane_now(); C.r32 = l & 31; C.hi = l >> 5; }
    LAS float* wsf = (LAS float*)(C.lds + A_WSF) + C.wid * 64;
    if (C.hi == 0) wsf[C.r32] = f;
    asm volatile("s_waitcnt lgkmcnt(0)" ::: "memory");
#pragma unroll
    for (int g = 0; g < 4; ++g) { const f32x4 fv = *(const LAS f32x4*)(wsf + 8 * g + 4 * C.hi);
#pragma unroll
        for (int i = 0; i < 4; ++i) { o[0][4 * g + i] *= fv[i]; o[1][4 * g + i] *= fv[i]; } }
    asm volatile("s_waitcnt lgkmcnt(0)" ::: "memory");
}
__device__ __forceinline__ void axpy_rows(f32x16 (&acc)[2], const f32x16 (&o)[2], float f, const Ctx& C_) {
    Ctx C = C_; { const int l = lane_now(); C.r32 = l & 31; C.hi = l >> 5; }
    LAS float* wsf = (LAS float*)(C.lds + A_WSF) + C.wid * 64;
    if (C.hi == 0) wsf[C.r32] = f;
    asm volatile("s_waitcnt lgkmcnt(0)" ::: "memory");
#pragma unroll
    for (int g = 0; g < 4; ++g) { const f32x4 fv = *(const LAS f32x4*)(wsf + 8 * g + 4 * C.hi);
#pragma unroll
        for (int i = 0; i < 4; ++i) { acc[0][4 * g + i] += o[0][4 * g + i] * fv[i]; acc[1][4 * g + i] += o[1][4 * g + i] * fv[i]; } }
    asm volatile("s_waitcnt lgkmcnt(0)" ::: "memory");
}
struct SM { float m, l; f32x16 o[2]; };
__device__ __forceinline__ void sm_init(SM& s) { s.m = -1e30f; s.l = 0.f; s.o[0] = f32x16{}; s.o[1] = f32x16{}; }
__device__ __forceinline__ void sm_part1(SM& s, f32x16& p0, f32x16& p1, u32x4& w0, u32x4& w1, u32x4& w2, u32x4& w3, const Ctx& C) {
    const float rm = rowmax(p0, p1);
    if (__any(rm > s.m + THR)) {
        const float mn = fmaxf(s.m, rm); const float f = __builtin_amdgcn_exp2f(s.m - mn);
        s.l *= f; s.m = mn; scale_rows(s.o, f, C);
    }
    float sum = 0.f;
#pragma unroll
    for (int r = 0; r < 16; ++r) { p0[r] = __builtin_amdgcn_exp2f(p0[r] - s.m); p1[r] = __builtin_amdgcn_exp2f(p1[r] - s.m); sum += p0[r] + p1[r]; }
    s.l += sum;
    w0 = ATT_PACK4(p0, 0); w1 = ATT_PACK4(p0, 8); w2 = ATT_PACK4(p1, 0); w3 = ATT_PACK4(p1, 8);
}
template <int NS> __device__ __forceinline__ void dma_tile(const Ctx& C, const bf16_t* Kp, const bf16_t* Vp, long rs, int tile, int stage, int q, int base_off = 0) {
    const unsigned base = C.lds0 + (unsigned)(base_off + (stage * NS + q) * 16384);
    const long k0 = (long)tile * 64; const int lane = lane_now();
#pragma unroll
    for (int j = 0; j < NS; ++j) {
        const int pw = (NS == 1) ? C.wid : (2 * (C.wid & 3) + j);
        const bf16_t* ks = Kp + (k0 + lane) * rs + pw * 8;
        const bf16_t* vs = Vp + (k0 + 16 * (pw & 3) + (lane >> 2)) * rs + (pw >> 2) * 32 + (lane & 3) * 8;
        glds16(ks, (unsigned)__builtin_amdgcn_readfirstlane(base + pw * 1024));
        glds16(vs, (unsigned)__builtin_amdgcn_readfirstlane(base + 8192 + pw * 1024));
    }
}
template <int NS> __device__ __forceinline__ void wait_bar_tiles(int allowed) {
    if (allowed <= 0) ATT_WAIT_BAR(0);
    else if (allowed == 1) { if (NS == 1) ATT_WAIT_BAR(2); else ATT_WAIT_BAR(4); }
    else { if (NS == 1) ATT_WAIT_BAR(4); else ATT_WAIT_BAR(8); }
}
template <int NS, class MaskF, class SkipF>
__device__ __forceinline__ void run_pass(const Ctx& C, SM& st, const bf16x8 (&qr)[4], const bf16_t* Kp, const bf16_t* Vp, long rs, int t_lo, int t_hi, int nsteps, MaskF mask, SkipF skip) {
    const int q = (NS == 1) ? 0 : (C.wid >> 2);
    const int nvalid = t_hi - t_lo;
#pragma unroll
    for (int s = 0; s < 2; ++s) if (s < nvalid) dma_tile<NS>(C, Kp, Vp, rs, t_lo + s, s, q);
#pragma unroll 1
    for (int s = 0; s < nsteps; ++s) {
        wait_bar_tiles<NS>((s + 1 < nvalid) ? 1 : 0);
        if (s + 2 < nvalid) dma_tile<NS>(C, Kp, Vp, rs, t_lo + s + 2, (s + 2) % 3, q);
        if (s < nvalid && !skip(t_lo + s)) {
            const int sb = ((s % 3) * NS + q) * 16384;
            f32x16 p0, p1; qkt(p0, p1, C.lds + sb, qr, C.lane);
            mask(p0, p1, t_lo + s);
            u32x4 w0, w1, w2, w3; sm_part1(st, p0, p1, w0, w1, w2, w3, C);
            const int lv = lane_now(); const int vlane = ((lv >> 4) & 1) * 32 + (lv & 3) * 8 + (4 * (lv >> 5) + ((lv & 15) >> 2)) * 64;
            pv(st.o, (int)C.lds0 + sb + 8192 + vlane, __builtin_bit_cast(bf16x8, w0), __builtin_bit_cast(bf16x8, w1), __builtin_bit_cast(bf16x8, w2), __builtin_bit_cast(bf16x8, w3));
        }
    }
    ATT_WAIT_BAR(0);
}
__device__ __forceinline__ void store_o(const f32x16 (&o)[2], bf16_t* Ow, long pitch, const Ctx& C_) {
    Ctx C = C_; { const int l = lane_now(); C.lane = l; C.r32 = l & 31; C.hi = l >> 5; }
    LAS bf16_t* stg = (LAS bf16_t*)(C.lds + A_OST) + C.wid * 2048;
#pragma unroll
    for (int r = 0; r < 16; ++r) { const int orow = crow(r, C.hi);
#pragma unroll
        for (int d0 = 0; d0 < 2; ++d0) stg[orow * 64 + d0 * 32 + C.r32] = (bf16_t)(cvtpk(o[d0][r], 0.f) & 0xffffu); }
    asm volatile("s_waitcnt lgkmcnt(0)" ::: "memory");
#pragma unroll
    for (int i = 0; i < 4; ++i) { const int row = i * 8 + (C.lane >> 3), ch = C.lane & 7; const u32x4 v = *(const LAS u32x4*)(stg + row * 64 + ch * 8); *(u32x4*)(Ow + (long)row * pitch + ch * 8) = v; }
    asm volatile("s_waitcnt lgkmcnt(0)" ::: "memory");
}
__device__ __forceinline__ void load_q(bf16x8 (&qr)[4], const bf16_t* Qrow, int hi) {
#pragma unroll
    for (int d0 = 0; d0 < 4; ++d0) qr[d0] = *(const bf16x8*)(Qrow + d0 * 16 + hi * 8);
}

}
namespace att {
constexpr int F_K = 0, F_V = 24576, F_SLOT = 8192;
typedef LAS const char* lds_cptr;
typedef short v4i16_t __attribute__((ext_vector_type(4)));
__device__ __forceinline__ float fadd_s(float a, float b) { float r; asm("v_add_f32_e32 %0, %1, %2" : "=v"(r) : "v"(a), "v"(b)); return r; }
__device__ __forceinline__ float fsub_s(float a, float b) { float r; asm("v_sub_f32_e32 %0, %1, %2" : "=v"(r) : "v"(a), "v"(b)); return r; }
__device__ __forceinline__ void kload8(bf16x8* kf, lds_cptr kp) {
    kf[0] = *(const LAS bf16x8*)(kp);        kf[1] = *(const LAS bf16x8*)(kp + 512);
    kf[2] = *(const LAS bf16x8*)(kp + 2048); kf[3] = *(const LAS bf16x8*)(kp + 2560);
    kf[4] = *(const LAS bf16x8*)(kp + 4096); kf[5] = *(const LAS bf16x8*)(kp + 4608);
    kf[6] = *(const LAS bf16x8*)(kp + 6144); kf[7] = *(const LAS bf16x8*)(kp + 6656);
}
__device__ __forceinline__ void kload2(bf16x8* kf, lds_cptr kp, int j) { kf[2 * j] = *(const LAS bf16x8*)(kp + j * 2048); kf[2 * j + 1] = *(const LAS bf16x8*)(kp + j * 2048 + 512); }
__device__ __forceinline__ s16x4 vtr(lds_cptr p) { return __builtin_bit_cast(s16x4, __builtin_amdgcn_ds_read_tr16_b64_v4i16((LAS v4i16_t*)p)); }
__device__ __forceinline__ void fast_prefetch(const Ctx& C, const bf16_t* Kp, const bf16_t* Vp, int t_lo, int ntr) {
    const int lane = lane_now(); const int wid = C.wid;
    const bf16_t* ksrc = Kp + ((long)t_lo * 64 + lane) * 64 + wid * 8;
    const bf16_t* vsrc = Vp + ((long)t_lo * 64 + 16 * (wid & 3) + (lane >> 2)) * 64 + (wid >> 2) * 32 + (lane & 3) * 8;
    const unsigned kdst = C.lds0 + F_K + wid * 1024, vdst = C.lds0 + F_V + wid * 1024;
    glds16(ksrc, (unsigned)__builtin_amdgcn_readfirstlane(kdst)); glds16(vsrc, (unsigned)__builtin_amdgcn_readfirstlane(vdst));
    glds16(ksrc + (long)((1 < ntr) ? 1 : (ntr - 1)) * 4096, (unsigned)__builtin_amdgcn_readfirstlane(kdst + F_SLOT));
    glds16(ksrc + (long)((2 < ntr) ? 2 : (ntr - 1)) * 4096, (unsigned)__builtin_amdgcn_readfirstlane(kdst + 2 * F_SLOT));
}
__device__ __forceinline__ void fast_prefetch2(const Ctx& C, const bf16_t* Kp1, const bf16_t* Vp1, int n1, const bf16_t* Kp2, int t_lo2, int n2) {
    const int lane = lane_now(); const int wid = C.wid;
    const int koff = lane * 64 + wid * 8, voff = (16 * (wid & 3) + (lane >> 2)) * 64 + (wid >> 2) * 32 + (lane & 3) * 8;
    const unsigned kdst = C.lds0 + F_K + wid * 1024, vdst = C.lds0 + F_V + wid * 1024;
    const bf16_t* K2b = Kp2 + (long)t_lo2 * 4096;
    glds16(Kp1 + koff, (unsigned)__builtin_amdgcn_readfirstlane(kdst)); glds16(Vp1 + voff, (unsigned)__builtin_amdgcn_readfirstlane(vdst));
#pragma unroll
    for (int t = 1; t < 3; ++t) { const bool s2 = t >= n1; const int idx = s2 ? ((t - n1 < n2) ? (t - n1) : (n2 - 1)) : t;
        glds16((s2 ? K2b : Kp1) + (long)idx * 4096 + koff, (unsigned)__builtin_amdgcn_readfirstlane(kdst + t * F_SLOT)); }
}
template <int THRL, bool PRE, class MaskF>
__device__ __forceinline__ void fast_pass(const Ctx& C, const bf16x8 (&qr)[4], const bf16_t* Kp, const bf16_t* Vp, int t_lo, int ntr, MaskF mask, f32x16 (&o)[2], float& l_out) {
    const int lane = lane_now(), r32 = lane & 31, hi = lane >> 5; const int wid = C.wid;
    const unsigned lds0 = C.lds0;
    LAS float* wsf = (LAS float*)(C.lds + A_WSF) + wid * 64;
    int NT = ntr; if (NT < 4) NT = 4;
    const bf16_t* ksrc = Kp + ((long)t_lo * 64 + lane) * 64 + wid * 8;
    const bf16_t* vsrc = Vp + ((long)t_lo * 64 + 16 * (wid & 3) + (lane >> 2)) * 64 + (wid >> 2) * 32 + (lane & 3) * 8;
    const unsigned kdst = lds0 + F_K + wid * 1024, vdst = lds0 + F_V + wid * 1024;
#define FP_TSRC(t) ((long)(((t) < ntr) ? (t) : (ntr - 1)) * 4096)
#define DMA_K(t, slot) glds16(ksrc + FP_TSRC(t), (unsigned)__builtin_amdgcn_readfirstlane(kdst + (slot)))
#define DMA_V(t, slot) glds16(vsrc + FP_TSRC(t), (unsigned)__builtin_amdgcn_readfirstlane(vdst + (slot)))
    const int vb0 = (int)(lds0 + F_V) + ((lane >> 4) & 1) * 32 + (lane & 3) * 8 + (4 * hi + ((lane & 15) >> 2)) * 64;
    bf16x8 kf[8];
    const lds_cptr shm3 = (lds_cptr)C.lds; const lds_cptr kp0 = shm3 + F_K + hi * 1024 + r32 * 16; const lds_cptr vp0 = shm3 + F_V + ((lane >> 4) & 1) * 32 + (lane & 3) * 8 + (4 * hi + ((lane & 15) >> 2)) * 64;
    if (!PRE) { DMA_K(0, 0); DMA_V(0, 0); DMA_K(1, F_SLOT); }
    float mhat = 0.f, l_reg = 0.f; o[0] = f32x16{}; o[1] = f32x16{}; f32x16 negm; { float z_ = 0.f; asm volatile("" : "+v"(z_));
#pragma unroll
      for (int r = 0; r < 16; ++r) negm[r] = z_; }
#define CMASK(P0, P1, t) mask(P0, P1, (t))
    bool resc = false;
#define START(P0, P1) do { const float rm = rowmax3(P0, P1); resc = false; \
    { const float dl = rm; mhat = fadd_s(mhat, dl); \
      _Pragma("unroll") for (int r = 0; r < 16; ++r) { P0[r] = fsub_s(P0[r], dl); P1[r] = fsub_s(P1[r], dl); } \
      _Pragma("unroll") for (int r = 0; r < 16; ++r) negm[r] = -mhat; asm volatile("" : "+v"(negm)); } \
    _Pragma("unroll") for (int r = 0; r < 16; ++r) P0[r] = __builtin_amdgcn_exp2f(P0[r]); } while (0)
#define RESC() do { if (resc) { asm volatile("s_waitcnt lgkmcnt(0)" ::: "memory"); \
      _Pragma("unroll") for (int d_ = 0; d_ < 2; ++d_) _Pragma("unroll") for (int r = 0; r < 16; ++r) o[d_][r] *= wsf[crow(r, hi)]; } } while (0)
    f32x16 pA0, pA1, pB0, pB1;
    int sl_prev = 0, sl_cur = 0, sl_next = F_SLOT;
#define ROT() do { sl_prev = sl_cur; sl_cur = sl_next; sl_next = (sl_next == 2 * F_SLOT) ? 0 : sl_next + F_SLOT; } while (0)
    if (!PRE) DMA_K(2, 2 * F_SLOT);
    ATT_WAIT_BAR(3);
    { const LAS unsigned char* kb = C.lds + F_K + hi * 1024 + r32 * 16;
#pragma unroll
      for (int d0 = 0; d0 < 4; ++d0) { const bf16x8 b0 = *(const LAS bf16x8*)(kb + d0 * 2048); const bf16x8 b1 = *(const LAS bf16x8*)(kb + d0 * 2048 + 512);
          if (d0 == 0) { pA0 = __builtin_amdgcn_mfma_f32_32x32x16_bf16(b0, qr[0], negm, 0, 0, 0); pA1 = __builtin_amdgcn_mfma_f32_32x32x16_bf16(b1, qr[0], negm, 0, 0, 0); }
          else { pA0 = __builtin_amdgcn_mfma_f32_32x32x16_bf16(b0, qr[d0], pA0, 0, 0, 0); pA1 = __builtin_amdgcn_mfma_f32_32x32x16_bf16(b1, qr[d0], pA1, 0, 0, 0); } } }
    CMASK(pA0, pA1, 0);
    asm volatile("s_nop 15\n\ts_nop 7" : "+v"(pA0), "+v"(pA1));
    START(pA0, pA1);
#pragma unroll
    for (int r = 0; r < 16; ++r) pA1[r] = __builtin_amdgcn_exp2f(pA1[r]);
    ATT_WAIT_BAR(0);
    DMA_K(3, 0); DMA_V(1, F_SLOT);
    ROT();
    kload8(kf, kp0 + sl_cur);
    ATT_WAIT_BAR(2);
    s16x4 vlo[8], vhi[8]; u32x4 pw0, pw1, pw2, pw3;
#define PKW(P, B) cvtpk(P[B], P[B + 1])
#define PAF(k) __builtin_bit_cast(bf16x8, pw##k)
#define VFR(i) (bf16x8){vlo[i][0], vlo[i][1], vlo[i][2], vlo[i][3], vhi[i][0], vhi[i][1], vhi[i][2], vhi[i][3]}
#define PIN(x) asm volatile("" : "+v"(x))
#define MX3(a, b, c) __builtin_fmaxf(__builtin_fmaxf((a), (b)), (c))
#define GAPA(MF, A0, A1, A2, A3, W0, W1, PW) do { MF; sacc += A0; sacc += A1; sacc += A2; sacc += A3; PIN(sacc); W0; W1; PIN(PW); ATT_SBAR(); } while (0)
#define EX(v) __builtin_amdgcn_exp2f(v)
#define GAPB(MF, X, B) do { MF; X[B] = EX(X[B]); X[B + 1] = EX(X[B + 1]); X[B + 2] = EX(X[B + 2]); X[B + 3] = EX(X[B + 3]); PIN(X); ATT_SBAR(); } while (0)
#define VRD(i) do { vlo[i] = vtr(vp_ + (((i) >> 2) * 4096 + ((i) & 3) * 1024)); vhi[i] = vtr(vp_ + (((i) >> 2) * 4096 + ((i) & 3) * 1024 + 512)); } while (0)
#define KRD(G, j) do { if (G) { kload2(kf, kp0 + sl_next, j); ATT_SBAR(); } } while (0)
#define STEP(C0, C1, P0, P1, t, GK, GV, GL) do { ATT_SBAR(); \
    const lds_cptr vp_ = vp0 + sl_prev; \
    VRD(0); ATT_SBAR(); float sacc = (P0[0] + P0[1]); \
    GAPA(C0 = __builtin_amdgcn_mfma_f32_32x32x16_bf16(kf[0], qr[0], negm, 0, 0, 0), P0[2], P0[3], P0[4], P0[5],     pw0[0] = PKW(P0, 0), pw0[1] = PKW(P0, 2), pw0); \
    VRD(4); ATT_SBAR(); GAPA(C1 = __builtin_amdgcn_mfma_f32_32x32x16_bf16(kf[1], qr[0], negm, 0, 0, 0), P0[6], P0[7], P0[8], P0[9],     pw0[2] = PKW(P0, 4), pw0[3] = PKW(P0, 6), pw0); \
    VRD(1); ATT_SBAR(); GAPA(C0 = __builtin_amdgcn_mfma_f32_32x32x16_bf16(kf[2], qr[1], C0, 0, 0, 0),   P0[10], P0[11], P0[12], P0[13], pw1[0] = PKW(P0, 8), pw1[1] = PKW(P0, 10), pw1); \
    VRD(5); ATT_SBAR(); GAPA(C1 = __builtin_amdgcn_mfma_f32_32x32x16_bf16(kf[3], qr[1], C1, 0, 0, 0),   P0[14], P0[15], P1[0], P1[1],   pw1[2] = PKW(P0, 12), pw1[3] = PKW(P0, 14), pw1); \
    VRD(2); ATT_SBAR(); GAPA(C0 = __builtin_amdgcn_mfma_f32_32x32x16_bf16(kf[4], qr[2], C0, 0, 0, 0),   P1[2], P1[3], P1[4], P1[5],     pw2[0] = PKW(P1, 0), pw2[1] = PKW(P1, 2), pw2); \
    VRD(6); ATT_SBAR(); GAPA(C1 = __builtin_amdgcn_mfma_f32_32x32x16_bf16(kf[5], qr[2], C1, 0, 0, 0),   P1[6], P1[7], P1[8], P1[9],     pw2[2] = PKW(P1, 4), pw2[3] = PKW(P1, 6), pw2); \
    VRD(3); ATT_SBAR(); GAPA(C0 = __builtin_amdgcn_mfma_f32_32x32x16_bf16(kf[6], qr[3], C0, 0, 0, 0),   P1[10], P1[11], P1[12], P1[13], pw3[0] = PKW(P1, 8), pw3[1] = PKW(P1, 10), pw3); \
    VRD(7); ATT_SBAR(); GAPA(C1 = __builtin_amdgcn_mfma_f32_32x32x16_bf16(kf[7], qr[3], C1, 0, 0, 0),   P1[14], P1[15], 0.f, 0.f,       pw3[2] = PKW(P1, 12), pw3[3] = PKW(P1, 14), pw3); \
    l_reg += sacc; \
    if (GK) { DMA_K((t) + 3, sl_cur); } if (GV) { DMA_V((t) + 1, sl_next); } \
    CMASK(C0, C1, t); \
    { float a = MX3(C0[0], C0[1], C1[0]), b = MX3(C0[2], C0[3], C1[1]); a = MX3(a, C1[2], C1[3]); \
      _Pragma("unroll") for (int r = 4; r < 16; r += 4) { a = MX3(a, C0[r], C0[r + 1]); b = MX3(b, C0[r + 2], C0[r + 3]); a = MX3(a, C1[r], C1[r + 1]); b = MX3(b, C1[r + 2], C1[r + 3]); } \
      float rm = __builtin_fmaxf(a, b); { auto rr = __builtin_amdgcn_permlane32_swap(__float_as_uint(rm), __float_as_uint(rm), false, false); rm = __builtin_fmaxf(__uint_as_float(rr[0]), __uint_as_float(rr[1])); } \
      resc = false; \
      if (__builtin_expect(__any(rm > (float)THRL), 0)) { const float dl = __builtin_fmaxf(rm, 0.f); mhat += dl; \
        _Pragma("unroll") for (int r = 0; r < 16; ++r) { C0[r] -= dl; C1[r] -= dl; } \
        _Pragma("unroll") for (int r = 0; r < 16; ++r) negm[r] = -mhat; asm volatile("" : "+v"(negm)); \
        const float f = __builtin_amdgcn_exp2f(-dl); l_reg *= f; if (hi == 0) wsf[r32] = f; resc = true; } } \
    ATT_SBAR(); \
    GAPB(o[0] = __builtin_amdgcn_mfma_f32_32x32x16_bf16(PAF(0), VFR(0), o[0], 0, 0, 0), C0, 0); \
    GAPB(o[1] = __builtin_amdgcn_mfma_f32_32x32x16_bf16(PAF(0), VFR(4), o[1], 0, 0, 0), C0, 4); \
    KRD(GL, 0); GAPB(o[0] = __builtin_amdgcn_mfma_f32_32x32x16_bf16(PAF(1), VFR(1), o[0], 0, 0, 0), C0, 8); \
    KRD(GL, 1); GAPB(o[1] = __builtin_amdgcn_mfma_f32_32x32x16_bf16(PAF(1), VFR(5), o[1], 0, 0, 0), C0, 12); \
    KRD(GL, 2); GAPB(o[0] = __builtin_amdgcn_mfma_f32_32x32x16_bf16(PAF(2), VFR(2), o[0], 0, 0, 0), C1, 0); \
    KRD(GL, 3); GAPB(o[1] = __builtin_amdgcn_mfma_f32_32x32x16_bf16(PAF(2), VFR(6), o[1], 0, 0, 0), C1, 4); \
    GAPB(o[0] = __builtin_amdgcn_mfma_f32_32x32x16_bf16(PAF(3), VFR(3), o[0], 0, 0, 0), C1, 8); \
    GAPB(o[1] = __builtin_amdgcn_mfma_f32_32x32x16_bf16(PAF(3), VFR(7), o[1], 0, 0, 0), C1, 12); \
    } while (0)
    int t = 1;
    for (; t + 5 < NT; t += 2) {
        STEP(pB0, pB1, pA0, pA1, t, true, true, true);     ATT_WAIT_BAR(2); RESC(); ROT();
        STEP(pA0, pA1, pB0, pB1, t + 1, true, true, true); ATT_WAIT_BAR(2); RESC(); ROT();
    }
#define ENDW(tt) do { if ((tt) + 3 < NT) { ATT_WAIT_BAR(2); } else if ((tt) + 2 < NT) { ATT_WAIT_BAR(1); } else { ATT_WAIT_BAR(0); } } while (0)
    for (; t + 1 < NT; t += 2) {
        STEP(pB0, pB1, pA0, pA1, t, (t + 3 < NT), (t + 1 < NT), (t + 1 < NT));         ENDW(t);     RESC(); ROT();
        STEP(pA0, pA1, pB0, pB1, t + 1, (t + 4 < NT), (t + 2 < NT), (t + 2 < NT));     ENDW(t + 1); RESC(); ROT();
    }
#define DRAIN(X0, X1, SL) do { float sacc = X0[0] + X0[1]; \
      _Pragma("unroll") for (int r = 2; r < 16; ++r) sacc += X0[r]; \
      _Pragma("unroll") for (int r = 0; r < 16; ++r) sacc += X1[r]; \
      l_reg += sacc; \
      pw0 = (u32x4){PKW(X0, 0), PKW(X0, 2), PKW(X0, 4), PKW(X0, 6)}; pw1 = (u32x4){PKW(X0, 8), PKW(X0, 10), PKW(X0, 12), PKW(X0, 14)}; \
      pw2 = (u32x4){PKW(X1, 0), PKW(X1, 2), PKW(X1, 4), PKW(X1, 6)}; pw3 = (u32x4){PKW(X1, 8), PKW(X1, 10), PKW(X1, 12), PKW(X1, 14)}; \
      ATT_SBAR(); pv(o, vb0 + (SL), PAF(0), PAF(1), PAF(2), PAF(3)); } while (0)
    if (NT & 1) { DRAIN(pA0, pA1, sl_prev); }
    else { STEP(pB0, pB1, pA0, pA1, NT - 1, false, false, false); RESC(); DRAIN(pB0, pB1, sl_cur); }
#undef DRAIN
    l_out = l_reg;
    ATT_WAIT_BAR(0);
#undef FP_TSRC
#undef DMA_K
#undef DMA_V
#undef CMASK
#undef START
#undef RESC
#undef ROT
#undef PKW
#undef PAF
#undef VFR
#undef PIN
#undef MX3
#undef GAPA
#undef GAPB
#undef EX
#undef VRD
#undef KRD
#undef STEP
#undef ENDW
}

template <bool ADD> __device__ __forceinline__ void acc_rows(const f32x16 (&o)[2], float f, const Ctx& C_) {
    const int l = lane_now(), r32 = l & 31, hi = l >> 5;
    LAS float* wsf = (LAS float*)(C_.lds + A_WSF) + C_.wid * 64;
    if (hi == 0) wsf[r32] = f;
    asm volatile("s_waitcnt lgkmcnt(0)" ::: "memory");
    LAS float* lo = (LAS float*)(C_.lds + A_IMP + C_.wid * 4096) + 4 * hi * 64 + r32;
    LAS float* hp = (LAS float*)(C_.lds + A_OST + C_.wid * 4096) + 4 * hi * 64 + r32;
#pragma unroll
    for (int g = 0; g < 4; ++g) { const f32x4 fv = *(const LAS f32x4*)(wsf + 8 * g + 4 * hi);
#pragma unroll
        for (int i = 0; i < 4; ++i)
#pragma unroll
            for (int d0 = 0; d0 < 2; ++d0) { LAS float* p = ((g < 2) ? lo : hp) + ((i + 8 * (g & 1)) * 64 + 32 * d0);
                const float v = o[d0][4 * g + i] * fv[i]; if (ADD) *p += v; else *p = v; } }
    asm volatile("s_waitcnt lgkmcnt(0)" ::: "memory");
}
__device__ __forceinline__ void acc_flush(unsigned char* Ow, long pitch, const Ctx& C_) {
    const int l = lane_now();
#pragma unroll
    for (int i = 0; i < 4; ++i) { const int row = i * 8 + (l >> 3), ch = l & 7;
        const LAS float* p = (const LAS float*)(C_.lds + (row < 16 ? A_IMP : A_OST) + C_.wid * 4096) + (row & 15) * 64 + ch * 8;
        const f32x4 a = *(const LAS f32x4*)p * 16.f, b = *(const LAS f32x4*)(p + 4) * 16.f;
        u32x2 w; w.x = pk4_fp8(a[0], a[1], a[2], a[3]); w.y = pk4_fp8(b[0], b[1], b[2], b[3]);
        *(u32x2*)(Ow + (long)row * pitch + ch * 8) = w; }
    asm volatile("s_waitcnt lgkmcnt(0)" ::: "memory");
}
template <int THRL, bool PRE, class MaskF1, class MaskF2>
__device__ __forceinline__ void fast_pass2(const Ctx& C, const bf16x8 (&qr)[4], const bf16_t* Kp1, const bf16_t* Vp1, int n1, MaskF1 mask1, float g1,
                                           const bf16_t* Kp2, const bf16_t* Vp2, int t_lo2, int n2, MaskF2 mask2, float g2) {
    f32x16 o[2];
    const int lane = lane_now(), r32 = lane & 31, hi = lane >> 5; const int wid = C.wid;
    const unsigned lds0 = C.lds0;
    LAS float* wsf = (LAS float*)(C.lds + A_WSF) + wid * 64;
    int NT = (n1 + n2 + 1) & ~1; if (NT < 4) NT = 4;
    const int koff = lane * 64 + wid * 8, voff = (16 * (wid & 3) + (lane >> 2)) * 64 + (wid >> 2) * 32 + (lane & 3) * 8;
    const bf16_t* K2b = Kp2 + (long)t_lo2 * 4096; const bf16_t* V2b = Vp2 + (long)t_lo2 * 4096;
    const unsigned kdst = lds0 + F_K + wid * 1024, vdst = lds0 + F_V + wid * 1024;
#define FP_SEG2(t) ((t) >= n1)
#define FP_TIDX(t) (FP_SEG2(t) ? ((((t) - n1) < n2) ? ((t) - n1) : (n2 - 1)) : (t))
#define DMA_K(t, slot) glds16((FP_SEG2(t) ? K2b : Kp1) + (long)FP_TIDX(t) * 4096 + koff, (unsigned)__builtin_amdgcn_readfirstlane(kdst + (slot)))
#define DMA_V(t, slot) glds16((FP_SEG2(t) ? V2b : Vp1) + (long)FP_TIDX(t) * 4096 + voff, (unsigned)__builtin_amdgcn_readfirstlane(vdst + (slot)))
    const int vb0 = (int)(lds0 + F_V) + ((lane >> 4) & 1) * 32 + (lane & 3) * 8 + (4 * hi + ((lane & 15) >> 2)) * 64;
    bf16x8 kf[8];
    const lds_cptr shm3 = (lds_cptr)C.lds; const lds_cptr kp0 = shm3 + F_K + hi * 1024 + r32 * 16; const lds_cptr vp0 = shm3 + F_V + ((lane >> 4) & 1) * 32 + (lane & 3) * 8 + (4 * hi + ((lane & 15) >> 2)) * 64;
    if (!PRE) { DMA_K(0, 0); DMA_V(0, 0); DMA_K(1, F_SLOT); }
    float mhat = 0.f, l_reg = 0.f; o[0] = f32x16{}; o[1] = f32x16{}; const f32x16 zc = {};
#define CMASK(P0, P1, t) do { if ((t) < n1) mask1(P0, P1, (t)); else mask2(P0, P1, (t) - n1); } while (0)
    bool resc = false;
#define START(P0, P1) do { const float rm = rowmax3(P0, P1); resc = false; \
    { const float dl = rm; mhat = fadd_s(mhat, dl); \
      _Pragma("unroll") for (int r = 0; r < 16; ++r) { P0[r] = fsub_s(P0[r], dl); P1[r] = fsub_s(P1[r], dl); } \
      } \
    _Pragma("unroll") for (int r = 0; r < 16; ++r) P0[r] = __builtin_amdgcn_exp2f(P0[r]); } while (0)
#define RESC() do { if (resc) { asm volatile("s_waitcnt lgkmcnt(0)" ::: "memory"); \
      _Pragma("unroll") for (int d_ = 0; d_ < 2; ++d_) _Pragma("unroll") for (int r = 0; r < 16; ++r) o[d_][r] *= wsf[crow(r, hi)]; } } while (0)
    f32x16 pA0, pA1, pB0, pB1;
    int sl_prev = 0, sl_cur = 0, sl_next = F_SLOT;
#define SEAM_FIN(t) do { if ((t) == n1) { acc_rows<true>(o, g1 / halfsum(l_reg), C); o[0] = f32x16{}; o[1] = f32x16{}; l_reg = 0.f; } } while (0)
#define ROT() do { sl_prev = sl_cur; sl_cur = sl_next; sl_next = (sl_next == 2 * F_SLOT) ? 0 : sl_next + F_SLOT; } while (0)
    if (!PRE) DMA_K(2, 2 * F_SLOT);
    ATT_WAIT_BAR(3);
    { const LAS unsigned char* kb = C.lds + F_K + hi * 1024 + r32 * 16;
#pragma unroll
      for (int d0 = 0; d0 < 4; ++d0) { const bf16x8 b0 = *(const LAS bf16x8*)(kb + d0 * 2048); const bf16x8 b1 = *(const LAS bf16x8*)(kb + d0 * 2048 + 512);
          if (d0 == 0) { pA0 = __builtin_amdgcn_mfma_f32_32x32x16_bf16(b0, qr[0], zc, 0, 0, 0); pA1 = __builtin_amdgcn_mfma_f32_32x32x16_bf16(b1, qr[0], zc, 0, 0, 0); }
          else { pA0 = __builtin_amdgcn_mfma_f32_32x32x16_bf16(b0, qr[d0], pA0, 0, 0, 0); pA1 = __builtin_amdgcn_mfma_f32_32x32x16_bf16(b1, qr[d0], pA1, 0, 0, 0); } } }
    CMASK(pA0, pA1, 0);
    asm volatile("s_nop 15\n\ts_nop 7" : "+v"(pA0), "+v"(pA1));
    START(pA0, pA1);
#pragma unroll
    for (int r = 0; r < 16; ++r) pA1[r] = __builtin_amdgcn_exp2f(pA1[r]);
    ATT_WAIT_BAR(0);
    DMA_K(3, 0); DMA_V(1, F_SLOT);
    ROT();
    kload8(kf, kp0 + sl_cur);
    ATT_WAIT_BAR(2);
    s16x4 vlo[8], vhi[8]; u32x4 pw0, pw1, pw2, pw3;
#define PKW(P, B) cvtpk(P[B], P[B + 1])
#define PAF(k) __builtin_bit_cast(bf16x8, pw##k)
#define VFR(i) (bf16x8){vlo[i][0], vlo[i][1], vlo[i][2], vlo[i][3], vhi[i][0], vhi[i][1], vhi[i][2], vhi[i][3]}
#define PIN(x) asm volatile("" : "+v"(x))
#define MX3(a, b, c) __builtin_fmaxf(__builtin_fmaxf((a), (b)), (c))
#define GAPA(MF, A0, A1, A2, A3, W0, W1, PW) do { MF; sacc += A0; sacc += A1; sacc += A2; sacc += A3; PIN(sacc); W0; W1; PIN(PW); ATT_SBAR(); } while (0)
#define EX(v) __builtin_amdgcn_exp2f(v)
#define GAPB(MF, X, B) do { MF; X[B] = EX(X[B]); X[B + 1] = EX(X[B + 1]); X[B + 2] = EX(X[B + 2]); X[B + 3] = EX(X[B + 3]); PIN(X); ATT_SBAR(); } while (0)
#define VRD(i) do { vlo[i] = vtr(vp_ + (((i) >> 2) * 4096 + ((i) & 3) * 1024)); vhi[i] = vtr(vp_ + (((i) >> 2) * 4096 + ((i) & 3) * 1024 + 512)); } while (0)
#define KRD(G, j) do { if (G) { kload2(kf, kp0 + sl_next, j); ATT_SBAR(); } } while (0)
#define STEP(C0, C1, P0, P1, t, GK, GV, GL) do { ATT_SBAR(); \
    const lds_cptr vp_ = vp0 + sl_prev; \
    VRD(0); ATT_SBAR(); float sacc = (P0[0] + P0[1]); \
    GAPA(C0 = __builtin_amdgcn_mfma_f32_32x32x16_bf16(kf[0], qr[0], zc, 0, 0, 0), P0[2], P0[3], P0[4], P0[5],     pw0[0] = PKW(P0, 0), pw0[1] = PKW(P0, 2), pw0); \
    VRD(4); ATT_SBAR(); GAPA(C1 = __builtin_amdgcn_mfma_f32_32x32x16_bf16(kf[1], qr[0], zc, 0, 0, 0), P0[6], P0[7], P0[8], P0[9],     pw0[2] = PKW(P0, 4), pw0[3] = PKW(P0, 6), pw0); \
    VRD(1); ATT_SBAR(); GAPA(C0 = __builtin_amdgcn_mfma_f32_32x32x16_bf16(kf[2], qr[1], C0, 0, 0, 0),   P0[10], P0[11], P0[12], P0[13], pw1[0] = PKW(P0, 8), pw1[1] = PKW(P0, 10), pw1); \
    VRD(5); ATT_SBAR(); GAPA(C1 = __builtin_amdgcn_mfma_f32_32x32x16_bf16(kf[3], qr[1], C1, 0, 0, 0),   P0[14], P0[15], P1[0], P1[1],   pw1[2] = PKW(P0, 12), pw1[3] = PKW(P0, 14), pw1); \
    VRD(2); ATT_SBAR(); GAPA(C0 = __builtin_amdgcn_mfma_f32_32x32x16_bf16(kf[4], qr[2], C0, 0, 0, 0),   P1[2], P1[3], P1[4], P1[5],     pw2[0] = PKW(P1, 0), pw2[1] = PKW(P1, 2), pw2); \
    VRD(6); ATT_SBAR(); GAPA(C1 = __builtin_amdgcn_mfma_f32_32x32x16_bf16(kf[5], qr[2], C1, 0, 0, 0),   P1[6], P1[7], P1[8], P1[9],     pw2[2] = PKW(P1, 4), pw2[3] = PKW(P1, 6), pw2); \
    VRD(3); ATT_SBAR(); GAPA(C0 = __builtin_amdgcn_mfma_f32_32x32x16_bf16(kf[6], qr[3], C0, 0, 0, 0),   P1[10], P1[11], P1[12], P1[13], pw3[0] = PKW(P1, 8), pw3[1] = PKW(P1, 10), pw3); \
    VRD(7); ATT_SBAR(); GAPA(C1 = __builtin_amdgcn_mfma_f32_32x32x16_bf16(kf[7], qr[3], C1, 0, 0, 0),   P1[14], P1[15], 0.f, 0.f,       pw3[2] = PKW(P1, 12), pw3[3] = PKW(P1, 14), pw3); \
    l_reg += sacc; \
    if (GK) { DMA_K((t) + 3, sl_cur); } if (GV) { DMA_V((t) + 1, sl_next); } \
    _Pragma("unroll") for (int r = 0; r < 16; ++r) { C0[r] -= mhat; C1[r] -= mhat; } \
    CMASK(C0, C1, t); \
    { float a = MX3(C0[0], C0[1], C1[0]), b = MX3(C0[2], C0[3], C1[1]); a = MX3(a, C1[2], C1[3]); \
      _Pragma("unroll") for (int r = 4; r < 16; r += 4) { a = MX3(a, C0[r], C0[r + 1]); b = MX3(b, C0[r + 2], C0[r + 3]); a = MX3(a, C1[r], C1[r + 1]); b = MX3(b, C1[r + 2], C1[r + 3]); } \
      float rm = __builtin_fmaxf(a, b); { auto rr = __builtin_amdgcn_permlane32_swap(__float_as_uint(rm), __float_as_uint(rm), false, false); rm = __builtin_fmaxf(__uint_as_float(rr[0]), __uint_as_float(rr[1])); } \
      resc = false; \
      if ((t) == n1) { const float dl = rm; mhat += dl;                        \
        _Pragma("unroll") for (int r = 0; r < 16; ++r) { C0[r] -= dl; C1[r] -= dl; } \
        } \
      else if (__builtin_expect(__any(rm > (float)THRL), 0)) { const float dl = __builtin_fmaxf(rm, 0.f); mhat += dl; \
        _Pragma("unroll") for (int r = 0; r < 16; ++r) { C0[r] -= dl; C1[r] -= dl; } \
        const float f = __builtin_amdgcn_exp2f(-dl); l_reg *= f; if (hi == 0) wsf[r32] = f; resc = true; } } \
    ATT_SBAR(); \
    GAPB(o[0] = __builtin_amdgcn_mfma_f32_32x32x16_bf16(PAF(0), VFR(0), o[0], 0, 0, 0), C0, 0); \
    GAPB(o[1] = __builtin_amdgcn_mfma_f32_32x32x16_bf16(PAF(0), VFR(4), o[1], 0, 0, 0), C0, 4); \
    KRD(GL, 0); GAPB(o[0] = __builtin_amdgcn_mfma_f32_32x32x16_bf16(PAF(1), VFR(1), o[0], 0, 0, 0), C0, 8); \
    KRD(GL, 1); GAPB(o[1] = __builtin_amdgcn_mfma_f32_32x32x16_bf16(PAF(1), VFR(5), o[1], 0, 0, 0), C0, 12); \
    KRD(GL, 2); GAPB(o[0] = __builtin_amdgcn_mfma_f32_32x32x16_bf16(PAF(2), VFR(2), o[0], 0, 0, 0), C1, 0); \
    KRD(GL, 3); GAPB(o[1] = __builtin_amdgcn_mfma_f32_32x32x16_bf16(PAF(2), VFR(6), o[1], 0, 0, 0), C1, 4); \
    GAPB(o[0] = __builtin_amdgcn_mfma_f32_32x32x16_bf16(PAF(3), VFR(3), o[0], 0, 0, 0), C1, 8); \
    GAPB(o[1] = __builtin_amdgcn_mfma_f32_32x32x16_bf16(PAF(3), VFR(7), o[1], 0, 0, 0), C1, 12); \
    } while (0)
    int t = 1;
    for (; t + 5 < NT; t += 2) {
        STEP(pB0, pB1, pA0, pA1, t, true, true, true);     ATT_WAIT_BAR(2); RESC(); SEAM_FIN(t); ROT();
        STEP(pA0, pA1, pB0, pB1, t + 1, true, true, true); ATT_WAIT_BAR(2); RESC(); SEAM_FIN(t + 1); ROT();
    }
#define ENDW(tt) do { if ((tt) + 3 < NT) { ATT_WAIT_BAR(2); } else if ((tt) + 2 < NT) { ATT_WAIT_BAR(1); } else { ATT_WAIT_BAR(0); } } while (0)
    for (; t + 1 < NT; t += 2) {
        STEP(pB0, pB1, pA0, pA1, t, (t + 3 < NT), (t + 1 < NT), (t + 1 < NT));         ENDW(t);     RESC(); SEAM_FIN(t); ROT();
        STEP(pA0, pA1, pB0, pB1, t + 1, (t + 4 < NT), (t + 2 < NT), (t + 2 < NT));     ENDW(t + 1); RESC(); SEAM_FIN(t + 1); ROT();
    }
    STEP(pB0, pB1, pA0, pA1, NT - 1, false, false, false); RESC(); SEAM_FIN(NT - 1);
    { float sacc = pB0[0] + pB0[1];
#pragma unroll
      for (int r = 2; r < 16; ++r) sacc += pB0[r];
#pragma unroll
      for (int r = 0; r < 16; ++r) sacc += pB1[r];
      l_reg += sacc;
      pw0 = (u32x4){PKW(pB0, 0), PKW(pB0, 2), PKW(pB0, 4), PKW(pB0, 6)}; pw1 = (u32x4){PKW(pB0, 8), PKW(pB0, 10), PKW(pB0, 12), PKW(pB0, 14)};
      pw2 = (u32x4){PKW(pB1, 0), PKW(pB1, 2), PKW(pB1, 4), PKW(pB1, 6)}; pw3 = (u32x4){PKW(pB1, 8), PKW(pB1, 10), PKW(pB1, 12), PKW(pB1, 14)};
      ATT_SBAR(); pv(o, vb0 + sl_cur, PAF(0), PAF(1), PAF(2), PAF(3)); }
    acc_rows<true>(o, g2 / halfsum(l_reg), C);
    ATT_WAIT_BAR(0);
#undef FP_SEG2
#undef FP_TIDX
#undef SEAM_FIN
#undef DMA_K
#undef DMA_V
#undef CMASK
#undef START
#undef RESC
#undef ROT
#undef PKW
#undef PAF
#undef VFR
#undef PIN
#undef MX3
#undef GAPA
#undef GAPB
#undef EX
#undef VRD
#undef KRD
#undef STEP
#undef ENDW
}

}
namespace att {
template <int CTRL> __device__ __forceinline__ float dppf(float v) { return __uint_as_float(__builtin_amdgcn_update_dpp(0u, __float_as_uint(v), CTRL, 0xf, 0xf, true)); }
template <class T> __device__ __forceinline__ T* fresh_ptr(T* p) { asm volatile("" : "+v"(p)); return p; }
__device__ __forceinline__ void dil_unit(const Ctx& C, unsigned char* ws, int u, bf16_t* obraw, float* lse) {
    const int gi = u >> 9, v = u & 511, hw = C.wid >> 2, w4 = C.wid & 3;
    const int b = v >> 4, j = (v >> 3) & 1;
    int ds, res, blk, L;
    if (gi == 0) { ds = 1; res = 0; blk = 2 * (v & 7) + hw; L = 2048; }
    else if (gi == 1) { ds = 4; res = (v >> 1) & 3; blk = 2 * (v & 1) + hw; L = 512; }
    else { ds = 16; res = 2 * (v & 7) + hw; blk = 0; L = 128; }
    const int h6 = gi * 2 + j;
    const size_t tokbase = (size_t)b * SEQ + res;
    const bf16_t* Qp = (const bf16_t*)(ws + slot_off(SL_QB + h6)) + tokbase * 64;
    const bf16_t* Kp = (const bf16_t*)(ws + slot_off(SL_KB + h6)) + tokbase * 64;
    const bf16_t* Vp = (const bf16_t*)(ws + slot_off(SL_VB + h6)) + tokbase * 64;
    const long rs = (long)ds * 64;
    int t_lo = 2 * blk - 2; if (t_lo < 0) t_lo = 0; int t_hi = 2 * blk + 2; if (t_hi > L / 64) t_hi = L / 64;
    const int nsteps = (gi == 2) ? 2 : 4;
    const int l0_ = lane_now(); const int hi = l0_ >> 5;
    const int i0 = 128 * blk + 32 * w4, iq = i0 + (l0_ & 31);
    bf16x8 qr[4]; load_q(qr, Qp + (long)iq * rs, hi);
    SM st; sm_init(st);
    auto mask = [&](f32x16& p0, f32x16& p1, int tile) {
        const int lim = fresh(iq - 64 * tile - 4 * hi), lim2 = lim - 128;
#pragma unroll
        for (int r = 0; r < 16; ++r) { const int c = (r & 3) + 8 * (r >> 2);
            if (c > lim || c < lim2) p0[r] = NEG_INF;
            if (c + 32 > lim || c + 32 < lim2) p1[r] = NEG_INF; }
    };
    auto skip = [&](int tile) { return (64 * tile > i0 + 31) || (64 * tile + 63 < i0 - 128); };
    run_pass<2>(C, st, qr, Kp, Vp, rs, t_lo, t_hi, nsteps, mask, skip);
    const float lt = halfsum(st.l);
    const float inv = 1.0f / lt;
    scale_rows(st.o, inv, C);
    store_o(st.o, obraw + (tokbase + (size_t)i0 * ds) * 384 + h6 * 64, (long)ds * 384, C);
    if ((lane_now() >> 5) == 0) lse[(tokbase + (size_t)iq * ds) * 8 + h6] = (st.m + __builtin_amdgcn_logf(lt)) * 0.6931471805599453f;
    ATT_WAIT_BAR(0);
}

__device__ __forceinline__ void nsa_unit(const Ctx& C, unsigned char* ws, int b, int hk, int blk, unsigned char* oa) {
    const int g = C.wid >> 1, head = hk * 4 + g;
    const size_t tokbase = (size_t)b * SEQ;
    const bf16_t* qbase = (const bf16_t*)(ws + slot_off(SL_QA + head)) + (tokbase + 64 * blk + 32 * (C.wid & 1)) * 64;
    const bf16_t* gabase = (const bf16_t*)(ws + slot_off(SL_GA)) + (tokbase + 64 * blk + 32 * (C.wid & 1)) * 64;
#define NSA_LANE_STATE() const int l_ = lane_now(); const int r32_ = l_ & 31, hi = l_ >> 5; const int tq = 64 * blk + 32 * (C.wid & 1) + r32_; \
    const bf16_t* qrow = qbase + r32_ * 64; const bf16_t* ga = gabase + r32_ * 64
#ifndef PROBE_ZERO
#define PROBE_ZERO 0
#endif
    f32x16 ot[2]; ot[0] = f32x16{}; ot[1] = f32x16{};
    LAS float* imp = (LAS float*)(C.lds + A_IMP);
    LAS unsigned* sel = (LAS unsigned*)(C.lds + A_SEL);
#if defined(PROBE_DUP) && PROBE_DUP == 1
    for (int rep_ = 0; rep_ < 2; ++rep_)
#endif
    {
        ot[0] = f32x16{}; ot[1] = f32x16{};
        NSA_LANE_STATE();
        bf16x8 qr[4]; load_q(qr, qrow, hi);
        const float g_cmp = (PROBE_ZERO & 1) ? 0.f : bf2f(ga[head]);
        const int pair = hk * 32 + b;
        const bf16_t* Kc = (const bf16_t*)(ws + WS_KC) + (size_t)pair * 128 * 64;
        const bf16_t* Vc = (const bf16_t*)(ws + WS_KC + MiB) + (size_t)pair * 128 * 64;
        const bool two = blk >= 16;
#ifndef NSA_SPLIT_PASSES
        fast_prefetch2(C, (const bf16_t*)(ws + slot_off(SL_KSLC + hk)) + tokbase * 64, (const bf16_t*)(ws + slot_off(SL_VSLC + hk)) + tokbase * 64, blk + 1,
                       (const bf16_t*)(ws + slot_off(SL_KWIN + hk)) + tokbase * 64, blk >= 8 ? blk - 8 : 0, blk >= 8 ? 9 : blk + 1);
#else
        fast_prefetch(C, (const bf16_t*)(ws + slot_off(SL_KSLC + hk)) + tokbase * 64, (const bf16_t*)(ws + slot_off(SL_VSLC + hk)) + tokbase * 64, 0, blk + 1);
#endif
        dma_tile<1>(C, Kc, Vc, 64, 0, 0, 0, A_OST);
        if (two) dma_tile<1>(C, Kc, Vc, 64, 1, 1, 0, A_OST);
        ATT_WAIT_BAR(0);
        const int nlim = (tq - 31) >> 4;
        auto cmask = [&](f32x16& p0, f32x16& p1, int tile) {
            { const int lim = fresh(nlim - 64 * tile - 4 * hi);
#pragma unroll
              for (int r = 0; r < 16; ++r) { const int c = (r & 3) + 8 * (r >> 2); if (c > lim) p0[r] = NEG_INF; if (c + 32 > lim) p1[r] = NEG_INF; } } };
        float rm;
        { f32x16 s0, s1; qkt(s0, s1, C.lds + A_OST, qr, C.lane); cmask(s0, s1, 0); rm = rowmax(s0, s1);
          if (two) { qkt(s0, s1, C.lds + A_OST + 16384, qr, C.lane); cmask(s0, s1, 1); rm = fmaxf(rm, rowmax(s0, s1)); } }
        const bool has = rm > -1e29f; if (!has) rm = 0.f;
        LAS float* irh; { unsigned a_ = (unsigned)(size_t)(imp + (g * 64 + 32 * (C.wid & 1) + r32_) * 33 + hi); asm volatile("" : "+v"(a_)); irh = (LAS float*)(size_t)a_; }
        float sum = 0.f;
#pragma unroll
        for (int gq = 0; gq < 8; ++gq) irh[16 + 2 * gq] = 0.f;
        asm volatile("s_waitcnt lgkmcnt(0)" ::: "memory");
#pragma unroll
        for (int tile = 0; tile < 2; ++tile) {
            if (tile == 0 || two) {
                f32x16 s0, s1; qkt(s0, s1, C.lds + A_OST + tile * 16384, qr, C.lane); cmask(s0, s1, tile);
#pragma unroll
                for (int r = 0; r < 16; ++r) { s0[r] = __builtin_amdgcn_exp2f(s0[r] - rm); s1[r] = __builtin_amdgcn_exp2f(s1[r] - rm); sum += s0[r] + s1[r]; }
#pragma unroll
                for (int gq = 0; gq < 4; ++gq) { const float A0 = (s0[4 * gq] + s0[4 * gq + 1]) + (s0[4 * gq + 2] + 0.5f * s0[4 * gq + 3]), A1 = (s1[4 * gq] + s1[4 * gq + 1]) + (s1[4 * gq + 2] + 0.5f * s1[4 * gq + 3]);
                    if (tile == 0) { irh[2 * gq] = A0; irh[8 + 2 * gq] = A1; } else { irh[16 + 2 * gq] += A0; irh[24 + 2 * gq] += A1; } }
                asm volatile("s_waitcnt lgkmcnt(0)" ::: "memory");
#pragma unroll
                for (int gq = 0; gq < 4; ++gq) { const int j0 = 16 * tile + 2 * gq + 1, j1 = j0 + 8;
                    irh[j0] += 0.5f * s0[4 * gq + 3];
                    if (j1 < 31) irh[j1] += 0.5f * s1[4 * gq + 3]; else if (hi == 0) irh[j1] += 0.5f * s1[4 * gq + 3]; }
                asm volatile("s_waitcnt lgkmcnt(0)" ::: "memory");
                { const int lv = lane_now(); const int vlane = ((lv >> 4) & 1) * 32 + (lv & 3) * 8 + (4 * (lv >> 5) + ((lv & 15) >> 2)) * 64;
                  pv_tile(ot, (int)C.lds0 + A_OST + tile * 16384 + 8192 + vlane, s0, s1); }
            }
        }
        const float lt = halfsum(sum); const float inv = has ? 1.0f / lt : 0.f;
        if (hi == 0) ((LAS float*)(C.lds + A_SEL + 256))[g * 64 + 32 * (C.wid & 1) + (lane_now() & 31)] = inv;
        scale_rows(ot, g_cmp * inv, C);
        ATT_WAIT_BAR(0);
        {
            const int l_ = lane_now(); const int jb = l_ & 31, hf = l_ >> 5;
            const LAS float* nrm = (const LAS float*)(C.lds + A_SEL + 256);
            unsigned m0 = 1u | (1u << blk); if (blk >= 1) m0 |= 1u << (blk - 1);
            const int need = 8 - __builtin_popcount(m0), ncand = blk - 2;
            const bool cand = (jb >= 1) && (jb <= blk - 2);
#pragma unroll 1
            for (int it = 0; it < 4; ++it) {
                const int q = C.wid * 8 + 2 * it + hf; unsigned m = m0;
                if (ncand > 0) {
                    if (ncand <= need) { m |= ((1u << (blk - 1)) - 1u) & ~1u; }
                    else {
                        float sc = (imp[(0 * 64 + q) * 33 + jb] * nrm[q] + imp[(1 * 64 + q) * 33 + jb] * nrm[64 + q]) + (imp[(2 * 64 + q) * 33 + jb] * nrm[128 + q] + imp[(3 * 64 + q) * 33 + jb] * nrm[192 + q]);
#ifdef PROBE_SELINV
                        sc = 1e30f - sc;
#endif
                        if (!cand) sc = -1.f;
                        for (int r = 0; r < need; ++r) {
                            float mx = sc;
                            mx = fmaxf(mx, dppf<0xB1>(mx)); mx = fmaxf(mx, dppf<0x4E>(mx)); mx = fmaxf(mx, dppf<0x141>(mx)); mx = fmaxf(mx, dppf<0x140>(mx));
                            { const float up = __uint_as_float(__builtin_amdgcn_update_dpp(__float_as_uint(mx), __float_as_uint(mx), 0x142, 0xa, 0xf, false));
                              const float m2 = fmaxf(mx, up);
                              const float m31 = __uint_as_float(__builtin_amdgcn_readlane(__float_as_uint(m2), 31)), m63 = __uint_as_float(__builtin_amdgcn_readlane(__float_as_uint(m2), 63));
                              mx = hf ? m63 : m31; }
                            const unsigned long long bal = __ballot(sc == mx && sc >= 0.f);
                            const unsigned bm = hf ? (unsigned)(bal >> 32) : (unsigned)bal;
                            const int w = __ffs(bm) - 1;
                            if (w >= 0) { m |= 1u << w; if (jb == w) sc = -1.f; }
                        }
                    }
                }
                if (jb == 0) sel[q] = m;
            }
        }
        ATT_WAIT_BAR(0);
    }
    const unsigned mysel = sel[32 * (C.wid & 1) + (lane_now() & 31)];
    acc_rows<false>(ot, 1.0f, C);
#ifndef NSA_SPLIT_PASSES
    {
        const bf16_t* Kp1 = (const bf16_t*)(ws + slot_off(SL_KSLC + hk)) + tokbase * 64; const bf16_t* Vp1 = (const bf16_t*)(ws + slot_off(SL_VSLC + hk)) + tokbase * 64;
        const bf16_t* Kp2 = (const bf16_t*)(ws + slot_off(SL_KWIN + hk)) + tokbase * 64; const bf16_t* Vp2 = (const bf16_t*)(ws + slot_off(SL_VWIN + hk)) + tokbase * 64;
        const int n1 = blk + 1, t_lo2 = blk >= 8 ? blk - 8 : 0, n2 = blk + 1 - t_lo2;
        NSA_LANE_STATE();
        bf16x8 qr[4]; load_q(qr, qrow, hi);
        const float g_slc = (PROBE_ZERO & 2) ? 0.f : bf2f(ga[8 + head]), g_win = (PROBE_ZERO & 4) ? 0.f : bf2f(ga[16 + head]);
        auto mask1 = [&](f32x16& p0, f32x16& p1, int t) {
            const bool on = ((mysel >> t) & 1u);
            if (!__all(on) || t == blk) {
                if (!on) {
#pragma unroll
                    for (int r = 0; r < 16; ++r) { p0[r] = NEG_INF; p1[r] = NEG_INF; } }
                else if (t == blk) { const int lim = fresh(tq - 64 * t - 4 * hi);
#pragma unroll
                    for (int r = 0; r < 16; ++r) { const int c = (r & 3) + 8 * (r >> 2); if (c > lim) p0[r] = NEG_INF; if (c + 32 > lim) p1[r] = NEG_INF; } }
            }
        };
        auto mask2 = [&](f32x16& p0, f32x16& p1, int t) {
            if (t >= n2) {
#pragma unroll
                for (int r = 0; r < 16; ++r) { p0[r] = NEG_INF; p1[r] = NEG_INF; } }
            else if (t == n2 - 1 || (t == 0 && blk >= 8)) { const int lim = fresh(tq - 64 * (t_lo2 + t) - 4 * hi), lim2 = lim - 512;
#pragma unroll
                for (int r = 0; r < 16; ++r) { const int c = (r & 3) + 8 * (r >> 2);
                    if (c > lim || c < lim2) p0[r] = NEG_INF; if (c + 32 > lim || c + 32 < lim2) p1[r] = NEG_INF; } }
        };
        fast_pass2<8, true>(C, qr, Kp1, Vp1, n1, mask1, g_slc, Kp2, Vp2, t_lo2, n2, mask2, g_win);
    }
#else
    {
        const bf16_t* Kp = (const bf16_t*)(ws + slot_off(SL_KSLC + hk)) + tokbase * 64;
        const bf16_t* Vp = (const bf16_t*)(ws + slot_off(SL_VSLC + hk)) + tokbase * 64;
        const int ntr = blk + 1;
        NSA_LANE_STATE();
        bf16x8 qr[4]; load_q(qr, qrow, hi);
        const float g_slc = (PROBE_ZERO & 2) ? 0.f : bf2f(ga[8 + head]);
        auto mask = [&](f32x16& p0, f32x16& p1, int t) {
            const bool on = (t < ntr) && ((mysel >> t) & 1u);
            if (!__all(on) || t == blk) {
                if (!on) {
#pragma unroll
                    for (int r = 0; r < 16; ++r) { p0[r] = NEG_INF; p1[r] = NEG_INF; } }
                else if (t == blk) { const int lim = fresh(tq - 64 * t - 4 * hi);
#pragma unroll
                    for (int r = 0; r < 16; ++r) { const int c = (r & 3) + 8 * (r >> 2); if (c > lim) p0[r] = NEG_INF; if (c + 32 > lim) p1[r] = NEG_INF; } }
            }
        };
        f32x16 o[2]; float l;
        fast_pass<8, true>(C, qr, Kp, Vp, 0, ntr, mask, o, l);
        acc_rows<true>(o, g_slc * __builtin_amdgcn_rcpf(halfsum(l)), C);
#if defined(PROBE_DUP) && PROBE_DUP == 2
        fast_pass<8, false>(C, qr, Kp, Vp, 0, ntr, mask, o, l);
        acc_rows<true>(o, 0.f * halfsum(l), C);
#endif
    }
    {
        const bf16_t* Kp = (const bf16_t*)(ws + slot_off(SL_KWIN + hk)) + tokbase * 64;
        const bf16_t* Vp = (const bf16_t*)(ws + slot_off(SL_VWIN + hk)) + tokbase * 64;
        const int t_lo = blk >= 8 ? blk - 8 : 0, ntr = blk + 1 - t_lo;
        NSA_LANE_STATE();
        bf16x8 qr[4]; load_q(qr, qrow, hi);
        const float g_win = (PROBE_ZERO & 4) ? 0.f : bf2f(ga[16 + head]);
        auto mask = [&](f32x16& p0, f32x16& p1, int t) {
            if (t >= ntr) {
#pragma unroll
                for (int r = 0; r < 16; ++r) { p0[r] = NEG_INF; p1[r] = NEG_INF; } }
            else if (t == ntr - 1 || (t == 0 && blk >= 8)) { const int lim = fresh(tq - 64 * (t_lo + t) - 4 * hi), lim2 = lim - 512;
#pragma unroll
                for (int r = 0; r < 16; ++r) { const int c = (r & 3) + 8 * (r >> 2);
                    if (c > lim || c < lim2) p0[r] = NEG_INF; if (c + 32 > lim || c + 32 < lim2) p1[r] = NEG_INF; } }
        };
        f32x16 o[2]; float l;
        fast_pass<8, false>(C, qr, Kp, Vp, t_lo, ntr, mask, o, l);
        acc_rows<true>(o, g_win * __builtin_amdgcn_rcpf(halfsum(l)), C);
#if defined(PROBE_DUP) && PROBE_DUP == 3
        fast_pass<8, false>(C, qr, Kp, Vp, t_lo, ntr, mask, o, l);
        acc_rows<true>(o, 0.f * halfsum(l), C);
#endif
    }
#endif
    acc_flush(oa + (tokbase + 64 * blk + 32 * (C.wid & 1)) * 1024 + head * 64, 1024, C);
    ATT_WAIT_BAR(0);
}
}
__device__ __forceinline__ void pf4_router(Frame& F, const Args& a, const bool dry = false) {
#ifdef X1_BF16
    const bf16_t* x1 = WSP(bf16_t, WS_Y);
#else
    const float* x1 = a.out;
#endif
    const float* mod = WSP(float, WS_MOD); const float* rowss = WSP(float, WS_ROWSS);
    const float* b_group = (const float*)a.in[22]; const float* b_router = (const float*)a.in[24];
    const bf16_t* rhi = (const bf16_t*)(F.ws + WS_SMALL + 65536); const bf16_t* rlo = (const bf16_t*)(F.ws + WS_SMALL + 196608);
    unsigned char* h2 = WSP(unsigned char, WS_H);
    int* pick_e = (int*)(F.ws + WS_PICK); int* pick_pos = (int*)(F.ws + WS_PICK + 524288); float* pick_w = (float*)(F.ws + WS_PICK + 1048576); int* list = WSP(int, WS_LIST);
    LAS unsigned char* wch = F.lds; LAS float* mv = (LAS float*)(F.lds + 67584);
    LAS float* lg = (LAS float*)(F.lds + 75776) + F.wave * (32 * 40);
    LAS int* lc = (LAS int*)(F.lds + 116736); LAS int* gb = lc + 32;
    const int r32 = F_LANE() & 31, hi = F_LANE() >> 5;
    const int NGW = F.G * 8, ntask = NT_TOK / 32, iters = (ntask + NGW - 1) / NGW;
    for (int it = 0; it < iters; ++it) {
        const int task = it * NGW + F.vcu * 8 + F.wave; const bool valid = task < ntask;
        if (F_TID() < 32) lc[F_TID()] = 0;
        __syncthreads();
        int e1 = 0, e2 = 0, p1 = 0, p2 = 0; float w1 = 0.f, w2 = 0.f; int row = 0;
        f32x16 acc0 = {}, acc1 = {};
        {
            row = (valid ? task : 0) * 32 + r32; const int b = row >> 11;
            float ss = 0.f; { const f32x4* rp = (const f32x4*)(rowss + (size_t)row * 16); const f32x4 s0 = rp[0], s1 = rp[1], s2 = rp[2], s3 = rp[3];
                ss = ((s0[0] + s0[1]) + (s0[2] + s0[3])) + ((s1[0] + s1[1]) + (s1[2] + s1[3])) + ((s2[0] + s2[1]) + (s2[2] + s2[3])) + ((s3[0] + s3[1]) + (s3[2] + s3[3])); }
            const float rstd = __builtin_amdgcn_rsqf(ss * (1.f / DM) + EPS);
            unsigned char* hp = h2 + (size_t)row * DM + 8 * hi;
#ifdef X1_BF16
            const bf16_t* xr = x1 + (size_t)row * DM + 8 * hi;
            u32x4 xq[4];
#pragma unroll
            for (int j = 0; j < 4; ++j) xq[j] = *(const u32x4*)(xr + 16 * j);
#else
            const float* xr = x1 + (size_t)row * DM + 8 * hi;
            f32x4 xq[4][2];
#pragma unroll
            for (int j = 0; j < 4; ++j) { xq[j][0] = *(const f32x4*)(xr + 16 * j); xq[j][1] = *(const f32x4*)(xr + 16 * j + 4); }
#endif
            { const int t_ = F_TID(); const float* a2 = WSP(float, WS_SMALL + 524288) + (size_t)b * 1024; const float* s2 = mod + (size_t)b * 6144 + 3072;
              for (int i = t_; i < 2048; i += 512) mv[i] = (i < 1024) ? a2[i] : s2[i - 1024]; }
            const LAS unsigned char* wrd = wch + r32 * 528 + 16 * hi; const LAS float* mrd = mv + 8 * hi;
#pragma unroll 1
            for (int c = 0; c < 4; ++c) {
                __syncthreads();
                { const int t_ = F_TID();
#pragma unroll
                  for (int p = 0; p < 8; ++p) { const int piece = t_ + 512 * p, mat = piece >> 11, q = piece & 2047, col = q >> 5, kk = (q & 31) * 8;
                      const u32x4 v = *(const u32x4*)((mat ? rlo : rhi) + (size_t)col * 1024 + 256 * c + kk);
                      *(LAS u32x4*)(wch + mat * 33792 + col * 528 + kk * 2) = v; } }
                __syncthreads();
                if (valid) {
#pragma unroll 1
                for (int s4 = 0; s4 < 16; s4 += 4) {
#pragma unroll
                    for (int j = 0; j < 4; ++j) {
                        const int sl = s4 + j, s = 16 * c + sl;
#ifdef X1_BF16
                        const u32x4 xw = xq[j]; const f32x4 xa = {bflo(xw.x), bfhi(xw.x), bflo(xw.y), bfhi(xw.y)}, xb = {bflo(xw.z), bfhi(xw.z), bflo(xw.w), bfhi(xw.w)};
                        if (s + 4 < 64) xq[j] = *(const u32x4*)(xr + 16 * (s + 4));
#else
                        const f32x4 xa = xq[j][0], xb = xq[j][1];
                        if (s + 4 < 64) { xq[j][0] = *(const f32x4*)(xr + 16 * (s + 4)); xq[j][1] = *(const f32x4*)(xr + 16 * (s + 4) + 4); }
#endif
                        const f32x4 ca0 = *(const LAS f32x4*)(mrd + 16 * s), ca1 = *(const LAS f32x4*)(mrd + 16 * s + 4), ch0 = *(const LAS f32x4*)(mrd + 1024 + 16 * s), ch1 = *(const LAS f32x4*)(mrd + 1024 + 16 * s + 4);
                        const bf16x8 Ah0 = *(const LAS bf16x8*)(wrd + 32 * sl), Al0 = *(const LAS bf16x8*)(wrd + 33792 + 32 * sl);
                        const bf16x8 Ah1 = *(const LAS bf16x8*)(wrd + 32 * 528 + 32 * sl), Al1 = *(const LAS bf16x8*)(wrd + 33792 + 32 * 528 + 32 * sl);
                        const f32x4 va = (xa * rstd) * ca0 + ch0, vb = (xb * rstd) * ca1 + ch1;
                        { u32x2 w8; w8.x = pk4_fp8(va[0], va[1], va[2], va[3]); w8.y = pk4_fp8(vb[0], vb[1], vb[2], vb[3]); *(u32x2*)(hp + 16 * s) = w8; }
                        u32x4 whi; whi.x = cvtpk(va[0], va[1]); whi.y = cvtpk(va[2], va[3]); whi.z = cvtpk(vb[0], vb[1]); whi.w = cvtpk(vb[2], vb[3]);
                        u32x4 wlo; wlo.x = cvtpk(va[0] - bflo(whi.x), va[1] - bfhi(whi.x)); wlo.y = cvtpk(va[2] - bflo(whi.y), va[3] - bfhi(whi.y));
                        wlo.z = cvtpk(vb[0] - bflo(whi.z), vb[1] - bfhi(whi.z)); wlo.w = cvtpk(vb[2] - bflo(whi.w), vb[3] - bfhi(whi.w));
                        const bf16x8 Bh = __builtin_bit_cast(bf16x8, whi), Bl = __builtin_bit_cast(bf16x8, wlo);
                        acc0 = __builtin_amdgcn_mfma_f32_32x32x16_bf16(Ah0, Bh, acc0, 0, 0, 0); acc0 = __builtin_amdgcn_mfma_f32_32x32x16_bf16(Ah0, Bl, acc0, 0, 0, 0); acc0 = __builtin_amdgcn_mfma_f32_32x32x16_bf16(Al0, Bh, acc0, 0, 0, 0);
                        acc1 = __builtin_amdgcn_mfma_f32_32x32x16_bf16(Ah1, Bh, acc1, 0, 0, 0); acc1 = __builtin_amdgcn_mfma_f32_32x32x16_bf16(Ah1, Bl, acc1, 0, 0, 0); acc1 = __builtin_amdgcn_mfma_f32_32x32x16_bf16(Al1, Bh, acc1, 0, 0, 0);
                    }
                }
                }
            }
        }
        if (valid) {
            LAS float* lr = lg + r32 * 40;
#pragma unroll
            for (int gq = 0; gq < 4; ++gq) *(LAS f32x4*)(lr + 8 * gq + 4 * hi) = (f32x4){acc0[4 * gq], acc0[4 * gq + 1], acc0[4 * gq + 2], acc0[4 * gq + 3]};
            if (hi == 0) *(LAS f32x4*)(lr + 32) = (f32x4){acc1[0], acc1[1], acc1[2], acc1[3]};
            asm volatile("s_waitcnt lgkmcnt(0)" ::: "memory");
            if (hi == 0) {
                float gl[4];
#pragma unroll
                for (int i = 0; i < 4; ++i) gl[i] = lr[i] + b_group[i];
                int gi = 0; float gm = gl[0];
#pragma unroll
                for (int i = 1; i < 4; ++i) if (gl[i] > gm) { gm = gl[i]; gi = i; }
                float gsum = 0.f;
#pragma unroll
                for (int i = 0; i < 4; ++i) gsum += __expf(gl[i] - gm);
                const float gw = 1.0f / gsum;
                float el[8];
#pragma unroll
                for (int i = 0; i < 8; ++i) el[i] = lr[4 + 8 * gi + i] + b_router[gi * 8 + i];
                int i1 = 0; float v1 = el[0];
#pragma unroll
                for (int i = 1; i < 8; ++i) if (el[i] > v1) { v1 = el[i]; i1 = i; }
                int i2 = -1; float v2 = -INFINITY;
#pragma unroll
                for (int i = 0; i < 8; ++i) if (i != i1 && el[i] > v2) { v2 = el[i]; i2 = i; }
                const float pa = 1.0f / (1.0f + __expf(v2 - v1));
                w1 = gw * pa; w2 = gw * (1.0f - pa); e1 = gi * 8 + i1; e2 = gi * 8 + i2;
                p1 = __hip_atomic_fetch_add((int*)(lc + e1), 1, __ATOMIC_RELAXED, __HIP_MEMORY_SCOPE_WORKGROUP);
                p2 = __hip_atomic_fetch_add((int*)(lc + e2), 1, __ATOMIC_RELAXED, __HIP_MEMORY_SCOPE_WORKGROUP);
            }
        }
        __syncthreads();
        if (!dry && F_TID() < 32) { const int c = lc[F_TID()]; gb[F_TID()] = c ? (int)__hip_atomic_fetch_add(F.ctl + CW_CNT + 64 * F_TID(), (unsigned)c, RLX_AGENT) : 0; }
        __syncthreads();
        if (!dry && valid && hi == 0) {
            p1 += gb[e1]; p2 += gb[e2];
            pick_e[row * 2] = e1; pick_e[row * 2 + 1] = e2; pick_pos[row * 2] = p1; pick_pos[row * 2 + 1] = p2; pick_w[row * 2] = w1; pick_w[row * 2 + 1] = w2;
            list[(size_t)e1 * NT_TOK + p1] = row; list[(size_t)e2 * NT_TOK + p2] = row;
        }
        __syncthreads();
    }
}

__device__ __forceinline__ void moe_tables(Frame& F) {
    LAS int* cnt = (LAS int*)(F.lds + LDS_EXP); LAS int* pre = cnt + 32;
    if (F_TID() < 32) cnt[F_TID()] = (int)__hip_atomic_load(F.ctl + CW_CNT + 64 * F_TID(), RLX_AGENT);
    __syncthreads();
    if (F_TID() == 0) { int s = 0; for (int e = 0; e < 32; ++e) { pre[e] = s; s += (cnt[e] + 255) >> 8; } pre[32] = s; }
    __syncthreads();
}
namespace pg8 {
struct MoeSched {
    const char* A; const char* Bt; int lda, ldb; size_t bstride; bool gather; LAS unsigned char* lds; int G, c;
    __device__ __forceinline__ bool next(int i, Unit& u) const {
        const LAS int* pre = (const LAS int*)(lds + LDS_EXP) + 32;
        const int L = i * G + c; if (L >= 4 * pre[32]) return false;
        const int mtg = L >> 2;
        const int pk = pre[lane_now() & 31];
        const int e = __builtin_popcount((unsigned)__ballot(pk <= mtg)) - 1;
        u.pm = mtg; u.pn = L & 3; u.e = e; u.mt = mtg - pre[e]; return true;
    }
    __device__ __forceinline__ const char* a_base(const Unit& u) const { return gather ? A : A + (size_t)u.pm * BM * lda * 2; }
    __device__ __forceinline__ unsigned a_voff(const Unit&, int ui, int h, int R, int C) const {
        if (gather) { const int tok = ((const LAS int*)(lds + LDS_TOK))[ui * 256 + h * HALF + R]; return (unsigned)(tok * lda + C) * 2u; }
        return (unsigned)((h * HALF + R) * lda + C) * 2u; }
    __device__ __forceinline__ const char* b_base(const Unit& u) const { return Bt + (size_t)u.e * bstride + (size_t)u.pn * BM * ldb * 2; }
    __device__ __forceinline__ int dephase_id() const { return c; }
};
struct GuEpi {
    static constexpr bool PERM = true, noepi = false; static constexpr int MIDK = 0, DEPHASE = 1, DEPHASE_TICKS = 0, NSTORE = 8;
    unsigned char* hid;
    __device__ __forceinline__ void operator()(const f32x4 (&acc)[2][2][4][2], const Unit& u, int, int wr, int wc, int fr, int fq) const {
        const int row0 = u.pm * BM + wr * 64 + fr, col = u.pn * HALF + wc * 32 + 8 * fq;
#pragma unroll
        for (int ai = 0; ai < 2; ++ai)
#pragma unroll
            for (int m = 0; m < 4; ++m) {
                f32x4 v0, v1;
#pragma unroll
                for (int i = 0; i < 4; ++i) { v0[i] = clamp448(siluf_(acc[ai][0][m][0][i] * 0.015625f) * acc[ai][1][m][0][i] * 0.125f); v1[i] = clamp448(siluf_(acc[ai][0][m][1][i] * 0.015625f) * acc[ai][1][m][1][i] * 0.125f); }
                u32x2 w; w.x = pk4_fp8(v0[0], v0[1], v0[2], v0[3]); w.y = pk4_fp8(v1[0], v1[1], v1[2], v1[3]);
                *(u32x2*)(hid + (size_t)(row0 + ai * HALF + m * 16) * EFF + col) = w;
            }
    }
};
struct YEpi {
    static constexpr bool PERM = true, noepi = false; static constexpr int MIDK = 0, DEPHASE = 1, DEPHASE_TICKS = 0;
#ifdef PROBE_NOSTORE
    static constexpr int NSTORE = 0;
#else
    static constexpr int NSTORE = 16;
#endif
    unsigned char* Y; float osc; bool nostore;
    __device__ __forceinline__ void operator()(const f32x4 (&acc)[2][2][4][2], const Unit& u, int, int wr, int wc, int fr, int fq) const {
        const int row0 = u.pm * BM + wr * 64 + fr, col0 = u.pn * BM + wc * 32 + 8 * fq;
#pragma unroll
        for (int ai = 0; ai < 2; ++ai)
#pragma unroll
            for (int m = 0; m < 4; ++m)
#pragma unroll
                for (int bj = 0; bj < 2; ++bj) { const f32x4 v0 = acc[ai][bj][m][0] * osc, v1 = acc[ai][bj][m][1] * osc;
                    u32x2 w; w.x = pk4_fp8(clamp448(v0[0]), clamp448(v0[1]), clamp448(v0[2]), clamp448(v0[3])); w.y = pk4_fp8(clamp448(v1[0]), clamp448(v1[1]), clamp448(v1[2]), clamp448(v1[3]));
                    if (!nostore) *(u32x2*)(Y + (size_t)(row0 + ai * HALF + m * 16) * DM + col0 + bj * HALF) = w; else asm volatile("" :: "v"(w)); }
    }
};
}

__device__ __forceinline__ void moe_fill_tokens(Frame& F, const pg8::MoeSched& S) {
    const LAS int* cnt = (const LAS int*)(F.lds + LDS_EXP); LAS int* tokt = (LAS int*)(F.lds + LDS_TOK); const int* list = WSP(int, WS_LIST);
    pg8::Unit u;
    for (int i = 0; i < 12 && S.next(i, u); ++i) {
        if (F_TID() < 256) { const int idx = u.mt * 256 + F_TID(); tokt[i * 256 + F_TID()] = list[(size_t)u.e * NT_TOK + (idx < cnt[u.e] ? idx : 0)]; }
    }
    __syncthreads();
}

__device__ __forceinline__ void pi_combine(Frame& F, const Args& a, const float wsc = 1.0f) {
    const LAS int* pre = (const LAS int*)(F.lds + LDS_EXP) + 32;
    const int* pick_e = (const int*)(F.ws + WS_PICK); const int* pick_pos = (const int*)(F.ws + WS_PICK + 524288); const float* pick_w = (const float*)(F.ws + WS_PICK + 1048576);
    const unsigned char* Y = WSP(unsigned char, WS_R1); const float* mod = WSP(float, WS_MOD); float* out = a.out;
    const int gw = F.vcu * 8 + F.wave, NGW = F.G * 8, ln = F_LANE();
    struct Pk { int e0, e1, p0, p1; float w0, w1; };
#ifdef X1_BF16
    const bf16_t* x1b = WSP(bf16_t, WS_Y);
    struct Dat { unsigned a0[4], a1[4]; u32x2 x[4]; float w0, w1; };
#else
    struct Dat { unsigned a0[4], a1[4]; f32x4 x[4]; float w0, w1; };
#endif
    auto ldpk = [&](int r) { Pk k; k.e0 = pick_e[2 * r]; k.e1 = pick_e[2 * r + 1]; k.p0 = pick_pos[2 * r]; k.p1 = pick_pos[2 * r + 1]; k.w0 = pick_w[2 * r]; k.w1 = pick_w[2 * r + 1]; return k; };
    auto lddat = [&](int r, const Pk& k) { Dat d; d.w0 = k.w0 * wsc * 0.0625f; d.w1 = k.w1 * wsc * 0.0625f;
        const size_t s0 = (size_t)pre[k.e0] * 256 + k.p0, s1 = (size_t)pre[k.e1] * 256 + k.p1;
        const unsigned* y0 = (const unsigned*)(Y + s0 * DM) + ln; const unsigned* y1 = (const unsigned*)(Y + s1 * DM) + ln;
#ifdef X1_BF16
        const u32x2* xr = (const u32x2*)(x1b + (size_t)r * DM) + ln;
#else
        const f32x4* xr = (const f32x4*)(out + (size_t)r * DM) + ln;
#endif
#pragma unroll
        for (int j = 0; j < 4; ++j) { d.a0[j] = y0[64 * j]; d.a1[j] = y1[64 * j]; d.x[j] = xr[64 * j]; }
        return d; };
    f32x4 gtv[4];
    auto fin = [&](int r, const Dat& d) { f32x4* xw = (f32x4*)(out + (size_t)r * DM) + ln;
#pragma unroll
        for (int j = 0; j < 4; ++j) { const f32x4 g = gtv[j];
#ifdef X1_BF16
            f32x4 x = {bflo(d.x[j].x), bfhi(d.x[j].x), bflo(d.x[j].y), bfhi(d.x[j].y)};
#else
            f32x4 x = d.x[j];
#endif
            const f32x2 p0 = __builtin_amdgcn_cvt_pk_f32_fp8(d.a0[j], false), p1 = __builtin_amdgcn_cvt_pk_f32_fp8(d.a0[j], true), q0 = __builtin_amdgcn_cvt_pk_f32_fp8(d.a1[j], false), q1 = __builtin_amdgcn_cvt_pk_f32_fp8(d.a1[j], true);
            x[0] += g[0] * (d.w0 * p0[0] + d.w1 * q0[0]); x[1] += g[1] * (d.w0 * p0[1] + d.w1 * q0[1]);
            x[2] += g[2] * (d.w0 * p1[0] + d.w1 * q1[0]); x[3] += g[3] * (d.w0 * p1[1] + d.w1 * q1[1]); xw[64 * j] = x; } };
#pragma unroll 1
    for (int blk = gw; blk < NT_TOK / 32; blk += NGW) {
        const int m0 = blk * 32, b = m0 >> 11, m1 = m0 + 32;
        { const f32x4* gt = (const f32x4*)(mod + (size_t)b * 6144 + 5120) + ln;
#pragma unroll
          for (int j = 0; j < 4; ++j) gtv[j] = gt[64 * j]; }
        int r0 = m0;
        Pk k1 = ldpk(r0); Dat d0 = lddat(r0, k1);
        Pk k2 = ldpk(r0 + 1);
#pragma unroll 1
        for (; r0 < m1; ++r0) {
            const int r1 = r0 + 1, r2 = r0 + 2;
            Dat d1 = d0; if (r1 < m1) d1 = lddat(r1, k2);
            if (r2 < m1) k2 = ldpk(r2);
            fin(r0, d0);
            d0 = d1;
        }
    }
}
#ifndef MK_MODE
#define MK_MODE 2
#endif
constexpr int NPHASE = 12;
#ifndef REP_MASK
#define REP_MASK 0
#endif
#define REPS(k) (((REP_MASK >> (k)) & 1) ? 2 : 1)

__device__ __forceinline__ void pd_compress_stage2(Frame& F, const Args& a, int pm) {
    const int r32 = F_LANE() & 31, hi = F_LANE() >> 5, kv = pm >= 32 ? 1 : 0;
    const bf16_t* w2t = WSP(bf16_t, WS_CW2) + (size_t)kv * 64 * 256;
    const int rowg = 256 * pm + 32 * F.wave + r32;
    const bf16_t* hp = WSP(bf16_t, WS_CHID) + (size_t)rowg * 256 + 8 * hi;
    f32x16 acc0 = {}, acc1 = {};
#pragma unroll 4
    for (int s = 0; s < 16; ++s) {
        const bf16x8 B = *(const bf16x8*)(hp + 16 * s);
        const bf16x8 A0 = *(const bf16x8*)(w2t + (size_t)r32 * 256 + 16 * s + 8 * hi), A1 = *(const bf16x8*)(w2t + (size_t)(32 + r32) * 256 + 16 * s + 8 * hi);
        acc0 = __builtin_amdgcn_mfma_f32_32x32x16_bf16(A0, B, acc0, 0, 0, 0); acc1 = __builtin_amdgcn_mfma_f32_32x32x16_bf16(A1, B, acc1, 0, 0, 0);
    }
    const int mrow = rowg & 8191;
    bf16_t* dst = (bf16_t*)(F.ws + WS_KC + (kv ? MiB : 0)) + (size_t)mrow * 64;
    if (kv == 0) {
        float ss = 0.f;
#pragma unroll
        for (int r = 0; r < 16; ++r) ss += acc0[r] * acc0[r] + acc1[r] * acc1[r];
        ss = att::halfsum(ss);
        const float rstd = __builtin_amdgcn_rsqf(ss * (1.f / 64.f) + EPS);
        const float* nk = (const float*)a.in[9];
        const int b = (mrow >> 7) & 31, n = mrow & 127;
        const float* cc = WSP(float, WS_CROPE) + ((size_t)b * 128 + n) * 32; const float* sn = cc + 32 * 128 * 32;
#pragma unroll
        for (int gq = 0; gq < 4; ++gq) { const int d = 8 * gq + 4 * hi;
            const f32x4 g1 = *(const f32x4*)(nk + d), g2 = *(const f32x4*)(nk + 32 + d), c4 = *(const f32x4*)(cc + d), s4 = *(const f32x4*)(sn + d);
            f32x4 x1, x2;
#pragma unroll
            for (int i = 0; i < 4; ++i) { x1[i] = acc0[4 * gq + i] * rstd * g1[i]; x2[i] = acc1[4 * gq + i] * rstd * g2[i]; }
            const f32x4 o1 = x1 * c4 - x2 * s4, o2 = x1 * s4 + x2 * c4;
            u32x2 w1, w2; w1.x = cvtpk(o1[0], o1[1]); w1.y = cvtpk(o1[2], o1[3]); w2.x = cvtpk(o2[0], o2[1]); w2.y = cvtpk(o2[2], o2[3]);
            *(u32x2*)(dst + d) = w1; *(u32x2*)(dst + 32 + d) = w2; }
    } else {
#pragma unroll
        for (int gq = 0; gq < 4; ++gq) { const int d = 8 * gq + 4 * hi;
            u32x2 w1, w2; w1.x = cvtpk(acc0[4 * gq], acc0[4 * gq + 1]); w1.y = cvtpk(acc0[4 * gq + 2], acc0[4 * gq + 3]); w2.x = cvtpk(acc1[4 * gq], acc1[4 * gq + 1]); w2.y = cvtpk(acc1[4 * gq + 2], acc1[4 * gq + 3]);
            *(u32x2*)(dst + d) = w1; *(u32x2*)(dst + 32 + d) = w2; }
    }
}

__device__ __forceinline__ void pf1_scale_ob(Frame& F) {
    const float* lse = WSP(float, WS_LSE); const u32x2* src = (const u32x2*)(F.ws + WS_H + 64 * MiB); unsigned* dst = (unsigned*)(F.ws + WS_Y);
    const int gw = F.vcu * 8 + F.wave, NGW = F.G * 8, l = F_LANE();
    for (int m = gw; m < NT_TOK; m += NGW) {
        const int j = (l & 31) >> 4;
        const float l0 = lse[(size_t)m * 8 + j], l1 = lse[(size_t)m * 8 + 2 + j], l2 = lse[(size_t)m * 8 + 4 + j];
        const float mx = fmaxf(l0, fmaxf(l1, l2)); const float e0 = __expf(l0 - mx), e1 = __expf(l1 - mx), e2 = __expf(l2 - mx); const float inv = 16.0f * __builtin_amdgcn_rcpf(e0 + e1 + e2);
        const float al[3] = {(PROBE_ZERO & 8) ? 0.f : e0 * inv, (PROBE_ZERO & 8) ? 0.f : e1 * inv, (PROBE_ZERO & 8) ? 0.f : e2 * inv};
        if (l < 32) {
#pragma unroll
            for (int gi = 0; gi < 3; ++gi) { const u32x2 w = src[(size_t)m * 96 + gi * 32 + l]; dst[(size_t)m * 256 + 128 + gi * 32 + l] = pk4_fp8(bflo(w.x) * al[gi], bfhi(w.x) * al[gi], bflo(w.y) * al[gi], bfhi(w.y) * al[gi]); }
        } else dst[(size_t)m * 256 + 224 + (l - 32)] = 0u;
    }
}

__global__ void __launch_bounds__(512, 2) mk_fwd(Args args) {
    extern __shared__ __attribute__((aligned(16))) unsigned char lds_raw[];
    Frame F;
    F.lds = (LAS unsigned char*)lds_raw;
    F.MISC = (volatile LAS unsigned*)(F.lds + LDS_MISC);
    F.wave = __builtin_amdgcn_readfirstlane(threadIdx.x >> 6);
    F.G = gridDim.x; { const int bx = blockIdx.x; F.vcu = (F.G % 8 == 0) ? (bx % 8) * (F.G / 8) + bx / 8 : bx; }
    F.ws = args.ws; F.ctl = (unsigned*)(args.ws + WS_CTL);
    if (F_TID() < 64) ((LAS unsigned*)(F.lds + LDS_MISC))[F_TID()] = 0u;
    __syncthreads();
#if MK_MODE == 1
    cg::grid_group grid = cg::this_grid();
#define GRID_BAR() grid.sync()
#elif MK_MODE == 2
    XcdBarrier bar = xcd_barrier_post(F.ctl + CW_BAR, F.MISC + 8, F.wave);
#define GRID_BAR() xcd_barrier(bar)
#else
#define GRID_BAR() do {} while (0)
#endif
    int lo = args.ph_lo, hi = args.ph_hi; if (hi == 100 || hi == 102) { lo = 2; hi = 3; } if (hi == 101) { lo = 10; hi = 11; }
#ifndef PH_MASK
#define PH_MASK 0xfff
#endif
#define IN(k) (((PH_MASK >> (k)) & 1) && lo <= (k) && (k) < hi)
#ifdef PROBE_DBLBAR
#define SEAM(k) do { if (IN(k) && ((k) + 1 < hi)) { GRID_BAR(); GRID_BAR(); } } while (0)
#else
#define SEAM(k) do { if (IN(k) && ((k) + 1 < hi)) GRID_BAR(); } while (0)
#endif


    if (IN(0)) { pa_prologue(F, args); } SEAM(0);
    if (IN(1)) { pb_modnorm(F, (const float*)args.in[0], (const float*)args.in[5], WSP(float, WS_MOD), 0, 1024, WSP(bf16_t, WS_H), (const float*)args.in[6]); } SEAM(1);
    if (IN(2)) {
#ifdef PC_FP8
        pg8::DenseSched S; S.init(WSP(bf16_t, WS_H), 512, WSP(bf16_t, WS_WIN), 512, NT_TOK, NPROJ, F.G, (int)blockIdx.x);
#ifdef PROBE_HOT
        S.hot = args.ph_hi == 100;
#endif
#else
        pg8::DenseSched S; S.init(WSP(bf16_t, WS_H), 1024, WSP(bf16_t, WS_WIN), 1024, NT_TOK, NPROJ, F.G, (int)blockIdx.x);
#endif
        pg8::ProjEpi E{F.ws, (const int*)args.in[2], WSP(float, WS_ROPE), WSP(float, WS_ROPE) + (size_t)NT_TOK * 32, (const float*)args.in[8], (const float*)args.in[9], (const float*)args.in[16], (const float*)args.in[17], args.ph_hi == 100, args.ph_hi == 102};
#ifdef PC_FP8
        pg8::gemm_phase<pg8::ProjEpi, pg8::DenseSched, true, true>(F.lds, F.wave, 512, S, E);
#else
        pg8::gemm_phase<pg8::ProjEpi, pg8::DenseSched>(F.lds, F.wave, 1024, S, E);
#endif
    } SEAM(2);
    if (IN(3)) {
        const int ncw = F.G >= 128 ? 64 : (F.G > 1 ? F.G / 2 : 1);
        if ((int)blockIdx.x < ncw) {
            pg8::CmpSched S{(const char*)(F.ws + slot_off(SL_KCMP)), (const char*)(F.ws + WS_CW1), 2048, ncw, (int)blockIdx.x};
            pg8::CmpEpi E{WSP(float, WS_SMALL), WSP(bf16_t, WS_CHID)};
            pg8::gemm_phase<pg8::CmpEpi, pg8::CmpSched>(F.lds, F.wave, 2048, S, E);
            VM_WAIT(); __syncthreads();
            pg8::Unit u; for (int i = 0; S.next(i, u); ++i) pd_compress_stage2(F, args, u.pm);
        }
        if ((int)blockIdx.x >= ncw || F.G == 1) {
            att::Ctx C; C.lds = F.lds; C.lane = 0; C.r32 = 0; C.hi = 0; C.wid = F.wave; C.lds0 = (unsigned)(size_t)F.lds;
            const int nd = F.G == 1 ? 1 : F.G - ncw, c = F.G == 1 ? 0 : (int)blockIdx.x - ncw;
            for (int u = c; u < 1536; u += nd) att::dil_unit(C, F.ws, u, (bf16_t*)(F.ws + WS_H + 64 * MiB), WSP(float, WS_LSE));
        }
    } SEAM(3);
    if (IN(4)) {
        att::Ctx C; C.lds = F.lds; C.lane = 0; C.r32 = 0; C.hi = 0; C.wid = F.wave; C.lds0 = (unsigned)(size_t)F.lds;
        for (int v = F.vcu; v < 256; v += F.G) {
            const int bh = v >> 2, k = v & 3, b = bh >> 1, hk = bh & 1;
            for (int i = 0; i < 8; ++i) { const int blk = (i & 1) ? (8 * (i >> 1) + 7 - k) : (8 * (i >> 1) + k); att::nsa_unit(C, F.ws, b, hk, 31 - blk, F.ws + WS_Y); }
        }
        pf1_scale_ob(F);
    } SEAM(4);
    if (IN(5)) {
        pg8::DenseSched S; S.init(F.ws + WS_Y, 512, F.ws + WS_WUPA, 512, NT_TOK, DM, F.G, (int)blockIdx.x);
        pg8::Up2Epi E{F.ws, F.ws + WS_R1 + 64 * MiB};
        pg8::gemm_phase<pg8::Up2Epi, pg8::DenseSched, true, true>(F.lds, F.wave, 512, S, E);
    } SEAM(5);
    if (IN(7)) {
#ifdef PF3_FP8
        pg8::DenseSched S; S.init(F.ws + WS_R1 + 64 * MiB, 512, WSP(bf16_t, WS_WOUT), 512, NT_TOK, DM, F.G, (int)blockIdx.x);
#ifdef X1_BF16
        pg8::OutEpi E{(const float*)args.in[0], WSP(float, WS_Y), WSP(float, WS_MOD), WSP(float, WS_ROWSS), 1.0f / (16.f * 64.f)};
#else
        pg8::OutEpi E{(const float*)args.in[0], args.out, WSP(float, WS_MOD), WSP(float, WS_ROWSS), 1.0f / (16.f * 64.f)};
#endif
        pg8::gemm_phase<pg8::OutEpi, pg8::DenseSched, true, true>(F.lds, F.wave, 512, S, E);
#else
        pg8::DenseSched S; S.init(WSP(bf16_t, WS_Y), 1024, WSP(bf16_t, WS_WOUT), 1024, NT_TOK, DM, F.G, (int)blockIdx.x);
        pg8::OutEpi E{(const float*)args.in[0], args.out, WSP(float, WS_MOD), WSP(float, WS_ROWSS), 1.0f};
        pg8::gemm_phase<pg8::OutEpi, pg8::DenseSched>(F.lds, F.wave, 1024, S, E);
#endif
    } SEAM(7);
    if (IN(8)) { pf4_router(F, args);
#if defined(PROBE_DRY) && PROBE_DRY == 8
        GRID_BAR(); pf4_router(F, args, true);
#endif
    } SEAM(8);
    if (IN(9)) {
        moe_tables(F);
        pg8::MoeSched S{(const char*)(F.ws + WS_H), (const char*)(F.ws + WS_WGU), 512, 512, (size_t)1024 * 1024, true, F.lds, F.G, F.vcu};
        moe_fill_tokens(F, S);
        pg8::GuEpi E{WSP(unsigned char, WS_R2)};
        pg8::gemm_phase<pg8::GuEpi, pg8::MoeSched, true, true>(F.lds, F.wave, 512, S, E);
    } SEAM(9);
    if (IN(10)) {
        moe_tables(F);
        pg8::MoeSched S{(const char*)(F.ws + WS_R2), (const char*)(F.ws + WS_WD), 256, 256, (size_t)1024 * 512, false, F.lds, F.G, F.vcu};
        pg8::YEpi E{F.ws + WS_R1, 16.0f / (8.0f * 64.0f), args.ph_hi == 101};
#ifndef PH_ALIGN
#define PH_ALIGN true
#endif
        pg8::gemm_phase<pg8::YEpi, pg8::MoeSched, PH_ALIGN, true>(F.lds, F.wave, 256, S, E);
    } SEAM(10);
    if (IN(11)) { moe_tables(F); pi_combine(F, args);
#if defined(PROBE_DRY) && PROBE_DRY == 11
        GRID_BAR(); pi_combine(F, args, 0.0f);
#endif
    }
#undef IN
#undef SEAM
}

#ifdef PROBE_MFMA
__global__ void __launch_bounds__(512, 2) probe_mfma(float* sink, int iters) {
    typedef int v8i __attribute__((ext_vector_type(8)));
    const unsigned lane = threadIdx.x;
    v8i a[4], b[4];
    for (int i = 0; i < 4; ++i) for (int j = 0; j < 8; ++j) { unsigned h = lane * 2654435761u + i * 40503u + j * 9973u; h ^= h >> 13; h *= 0x5bd1e995u; h ^= h >> 15; a[i][j] = (int)(h & 0xbfbfbfbfu); h *= 0x9e3779b1u; h ^= h >> 11; b[i][j] = (int)(h & 0xbfbfbfbfu); }
    f32x4 acc[16];
    for (int i = 0; i < 16; ++i) acc[i] = (f32x4){0.f, 0.f, 0.f, 0.f};
#pragma unroll 1
    for (int it = 0; it < iters; ++it) {
#if PROBE_MFMA == 1
#pragma unroll
        for (int i = 0; i < 16; ++i) asm volatile("v_mfma_f32_16x16x128_f8f6f4 %0, %1, %2, %0" : "+v"(acc[i]) : "v"(a[i & 3]), "v"(b[i >> 2]));
#else
#pragma unroll
        for (int i = 0; i < 16; ++i) { bf16x8 x0, x1, y0, y1;
            for (int j = 0; j < 4; ++j) { ((int*)&x0)[j] = a[i & 3][j] & 0x3fff3fff; ((int*)&x1)[j] = a[i & 3][4 + j] & 0x3fff3fff; ((int*)&y0)[j] = b[i >> 2][j] & 0x3fff3fff; ((int*)&y1)[j] = b[i >> 2][4 + j] & 0x3fff3fff; }
            asm volatile("v_mfma_f32_16x16x32_bf16 %0, %1, %2, %0\n\tv_mfma_f32_16x16x32_bf16 %0, %3, %4, %0" : "+v"(acc[i]) : "v"(x0), "v"(y0), "v"(x1), "v"(y1)); }
#endif
    }
    asm volatile("s_nop 15\n\ts_nop 15" ::: "memory");
    float sum = 0.f; for (int i = 0; i < 16; ++i) sum += acc[i][0] + acc[i][1] + acc[i][2] + acc[i][3];
    if (sum == 12345.678f) sink[0] = sum;
}
#endif
extern "C" void kernel_launch(void* const* d_in, const int* in_sizes, int n_in, void* d_out, int out_size, void* d_ws, size_t ws_size, hipStream_t stream) {
    static int grid = 0;
    if (grid == 0) {
        if (n_in != 28 || in_sizes[0] != NT_TOK * DM || out_size != NT_TOK * DM || ws_size < WS_END) {
            fprintf(stderr, "kernel_launch: shape/workspace mismatch (n_in %d, in0 %d, out %d, ws %zu, need %zu)\n", n_in, n_in > 0 ? in_sizes[0] : -1, out_size, ws_size, (size_t)WS_END); grid = -1; return; }
        int dev = 0, cus = 0, per_cu = 0;
        hipGetDevice(&dev); hipDeviceGetAttribute(&cus, hipDeviceAttributeMultiprocessorCount, dev);
        if (hipFuncSetAttribute((const void*)mk_fwd, hipFuncAttributeMaxDynamicSharedMemorySize, LDS_BYTES) != hipSuccess) { fprintf(stderr, "kernel_launch: hipFuncSetAttribute failed\n"); grid = -1; return; }
        if (hipOccupancyMaxActiveBlocksPerMultiprocessor(&per_cu, (const void*)mk_fwd, 512, LDS_BYTES) != hipSuccess || per_cu < 1) { fprintf(stderr, "kernel_launch: occupancy query says %d blocks per CU\n", per_cu); per_cu = 1; }
        (void)hipGetLastError();
        grid = cus;
        fprintf(stderr, "kernel_launch: %d CUs, occupancy %d, grid %d\n", cus, per_cu, grid);
    }
    if (grid < 0) return;
    hipMemsetAsync((char*)d_ws + WS_CTL, 0, CTL_ZERO_BYTES, stream);
    Args a{};
    for (int i = 0; i < 28; ++i) a.in[i] = d_in[i];
    a.out = (float*)d_out; a.ws = (unsigned char*)d_ws;
#if MK_MODE == 0
#ifdef PROBE_NOSTORE
    for (int p = 0; p < NPHASE; ++p) { a.ph_lo = p; a.ph_hi = p + 1; hipLaunchKernelGGL(mk_fwd, dim3(grid), dim3(512), LDS_BYTES, stream, a);
        if (p == 10) { a.ph_lo = 10; a.ph_hi = 101; hipLaunchKernelGGL(mk_fwd, dim3(grid), dim3(512), LDS_BYTES, stream, a); } }
    if (0)
#endif
#ifdef PROBE_NOEPI
    for (int p = 0; p < NPHASE; ++p) { a.ph_lo = p; a.ph_hi = p + 1; hipLaunchKernelGGL(mk_fwd, dim3(grid), dim3(512), LDS_BYTES, stream, a);
        if (p == 2) { a.ph_lo = 2; a.ph_hi = PROBE_NOEPI == 2 ? 102 : 100; hipLaunchKernelGGL(mk_fwd, dim3(grid), dim3(512), LDS_BYTES, stream, a); } }
    if (0)
#endif
    for (int p = 0; p < NPHASE; ++p) for (int r = 0; r < REPS(p); ++r) { a.ph_lo = p; a.ph_hi = p + 1; hipLaunchKernelGGL(mk_fwd, dim3(grid), dim3(512), LDS_BYTES, stream, a); }
#ifdef PROBE_MFMA
    hipFuncSetAttribute((const void*)probe_mfma, hipFuncAttributeMaxDynamicSharedMemorySize, LDS_BYTES);
    hipLaunchKernelGGL(probe_mfma, dim3(grid), dim3(512), LDS_BYTES, stream, (float*)((char*)d_ws + WS_CTL), PROBE_ITERS);
#endif
#elif MK_MODE == 1
    a.ph_lo = 0; a.ph_hi = NPHASE;
    void* kargs[] = {&a};
    hipError_t e = hipLaunchCooperativeKernel((const void*)mk_fwd, dim3(grid), dim3(512), kargs, LDS_BYTES, stream);
    if (e != hipSuccess) fprintf(stderr, "cooperative launch failed: %s (grid %d)\n", hipGetErrorString(e), grid);
#else
    a.ph_lo = 0; a.ph_hi = NPHASE;
    hipLaunchKernelGGL(mk_fwd, dim3(grid), dim3(512), LDS_BYTES, stream, a);
#endif
}
```

```cpp
#include <hip/hip_runtime.h>
#include <hip/hip_cooperative_groups.h>
#include <cstdio>
#include <cstdint>
#include <cmath>
namespace cg = cooperative_groups;

#ifndef PC_BF16
#define PC_FP8 1
#endif
#ifndef NSA_MERGED_PASSES
#define NSA_SPLIT_PASSES 1
#endif
#ifndef X1_AS_F32
#define X1_BF16 1
#endif
#ifndef PF3_BF16
#define PF3_FP8 1
#endif
#define LAS __attribute__((address_space(3)))
#define GAS __attribute__((address_space(1)))
typedef unsigned short bf16_t;
typedef short bf16x8 __attribute__((ext_vector_type(8)));
typedef short s16x4 __attribute__((ext_vector_type(4)));
typedef float f32x2 __attribute__((ext_vector_type(2)));
typedef float f32x4 __attribute__((ext_vector_type(4)));
typedef float f32x16 __attribute__((ext_vector_type(16)));
typedef unsigned u32x2 __attribute__((ext_vector_type(2)));
typedef unsigned u32x4 __attribute__((ext_vector_type(4)));
typedef __bf16 bf16x2_t __attribute__((ext_vector_type(2)));

constexpr int NB = 32, SEQ = 2048, NT_TOK = NB * SEQ, DM = 1024;
constexpr int IN_COLS = 4504, NSLOT = 72, NPROJ = NSLOT * 64;
constexpr int NEXP = 32, EFF = 512;
constexpr float EPS = 1e-6f;
constexpr float C2 = 0.125f * 1.4426950408889634f;
constexpr int SL_QA = 0, SL_KCMP = 8, SL_VCMP = 10, SL_KSLC = 12, SL_VSLC = 14, SL_KWIN = 16, SL_VWIN = 18, SL_QB = 20, SL_KB = 26, SL_VB = 32, SL_GMA = 38, SL_GMB = 54, SL_GA = 70;

constexpr size_t MiB = 1u << 20;
constexpr size_t WS_CTL = 0, CTL_ZERO_BYTES = 256 * 1024;
constexpr size_t WS_MOD = 1 * MiB;
constexpr size_t WS_SMALL = 2 * MiB;
constexpr size_t WS_ROPE = 3 * MiB;
constexpr size_t WS_CROPE = 19 * MiB;
constexpr size_t WS_WIN = 20 * MiB;
constexpr size_t WS_WUPA = 29 * MiB;
constexpr size_t WS_WUPB = 30 * MiB;
constexpr size_t WS_WOUT = 31 * MiB;
constexpr size_t WS_CW1 = 33 * MiB;
constexpr size_t WS_CW2 = 35 * MiB;
constexpr size_t WS_WGU = 36 * MiB;
constexpr size_t WS_WD = 100 * MiB;
constexpr size_t WS_KC = 132 * MiB;
constexpr size_t WS_CHID = 134 * MiB;
constexpr size_t WS_LSE = 142 * MiB;
constexpr size_t WS_ROWSS = 144 * MiB;
constexpr size_t WS_PICK = 148 * MiB;
constexpr size_t WS_LIST = 150 * MiB;
constexpr size_t WS_H = 160 * MiB;
constexpr size_t WS_Y = 288 * MiB;
constexpr size_t WS_R1 = 416 * MiB;
constexpr size_t WS_R2 = 720 * MiB;
constexpr size_t WS_END = 992 * MiB;
constexpr size_t SLOT_BYTES = (size_t)NT_TOK * 64 * 2;
__host__ __device__ __forceinline__ size_t slot_off(int s) { return s < 38 ? WS_R1 + (size_t)s * SLOT_BYTES : WS_R2 + (size_t)(s - 38) * SLOT_BYTES; }
constexpr int CW_BAR = 4096;
constexpr int CW_CNT = 16384;

constexpr int LDS_BYTES = 163840;
constexpr int LDS_STAGE = 0;
constexpr int LDS_X = 131072;
constexpr int LDS_MISC = LDS_BYTES - 256;
constexpr int LDS_TOK = 135168;
constexpr int LDS_EXP = 147456;

__device__ __forceinline__ int lane_now() { int l; asm volatile("v_mbcnt_lo_u32_b32 %0, -1, 0\n\tv_mbcnt_hi_u32_b32 %0, -1, %0" : "=v"(l)); return l; }
#define RLX_AGENT __ATOMIC_RELAXED, __HIP_MEMORY_SCOPE_AGENT
#define LDS_WAIT() asm volatile("s_waitcnt lgkmcnt(0)" ::: "memory")
#define VM_WAIT() asm volatile("s_waitcnt vmcnt(0)" ::: "memory")
__device__ __forceinline__ unsigned cvtpk(float lo, float hi) { f32x2 v = {lo, hi}; bf16x2_t b = __builtin_convertvector(v, bf16x2_t); return __builtin_bit_cast(unsigned, b); }
__device__ __forceinline__ unsigned pk4_fp8(float a, float b, float c, float d) { int w = 0; w = __builtin_amdgcn_cvt_pk_fp8_f32(a, b, w, false); w = __builtin_amdgcn_cvt_pk_fp8_f32(c, d, w, true); return (unsigned)w; }
__device__ __forceinline__ float clamp448(float x) { return __builtin_amdgcn_fmed3f(x, -448.f, 448.f); }
__device__ __forceinline__ float bf2f(unsigned short h) { return __uint_as_float(((unsigned)h) << 16); }
__device__ __forceinline__ float bflo(unsigned w) { return __uint_as_float(w << 16); }
__device__ __forceinline__ float bfhi(unsigned w) { return __uint_as_float(w & 0xffff0000u); }
__device__ __forceinline__ float wave_sum(float v) {
    v += __uint_as_float(__builtin_amdgcn_update_dpp(0u, __float_as_uint(v), 0xB1, 0xf, 0xf, true));
    v += __uint_as_float(__builtin_amdgcn_update_dpp(0u, __float_as_uint(v), 0x4E, 0xf, 0xf, true));
    v += __uint_as_float(__builtin_amdgcn_update_dpp(0u, __float_as_uint(v), 0x141, 0xf, 0xf, true));
    v += __uint_as_float(__builtin_amdgcn_update_dpp(0u, __float_as_uint(v), 0x140, 0xf, 0xf, true));
    v += __uint_as_float(__builtin_amdgcn_update_dpp(0u, __float_as_uint(v), 0x142, 0xa, 0xf, false));
    v += __uint_as_float(__builtin_amdgcn_update_dpp(0u, __float_as_uint(v), 0x143, 0xc, 0xf, false));
    return __uint_as_float(__builtin_amdgcn_readlane(__float_as_uint(v), 63));
}
__device__ __forceinline__ float sigmoidf_(float x) { return __builtin_amdgcn_rcpf(1.0f + __builtin_amdgcn_exp2f(-1.4426950408889634f * x)); }
__device__ __forceinline__ float siluf_(float x) { return x * __builtin_amdgcn_rcpf(1.0f + __builtin_amdgcn_exp2f(-1.4426950408889634f * x)); }
__host__ __device__ __forceinline__ int slot_col0(int H) { return H < 8 ? 64 * H : H < 20 ? 512 + 64 * (H - 8) : H < 38 ? 1304 + 64 * (H - 20) : H < 70 ? 2456 + 64 * (H - 38) : H == 70 ? 1280 : 0; }
__host__ __device__ __forceinline__ int slot_valid(int H) { return H < 70 ? 64 : H == 70 ? 24 : 0; }

#define XB_TMO      128
#define XB_XCNT(j)  (256  + 64 * (j))
#define XB_XSUB(j)  (1280 + 64 * (j))
#define XB_XGEN(j)  (2304 + 64 * (j))
#define XB_TOP      3328
#define XB_TOPGEN   3392
#define XCD_BAR_WORDS 3456
#define XB_SPIN_CAP (1u << 22)
__device__ __forceinline__ unsigned xb_ld(unsigned* p)              { return __hip_atomic_load(p, __ATOMIC_RELAXED, __HIP_MEMORY_SCOPE_AGENT); }
__device__ __forceinline__ unsigned xb_add(unsigned* p, unsigned v) { return __hip_atomic_fetch_add(p, v, __ATOMIC_RELAXED, __HIP_MEMORY_SCOPE_AGENT); }
__device__ __forceinline__ unsigned xb_xcc_id() { return (unsigned)__builtin_amdgcn_s_getreg((3 << 11) | 20) & 0xFu; }
#define XB_SPIN(cond, bar) do { unsigned _sp = 0; while (cond) { __builtin_amdgcn_s_sleep(1); \
    if ((++_sp & 255u) == 0u) { if (xb_ld(&(bar)[XB_TMO])) break; if (_sp > XB_SPIN_CAP) { atomicAdd(&(bar)[XB_TMO], 1u); break; } } } } while (0)
struct XcdBarrier { unsigned* bar; unsigned x; volatile LAS unsigned* st; int wave; };
__device__ __forceinline__ XcdBarrier xcd_barrier_post(unsigned* bar, volatile LAS unsigned* st, int wave) {
    XcdBarrier b; b.bar = bar; b.x = xb_xcc_id(); b.st = st; b.wave = wave;
    if (wave == 0 && lane_now() == 0) (void)xb_add(&bar[XB_XCNT(b.x)], 1u);
    return b;
}
__device__ __forceinline__ void xcd_barrier_complete(unsigned* bar, unsigned x, unsigned& nloc, unsigned& nx) {
    const unsigned G = gridDim.x * gridDim.y * gridDim.z;
    unsigned sum, cnt, mine, sp = 0u;
    for (;;) {
        sum = 0u; cnt = 0u; mine = 0u;
#pragma unroll
        for (unsigned j = 0; j < 16; ++j) { const unsigned c = xb_ld(&bar[XB_XCNT(j)]); sum += c; cnt += (c > 0u) ? 1u : 0u; mine = (j == x) ? c : mine; }
        if (sum == G) break;
        __builtin_amdgcn_s_sleep(1);
        if ((++sp & 255u) == 0u) { if (xb_ld(&bar[XB_TMO])) break; if (sp > XB_SPIN_CAP) { atomicAdd(&bar[XB_TMO], 1u); break; } }
    }
    nloc = mine > 0u ? mine : 1u; nx = cnt > 0u ? cnt : 1u;
}
__device__ __forceinline__ void xcd_barrier(const XcdBarrier& b) {
    asm volatile("s_waitcnt vmcnt(0)" ::: "memory");
    __syncthreads();
    if (b.wave == 0 && lane_now() == 0) {
        unsigned* bar = b.bar;
        __builtin_amdgcn_s_waitcnt(0);
        unsigned nloc = b.st[0], nx = b.st[1];
        if (nloc == 0u) { xcd_barrier_complete(bar, b.x, nloc, nx); b.st[0] = nloc; b.st[1] = nx; }
        const unsigned old = xb_add(&bar[XB_XSUB(b.x)], 1u);
        const unsigned gen = old / nloc;
        if (old + 1u == (gen + 1u) * nloc) {
            __builtin_amdgcn_fence(__ATOMIC_RELEASE, "agent");
            asm volatile("s_waitcnt vmcnt(0)" ::: "memory");
            const unsigned og = xb_add(&bar[XB_TOP], 1u);
            const unsigned tg = og / nx;
            if (og + 1u == (tg + 1u) * nx) xb_add(&bar[XB_TOPGEN], 1u);
            else XB_SPIN(xb_ld(&bar[XB_TOPGEN]) == tg, bar);
            __builtin_amdgcn_fence(__ATOMIC_ACQUIRE, "agent");
            xb_add(&bar[XB_XGEN(b.x)], 1u);
            asm volatile("s_waitcnt vmcnt(0)" ::: "memory");
        } else {
            XB_SPIN(xb_ld(&bar[XB_XGEN(b.x)]) == gen, bar);
            __builtin_amdgcn_fence(__ATOMIC_ACQUIRE, "agent");
            asm volatile("s_waitcnt vmcnt(0)" ::: "memory");
        }
    }
    __syncthreads();
}
namespace pg8 {
constexpr int BM = 256, BK = 64, HALF = 128, HTB = HALF * BK * 2, STAGE_BYTES = 8 * HTB;
__host__ __device__ __forceinline__ int lds_byte(int r, int c) { const int st = (r >> 4) * 2 + (c >> 5), rr = r & 15, cc = c & 31, ob = rr * 64 + cc * 2; return st * 1024 + (ob ^ (((ob >> 9) & 1) << 5)); }
__host__ __device__ __forceinline__ void stage_rc(int b, int& R, int& C) { const int st = b / 1024, sb = b % 1024, swz = sb ^ (((sb >> 9) & 1) << 5); R = (st >> 1) * 16 + swz / 64; C = (st & 1) * 32 + (swz % 64) / 2; }
__host__ __device__ __forceinline__ int perm32(int rho) { const int n = rho >> 4, i = rho & 15; return 8 * (i >> 2) + 4 * n + (i & 3); }

typedef int v4i_t __attribute__((ext_vector_type(4)));
typedef int v8i_t __attribute__((ext_vector_type(8)));
struct Unit { int pm, pn, e, mt; };

template <int N> __device__ __forceinline__ void waitv_n() {
    static_assert(N == 8 || N == 16 || N == 24 || N == 40, "add the immediate");
    if constexpr (N == 8) asm volatile("s_waitcnt vmcnt(8)" ::: "memory");
    else if constexpr (N == 16) asm volatile("s_waitcnt vmcnt(16)" ::: "memory");
    else if constexpr (N == 24) asm volatile("s_waitcnt vmcnt(24)" ::: "memory");
    else asm volatile("s_waitcnt vmcnt(40)" ::: "memory");
}
template <class Epi, class Sched, bool ALIGN_EPI = true, bool FP8 = false>
__device__ __forceinline__ void gemm_phase(LAS unsigned char* lds, const int wid, const int K, const Sched& S, const Epi& E) {
    const int lane = lane_now(), tid = wid * 64 + lane, wr = wid >> 2, wc = wid & 3, fr = lane & 15, fq = lane >> 4;
    const int nt = K / BK;
    int Rr[2], Cc[2]; unsigned voffB[2];
#pragma unroll
    for (int i = 0; i < 2; ++i) { stage_rc(tid * 16 + i * 8192, Rr[i], Cc[i]); const int Rb = Epi::PERM ? ((Rr[i] & ~31) + perm32(Rr[i] & 31)) : Rr[i];
        voffB[i] = (unsigned)(Rb * S.ldb + Cc[i]) * 2u; }
    const size_t kstep = (size_t)(BK * 2);
    const size_t hstepB = (size_t)HALF * S.ldb * 2;
    const unsigned ldsw = (unsigned)wid * 1024u;
    const int aoff = lds_byte(wr * 64 + fr, fq * 8), boff = lds_byte(wc * 32 + fr, fq * 8);
#define PG8_SA(b, h) (((b) * 2 + (h)) * HTB)
#define PG8_SB(b, h) ((4 + (b) * 2 + (h)) * HTB)
#ifdef PROBE_SKIP
#define PG8_SK(bit) (E.noepi && (PROBE_SKIP & (bit)))
#else
#define PG8_SK(bit) false
#endif
#define PG8_STAGE(bufoff, gbase, voff) do { if (!PG8_SK(1)) _Pragma("unroll") for (int _i = 0; _i < 2; ++_i) \
        __builtin_amdgcn_global_load_lds((const unsigned*)((const char*)(gbase) + (voff)[_i]), (LAS unsigned*)(lds + (bufoff) + ldsw + _i * 8192), 16, 0, 0); } while (0)
#define PG8_LDA(dst, b, h) do { if (PG8_SK(2)) {} else if constexpr (FP8) { _Pragma("unroll") for (int m = 0; m < 4; ++m) { const v4i_t lo_ = *(const LAS v4i_t*)(lds + PG8_SA(b, h) + aoff + m * 2048), hi_ = *(const LAS v4i_t*)(lds + PG8_SA(b, h) + aoff + m * 2048 + 1024); \
            dst##8[m] = __builtin_shufflevector(lo_, hi_, 0, 1, 2, 3, 4, 5, 6, 7); } } \
        else { _Pragma("unroll") for (int m = 0; m < 4; ++m) _Pragma("unroll") for (int k = 0; k < 2; ++k) dst[m][k] = *(const LAS bf16x8*)(lds + PG8_SA(b, h) + aoff + m * 2048 + k * 1024); } } while (0)
#define PG8_LDB(dst, b, h) do { if (PG8_SK(2)) {} else if constexpr (FP8) { _Pragma("unroll") for (int n = 0; n < 2; ++n) { const v4i_t lo_ = *(const LAS v4i_t*)(lds + PG8_SB(b, h) + boff + n * 2048), hi_ = *(const LAS v4i_t*)(lds + PG8_SB(b, h) + boff + n * 2048 + 1024); \
            dst##8[n] = __builtin_shufflevector(lo_, hi_, 0, 1, 2, 3, 4, 5, 6, 7); } } \
        else { _Pragma("unroll") for (int n = 0; n < 2; ++n) _Pragma("unroll") for (int k = 0; k < 2; ++k) dst[n][k] = *(const LAS bf16x8*)(lds + PG8_SB(b, h) + boff + n * 2048 + k * 1024); } } while (0)
#ifdef PROBE_HALF
#define PG8_SKIP(ai) (E.noepi && (ai) >= PROBE_HALF)
#else
#define PG8_SKIP(ai) false
#endif
#define PG8_MMA(ai, bj, At, Bt) do { __builtin_amdgcn_s_setprio(1); \
        if (PG8_SKIP(ai)) {} else if constexpr (FP8) { _Pragma("unroll") for (int m = 0; m < 4; ++m) _Pragma("unroll") for (int n = 0; n < 2; ++n) \
            asm volatile("v_mfma_f32_16x16x128_f8f6f4 %0, %1, %2, %0" : "+v"(acc[ai][bj][m][n]) : "v"(Bt##8[n]), "v"(At##8[m])); } \
        else { _Pragma("unroll") for (int m = 0; m < 4; ++m) _Pragma("unroll") for (int n = 0; n < 2; ++n) _Pragma("unroll") for (int k = 0; k < 2; ++k) \
            acc[ai][bj][m][n] = __builtin_amdgcn_mfma_f32_16x16x32_bf16(Bt[n][k], At[m][k], acc[ai][bj][m][n], 0, 0, 0); } \
        __builtin_amdgcn_s_setprio(0); } while (0)
#define PG8_MMA0(ai, bj, At, Bt) do { __builtin_amdgcn_s_setprio(1); \
        _Pragma("unroll") for (int m = 0; m < 4; ++m) _Pragma("unroll") for (int n = 0; n < 2; ++n) \
            asm volatile("v_mfma_f32_16x16x128_f8f6f4 %0, %1, %2, 0" : "=&v"(acc[ai][bj][m][n]) : "v"(Bt##8[n]), "v"(At##8[m])); \
        __builtin_amdgcn_s_setprio(0); } while (0)
#define PG8_WAIT_V(n) asm volatile("s_waitcnt vmcnt(" #n ")" ::: "memory")
#ifndef WV_A
#define WV_A 8
#define WV_B 8
#endif
#define PG8_STR2(x) #x
#define PG8_STR(x) PG8_STR2(x)
#define PG8_WAIT_V_A asm volatile("s_waitcnt vmcnt(" PG8_STR(WV_A) ")" ::: "memory")
#define PG8_WAIT_V_B asm volatile("s_waitcnt vmcnt(" PG8_STR(WV_B) ")" ::: "memory")
#ifdef PG8_RELAX_FIRST
#define PG8_WAIT_V_FIRST do { if (FP8 && Epi::NSTORE > 0 && t == 0 && ui > 0) waitv_n<8 + (Epi::NSTORE > 0 ? Epi::NSTORE : 0)>(); else PG8_WAIT_V_A; } while (0)
#else
#define PG8_WAIT_V_FIRST PG8_WAIT_V_A
#endif
#define PG8_WAIT_L(n) asm volatile("s_waitcnt lgkmcnt(" #n ")" ::: "memory")
#define PG8_BAR __builtin_amdgcn_s_barrier()
#define PG8_SCHED __builtin_amdgcn_sched_barrier(0)
    Unit cur, nxt; int ui = 0;
    if (!S.next(0, cur)) return;
    if constexpr (Epi::DEPHASE > 1) {
        const unsigned slot = (unsigned)S.dephase_id() % Epi::DEPHASE;
        const unsigned long long t0 = __builtin_amdgcn_s_memrealtime(), dl = (unsigned long long)(slot * (unsigned)Epi::DEPHASE_TICKS) / Epi::DEPHASE;
        while (__builtin_amdgcn_s_memrealtime() - t0 < dl) __builtin_amdgcn_s_sleep(8);
    }
    f32x4 acc[2][2][4][2];
    if constexpr (!FP8) {
#pragma unroll
    for (int a = 0; a < 2; ++a)
#pragma unroll
        for (int b = 0; b < 2; ++b)
#pragma unroll
            for (int m = 0; m < 4; ++m)
#pragma unroll
                for (int n = 0; n < 2; ++n) acc[a][b][m][n] = (f32x4){0.f, 0.f, 0.f, 0.f};
    }
    bf16x8 At[4][2], B0[2][2], B1[2][2]; v8i_t At8[4], B08[2], B18[2];
#ifdef PROBE_SKIP
    for (int m = 0; m < 4; ++m) At8[m] = (v8i_t){0,0,0,0,0,0,0,0}; for (int n = 0; n < 2; ++n) { B08[n] = At8[0]; B18[n] = At8[0]; }
#endif
    unsigned vaC[2][2], vaN[2][2];
#pragma unroll
    for (int h = 0; h < 2; ++h)
#pragma unroll
        for (int i = 0; i < 2; ++i) vaC[h][i] = S.a_voff(cur, 0, h, Rr[i], Cc[i]);
    const char* cA = S.a_base(cur); const char* cB = S.b_base(cur);
    PG8_STAGE(PG8_SB(0, 0), cB, voffB); PG8_STAGE(PG8_SB(0, 1), cB + hstepB, voffB); PG8_STAGE(PG8_SA(0, 0), cA, vaC[0]); PG8_STAGE(PG8_SA(0, 1), cA, vaC[1]);
    if (wr == 1) PG8_BAR;
    PG8_WAIT_V(2); PG8_BAR;
    PG8_STAGE(PG8_SB(1, 0), cB + kstep, voffB); PG8_STAGE(PG8_SA(1, 0), cA + kstep, vaC[0]); PG8_STAGE(PG8_SB(1, 1), cB + hstepB + kstep, voffB);
    PG8_WAIT_V(6); PG8_BAR;
    for (;;) {
        const bool has_next = S.next(ui + 1, nxt);
        const char* nA = cA; const char* nB = cB;
        if (has_next) { nA = S.a_base(nxt); nB = S.b_base(nxt);
#pragma unroll
            for (int h = 0; h < 2; ++h)
#pragma unroll
                for (int i = 0; i < 2; ++i) vaN[h][i] = S.a_voff(nxt, ui + 1, h, Rr[i], Cc[i]);
        } else {
#pragma unroll
            for (int h = 0; h < 2; ++h)
#pragma unroll
                for (int i = 0; i < 2; ++i) vaN[h][i] = vaC[h][i];
        }
#pragma unroll 1
        for (int t = 0; t < nt; t += 2) {
            const bool last = (t == nt - 2);
            const char* a1 = cA + (size_t)(t + 1) * kstep;
            const char* a2 = last ? nA : cA + (size_t)(t + 2) * kstep; const char* b2 = last ? nB : cB + (size_t)(t + 2) * kstep;
            const char* a3 = a2 + kstep; const char* b3 = b2 + kstep;
            unsigned va2[2][2];
#pragma unroll
            for (int h = 0; h < 2; ++h)
#pragma unroll
                for (int i = 0; i < 2; ++i) va2[h][i] = last ? vaN[h][i] : vaC[h][i];
            PG8_LDB(B0, 0, 0); PG8_LDB(B1, 0, 1); PG8_SCHED; PG8_LDA(At, 0, 0); PG8_STAGE(PG8_SA(1, 1), a1, vaC[1]);
            PG8_WAIT_V_FIRST; PG8_WAIT_L(0); PG8_BAR; if (FP8 && t == 0) { PG8_MMA0(0, 0, At, B0); PG8_MMA0(0, 1, At, B1); } else { PG8_MMA(0, 0, At, B0); PG8_MMA(0, 1, At, B1); } PG8_BAR; PG8_SCHED;
            PG8_LDA(At, 0, 1); PG8_STAGE(PG8_SB(0, 0), b2, voffB); PG8_STAGE(PG8_SB(0, 1), b2 + hstepB, voffB); PG8_STAGE(PG8_SA(0, 0), a2, va2[0]);
            PG8_WAIT_V_FIRST; PG8_WAIT_L(0); PG8_BAR; if (FP8 && t == 0) { PG8_MMA0(1, 0, At, B0); PG8_MMA0(1, 1, At, B1); } else { PG8_MMA(1, 0, At, B0); PG8_MMA(1, 1, At, B1); } PG8_BAR; PG8_SCHED;
            PG8_LDB(B0, 1, 0); PG8_LDB(B1, 1, 1); PG8_SCHED; PG8_LDA(At, 1, 0); PG8_STAGE(PG8_SA(0, 1), a2, va2[1]);
            PG8_WAIT_V_A; PG8_WAIT_L(0); PG8_BAR; PG8_MMA(0, 0, At, B0); PG8_MMA(0, 1, At, B1); PG8_BAR; PG8_SCHED;
            PG8_LDA(At, 1, 1); PG8_STAGE(PG8_SB(1, 0), b3, voffB); PG8_STAGE(PG8_SB(1, 1), b3 + hstepB, voffB); PG8_STAGE(PG8_SA(1, 0), a3, va2[0]);
            PG8_WAIT_V_B; PG8_WAIT_L(0); PG8_BAR; PG8_MMA(1, 0, At, B0); PG8_MMA(1, 1, At, B1); PG8_BAR; PG8_SCHED;
            if constexpr (Epi::MIDK > 0) { if (t + 2 == Epi::MIDK) {
                if constexpr (FP8) asm volatile("s_nop 15\n\ts_nop 15" ::: "memory");
                int fr_ = fr, fq_ = fq; asm volatile("" : "+v"(fr_), "+v"(fq_)); E.mid(acc, cur, wr, wc, fr_, fq_); } }
        }
        if constexpr (ALIGN_EPI) { if (wr == 0) PG8_BAR; }
        if constexpr (FP8) asm volatile("s_nop 15\n\ts_nop 15" ::: "memory");
#ifdef PROBE_NOEPI
        if (!E.noepi)
#endif
        { int fr_ = fr, fq_ = fq; asm volatile("" : "+v"(fr_), "+v"(fq_)); E(acc, cur, ui, wr, wc, fr_, fq_); }
        if (!has_next) break;
        if constexpr (!FP8) {
#pragma unroll
        for (int a = 0; a < 2; ++a)
#pragma unroll
            for (int b = 0; b < 2; ++b)
#pragma unroll
                for (int m = 0; m < 4; ++m)
#pragma unroll
                    for (int n = 0; n < 2; ++n) acc[a][b][m][n] = (f32x4){0.f, 0.f, 0.f, 0.f};
        }
        cur = nxt; cA = nA; cB = nB; ++ui;
#pragma unroll
        for (int h = 0; h < 2; ++h)
#pragma unroll
            for (int i = 0; i < 2; ++i) vaC[h][i] = vaN[h][i];
        if constexpr (ALIGN_EPI) { if (wr == 1) PG8_BAR; }
    }
    PG8_WAIT_V(0);
    if constexpr (!ALIGN_EPI) { if (wr == 0) PG8_BAR; }
    PG8_BAR;
#undef PG8_SA
#undef PG8_SB
#undef PG8_STAGE
#undef PG8_LDA
#undef PG8_LDB
#undef PG8_MMA
#undef PG8_MMA0
#undef PG8_WAIT_V
#undef PG8_WAIT_V_A
#undef PG8_WAIT_V_B
#undef PG8_WAIT_V_FIRST
#undef PG8_WAIT_L
#undef PG8_BAR
#undef PG8_SCHED
}

struct DenseSched {
    const char* A; const char* Bt; int lda, ldb; int nM, nN, nwg, G, c; bool hot = false;
    __device__ __forceinline__ void init(const void* A_, int lda_, const void* Bt_, int ldb_, int M, int N, int G_, int c_) {
        A = (const char*)A_; Bt = (const char*)Bt_; lda = lda_; ldb = ldb_; nM = M / BM; nN = N / BM; nwg = nM * nN; G = G_; c = c_; }
    __device__ __forceinline__ bool next(int i, Unit& u) const {
        const long L = (long)i * G + c; if (L >= nwg) return false;
        int wgid = (int)L; { const int q = nwg / 8, r = nwg % 8, xcd = wgid % 8, off = wgid / 8; wgid = (xcd < r ? xcd * (q + 1) : r * (q + 1) + (xcd - r) * q) + off; }
#ifndef DENSE_WGM
#define DENSE_WGM 8
#endif
        const int nig = DENSE_WGM * nN, gid = wgid / nig, fm = gid * DENSE_WGM, gsz = (nM - fm) < DENSE_WGM ? (nM - fm) : DENSE_WGM;
        u.pm = fm + ((wgid % nig) % gsz); u.pn = (wgid % nig) / gsz; u.e = 0; u.mt = 0; return true;
    }
#ifdef PROBE_HOT
    __device__ __forceinline__ const char* a_base(const Unit& u) const { return A + (size_t)(hot ? (c & 63) : u.pm) * BM * lda * 2; }
    __device__ __forceinline__ const char* b_base(const Unit& u) const { return Bt + (size_t)(hot ? (c & 15) : u.pn) * BM * ldb * 2; }
#else
    __device__ __forceinline__ const char* a_base(const Unit& u) const { return A + (size_t)u.pm * BM * lda * 2; }
    __device__ __forceinline__ const char* b_base(const Unit& u) const { return Bt + (size_t)u.pn * BM * ldb * 2; }
#endif
    __device__ __forceinline__ unsigned a_voff(const Unit&, int, int h, int R, int C) const { return (unsigned)((h * HALF + R) * lda + C) * 2u; }
    __device__ __forceinline__ int dephase_id() const { return c >> 3; }
};
}
struct Args { const void* in[28]; float* out; unsigned char* ws; int ph_lo, ph_hi; };
struct Frame {
    LAS unsigned char* lds; volatile LAS unsigned* MISC; unsigned* ctl; unsigned char* ws;
    int wave, vcu, G;
};
#define F_LANE() lane_now()
#define F_TID() (F.wave * 64 + lane_now())
#define WSP(T_, off) ((T_*)(F.ws + (off)))

__device__ __forceinline__ void transpose_item(const float* src, int src_ld, int k0, int n0, int nvalid, bf16_t* dst, int dst_ld, int drow0, LAS float* scr, int lane) {
    const int cl = lane & 31;
    float tv[32];
#pragma unroll
    for (int i = 0; i < 32; ++i) { const int kk = 2 * i + (lane >> 5); tv[i] = (cl < nvalid) ? src[(size_t)(k0 + kk) * src_ld + n0 + cl] : 0.f; }
#pragma unroll
    for (int i = 0; i < 32; ++i) { const int kk = 2 * i + (lane >> 5); scr[kk * 33 + cl] = tv[i]; }
    LDS_WAIT(); asm volatile("" ::: "memory");
    const int c = lane & 7;
#pragma unroll
    for (int j = 0; j < 4; ++j) { const int n = (lane >> 3) + 8 * j; const LAS float* s = scr + (8 * c) * 33 + n;
        u32x4 o; o.x = cvtpk(s[0 * 33], s[1 * 33]); o.y = cvtpk(s[2 * 33], s[3 * 33]); o.z = cvtpk(s[4 * 33], s[5 * 33]); o.w = cvtpk(s[6 * 33], s[7 * 33]);
        *(u32x4*)(dst + (size_t)(drow0 + n) * dst_ld + k0 + 8 * c) = o; }
    LDS_WAIT(); asm volatile("" ::: "memory");
}

__device__ __forceinline__ void transpose_item_fp8(const float* src, int src_ld, int k0, int n0, float sc, unsigned char* dst, int dst_ld, int drow0, LAS float* scr, int lane) {
    const int cl = lane & 31;
    float tv[32];
#pragma unroll
    for (int i = 0; i < 32; ++i) { const int kk = 2 * i + (lane >> 5); tv[i] = src[(size_t)(k0 + kk) * src_ld + n0 + cl] * sc; }
#pragma unroll
    for (int i = 0; i < 32; ++i) { const int kk = 2 * i + (lane >> 5); scr[kk * 33 + cl] = tv[i]; }
    LDS_WAIT(); asm volatile("" ::: "memory");
    const int c = lane & 7;
#pragma unroll
    for (int j = 0; j < 4; ++j) { const int n = (lane >> 3) + 8 * j; const LAS float* s = scr + (8 * c) * 33 + n;
        u32x2 o; o.x = pk4_fp8(s[0 * 33], s[1 * 33], s[2 * 33], s[3 * 33]); o.y = pk4_fp8(s[4 * 33], s[5 * 33], s[6 * 33], s[7 * 33]);
        *(u32x2*)(dst + (size_t)(drow0 + n) * dst_ld + k0 + 8 * c) = o; }
    LDS_WAIT(); asm volatile("" ::: "memory");
}
__device__ __forceinline__ void transpose_item_fp8v(const float* src, int src_ld, int k0, int n0, int nvalid, float sc, unsigned char* dst, int dst_ld, int drow0, LAS float* scr, int lane) {
    const int cl = lane & 31;
    float tv[32];
#pragma unroll
    for (int i = 0; i < 32; ++i) { const int kk = 2 * i + (lane >> 5); tv[i] = (cl < nvalid) ? src[(size_t)(k0 + kk) * src_ld + n0 + cl] * sc : 0.f; }
#pragma unroll
    for (int i = 0; i < 32; ++i) { const int kk = 2 * i + (lane >> 5); scr[kk * 33 + cl] = tv[i]; }
    LDS_WAIT(); asm volatile("" ::: "memory");
    const int c = lane & 7;
#pragma unroll
    for (int j = 0; j < 4; ++j) { const int n = (lane >> 3) + 8 * j; const LAS float* s = scr + (8 * c) * 33 + n;
        u32x2 o; o.x = pk4_fp8(s[0 * 33], s[1 * 33], s[2 * 33], s[3 * 33]); o.y = pk4_fp8(s[4 * 33], s[5 * 33], s[6 * 33], s[7 * 33]);
        *(u32x2*)(dst + (size_t)(drow0 + n) * dst_ld + k0 + 8 * c) = o; }
    LDS_WAIT(); asm volatile("" ::: "memory");
}
__device__ __forceinline__ void pa_prologue(Frame& F, const Args& a) {
    const float* c_in = (const float*)a.in[1]; const int* pos = (const int*)a.in[2];
    const float* w_ada = (const float*)a.in[3]; const float* b_ada = (const float*)a.in[4];
    {
        constexpr int MU = 256, MC = 24;
        LAS float* sc = (LAS float*)(F.lds);
        if ((int)blockIdx.x < MU) { for (int idx = F_TID(); idx < 32 * 1024; idx += 512) { const int k = idx >> 5, b = idx & 31; sc[idx] = siluf_(c_in[b * 1024 + k]); } }
        __syncthreads();
        for (int u = blockIdx.x; u < MU; u += F.G) {
            const int ln = F_LANE(); const bool on = ln < MC; const int n = MC * u + (on ? ln : 0);
            float acc[32];
#pragma unroll
            for (int b = 0; b < 32; ++b) acc[b] = 0.f;
            const float* wp = w_ada + (size_t)(128 * F.wave) * 6144 + n;
            const LAS float* sp = sc + (128 * F.wave) * 32;
            {
                float wv[128];
#pragma unroll
                for (int j = 0; j < 128; ++j) wv[j] = wp[(size_t)j * 6144];
                __builtin_amdgcn_sched_barrier(0);
#pragma unroll
                for (int j = 0; j < 128; ++j)
#pragma unroll
                    for (int b4 = 0; b4 < 8; ++b4) { const f32x4 s = *(const LAS f32x4*)(sp + j * 32 + 4 * b4);
                        acc[4 * b4] += s[0] * wv[j]; acc[4 * b4 + 1] += s[1] * wv[j]; acc[4 * b4 + 2] += s[2] * wv[j]; acc[4 * b4 + 3] += s[3] * wv[j]; }
            }
            __syncthreads();
            LAS float* red = (LAS float*)(F.lds);
#pragma unroll
            for (int b = 0; b < 32; ++b) red[(F.wave * 32 + b) * 64 + ln] = acc[b];
            __syncthreads();
            float* mod = WSP(float, WS_MOD);
            for (int o = F_TID(); o < 32 * MC; o += 512) { const int b = o / MC, col = o % MC; float s = b_ada[MC * u + col];
#pragma unroll
                for (int w = 0; w < 8; ++w) s += red[(w * 32 + b) * 64 + col];
                mod[(size_t)b * 6144 + MC * u + col] = s; }
            __syncthreads();
            if (u + F.G < MU) { for (int idx = F_TID(); idx < 32 * 1024; idx += 512) { const int k = idx >> 5, b = idx & 31; sc[idx] = siluf_(c_in[b * 1024 + k]); } __syncthreads(); }
        }
    }
#if defined(PROBE_PA) && PROBE_PA == 2
    for (int rep_ = 0; rep_ < 2; ++rep_)
#endif
    {
        LAS float* scr = (LAS float*)(F.lds + F.wave * 16384);
        const int gw = F.vcu * 8 + F.wave, NGW = F.G * 8, lane = F_LANE();
        constexpr int I_WIN = 16 * 144, I_UPA = 8 * 32, I_UPB = 6 * 32, I_OUT = 16 * 32, I_CW1 = 32 * 8, I_CW2 = 4 * 2, I_GU = 16 * 32, I_WD = 8 * 32;
        constexpr int NITEMS = I_WIN + I_UPA + I_UPB + I_OUT + 2 * I_CW1 + 2 * I_CW2 + NEXP * (I_GU + I_WD);
        struct TItem { const float* src; unsigned char* dst; int src_ld, k0, n0, nvalid, dst_ld, drow0, esz; float sc; };
        auto decode = [&](int r) -> TItem {
            TItem d; d.nvalid = 32; d.sc = 64.f; d.esz = 1;
            if (r < I_WIN) { const int kb = r / 144, rb = r % 144, rho0 = 32 * rb, pn = rho0 >> 8, bj = (rho0 >> 7) & 1, wc = (rho0 >> 5) & 3, H = 4 * pn + wc;
                int nv = slot_valid(H) - 32 * bj; nv = nv < 0 ? 0 : (nv > 32 ? 32 : nv);
                d.src = (const float*)a.in[7]; d.src_ld = IN_COLS; d.k0 = 64 * kb; d.n0 = slot_col0(H) + 32 * bj; d.nvalid = nv;
                if (H >= SL_GMA && H < SL_GA) { const int q = (H - SL_GMA) & 15; d.n0 = slot_col0(H < SL_GMB ? SL_GMA : SL_GMB) + 256 * (q >> 2) + 128 * bj + 32 * (q & 3); }
                d.dst = F.ws + WS_WIN; d.dst_ld = 1024; d.drow0 = rho0; return d; } r -= I_WIN;
            if (r < I_UPA) { const int kb = r / 32, rb = r % 32; d.src = (const float*)a.in[18]; d.src_ld = 1024; d.k0 = 64 * kb; d.n0 = 32 * rb; d.dst = F.ws + WS_WUPA; d.dst_ld = 1024; d.drow0 = 32 * rb; return d; } r -= I_UPA;
            if (r < I_UPB) { const int kb = r / 32, rb = r % 32; d.src = (const float*)a.in[19]; d.src_ld = 1024; d.k0 = 64 * kb; d.n0 = 32 * rb; d.dst = F.ws + WS_WUPA + 512; d.dst_ld = 1024; d.drow0 = 32 * rb; return d; } r -= I_UPB;
            if (r < I_OUT) { const int kb = r / 32, rb = r % 32; d.src = (const float*)a.in[20]; d.src_ld = 1024; d.k0 = 64 * kb; d.n0 = 32 * rb; d.dst = F.ws + WS_WOUT; d.dst_ld = 1024; d.drow0 = 32 * rb; return d; } r -= I_OUT;
            if (r < 2 * I_CW1) { const int kv = r / I_CW1, q = r % I_CW1, kb = q / 8, rb = q % 8; d.esz = 2; d.sc = 1.f;
                d.src = (const float*)a.in[kv ? 14 : 11]; d.src_ld = 256; d.k0 = 64 * kb; d.n0 = 32 * rb; d.dst = F.ws + WS_CW1 + (size_t)kv * 256 * 2048 * 2; d.dst_ld = 2048; d.drow0 = 32 * rb; return d; } r -= 2 * I_CW1;
            if (r < 2 * I_CW2) { const int kv = r / I_CW2, q = r % I_CW2, kb = q / 2, rb = q % 2; d.esz = 2; d.sc = 1.f;
                d.src = (const float*)a.in[kv ? 15 : 12]; d.src_ld = 64; d.k0 = 64 * kb; d.n0 = 32 * rb; d.dst = F.ws + WS_CW2 + (size_t)kv * 64 * 256 * 2; d.dst_ld = 256; d.drow0 = 32 * rb; return d; } r -= 2 * I_CW2;
            const int e = r / (I_GU + I_WD); int q = r % (I_GU + I_WD);
            if (q < I_GU) { const int kb = q / 32, rb = q % 32, rho0 = 32 * rb, pn = rho0 >> 8, bj = (rho0 >> 7) & 1, y0 = rho0 & 127;
                d.src = (const float*)a.in[bj ? 26 : 25] + (size_t)e * 1024 * 512; d.src_ld = 512; d.k0 = 64 * kb; d.n0 = 128 * pn + y0; d.dst = F.ws + WS_WGU + (size_t)e * 1024 * 1024; d.dst_ld = 1024; d.drow0 = rho0; return d; }
            q -= I_GU; { const int kb = q / 32, rb = q % 32;
                d.src = (const float*)a.in[27] + (size_t)e * 512 * 1024; d.src_ld = 1024; d.k0 = 64 * kb; d.n0 = 32 * rb; d.dst = F.ws + WS_WD + (size_t)e * 1024 * 512; d.dst_ld = 512; d.drow0 = 32 * rb; return d; }
        };
        auto iload = [&](const TItem& d, float (&tv)[32]) { const int cl = lane & 31;
#pragma unroll
            for (int i = 0; i < 32; ++i) { const int kk = 2 * i + (lane >> 5); tv[i] = d.src[(size_t)(d.k0 + kk) * d.src_ld + d.n0 + cl]; } };
        auto istore = [&](const TItem& d, const float (&tv)[32]) { const int cl = lane & 31;
#pragma unroll
            for (int i = 0; i < 32; ++i) { const int kk = 2 * i + (lane >> 5); scr[kk * 33 + cl] = (cl < d.nvalid) ? tv[i] * d.sc : 0.f; }
            LDS_WAIT(); asm volatile("" ::: "memory");
            const int c = lane & 7;
#pragma unroll
            for (int j = 0; j < 4; ++j) { const int n = (lane >> 3) + 8 * j; const LAS float* s = scr + (8 * c) * 33 + n;
                unsigned char* dp = d.dst + ((size_t)(d.drow0 + n) * d.dst_ld + d.k0 + 8 * c) * d.esz;
                if (d.esz == 1) { u32x2 o; o.x = pk4_fp8(s[0 * 33], s[1 * 33], s[2 * 33], s[3 * 33]); o.y = pk4_fp8(s[4 * 33], s[5 * 33], s[6 * 33], s[7 * 33]); *(u32x2*)dp = o; }
                else { u32x4 o; o.x = cvtpk(s[0 * 33], s[1 * 33]); o.y = cvtpk(s[2 * 33], s[3 * 33]); o.z = cvtpk(s[4 * 33], s[5 * 33]); o.w = cvtpk(s[6 * 33], s[7 * 33]); *(u32x4*)dp = o; } }
            LDS_WAIT(); asm volatile("" ::: "memory"); };
        float ta[32], tb[32]; TItem da, db;
        int it = gw;
        if (it < NITEMS) { da = decode(it); iload(da, ta); }
#pragma unroll 1
        for (; it < NITEMS; it += 2 * NGW) {
            const bool hb = it + NGW < NITEMS; if (hb) { db = decode(it + NGW); iload(db, tb); }
            istore(da, ta);
            const bool ha = it + 2 * NGW < NITEMS; if (ha) { da = decode(it + 2 * NGW); iload(da, ta); }
            if (hb) istore(db, tb);
        }
    }
#if defined(PROBE_PA) && PROBE_PA == 3
    for (int rep_ = 0; rep_ < 2; ++rep_)
#endif
    {
        const int gt = F.vcu * 512 + F_TID(), NGT = F.G * 512;
        const double inv_rev = exp2(-(double)(gt & 31) * (13.287712379549449 / 32.0)) * 0.15915494309189535;
        float* ccos = WSP(float, WS_CROPE); float* csin = ccos + 32 * 128 * 32;
        for (int idx = gt; idx < 32 * 128 * 32; idx += NGT) { const int n = (idx >> 5) & 127, b = idx >> 12;
            const int tt = 16 * n + 31; const int p = pos[b * SEQ + (tt < SEQ ? tt : SEQ - 1)];
            const double rv = (double)p * inv_rev; const float fr = (float)(rv - rint(rv));
            ccos[idx] = __builtin_amdgcn_cosf(fr); csin[idx] = __builtin_amdgcn_sinf(fr); }
        bf16_t* rhi = (bf16_t*)(F.ws + WS_SMALL + 65536); bf16_t* rlo = (bf16_t*)(F.ws + WS_SMALL + 196608);
        const float* w_group = (const float*)a.in[21]; const float* w_router = (const float*)a.in[23];
        for (int idx = gt; idx < 64 * 1024; idx += NGT) { const int c = idx >> 10, k = idx & 1023;
            float w = 0.f; if (c < 4) w = w_group[k * 4 + c]; else if (c < 36) { const int g = (c - 4) >> 3, e = (c - 4) & 7; w = w_router[((size_t)g * 1024 + k) * 8 + e]; }
            const unsigned hi = cvtpk(w, 0.f) & 0xffffu; const float lo = w - bf2f((unsigned short)hi);
            rhi[idx] = (bf16_t)hi; rlo[idx] = (bf16_t)(cvtpk(lo, 0.f) & 0xffffu); }
        float* bias = WSP(float, WS_SMALL);
        { const int gwv = F.vcu * 8 + F.wave, NGWV = F.G * 8, l = F_LANE(), sub = l >> 3, c8 = l & 7;
          for (int task = gwv; task < 16 * 2 * 32; task += NGWV) { const int ks = task >> 6, kv = (task >> 5) & 1, col = 8 * (task & 31) + c8;
              const float* pe = (const float*)a.in[kv ? 13 : 10] + 128 * ks + 16 * sub; const float* w1 = (const float*)a.in[kv ? 14 : 11] + (size_t)(128 * ks + 16 * sub) * 256 + col;
              float pv[16], wv[16];
#pragma unroll
              for (int i = 0; i < 16; ++i) { pv[i] = pe[i]; wv[i] = w1[(size_t)i * 256]; }
              float sm = 0.f;
#pragma unroll
              for (int i = 0; i < 16; ++i) sm += pv[i] * wv[i];
              sm += __shfl_xor(sm, 8); sm += __shfl_xor(sm, 16); sm += __shfl_xor(sm, 32);
              if (sub == 0) bias[ks * 512 + kv * 256 + col] = sm; } }
        for (int idx = gt; idx < 1024 * 32; idx += NGT) ((unsigned*)(F.ws + WS_WUPA))[(idx >> 5) * 256 + 224 + (idx & 31)] = 0u;
        if (gt < NEXP) F.ctl[CW_CNT + 64 * gt] = 0u;
    }
}

__device__ __forceinline__ void pb_modnorm(Frame& F, const float* x, const float* g, const float* mod, int sh_off, int sc_off, bf16_t* out, const float* g2) {
    const int gw = F.vcu * 8 + F.wave, NGW = F.G * 8;
    { float* a2 = WSP(float, WS_SMALL + 524288); for (int idx = F.vcu * 512 + F_TID(); idx < 32 * 1024; idx += F.G * 512) { const int b = idx >> 10, k = idx & 1023; a2[idx] = g2[k] * (1.0f + mod[(size_t)b * 6144 + 4096 + k]); } }
    const int ln = F_LANE();
#define PB_LOAD(V, M) do { const f32x4* xr_ = (const f32x4*)(x + (size_t)(M) * DM) + ln; _Pragma("unroll") for (int j = 0; j < 4; ++j) V[j] = xr_[64 * j]; } while (0)
#define PB_ROW(V, M) do { float s = 0.f; \
        _Pragma("unroll") for (int j = 0; j < 4; ++j) s += (V[j].x * V[j].x + V[j].y * V[j].y) + (V[j].z * V[j].z + V[j].w * V[j].w); \
        const float rstd = __builtin_amdgcn_rsqf(wave_sum(s) * (1.f / DM) + EPS); \
        unsigned* o4 = (unsigned*)((unsigned char*)out + (size_t)(M) * DM) + ln; \
        _Pragma("unroll") for (int j = 0; j < 4; ++j) { const f32x4 h = (V[j] * rstd) * ca[j] + cb[j]; o4[64 * j] = pk4_fp8(h.x, h.y, h.z, h.w); } } while (0)
#pragma unroll 1
    for (int blk = gw; blk < NT_TOK / 32; blk += NGW) {
        const int m0 = blk * 32, b = m0 >> 11;
        f32x4 ca[4], cb[4];
        { const f32x4* gr = (const f32x4*)g + ln; const f32x4* scr = (const f32x4*)(mod + (size_t)b * 6144 + sc_off) + ln; const f32x4* shr = (const f32x4*)(mod + (size_t)b * 6144 + sh_off) + ln;
#pragma unroll
          for (int j = 0; j < 4; ++j) { ca[j] = gr[64 * j] * (scr[64 * j] + 1.0f); cb[j] = shr[64 * j]; } }
        f32x4 va[4], vb[4];
        PB_LOAD(va, m0);
#pragma unroll 1
        for (int i = 0; i < 32; i += 2) {
            PB_LOAD(vb, m0 + i + 1);
            PB_ROW(va, m0 + i);
            if (i + 2 < 32) PB_LOAD(va, m0 + i + 2);
            PB_ROW(vb, m0 + i + 1);
        }
    }
#undef PB_ROW
#undef PB_LOAD
}
namespace pg8 {
#ifndef PC_DEPHASE
#define PC_DEPHASE 1
#define PC_DEPHASE_TICKS 0
#endif
struct ProjEpi {
    static constexpr bool PERM = true; static constexpr int MIDK = 0, DEPHASE = PC_DEPHASE, DEPHASE_TICKS = PC_DEPHASE_TICKS;
#ifdef PROBE_NOEPI
    static constexpr int NSTORE = 0;
#else
    static constexpr int NSTORE = 8;
#endif
    unsigned char* ws; const int* pos; const float* cosT; const float* sinT; const float* nq; const float* nk; const float* dq; const float* dk; bool noepi; bool hotst = false;
    static __device__ __forceinline__ float xsum(float x) {
        float y = x; asm("s_nop 1\n\tv_permlane16_swap_b32 %0, %1" : "+v"(x), "+v"(y)); x += y;
        y = x; asm("s_nop 1\n\tv_permlane32_swap_b32 %0, %1" : "+v"(x), "+v"(y)); return x + y; }
    __device__ __forceinline__ void operator()(const f32x4 (&acc)[2][2][4][2], const Unit& u, int, int wr, int wc, int fr, int fq) const {
#ifdef PC_FP8
        constexpr float SC = 0.015625f;
#else
        constexpr float SC = 1.0f;
#endif
        const int H = __builtin_amdgcn_readfirstlane(4 * u.pn + wc);
        int type = 0; const float* gn = nq; float qs = 1.f;
        if (H < 8) { type = 1; gn = nq; qs = C2; }
        else if (H == 12 || H == 13 || H == 16 || H == 17) { type = 1; gn = nk; }
        else if (H >= 20 && H < 26) { type = 1; gn = dq; qs = C2; }
        else if (H >= 26 && H < 32) { type = 1; gn = dk; }
        else if (H >= 38 && H <= 70) type = 2;
        bf16_t* dst = (bf16_t*)(ws + slot_off(H));
#ifdef PROBE_HOTST
        const int row0 = hotst ? (int)blockIdx.x * 256 + wr * 64 + fr : u.pm * BM + wr * 64 + fr;
        if (hotst) dst = (bf16_t*)(ws + WS_Y) + (size_t)wc * 65536 * 64;
#else
        const int row0 = u.pm * BM + wr * 64 + fr;
#endif
        if (type == 1) {
            f32x4 g0[2], g1[2], ir[2];
#pragma unroll
            for (int n = 0; n < 2; ++n) { g0[n] = *(const f32x4*)(gn + 8 * fq + 4 * n) * qs; g1[n] = *(const f32x4*)(gn + 32 + 8 * fq + 4 * n) * qs;
#pragma unroll
                for (int i = 0; i < 4; ++i) ir[n][i] = __builtin_amdgcn_exp2f(-(float)(8 * fq + 4 * n + i) * 0.41524101186092033f - 2.651496129472319f); }
            float pf[8], rs[8];
#pragma unroll
            for (int j = 0; j < 8; ++j) pf[j] = (float)pos[row0 + (j >> 2) * HALF + (j & 3) * 16];
#pragma unroll
            for (int j = 0; j < 8; ++j) { const int ai = j >> 2, m = j & 3;
                f32x4 q = acc[ai][0][m][0] * acc[ai][0][m][0]; q += acc[ai][0][m][1] * acc[ai][0][m][1]; q += acc[ai][1][m][0] * acc[ai][1][m][0]; q += acc[ai][1][m][1] * acc[ai][1][m][1];
                rs[j] = (q[0] + q[1]) + (q[2] + q[3]); }
#ifdef PC_XSUM_SWAP
#pragma unroll
            for (int j = 0; j < 8; ++j) rs[j] = xsum(rs[j]);
#else
            { float t[8];
#pragma unroll
                for (int j = 0; j < 8; ++j) t[j] = __shfl_xor(rs[j], 16);
#pragma unroll
                for (int j = 0; j < 8; ++j) rs[j] += t[j];
#pragma unroll
                for (int j = 0; j < 8; ++j) t[j] = __shfl_xor(rs[j], 32);
#pragma unroll
                for (int j = 0; j < 8; ++j) rs[j] += t[j]; }
#endif
#pragma unroll
            for (int j = 0; j < 8; ++j) rs[j] = SC * __builtin_amdgcn_rsqf(rs[j] * (SC * SC / 64.f) + EPS);
#pragma unroll
            for (int j = 0; j < 8; ++j) { const int ai = j >> 2, m = j & 3;
                const int tok = row0 + ai * HALF + m * 16;
                u32x4 w0, w1;
#pragma unroll
                for (int n = 0; n < 2; ++n) {
                    const f32x4 rv = ir[n] * pf[j];
                    f32x4 cs, sn;
#pragma unroll
                    for (int i = 0; i < 4; ++i) { const float fr2 = __builtin_amdgcn_fractf(rv[i]); cs[i] = __builtin_amdgcn_cosf(fr2); sn[i] = __builtin_amdgcn_sinf(fr2); }
                    const f32x4 x1 = acc[ai][0][m][n] * (g0[n] * rs[j]), x2 = acc[ai][1][m][n] * (g1[n] * rs[j]);
                    const f32x4 o1 = x1 * cs - x2 * sn, o2 = x1 * sn + x2 * cs;
                    w0[2 * n] = cvtpk(o1[0], o1[1]); w0[2 * n + 1] = cvtpk(o1[2], o1[3]); w1[2 * n] = cvtpk(o2[0], o2[1]); w1[2 * n + 1] = cvtpk(o2[2], o2[3]);
                }
                bf16_t* rp = dst + (size_t)tok * 64 + 8 * fq;
                *(u32x4*)rp = w0; *(u32x4*)(rp + 32) = w1;
            }
        } else if (type == 2 && H < SL_GA) {
            unsigned char* dst8 = (unsigned char*)dst;
#pragma unroll
            for (int ai = 0; ai < 2; ++ai)
#pragma unroll
                for (int m = 0; m < 4; ++m) {
                    const int tok = row0 + ai * HALF + m * 16;
                    u32x4 w;
#pragma unroll
                    for (int bj = 0; bj < 2; ++bj)
#pragma unroll
                        for (int n = 0; n < 2; ++n) { const f32x4 t = acc[ai][bj][m][n] * (-1.4426950408889634f * SC); f32x4 e, g;
#pragma unroll
                            for (int i = 0; i < 4; ++i) e[i] = __builtin_amdgcn_exp2f(t[i]);
                            e += 1.0f;
#pragma unroll
                            for (int i = 0; i < 4; ++i) g[i] = __builtin_amdgcn_rcpf(e[i]);
                            const float g0 = g[0] * 255.0f + 8388608.0f, g1 = g[1] * 255.0f + 8388608.0f, g2 = g[2] * 255.0f + 8388608.0f, g3 = g[3] * 255.0f + 8388608.0f;
                            const unsigned u0 = __builtin_bit_cast(unsigned, g0), u1 = __builtin_bit_cast(unsigned, g1), u2 = __builtin_bit_cast(unsigned, g2), u3 = __builtin_bit_cast(unsigned, g3);
                            w[2 * bj + n] = (u0 & 0xffu) | (u1 << 8) | (u2 << 16) | (u3 << 24); }
                    *(u32x4*)(dst8 + (size_t)tok * 64 + 16 * fq) = w;
                }
        } else if (type == 2) {
#pragma unroll
            for (int ai = 0; ai < 2; ++ai)
#pragma unroll
                for (int m = 0; m < 4; ++m) {
                    const int tok = row0 + ai * HALF + m * 16;
                    bf16_t* rp = dst + (size_t)tok * 64 + 8 * fq;
#pragma unroll
                    for (int bj = 0; bj < 2; ++bj) { f32x4 v[2];
#pragma unroll
                        for (int n = 0; n < 2; ++n) { const f32x4 t = acc[ai][bj][m][n] * (-1.4426950408889634f * SC); f32x4 e;
#pragma unroll
                            for (int i = 0; i < 4; ++i) e[i] = __builtin_amdgcn_exp2f(t[i]);
                            e += 1.0f;
#pragma unroll
                            for (int i = 0; i < 4; ++i) v[n][i] = __builtin_amdgcn_rcpf(e[i]); }
                        u32x4 w; w.x = cvtpk(v[0][0], v[0][1]); w.y = cvtpk(v[0][2], v[0][3]); w.z = cvtpk(v[1][0], v[1][1]); w.w = cvtpk(v[1][2], v[1][3]);
                        *(u32x4*)(rp + 32 * bj) = w; }
                }
        } else {
#pragma unroll
            for (int ai = 0; ai < 2; ++ai)
#pragma unroll
                for (int m = 0; m < 4; ++m) {
                    const int tok = row0 + ai * HALF + m * 16;
                    bf16_t* rp = dst + (size_t)tok * 64 + 8 * fq;
#pragma unroll
                    for (int bj = 0; bj < 2; ++bj) { const f32x4 v0 = acc[ai][bj][m][0] * SC, v1 = acc[ai][bj][m][1] * SC;
                        u32x4 w; w.x = cvtpk(v0[0], v0[1]); w.y = cvtpk(v0[2], v0[3]); w.z = cvtpk(v1[0], v1[1]); w.w = cvtpk(v1[2], v1[3]);
                        *(u32x4*)(rp + 32 * bj) = w; }
                }
        }
    }
};

template <bool ADD> struct UpEpi {
    static constexpr bool PERM = true, noepi = false; static constexpr int MIDK = 0, DEPHASE = 1, DEPHASE_TICKS = 0, NSTORE = 0;
    unsigned char* ws; bf16_t* Y; int gslot0; unsigned char* Y8;
    __device__ __forceinline__ void operator()(const f32x4 (&acc)[2][2][4][2], const Unit& u, int, int wr, int wc, int fr, int fq) const {
        const int row0 = u.pm * BM + wr * 64 + fr;
#pragma unroll
        for (int bj = 0; bj < 2; ++bj) {
            const int gs = __builtin_amdgcn_readfirstlane(gslot0 + 4 * u.pn + 2 * bj + (wc >> 1));
            const bf16_t* gp = (const bf16_t*)(ws + slot_off(gs)) + 32 * (wc & 1) + 8 * fq;
            const int col = u.pn * BM + bj * HALF + wc * 32 + 8 * fq;
#pragma unroll
            for (int ai = 0; ai < 2; ++ai) {
                u32x4 gg[4], yy[4];
#pragma unroll
                for (int m = 0; m < 4; ++m) { const int tok = row0 + ai * HALF + m * 16; gg[m] = *(const u32x4*)(gp + (size_t)tok * 64); if (ADD) yy[m] = *(const u32x4*)(Y + (size_t)tok * DM + col); }
#pragma unroll
                for (int m = 0; m < 4; ++m) {
                    const int tok = row0 + ai * HALF + m * 16;
                    const u32x4 g = gg[m];
                    bf16_t* yp = Y + (size_t)tok * DM + col;
                    f32x4 v0 = acc[ai][bj][m][0], v1 = acc[ai][bj][m][1];
                    v0[0] *= bflo(g.x); v0[1] *= bfhi(g.x); v0[2] *= bflo(g.y); v0[3] *= bfhi(g.y); v1[0] *= bflo(g.z); v1[1] *= bfhi(g.z); v1[2] *= bflo(g.w); v1[3] *= bfhi(g.w);
                    if (ADD) { const u32x4 y = yy[m];
                        v0[0] += bflo(y.x); v0[1] += bfhi(y.x); v0[2] += bflo(y.y); v0[3] += bfhi(y.y); v1[0] += bflo(y.z); v1[1] += bfhi(y.z); v1[2] += bflo(y.w); v1[3] += bfhi(y.w); }
                    if (ADD && Y8) { u32x2 w8; w8.x = pk4_fp8(v0[0] * 16.f, v0[1] * 16.f, v0[2] * 16.f, v0[3] * 16.f); w8.y = pk4_fp8(v1[0] * 16.f, v1[1] * 16.f, v1[2] * 16.f, v1[3] * 16.f); *(u32x2*)(Y8 + (size_t)tok * DM + col) = w8; }
                    else { u32x4 w; w.x = cvtpk(v0[0], v0[1]); w.y = cvtpk(v0[2], v0[3]); w.z = cvtpk(v1[0], v1[1]); w.w = cvtpk(v1[2], v1[3]); *(u32x4*)yp = w; }
                }
                asm volatile("" ::: "memory");
            }
            asm volatile("" ::: "memory");
        }
    }
};

struct Up2Epi {
    static constexpr bool PERM = true, noepi = false; static constexpr int MIDK = 4, DEPHASE = 1, DEPHASE_TICKS = 0, NSTORE = 16;
    unsigned char* ws; unsigned char* Y8;
    static __device__ __forceinline__ unsigned fixz(unsigned x) { return x | ((((x - 0x01010101u) & ~x) & 0x80808080u) >> 7); }
    static __device__ __forceinline__ f32x4 ub4(unsigned x) { return (f32x4){(float)(x & 0xffu), (float)((x >> 8) & 0xffu), (float)((x >> 16) & 0xffu), (float)(x >> 24)}; }
    __device__ __forceinline__ void mid(f32x4 (&acc)[2][2][4][2], const Unit& u, int wr, int wc, int fr, int fq) const {
        const int row0 = u.pm * BM + wr * 64 + fr;
        const int sa = __builtin_amdgcn_readfirstlane(SL_GMA + 4 * u.pn + wc);
        const unsigned char* ga = ws + slot_off(sa) + 16 * fq;
        const unsigned char* gb = ws + slot_off(sa + (SL_GMB - SL_GMA)) + 16 * fq;
#pragma unroll
        for (int ai = 0; ai < 2; ++ai) {
            u32x4 xa[4], xb[4];
#pragma unroll
            for (int m = 0; m < 4; ++m) { const int tok = row0 + ai * HALF + m * 16; xa[m] = *(const u32x4*)(ga + (size_t)tok * 64); xb[m] = *(const u32x4*)(gb + (size_t)tok * 64); }
#pragma unroll
            for (int m = 0; m < 4; ++m)
#pragma unroll
                for (int bj = 0; bj < 2; ++bj)
#pragma unroll
                    for (int n = 0; n < 2; ++n) { const f32x4 a = ub4(xa[m][2 * bj + n]), b = ub4(fixz(xb[m][2 * bj + n])); f32x4 r;
#pragma unroll
                        for (int i = 0; i < 4; ++i) r[i] = __builtin_amdgcn_rcpf(b[i]);
                        acc[ai][bj][m][n] *= a * r; }
            asm volatile("" ::: "memory");
        }
    }
    __device__ __forceinline__ void operator()(const f32x4 (&acc)[2][2][4][2], const Unit& u, int, int wr, int wc, int fr, int fq) const {
        const int row0 = u.pm * BM + wr * 64 + fr;
        const int sb = __builtin_amdgcn_readfirstlane(SL_GMB + 4 * u.pn + wc);
        const unsigned char* gb = ws + slot_off(sb) + 16 * fq;
        u32x4 xb[8];
#pragma unroll
        for (int j = 0; j < 8; ++j) xb[j] = *(const u32x4*)(gb + (size_t)(row0 + (j >> 2) * HALF + (j & 3) * 16) * 64);
#pragma unroll
        for (int j = 0; j < 8; ++j) { const int ai = j >> 2, m = j & 3;
            const int tok = row0 + ai * HALF + m * 16; const float s = 1.0f / (64.0f * 255.0f);
#pragma unroll
            for (int bj = 0; bj < 2; ++bj) {
                const int col = u.pn * BM + bj * HALF + wc * 32 + 8 * fq;
                const f32x4 v0 = acc[ai][bj][m][0] * s * ub4(fixz(xb[j][2 * bj])), v1 = acc[ai][bj][m][1] * s * ub4(fixz(xb[j][2 * bj + 1]));
                u32x2 w8; w8.x = pk4_fp8(v0[0], v0[1], v0[2], v0[3]); w8.y = pk4_fp8(v1[0], v1[1], v1[2], v1[3]);
                *(u32x2*)(Y8 + (size_t)tok * DM + col) = w8;
            }
        }
    }
};

#ifndef OUT_DEPHASE
#define OUT_DEPHASE 1
#endif
struct OutEpi {
    static constexpr bool PERM = false, noepi = false; static constexpr int MIDK = 0, DEPHASE = OUT_DEPHASE, DEPHASE_TICKS = 3400, NSTORE = 32;
    const float* x; float* out; const float* mod; float* rowss; float asc;
    __device__ __forceinline__ void operator()(const f32x4 (&acc)[2][2][4][2], const Unit& u, int, int wr, int wc, int fr, int fq) const {
        const int row0 = u.pm * BM + wr * 64 + fr, col0 = u.pn * BM + wc * 32 + 4 * fq;
        const int b = (u.pm * BM) >> 11;
        const float* gt = mod + (size_t)b * 6144 + 2048 + col0;
        f32x4 gv[2][2];
#pragma unroll
        for (int bj = 0; bj < 2; ++bj)
#pragma unroll
            for (int n = 0; n < 2; ++n) gv[bj][n] = *(const f32x4*)(gt + bj * HALF + n * 16) * asc;
#pragma unroll
        for (int ai = 0; ai < 2; ++ai) {
            f32x4 xv[4][2][2];
#pragma unroll
            for (int m = 0; m < 4; ++m) { const size_t off = (size_t)(row0 + ai * HALF + m * 16) * DM + col0;
#pragma unroll
                for (int bj = 0; bj < 2; ++bj)
#pragma unroll
                    for (int n = 0; n < 2; ++n) xv[m][bj][n] = *(const f32x4*)(x + off + bj * HALF + n * 16); }
#pragma unroll
            for (int m = 0; m < 4; ++m) {
                const int tok = row0 + ai * HALF + m * 16; const size_t off = (size_t)tok * DM + col0; float ss = 0.f;
#pragma unroll
                for (int bj = 0; bj < 2; ++bj)
#pragma unroll
                    for (int n = 0; n < 2; ++n) { const f32x4 o = xv[m][bj][n] + gv[bj][n] * acc[ai][bj][m][n];
                        ss += (o[0] * o[0] + o[1] * o[1]) + (o[2] * o[2] + o[3] * o[3]);
#ifdef X1_BF16
                        { u32x2 w; w.x = cvtpk(o[0], o[1]); w.y = cvtpk(o[2], o[3]); *(u32x2*)((bf16_t*)out + off + bj * HALF + n * 16) = w; }
#else
                        *(f32x4*)(out + off + bj * HALF + n * 16) = o;
#endif
                    }
                ss += __shfl_xor(ss, 16); ss += __shfl_xor(ss, 32);
                if (fq == 0) rowss[(size_t)tok * 16 + 4 * u.pn + wc] = ss;
            }
            asm volatile("" ::: "memory");
        }
    }
};

struct CmpEpi {
    static constexpr bool PERM = true, noepi = false; static constexpr int MIDK = 0, DEPHASE = 1, DEPHASE_TICKS = 0, NSTORE = 0;
    const float* biasp; bf16_t* hid;
    __device__ __forceinline__ void operator()(const f32x4 (&acc)[2][2][4][2], const Unit& u, int, int wr, int wc, int fr, int fq) const {
        const int kv = u.pm >= 32 ? 1 : 0; const int row0 = u.pm * BM + wr * 64 + fr;
#pragma unroll
        for (int bj = 0; bj < 2; ++bj) {
            const int col = bj * HALF + wc * 32 + 8 * fq;
            f32x4 b0 = (f32x4){0.f, 0.f, 0.f, 0.f}, b1 = b0;
            for (int ks = 0; ks < 16; ++ks) { b0 += *(const f32x4*)(biasp + ks * 512 + kv * 256 + col); b1 += *(const f32x4*)(biasp + ks * 512 + kv * 256 + col + 4); }
#pragma unroll
            for (int ai = 0; ai < 2; ++ai)
#pragma unroll
                for (int m = 0; m < 4; ++m) {
                    const int row = row0 + ai * HALF + m * 16;
                    f32x4 v0 = acc[ai][bj][m][0] + b0, v1 = acc[ai][bj][m][1] + b1;
#pragma unroll
                    for (int i = 0; i < 4; ++i) { v0[i] = siluf_(v0[i]); v1[i] = siluf_(v1[i]); }
                    u32x4 w; w.x = cvtpk(v0[0], v0[1]); w.y = cvtpk(v0[2], v0[3]); w.z = cvtpk(v1[0], v1[1]); w.w = cvtpk(v1[2], v1[3]);
                    *(u32x4*)(hid + (size_t)row * 256 + col) = w;
                }
        }
    }
};
struct CmpSched {
    const char* A; const char* Bt; int ldb; int nwg_c, c;
    __device__ __forceinline__ bool next(int i, Unit& u) const { if (c < 0) return false; const int L = i * nwg_c + c; if (L >= 64) return false; u.pm = L; u.pn = 0; u.e = 0; u.mt = 0; return true; }
    __device__ __forceinline__ const char* a_base(const Unit& u) const { return A + (size_t)u.pm * BM * 1024 * 2; }
    __device__ __forceinline__ unsigned a_voff(const Unit&, int, int h, int R, int C) const { return (unsigned)((h * HALF + R) * 1024 + C) * 2u; }
    __device__ __forceinline__ const char* b_base(const Unit& u) const { return Bt + (u.pm >= 32 ? (size_t)256 * 2048 * 2 : 0); }
    __device__ __forceinline__ int dephase_id() const { return 0; }
};
}
namespace att {
constexpr int A_KV = 0;
constexpr int A_IMP = 49152;
constexpr int A_SEL = 83968;
constexpr int A_WSF = 98304;
constexpr int A_OST = 100352;
constexpr float NEG_INF = -INFINITY;
constexpr float THR = 8.0f;
__device__ __forceinline__ int crow(int r, int hi) { return (r & 3) + 8 * (r >> 2) + 4 * hi; }
__device__ __forceinline__ void glds16(const void* gsrc, unsigned lds_dst) { unsigned keep;
    asm volatile("s_mov_b32 %0, m0\n\ts_mov_b32 m0, %2\n\ts_nop 0\n\tglobal_load_lds_dwordx4 %1, off\n\ts_mov_b32 m0, %0" : "=&s"(keep) : "v"(gsrc), "s"(lds_dst) : "memory"); }
#define ATT_WAIT_BAR(N) asm volatile("s_waitcnt vmcnt(" #N ") lgkmcnt(0)\n\ts_barrier" ::: "memory")
#define ATT_SBAR() __builtin_amdgcn_sched_barrier(0)

struct Ctx { LAS unsigned char* lds; int lane, r32, hi, wid; unsigned lds0; };
__device__ __forceinline__ int fresh(int v) { asm volatile("" : "+v"(v)); return v; }

__device__ __forceinline__ void qkt(f32x16& p0, f32x16& p1, const LAS unsigned char* Kslot, const bf16x8 (&qr)[4], int lane_) {
    const int lq = lane_now(); const int r32 = lq & 31, hi = lq >> 5;
    const LAS unsigned char* kb = Kslot + hi * 1024 + r32 * 16;
    const f32x16 z = {};
#pragma unroll
    for (int d0 = 0; d0 < 4; ++d0) {
        const bf16x8 b0 = *(const LAS bf16x8*)(kb + d0 * 2048);
        const bf16x8 b1 = *(const LAS bf16x8*)(kb + d0 * 2048 + 512);
        if (d0 == 0) { p0 = __builtin_amdgcn_mfma_f32_32x32x16_bf16(b0, qr[0], z, 0, 0, 0); p1 = __builtin_amdgcn_mfma_f32_32x32x16_bf16(b1, qr[0], z, 0, 0, 0); }
        else { p0 = __builtin_amdgcn_mfma_f32_32x32x16_bf16(b0, qr[d0], p0, 0, 0, 0); p1 = __builtin_amdgcn_mfma_f32_32x32x16_bf16(b1, qr[d0], p1, 0, 0, 0); } }
}
__device__ __forceinline__ void pv(f32x16 (&o)[2], int vb, bf16x8 pa0, bf16x8 pa1, bf16x8 pa2, bf16x8 pa3) {
#pragma unroll
    for (int d0 = 0; d0 < 2; ++d0) { s16x4 lo[4], hh[4];
#pragma unroll
        for (int ks = 0; ks < 4; ++ks) {
            asm volatile("ds_read_b64_tr_b16 %0,%1 offset:%c2" : "=&v"(lo[ks]) : "v"(vb), "i"(d0 * 4096 + ks * 1024) : "memory");
            asm volatile("ds_read_b64_tr_b16 %0,%1 offset:%c2" : "=&v"(hh[ks]) : "v"(vb), "i"(d0 * 4096 + ks * 1024 + 512) : "memory"); }
        asm volatile("s_waitcnt lgkmcnt(0)" ::: "memory"); ATT_SBAR();
#define ATT_PK(k) (bf16x8){lo[k][0], lo[k][1], lo[k][2], lo[k][3], hh[k][0], hh[k][1], hh[k][2], hh[k][3]}
        o[d0] = __builtin_amdgcn_mfma_f32_32x32x16_bf16(pa0, ATT_PK(0), o[d0], 0, 0, 0);
        o[d0] = __builtin_amdgcn_mfma_f32_32x32x16_bf16(pa1, ATT_PK(1), o[d0], 0, 0, 0);
        o[d0] = __builtin_amdgcn_mfma_f32_32x32x16_bf16(pa2, ATT_PK(2), o[d0], 0, 0, 0);
        o[d0] = __builtin_amdgcn_mfma_f32_32x32x16_bf16(pa3, ATT_PK(3), o[d0], 0, 0, 0);
#undef ATT_PK
    }
}
__device__ __forceinline__ float max3f(float a, float b, float c) { float r; asm("v_max3_f32 %0, %1, %2, %3" : "=v"(r) : "v"(a), "v"(b), "v"(c)); return r; }
__device__ __forceinline__ float max2f(float a, float b) { float r; asm("v_max_f32_e32 %0, %1, %2" : "=v"(r) : "v"(a), "v"(b)); return r; }
__device__ __forceinline__ float rowmax3(const f32x16& p0, const f32x16& p1) {
    float a = max3f(p0[0], p0[1], p1[0]), b = max3f(p0[2], p0[3], p1[1]); a = max3f(a, p1[2], p1[3]);
#pragma unroll
    for (int r = 4; r < 16; r += 4) { a = max3f(a, p0[r], p0[r + 1]); b = max3f(b, p0[r + 2], p0[r + 3]); a = max3f(a, p1[r], p1[r + 1]); b = max3f(b, p1[r + 2], p1[r + 3]); }
    const float m = max2f(a, b);
    auto rr = __builtin_amdgcn_permlane32_swap(__float_as_uint(m), __float_as_uint(m), false, false);
    return max2f(__uint_as_float(rr[0]), __uint_as_float(rr[1]));
}

__device__ __forceinline__ float rowmax(const f32x16& p0, const f32x16& p1) { return rowmax3(p0, p1); }
__device__ __forceinline__ float halfsum(float v) { auto rr = __builtin_amdgcn_permlane32_swap(__float_as_uint(v), __float_as_uint(v), false, false); return __uint_as_float(rr[0]) + __uint_as_float(rr[1]); }
#define ATT_PACK4(P, B) (u32x4){cvtpk(P[B], P[B + 1]), cvtpk(P[B + 2], P[B + 3]), cvtpk(P[B + 4], P[B + 5]), cvtpk(P[B + 6], P[B + 7])}
__device__ __forceinline__ void pv_tile(f32x16 (&o)[2], int vb, const f32x16& p0, const f32x16& p1) {
    const u32x4 w0 = ATT_PACK4(p0, 0), w1 = ATT_PACK4(p0, 8), w2 = ATT_PACK4(p1, 0), w3 = ATT_PACK4(p1, 8);
    pv(o, vb, __builtin_bit_cast(bf16x8, w0), __builtin_bit_cast(bf16x8, w1), __builtin_bit_cast(bf16x8, w2), __builtin_bit_cast(bf16x8, w3));
}
__device__ __forceinline__ void scale_rows(f32x16 (&o)[2], float f, const Ctx& C_) {
    Ctx C = C_; { const int l = lane_now(); C.r32 = l & 31; C.hi = l >> 5; }
    LAS float* wsf = (LAS float*)(C.lds + A_WSF) + C.wid * 64;
    if (C.hi == 0) wsf[C.r32] = f;
    asm volatile("s_waitcnt lgkmcnt(0)" ::: "memory");
#pragma unroll
    for (int g = 0; g < 4; ++g) { const f32x4 fv = *(const LAS f32x4*)(wsf + 8 * g + 4 * C.hi);
#pragma unroll
        for (int i = 0; i < 4; ++i) { o[0][4 * g + i] *= fv[i]; o[1][4 * g + i] *= fv[i]; } }
    asm volatile("s_waitcnt lgkmcnt(0)" ::: "memory");
}
__device__ __forceinline__ void axpy_rows(f32x16 (&acc)[2], const f32x16 (&o)[2], float f, const Ctx& C_) {
    Ctx C = C_; { const int l = lane_now(); C.r32 = l & 31; C.hi = l >> 5; }
    LAS float* wsf = (LAS float*)(C.lds + A_WSF) + C.wid * 64;
    if (C.hi == 0) wsf[C.r32] = f;
    asm volatile("s_waitcnt lgkmcnt(0)" ::: "memory");
#pragma unroll
    for (int g = 0; g < 4; ++g) { const f32x4 fv = *(const LAS f32x4*)(wsf + 8 * g + 4 * C.hi);
#pragma unroll
        for (int i = 0; i < 4; ++i) { acc[0][4 * g + i] += o[0][4 * g + i] * fv[i]; acc[1][4 * g + i] += o[1][4 * g + i] * fv[i]; } }
    asm volatile("s_waitcnt lgkmcnt(0)" ::: "memory");
}
struct SM { float m, l; f32x16 o[2]; };
__device__ __forceinline__ void sm_init(SM& s) { s.m = -1e30f; s.l = 0.f; s.o[0] = f32x16{}; s.o[1] = f32x16{}; }
__device__ __forceinline__ void sm_part1(SM& s, f32x16& p0, f32x16& p1, u32x4& w0, u32x4& w1, u32x4& w2, u32x4& w3, const Ctx& C) {
    const float rm = rowmax(p0, p1);
    if (__any(rm > s.m + THR)) {
        const float mn = fmaxf(s.m, rm); const float f = __builtin_amdgcn_exp2f(s.m - mn);
        s.l *= f; s.m = mn; scale_rows(s.o, f, C);
    }
    float sum = 0.f;
#pragma unroll
    for (int r = 0; r < 16; ++r) { p0[r] = __builtin_amdgcn_exp2f(p0[r] - s.m); p1[r] = __builtin_amdgcn_exp2f(p1[r] - s.m); sum += p0[r] + p1[r]; }
    s.l += sum;
    w0 = ATT_PACK4(p0, 0); w1 = ATT_PACK4(p0, 8); w2 = ATT_PACK4(p1, 0); w3 = ATT_PACK4(p1, 8);
}
template <int NS> __device__ __forceinline__ void dma_tile(const Ctx& C, const bf16_t* Kp, const bf16_t* Vp, long rs, int tile, int stage, int q, int base_off = 0) {
    const unsigned base = C.lds0 + (unsigned)(base_off + (stage * NS + q) * 16384);
    const long k0 = (long)tile * 64; const int lane = lane_now();
#pragma unroll
    for (int j = 0; j < NS; ++j) {
        const int pw = (NS == 1) ? C.wid : (2 * (C.wid & 3) + j);
        const bf16_t* ks = Kp + (k0 + lane) * rs + pw * 8;
        const bf16_t* vs = Vp + (k0 + 16 * (pw & 3) + (lane >> 2)) * rs + (pw >> 2) * 32 + (lane & 3) * 8;
        glds16(ks, (unsigned)__builtin_amdgcn_readfirstlane(base + pw * 1024));
        glds16(vs, (unsigned)__builtin_amdgcn_readfirstlane(base + 8192 + pw * 1024));
    }
}
template <int NS> __device__ __forceinline__ void wait_bar_tiles(int allowed) {
    if (allowed <= 0) ATT_WAIT_BAR(0);
    else if (allowed == 1) { if (NS == 1) ATT_WAIT_BAR(2); else ATT_WAIT_BAR(4); }
    else { if (NS == 1) ATT_WAIT_BAR(4); else ATT_WAIT_BAR(8); }
}
template <int NS, class MaskF, class SkipF>
__device__ __forceinline__ void run_pass(const Ctx& C, SM& st, const bf16x8 (&qr)[4], const bf16_t* Kp, const bf16_t* Vp, long rs, int t_lo, int t_hi, int nsteps, MaskF mask, SkipF skip) {
    const int q = (NS == 1) ? 0 : (C.wid >> 2);
    const int nvalid = t_hi - t_lo;
#pragma unroll
    for (int s = 0; s < 2; ++s) if (s < nvalid) dma_tile<NS>(C, Kp, Vp, rs, t_lo + s, s, q);
#pragma unroll 1
    for (int s = 0; s < nsteps; ++s) {
        wait_bar_tiles<NS>((s + 1 < nvalid) ? 1 : 0);
        if (s + 2 < nvalid) dma_tile<NS>(C, Kp, Vp, rs, t_lo + s + 2, (s + 2) % 3, q);
        if (s < nvalid && !skip(t_lo + s)) {
            const int sb = ((s % 3) * NS + q) * 16384;
            f32x16 p0, p1; qkt(p0, p1, C.lds + sb, qr, C.lane);
            mask(p0, p1, t_lo + s);
            u32x4 w0, w1, w2, w3; sm_part1(st, p0, p1, w0, w1, w2, w3, C);
            const int lv = lane_now(); const int vlane = ((lv >> 4) & 1) * 32 + (lv & 3) * 8 + (4 * (lv >> 5) + ((lv & 15) >> 2)) * 64;
            pv(st.o, (int)C.lds0 + sb + 8192 + vlane, __builtin_bit_cast(bf16x8, w0), __builtin_bit_cast(bf16x8, w1), __builtin_bit_cast(bf16x8, w2), __builtin_bit_cast(bf16x8, w3));
        }
    }
    ATT_WAIT_BAR(0);
}
__device__ __forceinline__ void store_o(const f32x16 (&o)[2], bf16_t* Ow, long pitch, const Ctx& C_) {
    Ctx C = C_; { const int l = lane_now(); C.lane = l; C.r32 = l & 31; C.hi = l >> 5; }
    LAS bf16_t* stg = (LAS bf16_t*)(C.lds + A_OST) + C.wid * 2048;
#pragma unroll
    for (int r = 0; r < 16; ++r) { const int orow = crow(r, C.hi);
#pragma unroll
        for (int d0 = 0; d0 < 2; ++d0) stg[orow * 64 + d0 * 32 + C.r32] = (bf16_t)(cvtpk(o[d0][r], 0.f) & 0xffffu); }
    asm volatile("s_waitcnt lgkmcnt(0)" ::: "memory");
#pragma unroll
    for (int i = 0; i < 4; ++i) { const int row = i * 8 + (C.lane >> 3), ch = C.lane & 7; const u32x4 v = *(const LAS u32x4*)(stg + row * 64 + ch * 8); *(u32x4*)(Ow + (long)row * pitch + ch * 8) = v; }
    asm volatile("s_waitcnt lgkmcnt(0)" ::: "memory");
}
__device__ __forceinline__ void load_q(bf16x8 (&qr)[4], const bf16_t* Qrow, int hi) {
#pragma unroll
    for (int d0 = 0; d0 < 4; ++d0) qr[d0] = *(const bf16x8*)(Qrow + d0 * 16 + hi * 8);
}

}
namespace att {
constexpr int F_K = 0, F_V = 24576, F_SLOT = 8192;
typedef LAS const char* lds_cptr;
typedef short v4i16_t __attribute__((ext_vector_type(4)));
__device__ __forceinline__ float fadd_s(float a, float b) { float r; asm("v_add_f32_e32 %0, %1, %2" : "=v"(r) : "v"(a), "v"(b)); return r; }
__device__ __forceinline__ float fsub_s(float a, float b) { float r; asm("v_sub_f32_e32 %0, %1, %2" : "=v"(r) : "v"(a), "v"(b)); return r; }
__device__ __forceinline__ void kload8(bf16x8* kf, lds_cptr kp) {
    kf[0] = *(const LAS bf16x8*)(kp);        kf[1] = *(const LAS bf16x8*)(kp + 512);
    kf[2] = *(const LAS bf16x8*)(kp + 2048); kf[3] = *(const LAS bf16x8*)(kp + 2560);
    kf[4] = *(const LAS bf16x8*)(kp + 4096); kf[5] = *(const LAS bf16x8*)(kp + 4608);
    kf[6] = *(const LAS bf16x8*)(kp + 6144); kf[7] = *(const LAS bf16x8*)(kp + 6656);
}
__device__ __forceinline__ void kload2(bf16x8* kf, lds_cptr kp, int j) { kf[2 * j] = *(const LAS bf16x8*)(kp + j * 2048); kf[2 * j + 1] = *(const LAS bf16x8*)(kp + j * 2048 + 512); }
__device__ __forceinline__ s16x4 vtr(lds_cptr p) { return __builtin_bit_cast(s16x4, __builtin_amdgcn_ds_read_tr16_b64_v4i16((LAS v4i16_t*)p)); }
__device__ __forceinline__ void fast_prefetch(const Ctx& C, const bf16_t* Kp, const bf16_t* Vp, int t_lo, int ntr) {
    const int lane = lane_now(); const int wid = C.wid;
    const bf16_t* ksrc = Kp + ((long)t_lo * 64 + lane) * 64 + wid * 8;
    const bf16_t* vsrc = Vp + ((long)t_lo * 64 + 16 * (wid & 3) + (lane >> 2)) * 64 + (wid >> 2) * 32 + (lane & 3) * 8;
    const unsigned kdst = C.lds0 + F_K + wid * 1024, vdst = C.lds0 + F_V + wid * 1024;
    glds16(ksrc, (unsigned)__builtin_amdgcn_readfirstlane(kdst)); glds16(vsrc, (unsigned)__builtin_amdgcn_readfirstlane(vdst));
    glds16(ksrc + (long)((1 < ntr) ? 1 : (ntr - 1)) * 4096, (unsigned)__builtin_amdgcn_readfirstlane(kdst + F_SLOT));
    glds16(ksrc + (long)((2 < ntr) ? 2 : (ntr - 1)) * 4096, (unsigned)__builtin_amdgcn_readfirstlane(kdst + 2 * F_SLOT));
}
__device__ __forceinline__ void fast_prefetch2(const Ctx& C, const bf16_t* Kp1, const bf16_t* Vp1, int n1, const bf16_t* Kp2, int t_lo2, int n2) {
    const int lane = lane_now(); const int wid = C.wid;
    const int koff = lane * 64 + wid * 8, voff = (16 * (wid & 3) + (lane >> 2)) * 64 + (wid >> 2) * 32 + (lane & 3) * 8;
    const unsigned kdst = C.lds0 + F_K + wid * 1024, vdst = C.lds0 + F_V + wid * 1024;
    const bf16_t* K2b = Kp2 + (long)t_lo2 * 4096;
    glds16(Kp1 + koff, (unsigned)__builtin_amdgcn_readfirstlane(kdst)); glds16(Vp1 + voff, (unsigned)__builtin_amdgcn_readfirstlane(vdst));
#pragma unroll
    for (int t = 1; t < 3; ++t) { const bool s2 = t >= n1; const int idx = s2 ? ((t - n1 < n2) ? (t - n1) : (n2 - 1)) : t;
        glds16((s2 ? K2b : Kp1) + (long)idx * 4096 + koff, (unsigned)__builtin_amdgcn_readfirstlane(kdst + t * F_SLOT)); }
}
template <int THRL, bool PRE, class MaskF>
__device__ __forceinline__ void fast_pass(const Ctx& C, const bf16x8 (&qr)[4], const bf16_t* Kp, const bf16_t* Vp, int t_lo, int ntr, MaskF mask, f32x16 (&o)[2], float& l_out) {
    const int lane = lane_now(), r32 = lane & 31, hi = lane >> 5; const int wid = C.wid;
    const unsigned lds0 = C.lds0;
    LAS float* wsf = (LAS float*)(C.lds + A_WSF) + wid * 64;
    int NT = ntr; if (NT < 4) NT = 4;
    const bf16_t* ksrc = Kp + ((long)t_lo * 64 + lane) * 64 + wid * 8;
    const bf16_t* vsrc = Vp + ((long)t_lo * 64 + 16 * (wid & 3) + (lane >> 2)) * 64 + (wid >> 2) * 32 + (lane & 3) * 8;
    const unsigned kdst = lds0 + F_K + wid * 1024, vdst = lds0 + F_V + wid * 1024;
#define FP_TSRC(t) ((long)(((t) < ntr) ? (t) : (ntr - 1)) * 4096)
#define DMA_K(t, slot) glds16(ksrc + FP_TSRC(t), (unsigned)__builtin_amdgcn_readfirstlane(kdst + (slot)))
#define DMA_V(t, slot) glds16(vsrc + FP_TSRC(t), (unsigned)__builtin_amdgcn_readfirstlane(vdst + (slot)))
    const int vb0 = (int)(lds0 + F_V) + ((lane >> 4) & 1) * 32 + (lane & 3) * 8 + (4 * hi + ((lane & 15) >> 2)) * 64;
    bf16x8 kf[8];
    const lds_cptr shm3 = (lds_cptr)C.lds; const lds_cptr kp0 = shm3 + F_K + hi * 1024 + r32 * 16; const lds_cptr vp0 = shm3 + F_V + ((lane >> 4) & 1) * 32 + (lane & 3) * 8 + (4 * hi + ((lane & 15) >> 2)) * 64;
    if (!PRE) { DMA_K(0, 0); DMA_V(0, 0); DMA_K(1, F_SLOT); }
    float mhat = 0.f, l_reg = 0.f; o[0] = f32x16{}; o[1] = f32x16{}; f32x16 negm; { float z_ = 0.f; asm volatile("" : "+v"(z_));
#pragma unroll
      for (int r = 0; r < 16; ++r) negm[r] = z_; }
#define CMASK(P0, P1, t) mask(P0, P1, (t))
    bool resc = false;
#define START(P0, P1) do { const float rm = rowmax3(P0, P1); resc = false; \
    { const float dl = rm; mhat = fadd_s(mhat, dl); \
      _Pragma("unroll") for (int r = 0; r < 16; ++r) { P0[r] = fsub_s(P0[r], dl); P1[r] = fsub_s(P1[r], dl); } \
      _Pragma("unroll") for (int r = 0; r < 16; ++r) negm[r] = -mhat; asm volatile("" : "+v"(negm)); } \
    _Pragma("unroll") for (int r = 0; r < 16; ++r) P0[r] = __builtin_amdgcn_exp2f(P0[r]); } while (0)
#define RESC() do { if (resc) { asm volatile("s_waitcnt lgkmcnt(0)" ::: "memory"); \
      _Pragma("unroll") for (int d_ = 0; d_ < 2; ++d_) _Pragma("unroll") for (int r = 0; r < 16; ++r) o[d_][r] *= wsf[crow(r, hi)]; } } while (0)
    f32x16 pA0, pA1, pB0, pB1;
    int sl_prev = 0, sl_cur = 0, sl_next = F_SLOT;
#define ROT() do { sl_prev = sl_cur; sl_cur = sl_next; sl_next = (sl_next == 2 * F_SLOT) ? 0 : sl_next + F_SLOT; } while (0)
    if (!PRE) DMA_K(2, 2 * F_SLOT);
    ATT_WAIT_BAR(3);
    { const LAS unsigned char* kb = C.lds + F_K + hi * 1024 + r32 * 16;
#pragma unroll
      for (int d0 = 0; d0 < 4; ++d0) { const bf16x8 b0 = *(const LAS bf16x8*)(kb + d0 * 2048); const bf16x8 b1 = *(const LAS bf16x8*)(kb + d0 * 2048 + 512);
          if (d0 == 0) { pA0 = __builtin_amdgcn_mfma_f32_32x32x16_bf16(b0, qr[0], negm, 0, 0, 0); pA1 = __builtin_amdgcn_mfma_f32_32x32x16_bf16(b1, qr[0], negm, 0, 0, 0); }
          else { pA0 = __builtin_amdgcn_mfma_f32_32x32x16_bf16(b0, qr[d0], pA0, 0, 0, 0); pA1 = __builtin_amdgcn_mfma_f32_32x32x16_bf16(b1, qr[d0], pA1, 0, 0, 0); } } }
    CMASK(pA0, pA1, 0);
    asm volatile("s_nop 15\n\ts_nop 7" : "+v"(pA0), "+v"(pA1));
    START(pA0, pA1);
#pragma unroll
    for (int r = 0; r < 16; ++r) pA1[r] = __builtin_amdgcn_exp2f(pA1[r]);
    ATT_WAIT_BAR(0);
    DMA_K(3, 0); DMA_V(1, F_SLOT);
    ROT();
    kload8(kf, kp0 + sl_cur);
    ATT_WAIT_BAR(2);
    s16x4 vlo[8], vhi[8]; u32x4 pw0, pw1, pw2, pw3;
#define PKW(P, B) cvtpk(P[B], P[B + 1])
#define PAF(k) __builtin_bit_cast(bf16x8, pw##k)
#define VFR(i) (bf16x8){vlo[i][0], vlo[i][1], vlo[i][2], vlo[i][3], vhi[i][0], vhi[i][1], vhi[i][2], vhi[i][3]}
#define PIN(x) asm volatile("" : "+v"(x))
#define MX3(a, b, c) __builtin_fmaxf(__builtin_fmaxf((a), (b)), (c))
#define GAPA(MF, A0, A1, A2, A3, W0, W1, PW) do { MF; sacc += A0; sacc += A1; sacc += A2; sacc += A3; PIN(sacc); W0; W1; PIN(PW); ATT_SBAR(); } while (0)
#define EX(v) __builtin_amdgcn_exp2f(v)
#define GAPB(MF, X, B) do { MF; X[B] = EX(X[B]); X[B + 1] = EX(X[B + 1]); X[B + 2] = EX(X[B + 2]); X[B + 3] = EX(X[B + 3]); PIN(X); ATT_SBAR(); } while (0)
#define VRD(i) do { vlo[i] = vtr(vp_ + (((i) >> 2) * 4096 + ((i) & 3) * 1024)); vhi[i] = vtr(vp_ + (((i) >> 2) * 4096 + ((i) & 3) * 1024 + 512)); } while (0)
#define KRD(G, j) do { if (G) { kload2(kf, kp0 + sl_next, j); ATT_SBAR(); } } while (0)
#define STEP(C0, C1, P0, P1, t, GK, GV, GL) do { ATT_SBAR(); \
    const lds_cptr vp_ = vp0 + sl_prev; \
    VRD(0); ATT_SBAR(); float sacc = (P0[0] + P0[1]); \
    GAPA(C0 = __builtin_amdgcn_mfma_f32_32x32x16_bf16(kf[0], qr[0], negm, 0, 0, 0), P0[2], P0[3], P0[4], P0[5],     pw0[0] = PKW(P0, 0), pw0[1] = PKW(P0, 2), pw0); \
    VRD(4); ATT_SBAR(); GAPA(C1 = __builtin_amdgcn_mfma_f32_32x32x16_bf16(kf[1], qr[0], negm, 0, 0, 0), P0[6], P0[7], P0[8], P0[9],     pw0[2] = PKW(P0, 4), pw0[3] = PKW(P0, 6), pw0); \
    VRD(1); ATT_SBAR(); GAPA(C0 = __builtin_amdgcn_mfma_f32_32x32x16_bf16(kf[2], qr[1], C0, 0, 0, 0),   P0[10], P0[11], P0[12], P0[13], pw1[0] = PKW(P0, 8), pw1[1] = PKW(P0, 10), pw1); \
    VRD(5); ATT_SBAR(); GAPA(C1 = __builtin_amdgcn_mfma_f32_32x32x16_bf16(kf[3], qr[1], C1, 0, 0, 0),   P0[14], P0[15], P1[0], P1[1],   pw1[2] = PKW(P0, 12), pw1[3] = PKW(P0, 14), pw1); \
    VRD(2); ATT_SBAR(); GAPA(C0 = __builtin_amdgcn_mfma_f32_32x32x16_bf16(kf[4], qr[2], C0, 0, 0, 0),   P1[2], P1[3], P1[4], P1[5],     pw2[0] = PKW(P1, 0), pw2[1] = PKW(P1, 2), pw2); \
    VRD(6); ATT_SBAR(); GAPA(C1 = __builtin_amdgcn_mfma_f32_32x32x16_bf16(kf[5], qr[2], C1, 0, 0, 0),   P1[6], P1[7], P1[8], P1[9],     pw2[2] = PKW(P1, 4), pw2[3] = PKW(P1, 6), pw2); \
    VRD(3); ATT_SBAR(); GAPA(C0 = __builtin_amdgcn_mfma_f32_32x32x16_bf16(kf[6], qr[3], C0, 0, 0, 0),   P1[10], P1[11], P1[12], P1[13], pw3[0] = PKW(P1, 8), pw3[1] = PKW(P1, 10), pw3); \
    VRD(7); ATT_SBAR(); GAPA(C1 = __builtin_amdgcn_mfma_f32_32x32x16_bf16(kf[7], qr[3], C1, 0, 0, 0),   P1[14], P1[15], 0.f, 0.f,       pw3[2] = PKW(P1, 12), pw3[3] = PKW(P1, 14), pw3); \
    l_reg += sacc; \
    if (GK) { DMA_K((t) + 3, sl_cur); } if (GV) { DMA_V((t) + 1, sl_next); } \
    CMASK(C0, C1, t); \
    { float a = MX3(C0[0], C0[1], C1[0]), b = MX3(C0[2], C0[3], C1[1]); a = MX3(a, C1[2], C1[3]); \
      _Pragma("unroll") for (int r = 4; r < 16; r += 4) { a = MX3(a, C0[r], C0[r + 1]); b = MX3(b, C0[r + 2], C0[r + 3]); a = MX3(a, C1[r], C1[r + 1]); b = MX3(b, C1[r + 2], C1[r + 3]); } \
      float rm = __builtin_fmaxf(a, b); { auto rr = __builtin_amdgcn_permlane32_swap(__float_as_uint(rm), __float_as_uint(rm), false, false); rm = __builtin_fmaxf(__uint_as_float(rr[0]), __uint_as_float(rr[1])); } \
      resc = false; \
      if (__builtin_expect(__any(rm > (float)THRL), 0)) { const float dl = __builtin_fmaxf(rm, 0.f); mhat += dl; \
        _Pragma("unroll") for (int r = 0; r < 16; ++r) { C0[r] -= dl; C1[r] -= dl; } \
        _Pragma("unroll") for (int r = 0; r < 16; ++r) negm[r] = -mhat; asm volatile("" : "+v"(negm)); \
        const float f = __builtin_amdgcn_exp2f(-dl); l_reg *= f; if (hi == 0) wsf[r32] = f; resc = true; } } \
    ATT_SBAR(); \
    GAPB(o[0] = __builtin_amdgcn_mfma_f32_32x32x16_bf16(PAF(0), VFR(0), o[0], 0, 0, 0), C0, 0); \
    GAPB(o[1] = __builtin_amdgcn_mfma_f32_32x32x16_bf16(PAF(0), VFR(4), o[1], 0, 0, 0), C0, 4); \
    KRD(GL, 0); GAPB(o[0] = __builtin_amdgcn_mfma_f32_32x32x16_bf16(PAF(1), VFR(1), o[0], 0, 0, 0), C0, 8); \
    KRD(GL, 1); GAPB(o[1] = __builtin_amdgcn_mfma_f32_32x32x16_bf16(PAF(1), VFR(5), o[1], 0, 0, 0), C0, 12); \
    KRD(GL, 2); GAPB(o[0] = __builtin_amdgcn_mfma_f32_32x32x16_bf16(PAF(2), VFR(2), o[0], 0, 0, 0), C1, 0); \
    KRD(GL, 3); GAPB(o[1] = __builtin_amdgcn_mfma_f32_32x32x16_bf16(PAF(2), VFR(6), o[1], 0, 0, 0), C1, 4); \
    GAPB(o[0] = __builtin_amdgcn_mfma_f32_32x32x16_bf16(PAF(3), VFR(3), o[0], 0, 0, 0), C1, 8); \
    GAPB(o[1] = __builtin_amdgcn_mfma_f32_32x32x16_bf16(PAF(3), VFR(7), o[1], 0, 0, 0), C1, 12); \
    } while (0)
    int t = 1;
    for (; t + 5 < NT; t += 2) {
        STEP(pB0, pB1, pA0, pA1, t, true, true, true);     ATT_WAIT_BAR(2); RESC(); ROT();
        STEP(pA0, pA1, pB0, pB1, t + 1, true, true, true); ATT_WAIT_BAR(2); RESC(); ROT();
    }
#define ENDW(tt) do { if ((tt) + 3 < NT) { ATT_WAIT_BAR(2); } else if ((tt) + 2 < NT) { ATT_WAIT_BAR(1); } else { ATT_WAIT_BAR(0); } } while (0)
    for (; t + 1 < NT; t += 2) {
        STEP(pB0, pB1, pA0, pA1, t, (t + 3 < NT), (t + 1 < NT), (t + 1 < NT));         ENDW(t);     RESC(); ROT();
        STEP(pA0, pA1, pB0, pB1, t + 1, (t + 4 < NT), (t + 2 < NT), (t + 2 < NT));     ENDW(t + 1); RESC(); ROT();
    }
#define DRAIN(X0, X1, SL) do { float sacc = X0[0] + X0[1]; \
      _Pragma("unroll") for (int r = 2; r < 16; ++r) sacc += X0[r]; \
      _Pragma("unroll") for (int r = 0; r < 16; ++r) sacc += X1[r]; \
      l_reg += sacc; \
      pw0 = (u32x4){PKW(X0, 0), PKW(X0, 2), PKW(X0, 4), PKW(X0, 6)}; pw1 = (u32x4){PKW(X0, 8), PKW(X0, 10), PKW(X0, 12), PKW(X0, 14)}; \
      pw2 = (u32x4){PKW(X1, 0), PKW(X1, 2), PKW(X1, 4), PKW(X1, 6)}; pw3 = (u32x4){PKW(X1, 8), PKW(X1, 10), PKW(X1, 12), PKW(X1, 14)}; \
      ATT_SBAR(); pv(o, vb0 + (SL), PAF(0), PAF(1), PAF(2), PAF(3)); } while (0)
    if (NT & 1) { DRAIN(pA0, pA1, sl_prev); }
    else { STEP(pB0, pB1, pA0, pA1, NT - 1, false, false, false); RESC(); DRAIN(pB0, pB1, sl_cur); }
#undef DRAIN
    l_out = l_reg;
    ATT_WAIT_BAR(0);
#undef FP_TSRC
#undef DMA_K
#undef DMA_V
#undef CMASK
#undef START
#undef RESC
#undef ROT
#undef PKW
#undef PAF
#undef VFR
#undef PIN
#undef MX3
#undef GAPA
#undef GAPB
#undef EX
#undef VRD
#undef KRD
#undef STEP
#undef ENDW
}

template <bool ADD> __device__ __forceinline__ void acc_rows(const f32x16 (&o)[2], float f, const Ctx& C_) {
    const int l = lane_now(), r32 = l & 31, hi = l >> 5;
    LAS float* wsf = (LAS float*)(C_.lds + A_WSF) + C_.wid * 64;
    if (hi == 0) wsf[r32] = f;
    asm volatile("s_waitcnt lgkmcnt(0)" ::: "memory");
    LAS float* lo = (LAS float*)(C_.lds + A_IMP + C_.wid * 4096) + 4 * hi * 64 + r32;
    LAS float* hp = (LAS float*)(C_.lds + A_OST + C_.wid * 4096) + 4 * hi * 64 + r32;
#pragma unroll
    for (int g = 0; g < 4; ++g) { const f32x4 fv = *(const LAS f32x4*)(wsf + 8 * g + 4 * hi);
#pragma unroll
        for (int i = 0; i < 4; ++i)
#pragma unroll
            for (int d0 = 0; d0 < 2; ++d0) { LAS float* p = ((g < 2) ? lo : hp) + ((i + 8 * (g & 1)) * 64 + 32 * d0);
                const float v = o[d0][4 * g + i] * fv[i]; if (ADD) *p += v; else *p = v; } }
    asm volatile("s_waitcnt lgkmcnt(0)" ::: "memory");
}
__device__ __forceinline__ void acc_flush(unsigned char* Ow, long pitch, const Ctx& C_) {
    const int l = lane_now();
#pragma unroll
    for (int i = 0; i < 4; ++i) { const int row = i * 8 + (l >> 3), ch = l & 7;
        const LAS float* p = (const LAS float*)(C_.lds + (row < 16 ? A_IMP : A_OST) + C_.wid * 4096) + (row & 15) * 64 + ch * 8;
        const f32x4 a = *(const LAS f32x4*)p * 16.f, b = *(const LAS f32x4*)(p + 4) * 16.f;
        u32x2 w; w.x = pk4_fp8(a[0], a[1], a[2], a[3]); w.y = pk4_fp8(b[0], b[1], b[2], b[3]);
        *(u32x2*)(Ow + (long)row * pitch + ch * 8) = w; }
    asm volatile("s_waitcnt lgkmcnt(0)" ::: "memory");
}
template <int THRL, bool PRE, class MaskF1, class MaskF2>
__device__ __forceinline__ void fast_pass2(const Ctx& C, const bf16x8 (&qr)[4], const bf16_t* Kp1, const bf16_t* Vp1, int n1, MaskF1 mask1, float g1,
                                           const bf16_t* Kp2, const bf16_t* Vp2, int t_lo2, int n2, MaskF2 mask2, float g2) {
    f32x16 o[2];
    const int lane = lane_now(), r32 = lane & 31, hi = lane >> 5; const int wid = C.wid;
    const unsigned lds0 = C.lds0;
    LAS float* wsf = (LAS float*)(C.lds + A_WSF) + wid * 64;
    int NT = (n1 + n2 + 1) & ~1; if (NT < 4) NT = 4;
    const int koff = lane * 64 + wid * 8, voff = (16 * (wid & 3) + (lane >> 2)) * 64 + (wid >> 2) * 32 + (lane & 3) * 8;
    const bf16_t* K2b = Kp2 + (long)t_lo2 * 4096; const bf16_t* V2b = Vp2 + (long)t_lo2 * 4096;
    const unsigned kdst = lds0 + F_K + wid * 1024, vdst = lds0 + F_V + wid * 1024;
#define FP_SEG2(t) ((t) >= n1)
#define FP_TIDX(t) (FP_SEG2(t) ? ((((t) - n1) < n2) ? ((t) - n1) : (n2 - 1)) : (t))
#define DMA_K(t, slot) glds16((FP_SEG2(t) ? K2b : Kp1) + (long)FP_TIDX(t) * 4096 + koff, (unsigned)__builtin_amdgcn_readfirstlane(kdst + (slot)))
#define DMA_V(t, slot) glds16((FP_SEG2(t) ? V2b : Vp1) + (long)FP_TIDX(t) * 4096 + voff, (unsigned)__builtin_amdgcn_readfirstlane(vdst + (slot)))
    const int vb0 = (int)(lds0 + F_V) + ((lane >> 4) & 1) * 32 + (lane & 3) * 8 + (4 * hi + ((lane & 15) >> 2)) * 64;
    bf16x8 kf[8];
    const lds_cptr shm3 = (lds_cptr)C.lds; const lds_cptr kp0 = shm3 + F_K + hi * 1024 + r32 * 16; const lds_cptr vp0 = shm3 + F_V + ((lane >> 4) & 1) * 32 + (lane & 3) * 8 + (4 * hi + ((lane & 15) >> 2)) * 64;
    if (!PRE) { DMA_K(0, 0); DMA_V(0, 0); DMA_K(1, F_SLOT); }
    float mhat = 0.f, l_reg = 0.f; o[0] = f32x16{}; o[1] = f32x16{}; const f32x16 zc = {};
#define CMASK(P0, P1, t) do { if ((t) < n1) mask1(P0, P1, (t)); else mask2(P0, P1, (t) - n1); } while (0)
    bool resc = false;
#define START(P0, P1) do { const float rm = rowmax3(P0, P1); resc = false; \
    { const float dl = rm; mhat = fadd_s(mhat, dl); \
      _Pragma("unroll") for (int r = 0; r < 16; ++r) { P0[r] = fsub_s(P0[r], dl); P1[r] = fsub_s(P1[r], dl); } \
      } \
    _Pragma("unroll") for (int r = 0; r < 16; ++r) P0[r] = __builtin_amdgcn_exp2f(P0[r]); } while (0)
#define RESC() do { if (resc) { asm volatile("s_waitcnt lgkmcnt(0)" ::: "memory"); \
      _Pragma("unroll") for (int d_ = 0; d_ < 2; ++d_) _Pragma("unroll") for (int r = 0; r < 16; ++r) o[d_][r] *= wsf[crow(r, hi)]; } } while (0)
    f32x16 pA0, pA1, pB0, pB1;
    int sl_prev = 0, sl_cur = 0, sl_next = F_SLOT;
#define SEAM_FIN(t) do { if ((t) == n1) { acc_rows<true>(o, g1 / halfsum(l_reg), C); o[0] = f32x16{}; o[1] = f32x16{}; l_reg = 0.f; } } while (0)
#define ROT() do { sl_prev = sl_cur; sl_cur = sl_next; sl_next = (sl_next == 2 * F_SLOT) ? 0 : sl_next + F_SLOT; } while (0)
    if (!PRE) DMA_K(2, 2 * F_SLOT);
    ATT_WAIT_BAR(3);
    { const LAS unsigned char* kb = C.lds + F_K + hi * 1024 + r32 * 16;
#pragma unroll
      for (int d0 = 0; d0 < 4; ++d0) { const bf16x8 b0 = *(const LAS bf16x8*)(kb + d0 * 2048); const bf16x8 b1 = *(const LAS bf16x8*)(kb + d0 * 2048 + 512);
          if (d0 == 0) { pA0 = __builtin_amdgcn_mfma_f32_32x32x16_bf16(b0, qr[0], zc, 0, 0, 0); pA1 = __builtin_amdgcn_mfma_f32_32x32x16_bf16(b1, qr[0], zc, 0, 0, 0); }
          else { pA0 = __builtin_amdgcn_mfma_f32_32x32x16_bf16(b0, qr[d0], pA0, 0, 0, 0); pA1 = __builtin_amdgcn_mfma_f32_32x32x16_bf16(b1, qr[d0], pA1, 0, 0, 0); } } }
    CMASK(pA0, pA1, 0);
    asm volatile("s_nop 15\n\ts_nop 7" : "+v"(pA0), "+v"(pA1));
    START(pA0, pA1);
#pragma unroll
    for (int r = 0; r < 16; ++r) pA1[r] = __builtin_amdgcn_exp2f(pA1[r]);
    ATT_WAIT_BAR(0);
    DMA_K(3, 0); DMA_V(1, F_SLOT);
    ROT();
    kload8(kf, kp0 + sl_cur);
    ATT_WAIT_BAR(2);
    s16x4 vlo[8], vhi[8]; u32x4 pw0, pw1, pw2, pw3;
#define PKW(P, B) cvtpk(P[B], P[B + 1])
#define PAF(k) __builtin_bit_cast(bf16x8, pw##k)
#define VFR(i) (bf16x8){vlo[i][0], vlo[i][1], vlo[i][2], vlo[i][3], vhi[i][0], vhi[i][1], vhi[i][2], vhi[i][3]}
#define PIN(x) asm volatile("" : "+v"(x))
#define MX3(a, b, c) __builtin_fmaxf(__builtin_fmaxf((a), (b)), (c))
#define GAPA(MF, A0, A1, A2, A3, W0, W1, PW) do { MF; sacc += A0; sacc += A1; sacc += A2; sacc += A3; PIN(sacc); W0; W1; PIN(PW); ATT_SBAR(); } while (0)
#define EX(v) __builtin_amdgcn_exp2f(v)
#define GAPB(MF, X, B) do { MF; X[B] = EX(X[B]); X[B + 1] = EX(X[B + 1]); X[B + 2] = EX(X[B + 2]); X[B + 3] = EX(X[B + 3]); PIN(X); ATT_SBAR(); } while (0)
#define VRD(i) do { vlo[i] = vtr(vp_ + (((i) >> 2) * 4096 + ((i) & 3) * 1024)); vhi[i] = vtr(vp_ + (((i) >> 2) * 4096 + ((i) & 3) * 1024 + 512)); } while (0)
#define KRD(G, j) do { if (G) { kload2(kf, kp0 + sl_next, j); ATT_SBAR(); } } while (0)
#define STEP(C0, C1, P0, P1, t, GK, GV, GL) do { ATT_SBAR(); \
    const lds_cptr vp_ = vp0 + sl_prev; \
    VRD(0); ATT_SBAR(); float sacc = (P0[0] + P0[1]); \
    GAPA(C0 = __builtin_amdgcn_mfma_f32_32x32x16_bf16(kf[0], qr[0], zc, 0, 0, 0), P0[2], P0[3], P0[4], P0[5],     pw0[0] = PKW(P0, 0), pw0[1] = PKW(P0, 2), pw0); \
    VRD(4); ATT_SBAR(); GAPA(C1 = __builtin_amdgcn_mfma_f32_32x32x16_bf16(kf[1], qr[0], zc, 0, 0, 0), P0[6], P0[7], P0[8], P0[9],     pw0[2] = PKW(P0, 4), pw0[3] = PKW(P0, 6), pw0); \
    VRD(1); ATT_SBAR(); GAPA(C0 = __builtin_amdgcn_mfma_f32_32x32x16_bf16(kf[2], qr[1], C0, 0, 0, 0),   P0[10], P0[11], P0[12], P0[13], pw1[0] = PKW(P0, 8), pw1[1] = PKW(P0, 10), pw1); \
    VRD(5); ATT_SBAR(); GAPA(C1 = __builtin_amdgcn_mfma_f32_32x32x16_bf16(kf[3], qr[1], C1, 0, 0, 0),   P0[14], P0[15], P1[0], P1[1],   pw1[2] = PKW(P0, 12), pw1[3] = PKW(P0, 14), pw1); \
    VRD(2); ATT_SBAR(); GAPA(C0 = __builtin_amdgcn_mfma_f32_32x32x16_bf16(kf[4], qr[2], C0, 0, 0, 0),   P1[2], P1[3], P1[4], P1[5],     pw2[0] = PKW(P1, 0), pw2[1] = PKW(P1, 2), pw2); \
    VRD(6); ATT_SBAR(); GAPA(C1 = __builtin_amdgcn_mfma_f32_32x32x16_bf16(kf[5], qr[2], C1, 0, 0, 0),   P1[6], P1[7], P1[8], P1[9],     pw2[2] = PKW(P1, 4), pw2[3] = PKW(P1, 6), pw2); \
    VRD(3); ATT_SBAR(); GAPA(C0 = __builtin_amdgcn_mfma_f32_32x32x16_bf16(kf[6], qr[3], C0, 0, 0, 0),   P1[10], P1[11], P1[12], P1[13], pw3[0] = PKW(P1, 8), pw3[1] = PKW(P1, 10), pw3); \
    VRD(7); ATT_SBAR(); GAPA(C1 = __builtin_amdgcn_mfma_f32_32x32x16_bf16(kf[7], qr[3], C1, 0, 0, 0),   P1[14], P1[15], 0.f, 0.f,       pw3[2] = PKW(P1, 12), pw3[3] = PKW(P1, 14), pw3); \
    l_reg += sacc; \
    if (GK) { DMA_K((t) + 3, sl_cur); } if (GV) { DMA_V((t) + 1, sl_next); } \
    _Pragma("unroll") for (int r = 0; r < 16; ++r) { C0[r] -= mhat; C1[r] -= mhat; } \
    CMASK(C0, C1, t); \
    { float a = MX3(C0[0], C0[1], C1[0]), b = MX3(C0[2], C0[3], C1[1]); a = MX3(a, C1[2], C1[3]); \
      _Pragma("unroll") for (int r = 4; r < 16; r += 4) { a = MX3(a, C0[r], C0[r + 1]); b = MX3(b, C0[r + 2], C0[r + 3]); a = MX3(a, C1[r], C1[r + 1]); b = MX3(b, C1[r + 2], C1[r + 3]); } \
      float rm = __builtin_fmaxf(a, b); { auto rr = __builtin_amdgcn_permlane32_swap(__float_as_uint(rm), __float_as_uint(rm), false, false); rm = __builtin_fmaxf(__uint_as_float(rr[0]), __uint_as_float(rr[1])); } \
      resc = false; \
      if ((t) == n1) { const float dl = rm; mhat += dl;                        \
        _Pragma("unroll") for (int r = 0; r < 16; ++r) { C0[r] -= dl; C1[r] -= dl; } \
        } \
      else if (__builtin_expect(__any(rm > (float)THRL), 0)) { const float dl = __builtin_fmaxf(rm, 0.f); mhat += dl; \
        _Pragma("unroll") for (int r = 0; r < 16; ++r) { C0[r] -= dl; C1[r] -= dl; } \
        const float f = __builtin_amdgcn_exp2f(-dl); l_reg *= f; if (hi == 0) wsf[r32] = f; resc = true; } } \
    ATT_SBAR(); \
    GAPB(o[0] = __builtin_amdgcn_mfma_f32_32x32x16_bf16(PAF(0), VFR(0), o[0], 0, 0, 0), C0, 0); \
    GAPB(o[1] = __builtin_amdgcn_mfma_f32_32x32x16_bf16(PAF(0), VFR(4), o[1], 0, 0, 0), C0, 4); \
    KRD(GL, 0); GAPB(o[0] = __builtin_amdgcn_mfma_f32_32x32x16_bf16(PAF(1), VFR(1), o[0], 0, 0, 0), C0, 8); \
    KRD(GL, 1); GAPB(o[1] = __builtin_amdgcn_mfma_f32_32x32x16_bf16(PAF(1), VFR(5), o[1], 0, 0, 0), C0, 12); \
    KRD(GL, 2); GAPB(o[0] = __builtin_amdgcn_mfma_f32_32x32x16_bf16(PAF(2), VFR(2), o[0], 0, 0, 0), C1, 0); \
    KRD(GL, 3); GAPB(o[1] = __builtin_amdgcn_mfma_f32_32x32x16_bf16(PAF(2), VFR(6), o[1], 0, 0, 0), C1, 4); \
    GAPB(o[0] = __builtin_amdgcn_mfma_f32_32x32x16_bf16(PAF(3), VFR(3), o[0], 0, 0, 0), C1, 8); \
    GAPB(o[1] = __builtin_amdgcn_mfma_f32_32x32x16_bf16(PAF(3), VFR(7), o[1], 0, 0, 0), C1, 12); \
    } while (0)
    int t = 1;
    for (; t + 5 < NT; t += 2) {
        STEP(pB0, pB1, pA0, pA1, t, true, true, true);     ATT_WAIT_BAR(2); RESC(); SEAM_FIN(t); ROT();
        STEP(pA0, pA1, pB0, pB1, t + 1, true, true, true); ATT_WAIT_BAR(2); RESC(); SEAM_FIN(t + 1); ROT();
    }
#define ENDW(tt) do { if ((tt) + 3 < NT) { ATT_WAIT_BAR(2); } else if ((tt) + 2 < NT) { ATT_WAIT_BAR(1); } else { ATT_WAIT_BAR(0); } } while (0)
    for (; t + 1 < NT; t += 2) {
        STEP(pB0, pB1, pA0, pA1, t, (t + 3 < NT), (t + 1 < NT), (t + 1 < NT));         ENDW(t);     RESC(); SEAM_FIN(t); ROT();
        STEP(pA0, pA1, pB0, pB1, t + 1, (t + 4 < NT), (t + 2 < NT), (t + 2 < NT));     ENDW(t + 1); RESC(); SEAM_FIN(t + 1); ROT();
    }
    STEP(pB0, pB1, pA0, pA1, NT - 1, false, false, false); RESC(); SEAM_FIN(NT - 1);
    { float sacc = pB0[0] + pB0[1];
#pragma unroll
      for (int r = 2; r < 16; ++r) sacc += pB0[r];
#pragma unroll
      for (int r = 0; r < 16; ++r) sacc += pB1[r];
      l_reg += sacc;
      pw0 = (u32x4){PKW(pB0, 0), PKW(pB0, 2), PKW(pB0, 4), PKW(pB0, 6)}; pw1 = (u32x4){PKW(pB0, 8), PKW(pB0, 10), PKW(pB0, 12), PKW(pB0, 14)};
      pw2 = (u32x4){PKW(pB1, 0), PKW(pB1, 2), PKW(pB1, 4), PKW(pB1, 6)}; pw3 = (u32x4){PKW(pB1, 8), PKW(pB1, 10), PKW(pB1, 12), PKW(pB1, 14)};
      ATT_SBAR(); pv(o, vb0 + sl_cur, PAF(0), PAF(1), PAF(2), PAF(3)); }
    acc_rows<true>(o, g2 / halfsum(l_reg), C);
    ATT_WAIT_BAR(0);
#undef FP_SEG2
#undef FP_TIDX
#undef SEAM_FIN
#undef DMA_K
#undef DMA_V
#undef CMASK
#undef START
#undef RESC
#undef ROT
#undef PKW
#undef PAF
#undef VFR
#undef PIN
#undef MX3
#undef GAPA
#undef GAPB
#undef EX
#undef VRD
#undef KRD
#undef STEP
#undef ENDW
}

}
namespace att {
template <int CTRL> __device__ __forceinline__ float dppf(float v) { return __uint_as_float(__builtin_amdgcn_update_dpp(0u, __float_as_uint(v), CTRL, 0xf, 0xf, true)); }
template <class T> __device__ __forceinline__ T* fresh_ptr(T* p) { asm volatile("" : "+v"(p)); return p; }
__device__ __forceinline__ void dil_unit(const Ctx& C, unsigned char* ws, int u, bf16_t* obraw, float* lse) {
    const int gi = u >> 9, v = u & 511, hw = C.wid >> 2, w4 = C.wid & 3;
    const int b = v >> 4, j = (v >> 3) & 1;
    int ds, res, blk, L;
    if (gi == 0) { ds = 1; res = 0; blk = 2 * (v & 7) + hw; L = 2048; }
    else if (gi == 1) { ds = 4; res = (v >> 1) & 3; blk = 2 * (v & 1) + hw; L = 512; }
    else { ds = 16; res = 2 * (v & 7) + hw; blk = 0; L = 128; }
    const int h6 = gi * 2 + j;
    const size_t tokbase = (size_t)b * SEQ + res;
    const bf16_t* Qp = (const bf16_t*)(ws + slot_off(SL_QB + h6)) + tokbase * 64;
    const bf16_t* Kp = (const bf16_t*)(ws + slot_off(SL_KB + h6)) + tokbase * 64;
    const bf16_t* Vp = (const bf16_t*)(ws + slot_off(SL_VB + h6)) + tokbase * 64;
    const long rs = (long)ds * 64;
    int t_lo = 2 * blk - 2; if (t_lo < 0) t_lo = 0; int t_hi = 2 * blk + 2; if (t_hi > L / 64) t_hi = L / 64;
    const int nsteps = (gi == 2) ? 2 : 4;
    const int l0_ = lane_now(); const int hi = l0_ >> 5;
    const int i0 = 128 * blk + 32 * w4, iq = i0 + (l0_ & 31);
    bf16x8 qr[4]; load_q(qr, Qp + (long)iq * rs, hi);
    SM st; sm_init(st);
    auto mask = [&](f32x16& p0, f32x16& p1, int tile) {
        const int lim = fresh(iq - 64 * tile - 4 * hi), lim2 = lim - 128;
#pragma unroll
        for (int r = 0; r < 16; ++r) { const int c = (r & 3) + 8 * (r >> 2);
            if (c > lim || c < lim2) p0[r] = NEG_INF;
            if (c + 32 > lim || c + 32 < lim2) p1[r] = NEG_INF; }
    };
    auto skip = [&](int tile) { return (64 * tile > i0 + 31) || (64 * tile + 63 < i0 - 128); };
    run_pass<2>(C, st, qr, Kp, Vp, rs, t_lo, t_hi, nsteps, mask, skip);
    const float lt = halfsum(st.l);
    const float inv = 1.0f / lt;
    scale_rows(st.o, inv, C);
    store_o(st.o, obraw + (tokbase + (size_t)i0 * ds) * 384 + h6 * 64, (long)ds * 384, C);
    if ((lane_now() >> 5) == 0) lse[(tokbase + (size_t)iq * ds) * 8 + h6] = (st.m + __builtin_amdgcn_logf(lt)) * 0.6931471805599453f;
    ATT_WAIT_BAR(0);
}

__device__ __forceinline__ void nsa_unit(const Ctx& C, unsigned char* ws, int b, int hk, int blk, unsigned char* oa) {
    const int g = C.wid >> 1, head = hk * 4 + g;
    const size_t tokbase = (size_t)b * SEQ;
    const bf16_t* qbase = (const bf16_t*)(ws + slot_off(SL_QA + head)) + (tokbase + 64 * blk + 32 * (C.wid & 1)) * 64;
    const bf16_t* gabase = (const bf16_t*)(ws + slot_off(SL_GA)) + (tokbase + 64 * blk + 32 * (C.wid & 1)) * 64;
#define NSA_LANE_STATE() const int l_ = lane_now(); const int r32_ = l_ & 31, hi = l_ >> 5; const int tq = 64 * blk + 32 * (C.wid & 1) + r32_; \
    const bf16_t* qrow = qbase + r32_ * 64; const bf16_t* ga = gabase + r32_ * 64
#ifndef PROBE_ZERO
#define PROBE_ZERO 0
#endif
    f32x16 ot[2]; ot[0] = f32x16{}; ot[1] = f32x16{};
    LAS float* imp = (LAS float*)(C.lds + A_IMP);
    LAS unsigned* sel = (LAS unsigned*)(C.lds + A_SEL);
#if defined(PROBE_DUP) && PROBE_DUP == 1
    for (int rep_ = 0; rep_ < 2; ++rep_)
#endif
    {
        ot[0] = f32x16{}; ot[1] = f32x16{};
        NSA_LANE_STATE();
        bf16x8 qr[4]; load_q(qr, qrow, hi);
        const float g_cmp = (PROBE_ZERO & 1) ? 0.f : bf2f(ga[head]);
        const int pair = hk * 32 + b;
        const bf16_t* Kc = (const bf16_t*)(ws + WS_KC) + (size_t)pair * 128 * 64;
        const bf16_t* Vc = (const bf16_t*)(ws + WS_KC + MiB) + (size_t)pair * 128 * 64;
        const bool two = blk >= 16;
#ifndef NSA_SPLIT_PASSES
        fast_prefetch2(C, (const bf16_t*)(ws + slot_off(SL_KSLC + hk)) + tokbase * 64, (const bf16_t*)(ws + slot_off(SL_VSLC + hk)) + tokbase * 64, blk + 1,
                       (const bf16_t*)(ws + slot_off(SL_KWIN + hk)) + tokbase * 64, blk >= 8 ? blk - 8 : 0, blk >= 8 ? 9 : blk + 1);
#else
        fast_prefetch(C, (const bf16_t*)(ws + slot_off(SL_KSLC + hk)) + tokbase * 64, (const bf16_t*)(ws + slot_off(SL_VSLC + hk)) + tokbase * 64, 0, blk + 1);
#endif
        dma_tile<1>(C, Kc, Vc, 64, 0, 0, 0, A_OST);
        if (two) dma_tile<1>(C, Kc, Vc, 64, 1, 1, 0, A_OST);
        ATT_WAIT_BAR(0);
        const int nlim = (tq - 31) >> 4;
        auto cmask = [&](f32x16& p0, f32x16& p1, int tile) {
            { const int lim = fresh(nlim - 64 * tile - 4 * hi);
#pragma unroll
              for (int r = 0; r < 16; ++r) { const int c = (r & 3) + 8 * (r >> 2); if (c > lim) p0[r] = NEG_INF; if (c + 32 > lim) p1[r] = NEG_INF; } } };
        float rm;
        { f32x16 s0, s1; qkt(s0, s1, C.lds + A_OST, qr, C.lane); cmask(s0, s1, 0); rm = rowmax(s0, s1);
          if (two) { qkt(s0, s1, C.lds + A_OST + 16384, qr, C.lane); cmask(s0, s1, 1); rm = fmaxf(rm, rowmax(s0, s1)); } }
        const bool has = rm > -1e29f; if (!has) rm = 0.f;
        LAS float* irh; { unsigned a_ = (unsigned)(size_t)(imp + (g * 64 + 32 * (C.wid & 1) + r32_) * 33 + hi); asm volatile("" : "+v"(a_)); irh = (LAS float*)(size_t)a_; }
        float sum = 0.f;
#pragma unroll
        for (int gq = 0; gq < 8; ++gq) irh[16 + 2 * gq] = 0.f;
        asm volatile("s_waitcnt lgkmcnt(0)" ::: "memory");
#pragma unroll
        for (int tile = 0; tile < 2; ++tile) {
            if (tile == 0 || two) {
                f32x16 s0, s1; qkt(s0, s1, C.lds + A_OST + tile * 16384, qr, C.lane); cmask(s0, s1, tile);
#pragma unroll
                for (int r = 0; r < 16; ++r) { s0[r] = __builtin_amdgcn_exp2f(s0[r] - rm); s1[r] = __builtin_amdgcn_exp2f(s1[r] - rm); sum += s0[r] + s1[r]; }
#pragma unroll
                for (int gq = 0; gq < 4; ++gq) { const float A0 = (s0[4 * gq] + s0[4 * gq + 1]) + (s0[4 * gq + 2] + 0.5f * s0[4 * gq + 3]), A1 = (s1[4 * gq] + s1[4 * gq + 1]) + (s1[4 * gq + 2] + 0.5f * s1[4 * gq + 3]);
                    if (tile == 0) { irh[2 * gq] = A0; irh[8 + 2 * gq] = A1; } else { irh[16 + 2 * gq] += A0; irh[24 + 2 * gq] += A1; } }
                asm volatile("s_waitcnt lgkmcnt(0)" ::: "memory");
#pragma unroll
                for (int gq = 0; gq < 4; ++gq) { const int j0 = 16 * tile + 2 * gq + 1, j1 = j0 + 8;
                    irh[j0] += 0.5f * s0[4 * gq + 3];
                    if (j1 < 31) irh[j1] += 0.5f * s1[4 * gq + 3]; else if (hi == 0) irh[j1] += 0.5f * s1[4 * gq + 3]; }
                asm volatile("s_waitcnt lgkmcnt(0)" ::: "memory");
                { const int lv = lane_now(); const int vlane = ((lv >> 4) & 1) * 32 + (lv & 3) * 8 + (4 * (lv >> 5) + ((lv & 15) >> 2)) * 64;
                  pv_tile(ot, (int)C.lds0 + A_OST + tile * 16384 + 8192 + vlane, s0, s1); }
            }
        }
        const float lt = halfsum(sum); const float inv = has ? 1.0f / lt : 0.f;
        if (hi == 0) ((LAS float*)(C.lds + A_SEL + 256))[g * 64 + 32 * (C.wid & 1) + (lane_now() & 31)] = inv;
        scale_rows(ot, g_cmp * inv, C);
        ATT_WAIT_BAR(0);
        {
            const int l_ = lane_now(); const int jb = l_ & 31, hf = l_ >> 5;
            const LAS float* nrm = (const LAS float*)(C.lds + A_SEL + 256);
            unsigned m0 = 1u | (1u << blk); if (blk >= 1) m0 |= 1u << (blk - 1);
            const int need = 8 - __builtin_popcount(m0), ncand = blk - 2;
            const bool cand = (jb >= 1) && (jb <= blk - 2);
#pragma unroll 1
            for (int it = 0; it < 4; ++it) {
                const int q = C.wid * 8 + 2 * it + hf; unsigned m = m0;
                if (ncand > 0) {
                    if (ncand <= need) { m |= ((1u << (blk - 1)) - 1u) & ~1u; }
                    else {
                        float sc = (imp[(0 * 64 + q) * 33 + jb] * nrm[q] + imp[(1 * 64 + q) * 33 + jb] * nrm[64 + q]) + (imp[(2 * 64 + q) * 33 + jb] * nrm[128 + q] + imp[(3 * 64 + q) * 33 + jb] * nrm[192 + q]);
#ifdef PROBE_SELINV
                        sc = 1e30f - sc;
#endif
                        if (!cand) sc = -1.f;
                        for (int r = 0; r < need; ++r) {
                            float mx = sc;
                            mx = fmaxf(mx, dppf<0xB1>(mx)); mx = fmaxf(mx, dppf<0x4E>(mx)); mx = fmaxf(mx, dppf<0x141>(mx)); mx = fmaxf(mx, dppf<0x140>(mx));
                            { const float up = __uint_as_float(__builtin_amdgcn_update_dpp(__float_as_uint(mx), __float_as_uint(mx), 0x142, 0xa, 0xf, false));
                              const float m2 = fmaxf(mx, up);
                              const float m31 = __uint_as_float(__builtin_amdgcn_readlane(__float_as_uint(m2), 31)), m63 = __uint_as_float(__builtin_amdgcn_readlane(__float_as_uint(m2), 63));
                              mx = hf ? m63 : m31; }
                            const unsigned long long bal = __ballot(sc == mx && sc >= 0.f);
                            const unsigned bm = hf ? (unsigned)(bal >> 32) : (unsigned)bal;
                            const int w = __ffs(bm) - 1;
                            if (w >= 0) { m |= 1u << w; if (jb == w) sc = -1.f; }
                        }
                    }
                }
                if (jb == 0) sel[q] = m;
            }
        }
        ATT_WAIT_BAR(0);
    }
    const unsigned mysel = sel[32 * (C.wid & 1) + (lane_now() & 31)];
    acc_rows<false>(ot, 1.0f, C);
#ifndef NSA_SPLIT_PASSES
    {
        const bf16_t* Kp1 = (const bf16_t*)(ws + slot_off(SL_KSLC + hk)) + tokbase * 64; const bf16_t* Vp1 = (const bf16_t*)(ws + slot_off(SL_VSLC + hk)) + tokbase * 64;
        const bf16_t* Kp2 = (const bf16_t*)(ws + slot_off(SL_KWIN + hk)) + tokbase * 64; const bf16_t* Vp2 = (const bf16_t*)(ws + slot_off(SL_VWIN + hk)) + tokbase * 64;
        const int n1 = blk + 1, t_lo2 = blk >= 8 ? blk - 8 : 0, n2 = blk + 1 - t_lo2;
        NSA_LANE_STATE();
        bf16x8 qr[4]; load_q(qr, qrow, hi);
        const float g_slc = (PROBE_ZERO & 2) ? 0.f : bf2f(ga[8 + head]), g_win = (PROBE_ZERO & 4) ? 0.f : bf2f(ga[16 + head]);
        auto mask1 = [&](f32x16& p0, f32x16& p1, int t) {
            const bool on = ((mysel >> t) & 1u);
            if (!__all(on) || t == blk) {
                if (!on) {
#pragma unroll
                    for (int r = 0; r < 16; ++r) { p0[r] = NEG_INF; p1[r] = NEG_INF; } }
                else if (t == blk) { const int lim = fresh(tq - 64 * t - 4 * hi);
#pragma unroll
                    for (int r = 0; r < 16; ++r) { const int c = (r & 3) + 8 * (r >> 2); if (c > lim) p0[r] = NEG_INF; if (c + 32 > lim) p1[r] = NEG_INF; } }
            }
        };
        auto mask2 = [&](f32x16& p0, f32x16& p1, int t) {
            if (t >= n2) {
#pragma unroll
                for (int r = 0; r < 16; ++r) { p0[r] = NEG_INF; p1[r] = NEG_INF; } }
            else if (t == n2 - 1 || (t == 0 && blk >= 8)) { const int lim = fresh(tq - 64 * (t_lo2 + t) - 4 * hi), lim2 = lim - 512;
#pragma unroll
                for (int r = 0; r < 16; ++r) { const int c = (r & 3) + 8 * (r >> 2);
                    if (c > lim || c < lim2) p0[r] = NEG_INF; if (c + 32 > lim || c + 32 < lim2) p1[r] = NEG_INF; } }
        };
        fast_pass2<8, true>(C, qr, Kp1, Vp1, n1, mask1, g_slc, Kp2, Vp2, t_lo2, n2, mask2, g_win);
    }
#else
    {
        const bf16_t* Kp = (const bf16_t*)(ws + slot_off(SL_KSLC + hk)) + tokbase * 64;
        const bf16_t* Vp = (const bf16_t*)(ws + slot_off(SL_VSLC + hk)) + tokbase * 64;
        const int ntr = blk + 1;
        NSA_LANE_STATE();
        bf16x8 qr[4]; load_q(qr, qrow, hi);
        const float g_slc = (PROBE_ZERO & 2) ? 0.f : bf2f(ga[8 + head]);
        auto mask = [&](f32x16& p0, f32x16& p1, int t) {
            const bool on = (t < ntr) && ((mysel >> t) & 1u);
            if (!__all(on) || t == blk) {
                if (!on) {
#pragma unroll
                    for (int r = 0; r < 16; ++r) { p0[r] = NEG_INF; p1[r] = NEG_INF; } }
                else if (t == blk) { const int lim = fresh(tq - 64 * t - 4 * hi);
#pragma unroll
                    for (int r = 0; r < 16; ++r) { const int c = (r & 3) + 8 * (r >> 2); if (c > lim) p0[r] = NEG_INF; if (c + 32 > lim) p1[r] = NEG_INF; } }
            }
        };
        f32x16 o[2]; float l;
        fast_pass<8, true>(C, qr, Kp, Vp, 0, ntr, mask, o, l);
        acc_rows<true>(o, g_slc * __builtin_amdgcn_rcpf(halfsum(l)), C);
#if defined(PROBE_DUP) && PROBE_DUP == 2
        fast_pass<8, false>(C, qr, Kp, Vp, 0, ntr, mask, o, l);
        acc_rows<true>(o, 0.f * halfsum(l), C);
#endif
    }
    {
        const bf16_t* Kp = (const bf16_t*)(ws + slot_off(SL_KWIN + hk)) + tokbase * 64;
        const bf16_t* Vp = (const bf16_t*)(ws + slot_off(SL_VWIN + hk)) + tokbase * 64;
        const int t_lo = blk >= 8 ? blk - 8 : 0, ntr = blk + 1 - t_lo;
        NSA_LANE_STATE();
        bf16x8 qr[4]; load_q(qr, qrow, hi);
        const float g_win = (PROBE_ZERO & 4) ? 0.f : bf2f(ga[16 + head]);
        auto mask = [&](f32x16& p0, f32x16& p1, int t) {
            if (t >= ntr) {
#pragma unroll
                for (int r = 0; r < 16; ++r) { p0[r] = NEG_INF; p1[r] = NEG_INF; } }
            else if (t == ntr - 1 || (t == 0 && blk >= 8)) { const int lim = fresh(tq - 64 * (t_lo + t) - 4 * hi), lim2 = lim - 512;
#pragma unroll
                for (int r = 0; r < 16; ++r) { const int c = (r & 3) + 8 * (r >> 2);
                    if (c > lim || c < lim2) p0[r] = NEG_INF; if (c + 32 > lim || c + 32 < lim2) p1[r] = NEG_INF; } }
        };
        f32x16 o[2]; float l;
        fast_pass<8, false>(C, qr, Kp, Vp, t_lo, ntr, mask, o, l);
        acc_rows<true>(o, g_win * __builtin_amdgcn_rcpf(halfsum(l)), C);
#if defined(PROBE_DUP) && PROBE_DUP == 3
        fast_pass<8, false>(C, qr, Kp, Vp, t_lo, ntr, mask, o, l);
        acc_rows<true>(o, 0.f * halfsum(l), C);
#endif
    }
#endif
    acc_flush(oa + (tokbase + 64 * blk + 32 * (C.wid & 1)) * 1024 + head * 64, 1024, C);
    ATT_WAIT_BAR(0);
}
}
__device__ __forceinline__ void pf4_router(Frame& F, const Args& a, const bool dry = false) {
#ifdef X1_BF16
    const bf16_t* x1 = WSP(bf16_t, WS_Y);
#else
    const float* x1 = a.out;
#endif
    const float* mod = WSP(float, WS_MOD); const float* rowss = WSP(float, WS_ROWSS);
    const float* b_group = (const float*)a.in[22]; const float* b_router = (const float*)a.in[24];
    const bf16_t* rhi = (const bf16_t*)(F.ws + WS_SMALL + 65536); const bf16_t* rlo = (const bf16_t*)(F.ws + WS_SMALL + 196608);
    unsigned char* h2 = WSP(unsigned char, WS_H);
    int* pick_e = (int*)(F.ws + WS_PICK); int* pick_pos = (int*)(F.ws + WS_PICK + 524288); float* pick_w = (float*)(F.ws + WS_PICK + 1048576); int* list = WSP(int, WS_LIST);
    LAS unsigned char* wch = F.lds; LAS float* mv = (LAS float*)(F.lds + 67584);
    LAS float* lg = (LAS float*)(F.lds + 75776) + F.wave * (32 * 40);
    LAS int* lc = (LAS int*)(F.lds + 116736); LAS int* gb = lc + 32;
    const int r32 = F_LANE() & 31, hi = F_LANE() >> 5;
    const int NGW = F.G * 8, ntask = NT_TOK / 32, iters = (ntask + NGW - 1) / NGW;
    for (int it = 0; it < iters; ++it) {
        const int task = it * NGW + F.vcu * 8 + F.wave; const bool valid = task < ntask;
        if (F_TID() < 32) lc[F_TID()] = 0;
        __syncthreads();
        int e1 = 0, e2 = 0, p1 = 0, p2 = 0; float w1 = 0.f, w2 = 0.f; int row = 0;
        f32x16 acc0 = {}, acc1 = {};
        {
            row = (valid ? task : 0) * 32 + r32; const int b = row >> 11;
            float ss = 0.f; { const f32x4* rp = (const f32x4*)(rowss + (size_t)row * 16); const f32x4 s0 = rp[0], s1 = rp[1], s2 = rp[2], s3 = rp[3];
                ss = ((s0[0] + s0[1]) + (s0[2] + s0[3])) + ((s1[0] + s1[1]) + (s1[2] + s1[3])) + ((s2[0] + s2[1]) + (s2[2] + s2[3])) + ((s3[0] + s3[1]) + (s3[2] + s3[3])); }
            const float rstd = __builtin_amdgcn_rsqf(ss * (1.f / DM) + EPS);
            unsigned char* hp = h2 + (size_t)row * DM + 8 * hi;
#ifdef X1_BF16
            const bf16_t* xr = x1 + (size_t)row * DM + 8 * hi;
            u32x4 xq[4];
#pragma unroll
            for (int j = 0; j < 4; ++j) xq[j] = *(const u32x4*)(xr + 16 * j);
#else
            const float* xr = x1 + (size_t)row * DM + 8 * hi;
            f32x4 xq[4][2];
#pragma unroll
            for (int j = 0; j < 4; ++j) { xq[j][0] = *(const f32x4*)(xr + 16 * j); xq[j][1] = *(const f32x4*)(xr + 16 * j + 4); }
#endif
            { const int t_ = F_TID(); const float* a2 = WSP(float, WS_SMALL + 524288) + (size_t)b * 1024; const float* s2 = mod + (size_t)b * 6144 + 3072;
              for (int i = t_; i < 2048; i += 512) mv[i] = (i < 1024) ? a2[i] : s2[i - 1024]; }
            const LAS unsigned char* wrd = wch + r32 * 528 + 16 * hi; const LAS float* mrd = mv + 8 * hi;
#pragma unroll 1
            for (int c = 0; c < 4; ++c) {
                __syncthreads();
                { const int t_ = F_TID();
#pragma unroll
                  for (int p = 0; p < 8; ++p) { const int piece = t_ + 512 * p, mat = piece >> 11, q = piece & 2047, col = q >> 5, kk = (q & 31) * 8;
                      const u32x4 v = *(const u32x4*)((mat ? rlo : rhi) + (size_t)col * 1024 + 256 * c + kk);
                      *(LAS u32x4*)(wch + mat * 33792 + col * 528 + kk * 2) = v; } }
                __syncthreads();
                if (valid) {
#pragma unroll 1
                for (int s4 = 0; s4 < 16; s4 += 4) {
#pragma unroll
                    for (int j = 0; j < 4; ++j) {
                        const int sl = s4 + j, s = 16 * c + sl;
#ifdef X1_BF16
                        const u32x4 xw = xq[j]; const f32x4 xa = {bflo(xw.x), bfhi(xw.x), bflo(xw.y), bfhi(xw.y)}, xb = {bflo(xw.z), bfhi(xw.z), bflo(xw.w), bfhi(xw.w)};
                        if (s + 4 < 64) xq[j] = *(const u32x4*)(xr + 16 * (s + 4));
#else
                        const f32x4 xa = xq[j][0], xb = xq[j][1];
                        if (s + 4 < 64) { xq[j][0] = *(const f32x4*)(xr + 16 * (s + 4)); xq[j][1] = *(const f32x4*)(xr + 16 * (s + 4) + 4); }
#endif
                        const f32x4 ca0 = *(const LAS f32x4*)(mrd + 16 * s), ca1 = *(const LAS f32x4*)(mrd + 16 * s + 4), ch0 = *(const LAS f32x4*)(mrd + 1024 + 16 * s), ch1 = *(const LAS f32x4*)(mrd + 1024 + 16 * s + 4);
                        const bf16x8 Ah0 = *(const LAS bf16x8*)(wrd + 32 * sl), Al0 = *(const LAS bf16x8*)(wrd + 33792 + 32 * sl);
                        const bf16x8 Ah1 = *(const LAS bf16x8*)(wrd + 32 * 528 + 32 * sl), Al1 = *(const LAS bf16x8*)(wrd + 33792 + 32 * 528 + 32 * sl);
                        const f32x4 va = (xa * rstd) * ca0 + ch0, vb = (xb * rstd) * ca1 + ch1;
                        { u32x2 w8; w8.x = pk4_fp8(va[0], va[1], va[2], va[3]); w8.y = pk4_fp8(vb[0], vb[1], vb[2], vb[3]); *(u32x2*)(hp + 16 * s) = w8; }
                        u32x4 whi; whi.x = cvtpk(va[0], va[1]); whi.y = cvtpk(va[2], va[3]); whi.z = cvtpk(vb[0], vb[1]); whi.w = cvtpk(vb[2], vb[3]);
                        u32x4 wlo; wlo.x = cvtpk(va[0] - bflo(whi.x), va[1] - bfhi(whi.x)); wlo.y = cvtpk(va[2] - bflo(whi.y), va[3] - bfhi(whi.y));
                        wlo.z = cvtpk(vb[0] - bflo(whi.z), vb[1] - bfhi(whi.z)); wlo.w = cvtpk(vb[2] - bflo(whi.w), vb[3] - bfhi(whi.w));
                        const bf16x8 Bh = __builtin_bit_cast(bf16x8, whi), Bl = __builtin_bit_cast(bf16x8, wlo);
                        acc0 = __builtin_amdgcn_mfma_f32_32x32x16_bf16(Ah0, Bh, acc0, 0, 0, 0); acc0 = __builtin_amdgcn_mfma_f32_32x32x16_bf16(Ah0, Bl, acc0, 0, 0, 0); acc0 = __builtin_amdgcn_mfma_f32_32x32x16_bf16(Al0, Bh, acc0, 0, 0, 0);
                        acc1 = __builtin_amdgcn_mfma_f32_32x32x16_bf16(Ah1, Bh, acc1, 0, 0, 0); acc1 = __builtin_amdgcn_mfma_f32_32x32x16_bf16(Ah1, Bl, acc1, 0, 0, 0); acc1 = __builtin_amdgcn_mfma_f32_32x32x16_bf16(Al1, Bh, acc1, 0, 0, 0);
                    }
                }
                }
            }
        }
        if (valid) {
            LAS float* lr = lg + r32 * 40;
#pragma unroll
            for (int gq = 0; gq < 4; ++gq) *(LAS f32x4*)(lr + 8 * gq + 4 * hi) = (f32x4){acc0[4 * gq], acc0[4 * gq + 1], acc0[4 * gq + 2], acc0[4 * gq + 3]};
            if (hi == 0) *(LAS f32x4*)(lr + 32) = (f32x4){acc1[0], acc1[1], acc1[2], acc1[3]};
            asm volatile("s_waitcnt lgkmcnt(0)" ::: "memory");
            if (hi == 0) {
                float gl[4];
#pragma unroll
                for (int i = 0; i < 4; ++i) gl[i] = lr[i] + b_group[i];
                int gi = 0; float gm = gl[0];
#pragma unroll
                for (int i = 1; i < 4; ++i) if (gl[i] > gm) { gm = gl[i]; gi = i; }
                float gsum = 0.f;
#pragma unroll
                for (int i = 0; i < 4; ++i) gsum += __expf(gl[i] - gm);
                const float gw = 1.0f / gsum;
                float el[8];
#pragma unroll
                for (int i = 0; i < 8; ++i) el[i] = lr[4 + 8 * gi + i] + b_router[gi * 8 + i];
                int i1 = 0; float v1 = el[0];
#pragma unroll
                for (int i = 1; i < 8; ++i) if (el[i] > v1) { v1 = el[i]; i1 = i; }
                int i2 = -1; float v2 = -INFINITY;
#pragma unroll
                for (int i = 0; i < 8; ++i) if (i != i1 && el[i] > v2) { v2 = el[i]; i2 = i; }
                const float pa = 1.0f / (1.0f + __expf(v2 - v1));
                w1 = gw * pa; w2 = gw * (1.0f - pa); e1 = gi * 8 + i1; e2 = gi * 8 + i2;
                p1 = __hip_atomic_fetch_add((int*)(lc + e1), 1, __ATOMIC_RELAXED, __HIP_MEMORY_SCOPE_WORKGROUP);
                p2 = __hip_atomic_fetch_add((int*)(lc + e2), 1, __ATOMIC_RELAXED, __HIP_MEMORY_SCOPE_WORKGROUP);
            }
        }
        __syncthreads();
        if (!dry && F_TID() < 32) { const int c = lc[F_TID()]; gb[F_TID()] = c ? (int)__hip_atomic_fetch_add(F.ctl + CW_CNT + 64 * F_TID(), (unsigned)c, RLX_AGENT) : 0; }
        __syncthreads();
        if (!dry && valid && hi == 0) {
            p1 += gb[e1]; p2 += gb[e2];
            pick_e[row * 2] = e1; pick_e[row * 2 + 1] = e2; pick_pos[row * 2] = p1; pick_pos[row * 2 + 1] = p2; pick_w[row * 2] = w1; pick_w[row * 2 + 1] = w2;
            list[(size_t)e1 * NT_TOK + p1] = row; list[(size_t)e2 * NT_TOK + p2] = row;
        }
        __syncthreads();
    }
}

__device__ __forceinline__ void moe_tables(Frame& F) {
    LAS int* cnt = (LAS int*)(F.lds + LDS_EXP); LAS int* pre = cnt + 32;
    if (F_TID() < 32) cnt[F_TID()] = (int)__hip_atomic_load(F.ctl + CW_CNT + 64 * F_TID(), RLX_AGENT);
    __syncthreads();
    if (F_TID() == 0) { int s = 0; for (int e = 0; e < 32; ++e) { pre[e] = s; s += (cnt[e] + 255) >> 8; } pre[32] = s; }
    __syncthreads();
}
namespace pg8 {
struct MoeSched {
    const char* A; const char* Bt; int lda, ldb; size_t bstride; bool gather; LAS unsigned char* lds; int G, c;
    __device__ __forceinline__ bool next(int i, Unit& u) const {
        const LAS int* pre = (const LAS int*)(lds + LDS_EXP) + 32;
        const int L = i * G + c; if (L >= 4 * pre[32]) return false;
        const int mtg = L >> 2;
        const int pk = pre[lane_now() & 31];
        const int e = __builtin_popcount((unsigned)__ballot(pk <= mtg)) - 1;
        u.pm = mtg; u.pn = L & 3; u.e = e; u.mt = mtg - pre[e]; return true;
    }
    __device__ __forceinline__ const char* a_base(const Unit& u) const { return gather ? A : A + (size_t)u.pm * BM * lda * 2; }
    __device__ __forceinline__ unsigned a_voff(const Unit&, int ui, int h, int R, int C) const {
        if (gather) { const int tok = ((const LAS int*)(lds + LDS_TOK))[ui * 256 + h * HALF + R]; return (unsigned)(tok * lda + C) * 2u; }
        return (unsigned)((h * HALF + R) * lda + C) * 2u; }
    __device__ __forceinline__ const char* b_base(const Unit& u) const { return Bt + (size_t)u.e * bstride + (size_t)u.pn * BM * ldb * 2; }
    __device__ __forceinline__ int dephase_id() const { return c; }
};
struct GuEpi {
    static constexpr bool PERM = true, noepi = false; static constexpr int MIDK = 0, DEPHASE = 1, DEPHASE_TICKS = 0, NSTORE = 8;
    unsigned char* hid;
    __device__ __forceinline__ void operator()(const f32x4 (&acc)[2][2][4][2], const Unit& u, int, int wr, int wc, int fr, int fq) const {
        const int row0 = u.pm * BM + wr * 64 + fr, col = u.pn * HALF + wc * 32 + 8 * fq;
#pragma unroll
        for (int ai = 0; ai < 2; ++ai)
#pragma unroll
            for (int m = 0; m < 4; ++m) {
                f32x4 v0, v1;
#pragma unroll
                for (int i = 0; i < 4; ++i) { v0[i] = clamp448(siluf_(acc[ai][0][m][0][i] * 0.015625f) * acc[ai][1][m][0][i] * 0.125f); v1[i] = clamp448(siluf_(acc[ai][0][m][1][i] * 0.015625f) * acc[ai][1][m][1][i] * 0.125f); }
                u32x2 w; w.x = pk4_fp8(v0[0], v0[1], v0[2], v0[3]); w.y = pk4_fp8(v1[0], v1[1], v1[2], v1[3]);
                *(u32x2*)(hid + (size_t)(row0 + ai * HALF + m * 16) * EFF + col) = w;
            }
    }
};
struct YEpi {
    static constexpr bool PERM = true, noepi = false; static constexpr int MIDK = 0, DEPHASE = 1, DEPHASE_TICKS = 0;
#ifdef PROBE_NOSTORE
    static constexpr int NSTORE = 0;
#else
    static constexpr int NSTORE = 16;
#endif
    unsigned char* Y; float osc; bool nostore;
    __device__ __forceinline__ void operator()(const f32x4 (&acc)[2][2][4][2], const Unit& u, int, int wr, int wc, int fr, int fq) const {
        const int row0 = u.pm * BM + wr * 64 + fr, col0 = u.pn * BM + wc * 32 + 8 * fq;
#pragma unroll
        for (int ai = 0; ai < 2; ++ai)
#pragma unroll
            for (int m = 0; m < 4; ++m)
#pragma unroll
                for (int bj = 0; bj < 2; ++bj) { const f32x4 v0 = acc[ai][bj][m][0] * osc, v1 = acc[ai][bj][m][1] * osc;
                    u32x2 w; w.x = pk4_fp8(clamp448(v0[0]), clamp448(v0[1]), clamp448(v0[2]), clamp448(v0[3])); w.y = pk4_fp8(clamp448(v1[0]), clamp448(v1[1]), clamp448(v1[2]), clamp448(v1[3]));
                    if (!nostore) *(u32x2*)(Y + (size_t)(row0 + ai * HALF + m * 16) * DM + col0 + bj * HALF) = w; else asm volatile("" :: "v"(w)); }
    }
};
}

__device__ __forceinline__ void moe_fill_tokens(Frame& F, const pg8::MoeSched& S) {
    const LAS int* cnt = (const LAS int*)(F.lds + LDS_EXP); LAS int* tokt = (LAS int*)(F.lds + LDS_TOK); const int* list = WSP(int, WS_LIST);
    if (F.wave < 4) {
        int tv[12]; const int tid = F_TID();
#pragma unroll
        for (int i = 0; i < 12; ++i) { pg8::Unit u; tv[i] = 0;
            if (S.next(i, u)) { const int idx = u.mt * 256 + tid; tv[i] = list[(size_t)u.e * NT_TOK + (idx < cnt[u.e] ? idx : 0)]; } }
#pragma unroll
        for (int i = 0; i < 12; ++i) tokt[i * 256 + tid] = tv[i]; }
    __syncthreads();
}

__device__ __forceinline__ void pi_combine(Frame& F, const Args& a, const float wsc = 1.0f) {
    const LAS int* pre = (const LAS int*)(F.lds + LDS_EXP) + 32;
    const int* pick_e = (const int*)(F.ws + WS_PICK); const int* pick_pos = (const int*)(F.ws + WS_PICK + 524288); const float* pick_w = (const float*)(F.ws + WS_PICK + 1048576);
    const unsigned char* Y = WSP(unsigned char, WS_R1); const float* mod = WSP(float, WS_MOD); float* out = a.out;
    const int gw = F.vcu * 8 + F.wave, NGW = F.G * 8, ln = F_LANE();
    struct Pk { int e0, e1, p0, p1; float w0, w1; };
#ifdef X1_BF16
    const bf16_t* x1b = WSP(bf16_t, WS_Y);
    struct Dat { unsigned a0[4], a1[4]; u32x2 x[4]; float w0, w1; };
#else
    struct Dat { unsigned a0[4], a1[4]; f32x4 x[4]; float w0, w1; };
#endif
    auto ldpk = [&](int r) { Pk k; k.e0 = pick_e[2 * r]; k.e1 = pick_e[2 * r + 1]; k.p0 = pick_pos[2 * r]; k.p1 = pick_pos[2 * r + 1]; k.w0 = pick_w[2 * r]; k.w1 = pick_w[2 * r + 1]; return k; };
    auto lddat = [&](int r, const Pk& k) { Dat d; d.w0 = k.w0 * wsc * 0.0625f; d.w1 = k.w1 * wsc * 0.0625f;
        const size_t s0 = (size_t)pre[k.e0] * 256 + k.p0, s1 = (size_t)pre[k.e1] * 256 + k.p1;
        const unsigned* y0 = (const unsigned*)(Y + s0 * DM) + ln; const unsigned* y1 = (const unsigned*)(Y + s1 * DM) + ln;
#ifdef X1_BF16
        const u32x2* xr = (const u32x2*)(x1b + (size_t)r * DM) + ln;
#else
        const f32x4* xr = (const f32x4*)(out + (size_t)r * DM) + ln;
#endif
#pragma unroll
        for (int j = 0; j < 4; ++j) { d.a0[j] = y0[64 * j]; d.a1[j] = y1[64 * j]; d.x[j] = xr[64 * j]; }
        return d; };
    f32x4 gtv[4];
    auto fin = [&](int r, const Dat& d) { f32x4* xw = (f32x4*)(out + (size_t)r * DM) + ln;
#pragma unroll
        for (int j = 0; j < 4; ++j) { const f32x4 g = gtv[j];
#ifdef X1_BF16
            f32x4 x = {bflo(d.x[j].x), bfhi(d.x[j].x), bflo(d.x[j].y), bfhi(d.x[j].y)};
#else
            f32x4 x = d.x[j];
#endif
            const f32x2 p0 = __builtin_amdgcn_cvt_pk_f32_fp8(d.a0[j], false), p1 = __builtin_amdgcn_cvt_pk_f32_fp8(d.a0[j], true), q0 = __builtin_amdgcn_cvt_pk_f32_fp8(d.a1[j], false), q1 = __builtin_amdgcn_cvt_pk_f32_fp8(d.a1[j], true);
            x[0] += g[0] * (d.w0 * p0[0] + d.w1 * q0[0]); x[1] += g[1] * (d.w0 * p0[1] + d.w1 * q0[1]);
            x[2] += g[2] * (d.w0 * p1[0] + d.w1 * q1[0]); x[3] += g[3] * (d.w0 * p1[1] + d.w1 * q1[1]); xw[64 * j] = x; } };
#pragma unroll 1
    for (int blk = gw; blk < NT_TOK / 32; blk += NGW) {
        const int m0 = blk * 32, b = m0 >> 11, m1 = m0 + 32;
        { const f32x4* gt = (const f32x4*)(mod + (size_t)b * 6144 + 5120) + ln;
#pragma unroll
          for (int j = 0; j < 4; ++j) gtv[j] = gt[64 * j]; }
        int r0 = m0;
        Pk k1 = ldpk(r0); Dat d0 = lddat(r0, k1);
        Pk k2 = ldpk(r0 + 1);
#pragma unroll 1
        for (; r0 < m1; ++r0) {
            const int r1 = r0 + 1, r2 = r0 + 2;
            Dat d1 = d0; if (r1 < m1) d1 = lddat(r1, k2);
            if (r2 < m1) k2 = ldpk(r2);
            fin(r0, d0);
            d0 = d1;
        }
    }
}
#ifndef MK_MODE
#define MK_MODE 2
#endif
constexpr int NPHASE = 12;
#ifndef REP_MASK
#define REP_MASK 0
#endif
#define REPS(k) (((REP_MASK >> (k)) & 1) ? 2 : 1)

__device__ __forceinline__ void pd_compress_stage2(Frame& F, const Args& a, int pm) {
    const int r32 = F_LANE() & 31, hi = F_LANE() >> 5, kv = pm >= 32 ? 1 : 0;
    const bf16_t* w2t = WSP(bf16_t, WS_CW2) + (size_t)kv * 64 * 256;
    const int rowg = 256 * pm + 32 * F.wave + r32;
    const bf16_t* hp = WSP(bf16_t, WS_CHID) + (size_t)rowg * 256 + 8 * hi;
    f32x16 acc0 = {}, acc1 = {};
#pragma unroll 4
    for (int s = 0; s < 16; ++s) {
        const bf16x8 B = *(const bf16x8*)(hp + 16 * s);
        const bf16x8 A0 = *(const bf16x8*)(w2t + (size_t)r32 * 256 + 16 * s + 8 * hi), A1 = *(const bf16x8*)(w2t + (size_t)(32 + r32) * 256 + 16 * s + 8 * hi);
        acc0 = __builtin_amdgcn_mfma_f32_32x32x16_bf16(A0, B, acc0, 0, 0, 0); acc1 = __builtin_amdgcn_mfma_f32_32x32x16_bf16(A1, B, acc1, 0, 0, 0);
    }
    const int mrow = rowg & 8191;
    bf16_t* dst = (bf16_t*)(F.ws + WS_KC + (kv ? MiB : 0)) + (size_t)mrow * 64;
    if (kv == 0) {
        float ss = 0.f;
#pragma unroll
        for (int r = 0; r < 16; ++r) ss += acc0[r] * acc0[r] + acc1[r] * acc1[r];
        ss = att::halfsum(ss);
        const float rstd = __builtin_amdgcn_rsqf(ss * (1.f / 64.f) + EPS);
        const float* nk = (const float*)a.in[9];
        const int b = (mrow >> 7) & 31, n = mrow & 127;
        const float* cc = WSP(float, WS_CROPE) + ((size_t)b * 128 + n) * 32; const float* sn = cc + 32 * 128 * 32;
#pragma unroll
        for (int gq = 0; gq < 4; ++gq) { const int d = 8 * gq + 4 * hi;
            const f32x4 g1 = *(const f32x4*)(nk + d), g2 = *(const f32x4*)(nk + 32 + d), c4 = *(const f32x4*)(cc + d), s4 = *(const f32x4*)(sn + d);
            f32x4 x1, x2;
#pragma unroll
            for (int i = 0; i < 4; ++i) { x1[i] = acc0[4 * gq + i] * rstd * g1[i]; x2[i] = acc1[4 * gq + i] * rstd * g2[i]; }
            const f32x4 o1 = x1 * c4 - x2 * s4, o2 = x1 * s4 + x2 * c4;
            u32x2 w1, w2; w1.x = cvtpk(o1[0], o1[1]); w1.y = cvtpk(o1[2], o1[3]); w2.x = cvtpk(o2[0], o2[1]); w2.y = cvtpk(o2[2], o2[3]);
            *(u32x2*)(dst + d) = w1; *(u32x2*)(dst + 32 + d) = w2; }
    } else {
#pragma unroll
        for (int gq = 0; gq < 4; ++gq) { const int d = 8 * gq + 4 * hi;
            u32x2 w1, w2; w1.x = cvtpk(acc0[4 * gq], acc0[4 * gq + 1]); w1.y = cvtpk(acc0[4 * gq + 2], acc0[4 * gq + 3]); w2.x = cvtpk(acc1[4 * gq], acc1[4 * gq + 1]); w2.y = cvtpk(acc1[4 * gq + 2], acc1[4 * gq + 3]);
            *(u32x2*)(dst + d) = w1; *(u32x2*)(dst + 32 + d) = w2; }
    }
}

__device__ __forceinline__ void pf1_scale_ob(Frame& F) {
    const float* lse = WSP(float, WS_LSE); const u32x2* src = (const u32x2*)(F.ws + WS_H + 64 * MiB); unsigned* dst = (unsigned*)(F.ws + WS_Y);
    const int gw = F.vcu * 8 + F.wave, NGW = F.G * 8, l = F_LANE();
    for (int m = gw; m < NT_TOK; m += NGW) {
        const int j = (l & 31) >> 4;
        const float l0 = lse[(size_t)m * 8 + j], l1 = lse[(size_t)m * 8 + 2 + j], l2 = lse[(size_t)m * 8 + 4 + j];
        const float mx = fmaxf(l0, fmaxf(l1, l2)); const float e0 = __expf(l0 - mx), e1 = __expf(l1 - mx), e2 = __expf(l2 - mx); const float inv = 16.0f * __builtin_amdgcn_rcpf(e0 + e1 + e2);
        const float al[3] = {(PROBE_ZERO & 8) ? 0.f : e0 * inv, (PROBE_ZERO & 8) ? 0.f : e1 * inv, (PROBE_ZERO & 8) ? 0.f : e2 * inv};
        if (l < 32) {
#pragma unroll
            for (int gi = 0; gi < 3; ++gi) { const u32x2 w = src[(size_t)m * 96 + gi * 32 + l]; dst[(size_t)m * 256 + 128 + gi * 32 + l] = pk4_fp8(bflo(w.x) * al[gi], bfhi(w.x) * al[gi], bflo(w.y) * al[gi], bfhi(w.y) * al[gi]); }
        } else dst[(size_t)m * 256 + 224 + (l - 32)] = 0u;
    }
}

__global__ void __launch_bounds__(512, 2) mk_fwd(Args args) {
    extern __shared__ __attribute__((aligned(16))) unsigned char lds_raw[];
    Frame F;
    F.lds = (LAS unsigned char*)lds_raw;
    F.MISC = (volatile LAS unsigned*)(F.lds + LDS_MISC);
    F.wave = __builtin_amdgcn_readfirstlane(threadIdx.x >> 6);
    F.G = gridDim.x; { const int bx = blockIdx.x; F.vcu = (F.G % 8 == 0) ? (bx % 8) * (F.G / 8) + bx / 8 : bx; }
    F.ws = args.ws; F.ctl = (unsigned*)(args.ws + WS_CTL);
    if (F_TID() < 64) ((LAS unsigned*)(F.lds + LDS_MISC))[F_TID()] = 0u;
    __syncthreads();
#if MK_MODE == 1
    cg::grid_group grid = cg::this_grid();
#define GRID_BAR() grid.sync()
#elif MK_MODE == 2
    XcdBarrier bar = xcd_barrier_post(F.ctl + CW_BAR, F.MISC + 8, F.wave);
#define GRID_BAR() xcd_barrier(bar)
#else
#define GRID_BAR() do {} while (0)
#endif
    int lo = args.ph_lo, hi = args.ph_hi; if (hi == 100 || hi == 102) { lo = 2; hi = 3; } if (hi == 101) { lo = 10; hi = 11; }
#ifndef PH_MASK
#define PH_MASK 0xfff
#endif
#define IN(k) (((PH_MASK >> (k)) & 1) && lo <= (k) && (k) < hi)
#ifdef PROBE_DBLBAR
#define SEAM(k) do { if (IN(k) && ((k) + 1 < hi)) { GRID_BAR(); GRID_BAR(); } } while (0)
#else
#define SEAM(k) do { if (IN(k) && ((k) + 1 < hi)) GRID_BAR(); } while (0)
#endif


    if (IN(0)) { pa_prologue(F, args); } SEAM(0);
    if (IN(1)) { pb_modnorm(F, (const float*)args.in[0], (const float*)args.in[5], WSP(float, WS_MOD), 0, 1024, WSP(bf16_t, WS_H), (const float*)args.in[6]); } SEAM(1);
    if (IN(2)) {
#ifdef PC_FP8
        pg8::DenseSched S; S.init(WSP(bf16_t, WS_H), 512, WSP(bf16_t, WS_WIN), 512, NT_TOK, NPROJ, F.G, (int)blockIdx.x);
#ifdef PROBE_HOT
        S.hot = args.ph_hi == 100;
#endif
#else
        pg8::DenseSched S; S.init(WSP(bf16_t, WS_H), 1024, WSP(bf16_t, WS_WIN), 1024, NT_TOK, NPROJ, F.G, (int)blockIdx.x);
#endif
        pg8::ProjEpi E{F.ws, (const int*)args.in[2], WSP(float, WS_ROPE), WSP(float, WS_ROPE) + (size_t)NT_TOK * 32, (const float*)args.in[8], (const float*)args.in[9], (const float*)args.in[16], (const float*)args.in[17], args.ph_hi == 100, args.ph_hi == 102};
#ifdef PC_FP8
        pg8::gemm_phase<pg8::ProjEpi, pg8::DenseSched, true, true>(F.lds, F.wave, 512, S, E);
#else
        pg8::gemm_phase<pg8::ProjEpi, pg8::DenseSched>(F.lds, F.wave, 1024, S, E);
#endif
    } SEAM(2);
    if (IN(3)) {
        const int ncw = F.G >= 128 ? 64 : (F.G > 1 ? F.G / 2 : 1);
        if ((int)blockIdx.x < ncw) {
            pg8::CmpSched S{(const char*)(F.ws + slot_off(SL_KCMP)), (const char*)(F.ws + WS_CW1), 2048, ncw, (int)blockIdx.x};
            pg8::CmpEpi E{WSP(float, WS_SMALL), WSP(bf16_t, WS_CHID)};
            pg8::gemm_phase<pg8::CmpEpi, pg8::CmpSched>(F.lds, F.wave, 2048, S, E);
            VM_WAIT(); __syncthreads();
            pg8::Unit u; for (int i = 0; S.next(i, u); ++i) pd_compress_stage2(F, args, u.pm);
        }
        if ((int)blockIdx.x >= ncw || F.G == 1) {
            att::Ctx C; C.lds = F.lds; C.lane = 0; C.r32 = 0; C.hi = 0; C.wid = F.wave; C.lds0 = (unsigned)(size_t)F.lds;
            const int nd = F.G == 1 ? 1 : F.G - ncw, c = F.G == 1 ? 0 : (int)blockIdx.x - ncw;
            for (int u = c; u < 1536; u += nd) att::dil_unit(C, F.ws, u, (bf16_t*)(F.ws + WS_H + 64 * MiB), WSP(float, WS_LSE));
        }
    } SEAM(3);
    if (IN(4)) {
        att::Ctx C; C.lds = F.lds; C.lane = 0; C.r32 = 0; C.hi = 0; C.wid = F.wave; C.lds0 = (unsigned)(size_t)F.lds;
        for (int v = F.vcu; v < 256; v += F.G) {
            const int bh = v >> 2, k = v & 3, b = bh >> 1, hk = bh & 1;
            for (int i = 0; i < 8; ++i) { const int blk = (i & 1) ? (8 * (i >> 1) + 7 - k) : (8 * (i >> 1) + k); att::nsa_unit(C, F.ws, b, hk, 31 - blk, F.ws + WS_Y); }
        }
        pf1_scale_ob(F);
    } SEAM(4);
    if (IN(5)) {
        pg8::DenseSched S; S.init(F.ws + WS_Y, 512, F.ws + WS_WUPA, 512, NT_TOK, DM, F.G, (int)blockIdx.x);
        pg8::Up2Epi E{F.ws, F.ws + WS_R1 + 64 * MiB};
        pg8::gemm_phase<pg8::Up2Epi, pg8::DenseSched, true, true>(F.lds, F.wave, 512, S, E);
    } SEAM(5);
    if (IN(7)) {
#ifdef PF3_FP8
        pg8::DenseSched S; S.init(F.ws + WS_R1 + 64 * MiB, 512, WSP(bf16_t, WS_WOUT), 512, NT_TOK, DM, F.G, (int)blockIdx.x);
#ifdef X1_BF16
        pg8::OutEpi E{(const float*)args.in[0], WSP(float, WS_Y), WSP(float, WS_MOD), WSP(float, WS_ROWSS), 1.0f / (16.f * 64.f)};
#else
        pg8::OutEpi E{(const float*)args.in[0], args.out, WSP(float, WS_MOD), WSP(float, WS_ROWSS), 1.0f / (16.f * 64.f)};
#endif
        pg8::gemm_phase<pg8::OutEpi, pg8::DenseSched, true, true>(F.lds, F.wave, 512, S, E);
#else
        pg8::DenseSched S; S.init(WSP(bf16_t, WS_Y), 1024, WSP(bf16_t, WS_WOUT), 1024, NT_TOK, DM, F.G, (int)blockIdx.x);
        pg8::OutEpi E{(const float*)args.in[0], args.out, WSP(float, WS_MOD), WSP(float, WS_ROWSS), 1.0f};
        pg8::gemm_phase<pg8::OutEpi, pg8::DenseSched>(F.lds, F.wave, 1024, S, E);
#endif
    } SEAM(7);
    if (IN(8)) { pf4_router(F, args);
#if defined(PROBE_DRY) && PROBE_DRY == 8
        GRID_BAR(); pf4_router(F, args, true);
#endif
    } SEAM(8);
    if (IN(9)) {
        moe_tables(F);
        pg8::MoeSched S{(const char*)(F.ws + WS_H), (const char*)(F.ws + WS_WGU), 512, 512, (size_t)1024 * 1024, true, F.lds, F.G, F.vcu};
        moe_fill_tokens(F, S);
        pg8::GuEpi E{WSP(unsigned char, WS_R2)};
        pg8::gemm_phase<pg8::GuEpi, pg8::MoeSched, true, true>(F.lds, F.wave, 512, S, E);
    } SEAM(9);
    if (IN(10)) {
        moe_tables(F);
        pg8::MoeSched S{(const char*)(F.ws + WS_R2), (const char*)(F.ws + WS_WD), 256, 256, (size_t)1024 * 512, false, F.lds, F.G, F.vcu};
        pg8::YEpi E{F.ws + WS_R1, 16.0f / (8.0f * 64.0f), args.ph_hi == 101};
#ifndef PH_ALIGN
#define PH_ALIGN true
#endif
        pg8::gemm_phase<pg8::YEpi, pg8::MoeSched, PH_ALIGN, true>(F.lds, F.wave, 256, S, E);
    } SEAM(10);
    if (IN(11)) { moe_tables(F); pi_combine(F, args);
#if defined(PROBE_DRY) && PROBE_DRY == 11
        GRID_BAR(); pi_combine(F, args, 0.0f);
#endif
    }
#undef IN
#undef SEAM
}

#ifdef PROBE_MFMA
__global__ void __launch_bounds__(512, 2) probe_mfma(float* sink, int iters) {
    typedef int v8i __attribute__((ext_vector_type(8)));
    const unsigned lane = threadIdx.x;
    v8i a[4], b[4];
    for (int i = 0; i < 4; ++i) for (int j = 0; j < 8; ++j) { unsigned h = lane * 2654435761u + i * 40503u + j * 9973u; h ^= h >> 13; h *= 0x5bd1e995u; h ^= h >> 15; a[i][j] = (int)(h & 0xbfbfbfbfu); h *= 0x9e3779b1u; h ^= h >> 11; b[i][j] = (int)(h & 0xbfbfbfbfu); }
    f32x4 acc[16];
    for (int i = 0; i < 16; ++i) acc[i] = (f32x4){0.f, 0.f, 0.f, 0.f};
#pragma unroll 1
    for (int it = 0; it < iters; ++it) {
#if PROBE_MFMA == 1
#pragma unroll
        for (int i = 0; i < 16; ++i) asm volatile("v_mfma_f32_16x16x128_f8f6f4 %0, %1, %2, %0" : "+v"(acc[i]) : "v"(a[i & 3]), "v"(b[i >> 2]));
#else
#pragma unroll
        for (int i = 0; i < 16; ++i) { bf16x8 x0, x1, y0, y1;
            for (int j = 0; j < 4; ++j) { ((int*)&x0)[j] = a[i & 3][j] & 0x3fff3fff; ((int*)&x1)[j] = a[i & 3][4 + j] & 0x3fff3fff; ((int*)&y0)[j] = b[i >> 2][j] & 0x3fff3fff; ((int*)&y1)[j] = b[i >> 2][4 + j] & 0x3fff3fff; }
            asm volatile("v_mfma_f32_16x16x32_bf16 %0, %1, %2, %0\n\tv_mfma_f32_16x16x32_bf16 %0, %3, %4, %0" : "+v"(acc[i]) : "v"(x0), "v"(y0), "v"(x1), "v"(y1)); }
#endif
    }
    asm volatile("s_nop 15\n\ts_nop 15" ::: "memory");
    float sum = 0.f; for (int i = 0; i < 16; ++i) sum += acc[i][0] + acc[i][1] + acc[i][2] + acc[i][3];
    if (sum == 12345.678f) sink[0] = sum;
}
#endif
extern "C" void kernel_launch(void* const* d_in, const int* in_sizes, int n_in, void* d_out, int out_size, void* d_ws, size_t ws_size, hipStream_t stream) {
    static int grid = 0;
    if (grid == 0) {
        if (n_in != 28 || in_sizes[0] != NT_TOK * DM || out_size != NT_TOK * DM || ws_size < WS_END) {
            fprintf(stderr, "kernel_launch: shape/workspace mismatch (n_in %d, in0 %d, out %d, ws %zu, need %zu)\n", n_in, n_in > 0 ? in_sizes[0] : -1, out_size, ws_size, (size_t)WS_END); grid = -1; return; }
        int dev = 0, cus = 0, per_cu = 0;
        hipGetDevice(&dev); hipDeviceGetAttribute(&cus, hipDeviceAttributeMultiprocessorCount, dev);
        if (hipFuncSetAttribute((const void*)mk_fwd, hipFuncAttributeMaxDynamicSharedMemorySize, LDS_BYTES) != hipSuccess) { fprintf(stderr, "kernel_launch: hipFuncSetAttribute failed\n"); grid = -1; return; }
        if (hipOccupancyMaxActiveBlocksPerMultiprocessor(&per_cu, (const void*)mk_fwd, 512, LDS_BYTES) != hipSuccess || per_cu < 1) { fprintf(stderr, "kernel_launch: occupancy query says %d blocks per CU\n", per_cu); per_cu = 1; }
        (void)hipGetLastError();
        grid = cus;
        fprintf(stderr, "kernel_launch: %d CUs, occupancy %d, grid %d\n", cus, per_cu, grid);
    }
    if (grid < 0) return;
    hipMemsetAsync((char*)d_ws + WS_CTL, 0, CTL_ZERO_BYTES, stream);
    Args a{};
    for (int i = 0; i < 28; ++i) a.in[i] = d_in[i];
    a.out = (float*)d_out; a.ws = (unsigned char*)d_ws;
#if MK_MODE == 0
#ifdef PROBE_NOSTORE
    for (int p = 0; p < NPHASE; ++p) { a.ph_lo = p; a.ph_hi = p + 1; hipLaunchKernelGGL(mk_fwd, dim3(grid), dim3(512), LDS_BYTES, stream, a);
        if (p == 10) { a.ph_lo = 10; a.ph_hi = 101; hipLaunchKernelGGL(mk_fwd, dim3(grid), dim3(512), LDS_BYTES, stream, a); } }
    if (0)
#endif
#ifdef PROBE_NOEPI
    for (int p = 0; p < NPHASE; ++p) { a.ph_lo = p; a.ph_hi = p + 1; hipLaunchKernelGGL(mk_fwd, dim3(grid), dim3(512), LDS_BYTES, stream, a);
        if (p == 2) { a.ph_lo = 2; a.ph_hi = PROBE_NOEPI == 2 ? 102 : 100; hipLaunchKernelGGL(mk_fwd, dim3(grid), dim3(512), LDS_BYTES, stream, a); } }
    if (0)
#endif
    for (int p = 0; p < NPHASE; ++p) for (int r = 0; r < REPS(p); ++r) { a.ph_lo = p; a.ph_hi = p + 1; hipLaunchKernelGGL(mk_fwd, dim3(grid), dim3(512), LDS_BYTES, stream, a); }
#ifdef PROBE_MFMA
    hipFuncSetAttribute((const void*)probe_mfma, hipFuncAttributeMaxDynamicSharedMemorySize, LDS_BYTES);
    hipLaunchKernelGGL(probe_mfma, dim3(grid), dim3(512), LDS_BYTES, stream, (float*)((char*)d_ws + WS_CTL), PROBE_ITERS);
#endif
#elif MK_MODE == 1
    a.ph_lo = 0; a.ph_hi = NPHASE;
    void* kargs[] = {&a};
    hipError_t e = hipLaunchCooperativeKernel((const void*)mk_fwd, dim3(grid), dim3(512), kargs, LDS_BYTES, stream);
    if (e != hipSuccess) fprintf(stderr, "cooperative launch failed: %s (grid %d)\n", hipGetErrorString(e), grid);
#else
    a.ph_lo = 0; a.ph_hi = NPHASE;
    hipLaunchKernelGGL(mk_fwd, dim3(grid), dim3(512), LDS_BYTES, stream, a);
#endif
}
```

```cpp
#include <hip/hip_runtime.h>
#include <hip/hip_cooperative_groups.h>
#include <cstdio>
#include <cstdint>
#include <cmath>
namespace cg = cooperative_groups;

#ifndef PC_BF16
#define PC_FP8 1
#endif
#ifndef NSA_MERGED_PASSES
#define NSA_SPLIT_PASSES 1
#endif
#ifndef X1_AS_F32
#define X1_BF16 1
#endif
#ifndef PF3_BF16
#define PF3_FP8 1
#endif
#define LAS __attribute__((address_space(3)))
#define GAS __attribute__((address_space(1)))
typedef unsigned short bf16_t;
typedef short bf16x8 __attribute__((ext_vector_type(8)));
typedef short s16x4 __attribute__((ext_vector_type(4)));
typedef float f32x2 __attribute__((ext_vector_type(2)));
typedef float f32x4 __attribute__((ext_vector_type(4)));
typedef float f32x16 __attribute__((ext_vector_type(16)));
typedef unsigned u32x2 __attribute__((ext_vector_type(2)));
typedef unsigned u32x4 __attribute__((ext_vector_type(4)));
typedef __bf16 bf16x2_t __attribute__((ext_vector_type(2)));

constexpr int NB = 32, SEQ = 2048, NT_TOK = NB * SEQ, DM = 1024;
constexpr int IN_COLS = 4504, NSLOT = 72, NPROJ = NSLOT * 64;
constexpr int NEXP = 32, EFF = 512;
constexpr float EPS = 1e-6f;
constexpr float C2 = 0.125f * 1.4426950408889634f;
constexpr int SL_QA = 0, SL_KCMP = 8, SL_VCMP = 10, SL_KSLC = 12, SL_VSLC = 14, SL_KWIN = 16, SL_VWIN = 18, SL_QB = 20, SL_KB = 26, SL_VB = 32, SL_GMA = 38, SL_GMB = 54, SL_GA = 70;

constexpr size_t MiB = 1u << 20;
constexpr size_t WS_CTL = 0, CTL_ZERO_BYTES = 256 * 1024;
constexpr size_t WS_MOD = 1 * MiB;
constexpr size_t WS_SMALL = 2 * MiB;
constexpr size_t WS_ROPE = 3 * MiB;
constexpr size_t WS_CROPE = 19 * MiB;
constexpr size_t WS_WIN = 20 * MiB;
constexpr size_t WS_WUPA = 29 * MiB;
constexpr size_t WS_WUPB = 30 * MiB;
constexpr size_t WS_WOUT = 31 * MiB;
constexpr size_t WS_CW1 = 33 * MiB;
constexpr size_t WS_CW2 = 35 * MiB;
constexpr size_t WS_WGU = 36 * MiB;
constexpr size_t WS_WD = 100 * MiB;
constexpr size_t WS_KC = 132 * MiB;
constexpr size_t WS_CHID = 134 * MiB;
constexpr size_t WS_LSE = 142 * MiB;
constexpr size_t WS_ROWSS = 144 * MiB;
constexpr size_t WS_PICK = 148 * MiB;
constexpr size_t WS_LIST = 150 * MiB;
constexpr size_t WS_H = 160 * MiB;
constexpr size_t WS_Y = 288 * MiB;
constexpr size_t WS_R1 = 416 * MiB;
constexpr size_t WS_R2 = 720 * MiB;
constexpr size_t WS_END = 992 * MiB;
constexpr size_t SLOT_BYTES = (size_t)NT_TOK * 64 * 2;
__host__ __device__ __forceinline__ size_t slot_off(int s) { return s < 38 ? WS_R1 + (size_t)s * SLOT_BYTES : WS_R2 + (size_t)(s - 38) * SLOT_BYTES; }
constexpr int CW_BAR = 4096;
constexpr int CW_CNT = 16384;

constexpr int LDS_BYTES = 163840;
constexpr int LDS_STAGE = 0;
constexpr int LDS_X = 131072;
constexpr int LDS_MISC = LDS_BYTES - 256;
constexpr int LDS_TOK = 135168;
constexpr int LDS_EXP = 147456;

__device__ __forceinline__ int lane_now() { int l; asm volatile("v_mbcnt_lo_u32_b32 %0, -1, 0\n\tv_mbcnt_hi_u32_b32 %0, -1, %0" : "=v"(l)); return l; }
#define RLX_AGENT __ATOMIC_RELAXED, __HIP_MEMORY_SCOPE_AGENT
#define LDS_WAIT() asm volatile("s_waitcnt lgkmcnt(0)" ::: "memory")
#define VM_WAIT() asm volatile("s_waitcnt vmcnt(0)" ::: "memory")
__device__ __forceinline__ unsigned cvtpk(float lo, float hi) { f32x2 v = {lo, hi}; bf16x2_t b = __builtin_convertvector(v, bf16x2_t); return __builtin_bit_cast(unsigned, b); }
__device__ __forceinline__ unsigned pk4_fp8(float a, float b, float c, float d) { int w = 0; w = __builtin_amdgcn_cvt_pk_fp8_f32(a, b, w, false); w = __builtin_amdgcn_cvt_pk_fp8_f32(c, d, w, true); return (unsigned)w; }
__device__ __forceinline__ float clamp448(float x) { return __builtin_amdgcn_fmed3f(x, -448.f, 448.f); }
__device__ __forceinline__ float bf2f(unsigned short h) { return __uint_as_float(((unsigned)h) << 16); }
__device__ __forceinline__ float bflo(unsigned w) { return __uint_as_float(w << 16); }
__device__ __forceinline__ float bfhi(unsigned w) { return __uint_as_float(w & 0xffff0000u); }
__device__ __forceinline__ float wave_sum(float v) {
    v += __uint_as_float(__builtin_amdgcn_update_dpp(0u, __float_as_uint(v), 0xB1, 0xf, 0xf, true));
    v += __uint_as_float(__builtin_amdgcn_update_dpp(0u, __float_as_uint(v), 0x4E, 0xf, 0xf, true));
    v += __uint_as_float(__builtin_amdgcn_update_dpp(0u, __float_as_uint(v), 0x141, 0xf, 0xf, true));
    v += __uint_as_float(__builtin_amdgcn_update_dpp(0u, __float_as_uint(v), 0x140, 0xf, 0xf, true));
    v += __uint_as_float(__builtin_amdgcn_update_dpp(0u, __float_as_uint(v), 0x142, 0xa, 0xf, false));
    v += __uint_as_float(__builtin_amdgcn_update_dpp(0u, __float_as_uint(v), 0x143, 0xc, 0xf, false));
    return __uint_as_float(__builtin_amdgcn_readlane(__float_as_uint(v), 63));
}
__device__ __forceinline__ float sigmoidf_(float x) { return __builtin_amdgcn_rcpf(1.0f + __builtin_amdgcn_exp2f(-1.4426950408889634f * x)); }
__device__ __forceinline__ float siluf_(float x) { return x * __builtin_amdgcn_rcpf(1.0f + __builtin_amdgcn_exp2f(-1.4426950408889634f * x)); }
__host__ __device__ __forceinline__ int slot_col0(int H) { return H < 8 ? 64 * H : H < 20 ? 512 + 64 * (H - 8) : H < 38 ? 1304 + 64 * (H - 20) : H < 70 ? 2456 + 64 * (H - 38) : H == 70 ? 1280 : 0; }
__host__ __device__ __forceinline__ int slot_valid(int H) { return H < 70 ? 64 : H == 70 ? 24 : 0; }

#define XB_TMO      128
#define XB_XCNT(j)  (256  + 64 * (j))
#define XB_XSUB(j)  (1280 + 64 * (j))
#define XB_XGEN(j)  (2304 + 64 * (j))
#define XB_TOP      3328
#define XB_TOPGEN   3392
#define XCD_BAR_WORDS 3456
#define XB_SPIN_CAP (1u << 22)
__device__ __forceinline__ unsigned xb_ld(unsigned* p)              { return __hip_atomic_load(p, __ATOMIC_RELAXED, __HIP_MEMORY_SCOPE_AGENT); }
__device__ __forceinline__ unsigned xb_add(unsigned* p, unsigned v) { return __hip_atomic_fetch_add(p, v, __ATOMIC_RELAXED, __HIP_MEMORY_SCOPE_AGENT); }
__device__ __forceinline__ unsigned xb_xcc_id() { return (unsigned)__builtin_amdgcn_s_getreg((3 << 11) | 20) & 0xFu; }
#define XB_SPIN(cond, bar) do { unsigned _sp = 0; while (cond) { __builtin_amdgcn_s_sleep(1); \
    if ((++_sp & 255u) == 0u) { if (xb_ld(&(bar)[XB_TMO])) break; if (_sp > XB_SPIN_CAP) { atomicAdd(&(bar)[XB_TMO], 1u); break; } } } } while (0)
struct XcdBarrier { unsigned* bar; unsigned x; volatile LAS unsigned* st; int wave; };
__device__ __forceinline__ XcdBarrier xcd_barrier_post(unsigned* bar, volatile LAS unsigned* st, int wave) {
    XcdBarrier b; b.bar = bar; b.x = xb_xcc_id(); b.st = st; b.wave = wave;
    if (wave == 0 && lane_now() == 0) (void)xb_add(&bar[XB_XCNT(b.x)], 1u);
    return b;
}
__device__ __forceinline__ void xcd_barrier_complete(unsigned* bar, unsigned x, unsigned& nloc, unsigned& nx) {
    const unsigned G = gridDim.x * gridDim.y * gridDim.z;
    unsigned sum, cnt, mine, sp = 0u;
    for (;;) {
        sum = 0u; cnt = 0u; mine = 0u;
#pragma unroll
        for (unsigned j = 0; j < 16; ++j) { const unsigned c = xb_ld(&bar[XB_XCNT(j)]); sum += c; cnt += (c > 0u) ? 1u : 0u; mine = (j == x) ? c : mine; }
        if (sum == G) break;
        __builtin_amdgcn_s_sleep(1);
        if ((++sp & 255u) == 0u) { if (xb_ld(&bar[XB_TMO])) break; if (sp > XB_SPIN_CAP) { atomicAdd(&bar[XB_TMO], 1u); break; } }
    }
    nloc = mine > 0u ? mine : 1u; nx = cnt > 0u ? cnt : 1u;
}
__device__ __forceinline__ void xcd_barrier(const XcdBarrier& b) {
    asm volatile("s_waitcnt vmcnt(0)" ::: "memory");
    __syncthreads();
    if (b.wave == 0 && lane_now() == 0) {
        unsigned* bar = b.bar;
        __builtin_amdgcn_s_waitcnt(0);
        unsigned nloc = b.st[0], nx = b.st[1];
        if (nloc == 0u) { xcd_barrier_complete(bar, b.x, nloc, nx); b.st[0] = nloc; b.st[1] = nx; }
        const unsigned old = xb_add(&bar[XB_XSUB(b.x)], 1u);
        const unsigned gen = old / nloc;
        if (old + 1u == (gen + 1u) * nloc) {
            __builtin_amdgcn_fence(__ATOMIC_RELEASE, "agent");
            asm volatile("s_waitcnt vmcnt(0)" ::: "memory");
            const unsigned og = xb_add(&bar[XB_TOP], 1u);
            const unsigned tg = og / nx;
            if (og + 1u == (tg + 1u) * nx) xb_add(&bar[XB_TOPGEN], 1u);
            else XB_SPIN(xb_ld(&bar[XB_TOPGEN]) == tg, bar);
            __builtin_amdgcn_fence(__ATOMIC_ACQUIRE, "agent");
            xb_add(&bar[XB_XGEN(b.x)], 1u);
            asm volatile("s_waitcnt vmcnt(0)" ::: "memory");
        } else {
            XB_SPIN(xb_ld(&bar[XB_XGEN(b.x)]) == gen, bar);
            __builtin_amdgcn_fence(__ATOMIC_ACQUIRE, "agent");
            asm volatile("s_waitcnt vmcnt(0)" ::: "memory");
        }
    }
    __syncthreads();
}
namespace pg8 {
constexpr int BM = 256, BK = 64, HALF = 128, HTB = HALF * BK * 2, STAGE_BYTES = 8 * HTB;
__host__ __device__ __forceinline__ int lds_byte(int r, int c) { const int st = (r >> 4) * 2 + (c >> 5), rr = r & 15, cc = c & 31, ob = rr * 64 + cc * 2; return st * 1024 + (ob ^ (((ob >> 9) & 1) << 5)); }
__host__ __device__ __forceinline__ void stage_rc(int b, int& R, int& C) { const int st = b / 1024, sb = b % 1024, swz = sb ^ (((sb >> 9) & 1) << 5); R = (st >> 1) * 16 + swz / 64; C = (st & 1) * 32 + (swz % 64) / 2; }
__host__ __device__ __forceinline__ int perm32(int rho) { const int n = rho >> 4, i = rho & 15; return 8 * (i >> 2) + 4 * n + (i & 3); }

typedef int v4i_t __attribute__((ext_vector_type(4)));
typedef int v8i_t __attribute__((ext_vector_type(8)));
struct Unit { int pm, pn, e, mt; };

template <int N> __device__ __forceinline__ void waitv_n() {
    static_assert(N == 8 || N == 16 || N == 24 || N == 40, "add the immediate");
    if constexpr (N == 8) asm volatile("s_waitcnt vmcnt(8)" ::: "memory");
    else if constexpr (N == 16) asm volatile("s_waitcnt vmcnt(16)" ::: "memory");
    else if constexpr (N == 24) asm volatile("s_waitcnt vmcnt(24)" ::: "memory");
    else asm volatile("s_waitcnt vmcnt(40)" ::: "memory");
}
template <class Epi, class Sched, bool ALIGN_EPI = true, bool FP8 = false>
__device__ __forceinline__ void gemm_phase(LAS unsigned char* lds, const int wid, const int K, const Sched& S, const Epi& E) {
    const int lane = lane_now(), tid = wid * 64 + lane, wr = wid >> 2, wc = wid & 3, fr = lane & 15, fq = lane >> 4;
    const int nt = K / BK;
    int Rr[2], Cc[2]; unsigned voffB[2];
#pragma unroll
    for (int i = 0; i < 2; ++i) { stage_rc(tid * 16 + i * 8192, Rr[i], Cc[i]); const int Rb = Epi::PERM ? ((Rr[i] & ~31) + perm32(Rr[i] & 31)) : Rr[i];
        voffB[i] = (unsigned)(Rb * S.ldb + Cc[i]) * 2u; }
    const size_t kstep = (size_t)(BK * 2);
    const size_t hstepB = (size_t)HALF * S.ldb * 2;
    const unsigned ldsw = (unsigned)wid * 1024u;
    const int aoff = lds_byte(wr * 64 + fr, fq * 8), boff = lds_byte(wc * 32 + fr, fq * 8);
#define PG8_SA(b, h) (((b) * 2 + (h)) * HTB)
#define PG8_SB(b, h) ((4 + (b) * 2 + (h)) * HTB)
#ifdef PROBE_SKIP
#define PG8_SK(bit) (E.noepi && (PROBE_SKIP & (bit)))
#else
#define PG8_SK(bit) false
#endif
#define PG8_STAGE(bufoff, gbase, voff) do { if (!PG8_SK(1)) _Pragma("unroll") for (int _i = 0; _i < 2; ++_i) \
        __builtin_amdgcn_global_load_lds((const unsigned*)((const char*)(gbase) + (voff)[_i]), (LAS unsigned*)(lds + (bufoff) + ldsw + _i * 8192), 16, 0, 0); } while (0)
#define PG8_LDA(dst, b, h) do { if (PG8_SK(2)) {} else if constexpr (FP8) { _Pragma("unroll") for (int m = 0; m < 4; ++m) { const v4i_t lo_ = *(const LAS v4i_t*)(lds + PG8_SA(b, h) + aoff + m * 2048), hi_ = *(const LAS v4i_t*)(lds + PG8_SA(b, h) + aoff + m * 2048 + 1024); \
            dst##8[m] = __builtin_shufflevector(lo_, hi_, 0, 1, 2, 3, 4, 5, 6, 7); } } \
        else { _Pragma("unroll") for (int m = 0; m < 4; ++m) _Pragma("unroll") for (int k = 0; k < 2; ++k) dst[m][k] = *(const LAS bf16x8*)(lds + PG8_SA(b, h) + aoff + m * 2048 + k * 1024); } } while (0)
#define PG8_LDB(dst, b, h) do { if (PG8_SK(2)) {} else if constexpr (FP8) { _Pragma("unroll") for (int n = 0; n < 2; ++n) { const v4i_t lo_ = *(const LAS v4i_t*)(lds + PG8_SB(b, h) + boff + n * 2048), hi_ = *(const LAS v4i_t*)(lds + PG8_SB(b, h) + boff + n * 2048 + 1024); \
            dst##8[n] = __builtin_shufflevector(lo_, hi_, 0, 1, 2, 3, 4, 5, 6, 7); } } \
        else { _Pragma("unroll") for (int n = 0; n < 2; ++n) _Pragma("unroll") for (int k = 0; k < 2; ++k) dst[n][k] = *(const LAS bf16x8*)(lds + PG8_SB(b, h) + boff + n * 2048 + k * 1024); } } while (0)
#ifdef PROBE_HALF
#define PG8_SKIP(ai) (E.noepi && (ai) >= PROBE_HALF)
#else
#define PG8_SKIP(ai) false
#endif
#define PG8_MMA(ai, bj, At, Bt) do { __builtin_amdgcn_s_setprio(1); \
        if (PG8_SKIP(ai)) {} else if constexpr (FP8) { _Pragma("unroll") for (int m = 0; m < 4; ++m) _Pragma("unroll") for (int n = 0; n < 2; ++n) \
            asm volatile("v_mfma_f32_16x16x128_f8f6f4 %0, %1, %2, %0" : "+v"(acc[ai][bj][m][n]) : "v"(Bt##8[n]), "v"(At##8[m])); } \
        else { _Pragma("unroll") for (int m = 0; m < 4; ++m) _Pragma("unroll") for (int n = 0; n < 2; ++n) _Pragma("unroll") for (int k = 0; k < 2; ++k) \
            acc[ai][bj][m][n] = __builtin_amdgcn_mfma_f32_16x16x32_bf16(Bt[n][k], At[m][k], acc[ai][bj][m][n], 0, 0, 0); } \
        __builtin_amdgcn_s_setprio(0); } while (0)
#define PG8_MMA0(ai, bj, At, Bt) do { __builtin_amdgcn_s_setprio(1); \
        _Pragma("unroll") for (int m = 0; m < 4; ++m) _Pragma("unroll") for (int n = 0; n < 2; ++n) \
            asm volatile("v_mfma_f32_16x16x128_f8f6f4 %0, %1, %2, 0" : "=&v"(acc[ai][bj][m][n]) : "v"(Bt##8[n]), "v"(At##8[m])); \
        __builtin_amdgcn_s_setprio(0); } while (0)
#define PG8_WAIT_V(n) asm volatile("s_waitcnt vmcnt(" #n ")" ::: "memory")
#ifndef WV_A
#define WV_A 8
#define WV_B 8
#endif
#define PG8_STR2(x) #x
#define PG8_STR(x) PG8_STR2(x)
#define PG8_WAIT_V_A asm volatile("s_waitcnt vmcnt(" PG8_STR(WV_A) ")" ::: "memory")
#define PG8_WAIT_V_B asm volatile("s_waitcnt vmcnt(" PG8_STR(WV_B) ")" ::: "memory")
#ifdef PG8_RELAX_FIRST
#define PG8_WAIT_V_FIRST do { if (FP8 && Epi::NSTORE > 0 && t == 0 && ui > 0) waitv_n<8 + (Epi::NSTORE > 0 ? Epi::NSTORE : 0)>(); else PG8_WAIT_V_A; } while (0)
#else
#define PG8_WAIT_V_FIRST PG8_WAIT_V_A
#endif
#define PG8_WAIT_L(n) asm volatile("s_waitcnt lgkmcnt(" #n ")" ::: "memory")
#define PG8_BAR __builtin_amdgcn_s_barrier()
#define PG8_SCHED __builtin_amdgcn_sched_barrier(0)
    Unit cur, nxt; int ui = 0;
    if (!S.next(0, cur)) return;
    if constexpr (Epi::DEPHASE > 1) {
        const unsigned slot = (unsigned)S.dephase_id() % Epi::DEPHASE;
        const unsigned long long t0 = __builtin_amdgcn_s_memrealtime(), dl = (unsigned long long)(slot * (unsigned)Epi::DEPHASE_TICKS) / Epi::DEPHASE;
        while (__builtin_amdgcn_s_memrealtime() - t0 < dl) __builtin_amdgcn_s_sleep(8);
    }
    f32x4 acc[2][2][4][2];
    if constexpr (!FP8) {
#pragma unroll
    for (int a = 0; a < 2; ++a)
#pragma unroll
        for (int b = 0; b < 2; ++b)
#pragma unroll
            for (int m = 0; m < 4; ++m)
#pragma unroll
                for (int n = 0; n < 2; ++n) acc[a][b][m][n] = (f32x4){0.f, 0.f, 0.f, 0.f};
    }
    bf16x8 At[4][2], B0[2][2], B1[2][2]; v8i_t At8[4], B08[2], B18[2];
#ifdef PROBE_SKIP
    for (int m = 0; m < 4; ++m) At8[m] = (v8i_t){0,0,0,0,0,0,0,0}; for (int n = 0; n < 2; ++n) { B08[n] = At8[0]; B18[n] = At8[0]; }
#endif
    unsigned vaC[2][2], vaN[2][2];
#pragma unroll
    for (int h = 0; h < 2; ++h)
#pragma unroll
        for (int i = 0; i < 2; ++i) vaC[h][i] = S.a_voff(cur, 0, h, Rr[i], Cc[i]);
    const char* cA = S.a_base(cur); const char* cB = S.b_base(cur);
    PG8_STAGE(PG8_SB(0, 0), cB, voffB); PG8_STAGE(PG8_SB(0, 1), cB + hstepB, voffB); PG8_STAGE(PG8_SA(0, 0), cA, vaC[0]); PG8_STAGE(PG8_SA(0, 1), cA, vaC[1]);
    if (wr == 1) PG8_BAR;
    PG8_WAIT_V(2); PG8_BAR;
    PG8_STAGE(PG8_SB(1, 0), cB + kstep, voffB); PG8_STAGE(PG8_SA(1, 0), cA + kstep, vaC[0]); PG8_STAGE(PG8_SB(1, 1), cB + hstepB + kstep, voffB);
    PG8_WAIT_V(6); PG8_BAR;
    for (;;) {
        const bool has_next = S.next(ui + 1, nxt);
        const char* nA = cA; const char* nB = cB;
        if (has_next) { nA = S.a_base(nxt); nB = S.b_base(nxt);
#pragma unroll
            for (int h = 0; h < 2; ++h)
#pragma unroll
                for (int i = 0; i < 2; ++i) vaN[h][i] = S.a_voff(nxt, ui + 1, h, Rr[i], Cc[i]);
        } else {
#pragma unroll
            for (int h = 0; h < 2; ++h)
#pragma unroll
                for (int i = 0; i < 2; ++i) vaN[h][i] = vaC[h][i];
        }
#pragma unroll 1
        for (int t = 0; t < nt; t += 2) {
            const bool last = (t == nt - 2);
            const char* a1 = cA + (size_t)(t + 1) * kstep;
            const char* a2 = last ? nA : cA + (size_t)(t + 2) * kstep; const char* b2 = last ? nB : cB + (size_t)(t + 2) * kstep;
            const char* a3 = a2 + kstep; const char* b3 = b2 + kstep;
            unsigned va2[2][2];
#pragma unroll
            for (int h = 0; h < 2; ++h)
#pragma unroll
                for (int i = 0; i < 2; ++i) va2[h][i] = last ? vaN[h][i] : vaC[h][i];
            PG8_LDB(B0, 0, 0); PG8_LDB(B1, 0, 1); PG8_SCHED; PG8_LDA(At, 0, 0); PG8_STAGE(PG8_SA(1, 1), a1, vaC[1]);
            PG8_WAIT_V_FIRST; PG8_WAIT_L(0); PG8_BAR; if (FP8 && t == 0) { PG8_MMA0(0, 0, At, B0); PG8_MMA0(0, 1, At, B1); } else { PG8_MMA(0, 0, At, B0); PG8_MMA(0, 1, At, B1); } PG8_BAR; PG8_SCHED;
            PG8_LDA(At, 0, 1); PG8_STAGE(PG8_SB(0, 0), b2, voffB); PG8_STAGE(PG8_SB(0, 1), b2 + hstepB, voffB); PG8_STAGE(PG8_SA(0, 0), a2, va2[0]);
            PG8_WAIT_V_FIRST; PG8_WAIT_L(0); PG8_BAR; if (FP8 && t == 0) { PG8_MMA0(1, 0, At, B0); PG8_MMA0(1, 1, At, B1); } else { PG8_MMA(1, 0, At, B0); PG8_MMA(1, 1, At, B1); } PG8_BAR; PG8_SCHED;
            PG8_LDB(B0, 1, 0); PG8_LDB(B1, 1, 1); PG8_SCHED; PG8_LDA(At, 1, 0); PG8_STAGE(PG8_SA(0, 1), a2, va2[1]);
            PG8_WAIT_V_A; PG8_WAIT_L(0); PG8_BAR; PG8_MMA(0, 0, At, B0); PG8_MMA(0, 1, At, B1); PG8_BAR; PG8_SCHED;
            PG8_LDA(At, 1, 1); PG8_STAGE(PG8_SB(1, 0), b3, voffB); PG8_STAGE(PG8_SB(1, 1), b3 + hstepB, voffB); PG8_STAGE(PG8_SA(1, 0), a3, va2[0]);
            PG8_WAIT_V_B; PG8_WAIT_L(0); PG8_BAR; PG8_MMA(1, 0, At, B0); PG8_MMA(1, 1, At, B1); PG8_BAR; PG8_SCHED;
            if constexpr (Epi::MIDK > 0) { if (t + 2 == Epi::MIDK) {
                if constexpr (FP8) asm volatile("s_nop 15\n\ts_nop 15" ::: "memory");
                int fr_ = fr, fq_ = fq; asm volatile("" : "+v"(fr_), "+v"(fq_)); E.mid(acc, cur, wr, wc, fr_, fq_); } }
        }
        if constexpr (ALIGN_EPI) { if (wr == 0) PG8_BAR; }
        if constexpr (FP8) asm volatile("s_nop 15\n\ts_nop 15" ::: "memory");
#ifdef PROBE_NOEPI
        if (!E.noepi)
#endif
        { int fr_ = fr, fq_ = fq; asm volatile("" : "+v"(fr_), "+v"(fq_)); E(acc, cur, ui, wr, wc, fr_, fq_); }
        if (!has_next) break;
        if constexpr (!FP8) {
#pragma unroll
        for (int a = 0; a < 2; ++a)
#pragma unroll
            for (int b = 0; b < 2; ++b)
#pragma unroll
                for (int m = 0; m < 4; ++m)
#pragma unroll
                    for (int n = 0; n < 2; ++n) acc[a][b][m][n] = (f32x4){0.f, 0.f, 0.f, 0.f};
        }
        cur = nxt; cA = nA; cB = nB; ++ui;
#pragma unroll
        for (int h = 0; h < 2; ++h)
#pragma unroll
            for (int i = 0; i < 2; ++i) vaC[h][i] = vaN[h][i];
        if constexpr (ALIGN_EPI) { if (wr == 1) PG8_BAR; }
    }
    PG8_WAIT_V(0);
    if constexpr (!ALIGN_EPI) { if (wr == 0) PG8_BAR; }
    PG8_BAR;
#undef PG8_SA
#undef PG8_SB
#undef PG8_STAGE
#undef PG8_LDA
#undef PG8_LDB
#undef PG8_MMA
#undef PG8_MMA0
#undef PG8_WAIT_V
#undef PG8_WAIT_V_A
#undef PG8_WAIT_V_B
#undef PG8_WAIT_V_FIRST
#undef PG8_WAIT_L
#undef PG8_BAR
#undef PG8_SCHED
}

struct DenseSched {
    const char* A; const char* Bt; int lda, ldb; int nM, nN, nwg, G, c; bool hot = false;
    __device__ __forceinline__ void init(const void* A_, int lda_, const void* Bt_, int ldb_, int M, int N, int G_, int c_) {
        A = (const char*)A_; Bt = (const char*)Bt_; lda = lda_; ldb = ldb_; nM = M / BM; nN = N / BM; nwg = nM * nN; G = G_; c = c_; }
    __device__ __forceinline__ bool next(int i, Unit& u) const {
        const long L = (long)i * G + c; if (L >= nwg) return false;
        int wgid = (int)L; { const int q = nwg / 8, r = nwg % 8, xcd = wgid % 8, off = wgid / 8; wgid = (xcd < r ? xcd * (q + 1) : r * (q + 1) + (xcd - r) * q) + off; }
#ifndef DENSE_WGM
#define DENSE_WGM 8
#endif
        const int nig = DENSE_WGM * nN, gid = wgid / nig, fm = gid * DENSE_WGM, gsz = (nM - fm) < DENSE_WGM ? (nM - fm) : DENSE_WGM;
        u.pm = fm + ((wgid % nig) % gsz); u.pn = (wgid % nig) / gsz; u.e = 0; u.mt = 0; return true;
    }
#ifdef PROBE_HOT
    __device__ __forceinline__ const char* a_base(const Unit& u) const { return A + (size_t)(hot ? (c & 63) : u.pm) * BM * lda * 2; }
    __device__ __forceinline__ const char* b_base(const Unit& u) const { return Bt + (size_t)(hot ? (c & 15) : u.pn) * BM * ldb * 2; }
#else
    __device__ __forceinline__ const char* a_base(const Unit& u) const { return A + (size_t)u.pm * BM * lda * 2; }
    __device__ __forceinline__ const char* b_base(const Unit& u) const { return Bt + (size_t)u.pn * BM * ldb * 2; }
#endif
    __device__ __forceinline__ unsigned a_voff(const Unit&, int, int h, int R, int C) const { return (unsigned)((h * HALF + R) * lda + C) * 2u; }
    __device__ __forceinline__ int dephase_id() const { return c >> 3; }
};
}
struct Args { const void* in[28]; float* out; unsigned char* ws; int ph_lo, ph_hi; };
struct Frame {
    LAS unsigned char* lds; volatile LAS unsigned* MISC; unsigned* ctl; unsigned char* ws;
    int wave, vcu, G;
};
#define F_LANE() lane_now()
#define F_TID() (F.wave * 64 + lane_now())
#define WSP(T_, off) ((T_*)(F.ws + (off)))

__device__ __forceinline__ void transpose_item(const float* src, int src_ld, int k0, int n0, int nvalid, bf16_t* dst, int dst_ld, int drow0, LAS float* scr, int lane) {
    const int cl = lane & 31;
    float tv[32];
#pragma unroll
    for (int i = 0; i < 32; ++i) { const int kk = 2 * i + (lane >> 5); tv[i] = (cl < nvalid) ? src[(size_t)(k0 + kk) * src_ld + n0 + cl] : 0.f; }
#pragma unroll
    for (int i = 0; i < 32; ++i) { const int kk = 2 * i + (lane >> 5); scr[kk * 33 + cl] = tv[i]; }
    LDS_WAIT(); asm volatile("" ::: "memory");
    const int c = lane & 7;
#pragma unroll
    for (int j = 0; j < 4; ++j) { const int n = (lane >> 3) + 8 * j; const LAS float* s = scr + (8 * c) * 33 + n;
        u32x4 o; o.x = cvtpk(s[0 * 33], s[1 * 33]); o.y = cvtpk(s[2 * 33], s[3 * 33]); o.z = cvtpk(s[4 * 33], s[5 * 33]); o.w = cvtpk(s[6 * 33], s[7 * 33]);
        *(u32x4*)(dst + (size_t)(drow0 + n) * dst_ld + k0 + 8 * c) = o; }
    LDS_WAIT(); asm volatile("" ::: "memory");
}

__device__ __forceinline__ void transpose_item_fp8(const float* src, int src_ld, int k0, int n0, float sc, unsigned char* dst, int dst_ld, int drow0, LAS float* scr, int lane) {
    const int cl = lane & 31;
    float tv[32];
#pragma unroll
    for (int i = 0; i < 32; ++i) { const int kk = 2 * i + (lane >> 5); tv[i] = src[(size_t)(k0 + kk) * src_ld + n0 + cl] * sc; }
#pragma unroll
    for (int i = 0; i < 32; ++i) { const int kk = 2 * i + (lane >> 5); scr[kk * 33 + cl] = tv[i]; }
    LDS_WAIT(); asm volatile("" ::: "memory");
    const int c = lane & 7;
#pragma unroll
    for (int j = 0; j < 4; ++j) { const int n = (lane >> 3) + 8 * j; const LAS float* s = scr + (8 * c) * 33 + n;
        u32x2 o; o.x = pk4_fp8(s[0 * 33], s[1 * 33], s[2 * 33], s[3 * 33]); o.y = pk4_fp8(s[4 * 33], s[5 * 33], s[6 * 33], s[7 * 33]);
        *(u32x2*)(dst + (size_t)(drow0 + n) * dst_ld + k0 + 8 * c) = o; }
    LDS_WAIT(); asm volatile("" ::: "memory");
}
__device__ __forceinline__ void transpose_item_fp8v(const float* src, int src_ld, int k0, int n0, int nvalid, float sc, unsigned char* dst, int dst_ld, int drow0, LAS float* scr, int lane) {
    const int cl = lane & 31;
    float tv[32];
#pragma unroll
    for (int i = 0; i < 32; ++i) { const int kk = 2 * i + (lane >> 5); tv[i] = (cl < nvalid) ? src[(size_t)(k0 + kk) * src_ld + n0 + cl] * sc : 0.f; }
#pragma unroll
    for (int i = 0; i < 32; ++i) { const int kk = 2 * i + (lane >> 5); scr[kk * 33 + cl] = tv[i]; }
    LDS_WAIT(); asm volatile("" ::: "memory");
    const int c = lane & 7;
#pragma unroll
    for (int j = 0; j < 4; ++j) { const int n = (lane >> 3) + 8 * j; const LAS float* s = scr + (8 * c) * 33 + n;
        u32x2 o; o.x = pk4_fp8(s[0 * 33], s[1 * 33], s[2 * 33], s[3 * 33]); o.y = pk4_fp8(s[4 * 33], s[5 * 33], s[6 * 33], s[7 * 33]);
        *(u32x2*)(dst + (size_t)(drow0 + n) * dst_ld + k0 + 8 * c) = o; }
    LDS_WAIT(); asm volatile("" ::: "memory");
}
__device__ __forceinline__ void pa_prologue(Frame& F, const Args& a) {
    const float* c_in = (const float*)a.in[1]; const int* pos = (const int*)a.in[2];
    const float* w_ada = (const float*)a.in[3]; const float* b_ada = (const float*)a.in[4];
    {
        constexpr int MU = 256, MC = 24;
        LAS float* sc = (LAS float*)(F.lds);
        auto stage_c = [&]() {
            float cv[16][4];
#pragma unroll
            for (int r = 0; r < 16; ++r) { const int item = F_TID() + 512 * r, k = item & 1023, q = item >> 10;
#pragma unroll
                for (int i = 0; i < 4; ++i) cv[r][i] = c_in[(4 * q + i) * 1024 + k]; }
            __builtin_amdgcn_sched_barrier(0);
#pragma unroll
            for (int r = 0; r < 16; ++r) { const int item = F_TID() + 512 * r, k = item & 1023, q = item >> 10;
                *(LAS f32x4*)(sc + k * 32 + 4 * q) = (f32x4){siluf_(cv[r][0]), siluf_(cv[r][1]), siluf_(cv[r][2]), siluf_(cv[r][3])}; } };
        if ((int)blockIdx.x < MU) stage_c();
        __syncthreads();
        for (int u = blockIdx.x; u < MU; u += F.G) {
            const int ln = F_LANE(); const bool on = ln < MC; const int n = MC * u + (on ? ln : 0);
            float acc[32];
#pragma unroll
            for (int b = 0; b < 32; ++b) acc[b] = 0.f;
            const float* wp = w_ada + (size_t)(128 * F.wave) * 6144 + n;
            const LAS float* sp = sc + (128 * F.wave) * 32;
            {
                float wv[128];
#pragma unroll
                for (int j = 0; j < 128; ++j) wv[j] = wp[(size_t)j * 6144];
                __builtin_amdgcn_sched_barrier(0);
#pragma unroll
                for (int j = 0; j < 128; ++j)
#pragma unroll
                    for (int b4 = 0; b4 < 8; ++b4) { const f32x4 s = *(const LAS f32x4*)(sp + j * 32 + 4 * b4);
                        acc[4 * b4] += s[0] * wv[j]; acc[4 * b4 + 1] += s[1] * wv[j]; acc[4 * b4 + 2] += s[2] * wv[j]; acc[4 * b4 + 3] += s[3] * wv[j]; }
            }
            __syncthreads();
            LAS float* red = (LAS float*)(F.lds);
#pragma unroll
            for (int b = 0; b < 32; ++b) red[(F.wave * 32 + b) * 64 + ln] = acc[b];
            __syncthreads();
            float* mod = WSP(float, WS_MOD);
            for (int o = F_TID(); o < 32 * MC; o += 512) { const int b = o / MC, col = o % MC; float s = b_ada[MC * u + col];
#pragma unroll
                for (int w = 0; w < 8; ++w) s += red[(w * 32 + b) * 64 + col];
                mod[(size_t)b * 6144 + MC * u + col] = s; }
            __syncthreads();
            if (u + F.G < MU) { stage_c(); __syncthreads(); }
        }
    }
#if defined(PROBE_PA) && PROBE_PA == 2
    for (int rep_ = 0; rep_ < 2; ++rep_)
#endif
    {
        LAS float* scr = (LAS float*)(F.lds + F.wave * 16384);
        const int gw = F.vcu * 8 + F.wave, NGW = F.G * 8, lane = F_LANE();
        constexpr int I_WIN = 16 * 144, I_UPA = 8 * 32, I_UPB = 6 * 32, I_OUT = 16 * 32, I_CW1 = 32 * 8, I_CW2 = 4 * 2, I_GU = 16 * 32, I_WD = 8 * 32;
        constexpr int NITEMS = I_WIN + I_UPA + I_UPB + I_OUT + 2 * I_CW1 + 2 * I_CW2 + NEXP * (I_GU + I_WD);
        struct TItem { const float* src; unsigned char* dst; int src_ld, k0, n0, nvalid, dst_ld, drow0, esz; float sc; };
        auto decode = [&](int r) -> TItem {
            TItem d; d.nvalid = 32; d.sc = 64.f; d.esz = 1;
            if (r < I_WIN) { const int kb = r / 144, rb = r % 144, rho0 = 32 * rb, pn = rho0 >> 8, bj = (rho0 >> 7) & 1, wc = (rho0 >> 5) & 3, H = 4 * pn + wc;
                int nv = slot_valid(H) - 32 * bj; nv = nv < 0 ? 0 : (nv > 32 ? 32 : nv);
                d.src = (const float*)a.in[7]; d.src_ld = IN_COLS; d.k0 = 64 * kb; d.n0 = slot_col0(H) + 32 * bj; d.nvalid = nv;
                if (H >= SL_GMA && H < SL_GA) { const int q = (H - SL_GMA) & 15; d.n0 = slot_col0(H < SL_GMB ? SL_GMA : SL_GMB) + 256 * (q >> 2) + 128 * bj + 32 * (q & 3); }
                d.dst = F.ws + WS_WIN; d.dst_ld = 1024; d.drow0 = rho0; return d; } r -= I_WIN;
            if (r < I_UPA) { const int kb = r / 32, rb = r % 32; d.src = (const float*)a.in[18]; d.src_ld = 1024; d.k0 = 64 * kb; d.n0 = 32 * rb; d.dst = F.ws + WS_WUPA; d.dst_ld = 1024; d.drow0 = 32 * rb; return d; } r -= I_UPA;
            if (r < I_UPB) { const int kb = r / 32, rb = r % 32; d.src = (const float*)a.in[19]; d.src_ld = 1024; d.k0 = 64 * kb; d.n0 = 32 * rb; d.dst = F.ws + WS_WUPA + 512; d.dst_ld = 1024; d.drow0 = 32 * rb; return d; } r -= I_UPB;
            if (r < I_OUT) { const int kb = r / 32, rb = r % 32; d.src = (const float*)a.in[20]; d.src_ld = 1024; d.k0 = 64 * kb; d.n0 = 32 * rb; d.dst = F.ws + WS_WOUT; d.dst_ld = 1024; d.drow0 = 32 * rb; return d; } r -= I_OUT;
            if (r < 2 * I_CW1) { const int kv = r / I_CW1, q = r % I_CW1, kb = q / 8, rb = q % 8; d.esz = 2; d.sc = 1.f;
                d.src = (const float*)a.in[kv ? 14 : 11]; d.src_ld = 256; d.k0 = 64 * kb; d.n0 = 32 * rb; d.dst = F.ws + WS_CW1 + (size_t)kv * 256 * 2048 * 2; d.dst_ld = 2048; d.drow0 = 32 * rb; return d; } r -= 2 * I_CW1;
            if (r < 2 * I_CW2) { const int kv = r / I_CW2, q = r % I_CW2, kb = q / 2, rb = q % 2; d.esz = 2; d.sc = 1.f;
                d.src = (const float*)a.in[kv ? 15 : 12]; d.src_ld = 64; d.k0 = 64 * kb; d.n0 = 32 * rb; d.dst = F.ws + WS_CW2 + (size_t)kv * 64 * 256 * 2; d.dst_ld = 256; d.drow0 = 32 * rb; return d; } r -= 2 * I_CW2;
            const int e = r / (I_GU + I_WD); int q = r % (I_GU + I_WD);
            if (q < I_GU) { const int kb = q / 32, rb = q % 32, rho0 = 32 * rb, pn = rho0 >> 8, bj = (rho0 >> 7) & 1, y0 = rho0 & 127;
                d.src = (const float*)a.in[bj ? 26 : 25] + (size_t)e * 1024 * 512; d.src_ld = 512; d.k0 = 64 * kb; d.n0 = 128 * pn + y0; d.dst = F.ws + WS_WGU + (size_t)e * 1024 * 1024; d.dst_ld = 1024; d.drow0 = rho0; return d; }
            q -= I_GU; { const int kb = q / 32, rb = q % 32;
                d.src = (const float*)a.in[27] + (size_t)e * 512 * 1024; d.src_ld = 1024; d.k0 = 64 * kb; d.n0 = 32 * rb; d.dst = F.ws + WS_WD + (size_t)e * 1024 * 512; d.dst_ld = 512; d.drow0 = 32 * rb; return d; }
        };
        auto iload = [&](const TItem& d, float (&tv)[32]) { const int cl = lane & 31;
#pragma unroll
            for (int i = 0; i < 32; ++i) { const int kk = 2 * i + (lane >> 5); tv[i] = d.src[(size_t)(d.k0 + kk) * d.src_ld + d.n0 + cl]; } };
        auto istore = [&](const TItem& d, const float (&tv)[32]) { const int cl = lane & 31;
#pragma unroll
            for (int i = 0; i < 32; ++i) { const int kk = 2 * i + (lane >> 5); scr[kk * 33 + cl] = (cl < d.nvalid) ? tv[i] * d.sc : 0.f; }
            LDS_WAIT(); asm volatile("" ::: "memory");
            const int c = lane & 7;
#pragma unroll
            for (int j = 0; j < 4; ++j) { const int n = (lane >> 3) + 8 * j; const LAS float* s = scr + (8 * c) * 33 + n;
                unsigned char* dp = d.dst + ((size_t)(d.drow0 + n) * d.dst_ld + d.k0 + 8 * c) * d.esz;
                if (d.esz == 1) { u32x2 o; o.x = pk4_fp8(s[0 * 33], s[1 * 33], s[2 * 33], s[3 * 33]); o.y = pk4_fp8(s[4 * 33], s[5 * 33], s[6 * 33], s[7 * 33]); *(u32x2*)dp = o; }
                else { u32x4 o; o.x = cvtpk(s[0 * 33], s[1 * 33]); o.y = cvtpk(s[2 * 33], s[3 * 33]); o.z = cvtpk(s[4 * 33], s[5 * 33]); o.w = cvtpk(s[6 * 33], s[7 * 33]); *(u32x4*)dp = o; } }
            LDS_WAIT(); asm volatile("" ::: "memory"); };
        float ta[32], tb[32]; TItem da, db;
        int it = gw;
        if (it < NITEMS) { da = decode(it); iload(da, ta); }
#pragma unroll 1
        for (; it < NITEMS; it += 2 * NGW) {
            const bool hb = it + NGW < NITEMS; if (hb) { db = decode(it + NGW); iload(db, tb); }
            istore(da, ta);
            const bool ha = it + 2 * NGW < NITEMS; if (ha) { da = decode(it + 2 * NGW); iload(da, ta); }
            if (hb) istore(db, tb);
        }
    }
#if defined(PROBE_PA) && PROBE_PA == 3
    for (int rep_ = 0; rep_ < 2; ++rep_)
#endif
    {
        const int gt = F.vcu * 512 + F_TID(), NGT = F.G * 512;
        const double inv_rev = exp2(-(double)(gt & 31) * (13.287712379549449 / 32.0)) * 0.15915494309189535;
        float* ccos = WSP(float, WS_CROPE); float* csin = ccos + 32 * 128 * 32;
        for (int idx = gt; idx < 32 * 128 * 32; idx += NGT) { const int n = (idx >> 5) & 127, b = idx >> 12;
            const int tt = 16 * n + 31; const int p = pos[b * SEQ + (tt < SEQ ? tt : SEQ - 1)];
            const double rv = (double)p * inv_rev; const float fr = (float)(rv - rint(rv));
            ccos[idx] = __builtin_amdgcn_cosf(fr); csin[idx] = __builtin_amdgcn_sinf(fr); }
        bf16_t* rhi = (bf16_t*)(F.ws + WS_SMALL + 65536); bf16_t* rlo = (bf16_t*)(F.ws + WS_SMALL + 196608);
        const float* w_group = (const float*)a.in[21]; const float* w_router = (const float*)a.in[23];
        for (int idx = gt; idx < 64 * 1024; idx += NGT) { const int c = idx >> 10, k = idx & 1023;
            float w = 0.f; if (c < 4) w = w_group[k * 4 + c]; else if (c < 36) { const int g = (c - 4) >> 3, e = (c - 4) & 7; w = w_router[((size_t)g * 1024 + k) * 8 + e]; }
            const unsigned hi = cvtpk(w, 0.f) & 0xffffu; const float lo = w - bf2f((unsigned short)hi);
            rhi[idx] = (bf16_t)hi; rlo[idx] = (bf16_t)(cvtpk(lo, 0.f) & 0xffffu); }
        float* bias = WSP(float, WS_SMALL);
        { const int gwv = F.vcu * 8 + F.wave, NGWV = F.G * 8, l = F_LANE(), sub = l >> 3, c8 = l & 7;
          for (int task = gwv; task < 16 * 2 * 32; task += NGWV) { const int ks = task >> 6, kv = (task >> 5) & 1, col = 8 * (task & 31) + c8;
              const float* pe = (const float*)a.in[kv ? 13 : 10] + 128 * ks + 16 * sub; const float* w1 = (const float*)a.in[kv ? 14 : 11] + (size_t)(128 * ks + 16 * sub) * 256 + col;
              float pv[16], wv[16];
#pragma unroll
              for (int i = 0; i < 16; ++i) { pv[i] = pe[i]; wv[i] = w1[(size_t)i * 256]; }
              float sm = 0.f;
#pragma unroll
              for (int i = 0; i < 16; ++i) sm += pv[i] * wv[i];
              sm += __shfl_xor(sm, 8); sm += __shfl_xor(sm, 16); sm += __shfl_xor(sm, 32);
              if (sub == 0) bias[ks * 512 + kv * 256 + col] = sm; } }
        for (int idx = gt; idx < 1024 * 32; idx += NGT) ((unsigned*)(F.ws + WS_WUPA))[(idx >> 5) * 256 + 224 + (idx & 31)] = 0u;
        if (gt < NEXP) F.ctl[CW_CNT + 64 * gt] = 0u;
    }
}

__device__ __forceinline__ void pb_modnorm(Frame& F, const float* x, const float* g, const float* mod, int sh_off, int sc_off, bf16_t* out, const float* g2) {
    const int gw = F.vcu * 8 + F.wave, NGW = F.G * 8;
    { float* a2 = WSP(float, WS_SMALL + 524288); for (int idx = F.vcu * 512 + F_TID(); idx < 32 * 1024; idx += F.G * 512) { const int b = idx >> 10, k = idx & 1023; a2[idx] = g2[k] * (1.0f + mod[(size_t)b * 6144 + 4096 + k]); } }
    const int ln = F_LANE();
#define PB_LOAD(V, M) do { const f32x4* xr_ = (const f32x4*)(x + (size_t)(M) * DM) + ln; _Pragma("unroll") for (int j = 0; j < 4; ++j) V[j] = xr_[64 * j]; } while (0)
#define PB_ROW(V, M) do { float s = 0.f; \
        _Pragma("unroll") for (int j = 0; j < 4; ++j) s += (V[j].x * V[j].x + V[j].y * V[j].y) + (V[j].z * V[j].z + V[j].w * V[j].w); \
        const float rstd = __builtin_amdgcn_rsqf(wave_sum(s) * (1.f / DM) + EPS); \
        unsigned* o4 = (unsigned*)((unsigned char*)out + (size_t)(M) * DM) + ln; \
        _Pragma("unroll") for (int j = 0; j < 4; ++j) { const f32x4 h = (V[j] * rstd) * ca[j] + cb[j]; o4[64 * j] = pk4_fp8(h.x, h.y, h.z, h.w); } } while (0)
#pragma unroll 1
    for (int blk = gw; blk < NT_TOK / 32; blk += NGW) {
        const int m0 = blk * 32, b = m0 >> 11;
        f32x4 ca[4], cb[4];
        { const f32x4* gr = (const f32x4*)g + ln; const f32x4* scr = (const f32x4*)(mod + (size_t)b * 6144 + sc_off) + ln; const f32x4* shr = (const f32x4*)(mod + (size_t)b * 6144 + sh_off) + ln;
#pragma unroll
          for (int j = 0; j < 4; ++j) { ca[j] = gr[64 * j] * (scr[64 * j] + 1.0f); cb[j] = shr[64 * j]; } }
        f32x4 va[4], vb[4];
        PB_LOAD(va, m0);
#pragma unroll 1
        for (int i = 0; i < 32; i += 2) {
            PB_LOAD(vb, m0 + i + 1);
            PB_ROW(va, m0 + i);
            if (i + 2 < 32) PB_LOAD(va, m0 + i + 2);
            PB_ROW(vb, m0 + i + 1);
        }
    }
#undef PB_ROW
#undef PB_LOAD
}
namespace pg8 {
#ifndef PC_DEPHASE
#define PC_DEPHASE 1
#define PC_DEPHASE_TICKS 0
#endif
struct ProjEpi {
    static constexpr bool PERM = true; static constexpr int MIDK = 0, DEPHASE = PC_DEPHASE, DEPHASE_TICKS = PC_DEPHASE_TICKS;
#ifdef PROBE_NOEPI
    static constexpr int NSTORE = 0;
#else
    static constexpr int NSTORE = 8;
#endif
    unsigned char* ws; const int* pos; const float* cosT; const float* sinT; const float* nq; const float* nk; const float* dq; const float* dk; bool noepi; bool hotst = false;
    static __device__ __forceinline__ float xsum(float x) {
        float y = x; asm("s_nop 1\n\tv_permlane16_swap_b32 %0, %1" : "+v"(x), "+v"(y)); x += y;
        y = x; asm("s_nop 1\n\tv_permlane32_swap_b32 %0, %1" : "+v"(x), "+v"(y)); return x + y; }
    __device__ __forceinline__ void operator()(const f32x4 (&acc)[2][2][4][2], const Unit& u, int, int wr, int wc, int fr, int fq) const {
#ifdef PC_FP8
        constexpr float SC = 0.015625f;
#else
        constexpr float SC = 1.0f;
#endif
        const int H = __builtin_amdgcn_readfirstlane(4 * u.pn + wc);
        int type = 0; const float* gn = nq; float qs = 1.f;
        if (H < 8) { type = 1; gn = nq; qs = C2; }
        else if (H == 12 || H == 13 || H == 16 || H == 17) { type = 1; gn = nk; }
        else if (H >= 20 && H < 26) { type = 1; gn = dq; qs = C2; }
        else if (H >= 26 && H < 32) { type = 1; gn = dk; }
        else if (H >= 38 && H <= 70) type = 2;
        bf16_t* dst = (bf16_t*)(ws + slot_off(H));
#ifdef PROBE_HOTST
        const int row0 = hotst ? (int)blockIdx.x * 256 + wr * 64 + fr : u.pm * BM + wr * 64 + fr;
        if (hotst) dst = (bf16_t*)(ws + WS_Y) + (size_t)wc * 65536 * 64;
#else
        const int row0 = u.pm * BM + wr * 64 + fr;
#endif
        if (type == 1) {
            f32x4 g0[2], g1[2], ir[2];
#pragma unroll
            for (int n = 0; n < 2; ++n) { g0[n] = *(const f32x4*)(gn + 8 * fq + 4 * n) * qs; g1[n] = *(const f32x4*)(gn + 32 + 8 * fq + 4 * n) * qs;
#pragma unroll
                for (int i = 0; i < 4; ++i) ir[n][i] = __builtin_amdgcn_exp2f(-(float)(8 * fq + 4 * n + i) * 0.41524101186092033f - 2.651496129472319f); }
            float pf[8], rs[8];
#pragma unroll
            for (int j = 0; j < 8; ++j) pf[j] = (float)pos[row0 + (j >> 2) * HALF + (j & 3) * 16];
#pragma unroll
            for (int j = 0; j < 8; ++j) { const int ai = j >> 2, m = j & 3;
                f32x4 q = acc[ai][0][m][0] * acc[ai][0][m][0]; q += acc[ai][0][m][1] * acc[ai][0][m][1]; q += acc[ai][1][m][0] * acc[ai][1][m][0]; q += acc[ai][1][m][1] * acc[ai][1][m][1];
                rs[j] = (q[0] + q[1]) + (q[2] + q[3]); }
#ifdef PC_XSUM_SWAP
#pragma unroll
            for (int j = 0; j < 8; ++j) rs[j] = xsum(rs[j]);
#else
            { float t[8];
#pragma unroll
                for (int j = 0; j < 8; ++j) t[j] = __shfl_xor(rs[j], 16);
#pragma unroll
                for (int j = 0; j < 8; ++j) rs[j] += t[j];
#pragma unroll
                for (int j = 0; j < 8; ++j) t[j] = __shfl_xor(rs[j], 32);
#pragma unroll
                for (int j = 0; j < 8; ++j) rs[j] += t[j]; }
#endif
#pragma unroll
            for (int j = 0; j < 8; ++j) rs[j] = SC * __builtin_amdgcn_rsqf(rs[j] * (SC * SC / 64.f) + EPS);
#pragma unroll
            for (int j = 0; j < 8; ++j) { const int ai = j >> 2, m = j & 3;
                const int tok = row0 + ai * HALF + m * 16;
                u32x4 w0, w1;
#pragma unroll
                for (int n = 0; n < 2; ++n) {
                    const f32x4 rv = ir[n] * pf[j];
                    f32x4 cs, sn;
#pragma unroll
                    for (int i = 0; i < 4; ++i) { const float fr2 = __builtin_amdgcn_fractf(rv[i]); cs[i] = __builtin_amdgcn_cosf(fr2); sn[i] = __builtin_amdgcn_sinf(fr2); }
                    const f32x4 x1 = acc[ai][0][m][n] * (g0[n] * rs[j]), x2 = acc[ai][1][m][n] * (g1[n] * rs[j]);
                    const f32x4 o1 = x1 * cs - x2 * sn, o2 = x1 * sn + x2 * cs;
                    w0[2 * n] = cvtpk(o1[0], o1[1]); w0[2 * n + 1] = cvtpk(o1[2], o1[3]); w1[2 * n] = cvtpk(o2[0], o2[1]); w1[2 * n + 1] = cvtpk(o2[2], o2[3]);
                }
                bf16_t* rp = dst + (size_t)tok * 64 + 8 * fq;
                *(u32x4*)rp = w0; *(u32x4*)(rp + 32) = w1;
            }
        } else if (type == 2 && H < SL_GA) {
            unsigned char* dst8 = (unsigned char*)dst;
#pragma unroll
            for (int ai = 0; ai < 2; ++ai)
#pragma unroll
                for (int m = 0; m < 4; ++m) {
                    const int tok = row0 + ai * HALF + m * 16;
                    u32x4 w;
#pragma unroll
                    for (int bj = 0; bj < 2; ++bj)
#pragma unroll
                        for (int n = 0; n < 2; ++n) { const f32x4 t = acc[ai][bj][m][n] * (-1.4426950408889634f * SC); f32x4 e, g;
#pragma unroll
                            for (int i = 0; i < 4; ++i) e[i] = __builtin_amdgcn_exp2f(t[i]);
                            e += 1.0f;
#pragma unroll
                            for (int i = 0; i < 4; ++i) g[i] = __builtin_amdgcn_rcpf(e[i]);
                            const float g0 = g[0] * 255.0f + 8388608.0f, g1 = g[1] * 255.0f + 8388608.0f, g2 = g[2] * 255.0f + 8388608.0f, g3 = g[3] * 255.0f + 8388608.0f;
                            const unsigned u0 = __builtin_bit_cast(unsigned, g0), u1 = __builtin_bit_cast(unsigned, g1), u2 = __builtin_bit_cast(unsigned, g2), u3 = __builtin_bit_cast(unsigned, g3);
                            w[2 * bj + n] = (u0 & 0xffu) | (u1 << 8) | (u2 << 16) | (u3 << 24); }
                    *(u32x4*)(dst8 + (size_t)tok * 64 + 16 * fq) = w;
                }
        } else if (type == 2) {
#pragma unroll
            for (int ai = 0; ai < 2; ++ai)
#pragma unroll
                for (int m = 0; m < 4; ++m) {
                    const int tok = row0 + ai * HALF + m * 16;
                    bf16_t* rp = dst + (size_t)tok * 64 + 8 * fq;
#pragma unroll
                    for (int bj = 0; bj < 2; ++bj) { f32x4 v[2];
#pragma unroll
                        for (int n = 0; n < 2; ++n) { const f32x4 t = acc[ai][bj][m][n] * (-1.4426950408889634f * SC); f32x4 e;
#pragma unroll
                            for (int i = 0; i < 4; ++i) e[i] = __builtin_amdgcn_exp2f(t[i]);
                            e += 1.0f;
#pragma unroll
                            for (int i = 0; i < 4; ++i) v[n][i] = __builtin_amdgcn_rcpf(e[i]); }
                        u32x4 w; w.x = cvtpk(v[0][0], v[0][1]); w.y = cvtpk(v[0][2], v[0][3]); w.z = cvtpk(v[1][0], v[1][1]); w.w = cvtpk(v[1][2], v[1][3]);
                        *(u32x4*)(rp + 32 * bj) = w; }
                }
        } else {
#pragma unroll
            for (int ai = 0; ai < 2; ++ai)
#pragma unroll
                for (int m = 0; m < 4; ++m) {
                    const int tok = row0 + ai * HALF + m * 16;
                    bf16_t* rp = dst + (size_t)tok * 64 + 8 * fq;
#pragma unroll
                    for (int bj = 0; bj < 2; ++bj) { const f32x4 v0 = acc[ai][bj][m][0] * SC, v1 = acc[ai][bj][m][1] * SC;
                        u32x4 w; w.x = cvtpk(v0[0], v0[1]); w.y = cvtpk(v0[2], v0[3]); w.z = cvtpk(v1[0], v1[1]); w.w = cvtpk(v1[2], v1[3]);
                        *(u32x4*)(rp + 32 * bj) = w; }
                }
        }
    }
};

template <bool ADD> struct UpEpi {
    static constexpr bool PERM = true, noepi = false; static constexpr int MIDK = 0, DEPHASE = 1, DEPHASE_TICKS = 0, NSTORE = 0;
    unsigned char* ws; bf16_t* Y; int gslot0; unsigned char* Y8;
    __device__ __forceinline__ void operator()(const f32x4 (&acc)[2][2][4][2], const Unit& u, int, int wr, int wc, int fr, int fq) const {
        const int row0 = u.pm * BM + wr * 64 + fr;
#pragma unroll
        for (int bj = 0; bj < 2; ++bj) {
            const int gs = __builtin_amdgcn_readfirstlane(gslot0 + 4 * u.pn + 2 * bj + (wc >> 1));
            const bf16_t* gp = (const bf16_t*)(ws + slot_off(gs)) + 32 * (wc & 1) + 8 * fq;
            const int col = u.pn * BM + bj * HALF + wc * 32 + 8 * fq;
#pragma unroll
            for (int ai = 0; ai < 2; ++ai) {
                u32x4 gg[4], yy[4];
#pragma unroll
                for (int m = 0; m < 4; ++m) { const int tok = row0 + ai * HALF + m * 16; gg[m] = *(const u32x4*)(gp + (size_t)tok * 64); if (ADD) yy[m] = *(const u32x4*)(Y + (size_t)tok * DM + col); }
#pragma unroll
                for (int m = 0; m < 4; ++m) {
                    const int tok = row0 + ai * HALF + m * 16;
                    const u32x4 g = gg[m];
                    bf16_t* yp = Y + (size_t)tok * DM + col;
                    f32x4 v0 = acc[ai][bj][m][0], v1 = acc[ai][bj][m][1];
                    v0[0] *= bflo(g.x); v0[1] *= bfhi(g.x); v0[2] *= bflo(g.y); v0[3] *= bfhi(g.y); v1[0] *= bflo(g.z); v1[1] *= bfhi(g.z); v1[2] *= bflo(g.w); v1[3] *= bfhi(g.w);
                    if (ADD) { const u32x4 y = yy[m];
                        v0[0] += bflo(y.x); v0[1] += bfhi(y.x); v0[2] += bflo(y.y); v0[3] += bfhi(y.y); v1[0] += bflo(y.z); v1[1] += bfhi(y.z); v1[2] += bflo(y.w); v1[3] += bfhi(y.w); }
                    if (ADD && Y8) { u32x2 w8; w8.x = pk4_fp8(v0[0] * 16.f, v0[1] * 16.f, v0[2] * 16.f, v0[3] * 16.f); w8.y = pk4_fp8(v1[0] * 16.f, v1[1] * 16.f, v1[2] * 16.f, v1[3] * 16.f); *(u32x2*)(Y8 + (size_t)tok * DM + col) = w8; }
                    else { u32x4 w; w.x = cvtpk(v0[0], v0[1]); w.y = cvtpk(v0[2], v0[3]); w.z = cvtpk(v1[0], v1[1]); w.w = cvtpk(v1[2], v1[3]); *(u32x4*)yp = w; }
                }
                asm volatile("" ::: "memory");
            }
            asm volatile("" ::: "memory");
        }
    }
};

struct Up2Epi {
    static constexpr bool PERM = true, noepi = false; static constexpr int MIDK = 4, DEPHASE = 1, DEPHASE_TICKS = 0, NSTORE = 16;
    unsigned char* ws; unsigned char* Y8;
    static __device__ __forceinline__ unsigned fixz(unsigned x) { return x | ((((x - 0x01010101u) & ~x) & 0x80808080u) >> 7); }
    static __device__ __forceinline__ f32x4 ub4(unsigned x) { return (f32x4){(float)(x & 0xffu), (float)((x >> 8) & 0xffu), (float)((x >> 16) & 0xffu), (float)(x >> 24)}; }
    __device__ __forceinline__ void mid(f32x4 (&acc)[2][2][4][2], const Unit& u, int wr, int wc, int fr, int fq) const {
        const int row0 = u.pm * BM + wr * 64 + fr;
        const int sa = __builtin_amdgcn_readfirstlane(SL_GMA + 4 * u.pn + wc);
        const unsigned char* ga = ws + slot_off(sa) + 16 * fq;
        const unsigned char* gb = ws + slot_off(sa + (SL_GMB - SL_GMA)) + 16 * fq;
#pragma unroll
        for (int ai = 0; ai < 2; ++ai) {
            u32x4 xa[4], xb[4];
#pragma unroll
            for (int m = 0; m < 4; ++m) { const int tok = row0 + ai * HALF + m * 16; xa[m] = *(const u32x4*)(ga + (size_t)tok * 64); xb[m] = *(const u32x4*)(gb + (size_t)tok * 64); }
#pragma unroll
            for (int m = 0; m < 4; ++m)
#pragma unroll
                for (int bj = 0; bj < 2; ++bj)
#pragma unroll
                    for (int n = 0; n < 2; ++n) { const f32x4 a = ub4(xa[m][2 * bj + n]), b = ub4(fixz(xb[m][2 * bj + n])); f32x4 r;
#pragma unroll
                        for (int i = 0; i < 4; ++i) r[i] = __builtin_amdgcn_rcpf(b[i]);
                        acc[ai][bj][m][n] *= a * r; }
            asm volatile("" ::: "memory");
        }
    }
    __device__ __forceinline__ void operator()(const f32x4 (&acc)[2][2][4][2], const Unit& u, int, int wr, int wc, int fr, int fq) const {
        const int row0 = u.pm * BM + wr * 64 + fr;
        const int sb = __builtin_amdgcn_readfirstlane(SL_GMB + 4 * u.pn + wc);
        const unsigned char* gb = ws + slot_off(sb) + 16 * fq;
        u32x4 xb[8];
#pragma unroll
        for (int j = 0; j < 8; ++j) xb[j] = *(const u32x4*)(gb + (size_t)(row0 + (j >> 2) * HALF + (j & 3) * 16) * 64);
#pragma unroll
        for (int j = 0; j < 8; ++j) { const int ai = j >> 2, m = j & 3;
            const int tok = row0 + ai * HALF + m * 16; const float s = 1.0f / (64.0f * 255.0f);
#pragma unroll
            for (int bj = 0; bj < 2; ++bj) {
                const int col = u.pn * BM + bj * HALF + wc * 32 + 8 * fq;
                const f32x4 v0 = acc[ai][bj][m][0] * s * ub4(fixz(xb[j][2 * bj])), v1 = acc[ai][bj][m][1] * s * ub4(fixz(xb[j][2 * bj + 1]));
                u32x2 w8; w8.x = pk4_fp8(v0[0], v0[1], v0[2], v0[3]); w8.y = pk4_fp8(v1[0], v1[1], v1[2], v1[3]);
                *(u32x2*)(Y8 + (size_t)tok * DM + col) = w8;
            }
        }
    }
};

#ifndef OUT_DEPHASE
#define OUT_DEPHASE 1
#endif
struct OutEpi {
    static constexpr bool PERM = false, noepi = false; static constexpr int MIDK = 0, DEPHASE = OUT_DEPHASE, DEPHASE_TICKS = 3400, NSTORE = 32;
    const float* x; float* out; const float* mod; float* rowss; float asc;
    __device__ __forceinline__ void operator()(const f32x4 (&acc)[2][2][4][2], const Unit& u, int, int wr, int wc, int fr, int fq) const {
        const int row0 = u.pm * BM + wr * 64 + fr, col0 = u.pn * BM + wc * 32 + 4 * fq;
        const int b = (u.pm * BM) >> 11;
        const float* gt = mod + (size_t)b * 6144 + 2048 + col0;
        f32x4 gv[2][2];
#pragma unroll
        for (int bj = 0; bj < 2; ++bj)
#pragma unroll
            for (int n = 0; n < 2; ++n) gv[bj][n] = *(const f32x4*)(gt + bj * HALF + n * 16) * asc;
#pragma unroll
        for (int ai = 0; ai < 2; ++ai) {
            f32x4 xv[4][2][2];
#pragma unroll
            for (int m = 0; m < 4; ++m) { const size_t off = (size_t)(row0 + ai * HALF + m * 16) * DM + col0;
#pragma unroll
                for (int bj = 0; bj < 2; ++bj)
#pragma unroll
                    for (int n = 0; n < 2; ++n) xv[m][bj][n] = *(const f32x4*)(x + off + bj * HALF + n * 16); }
#pragma unroll
            for (int m = 0; m < 4; ++m) {
                const int tok = row0 + ai * HALF + m * 16; const size_t off = (size_t)tok * DM + col0; float ss = 0.f;
#pragma unroll
                for (int bj = 0; bj < 2; ++bj)
#pragma unroll
                    for (int n = 0; n < 2; ++n) { const f32x4 o = xv[m][bj][n] + gv[bj][n] * acc[ai][bj][m][n];
                        ss += (o[0] * o[0] + o[1] * o[1]) + (o[2] * o[2] + o[3] * o[3]);
#ifdef X1_BF16
                        { u32x2 w; w.x = cvtpk(o[0], o[1]); w.y = cvtpk(o[2], o[3]); *(u32x2*)((bf16_t*)out + off + bj * HALF + n * 16) = w; }
#else
                        *(f32x4*)(out + off + bj * HALF + n * 16) = o;
#endif
                    }
                ss += __shfl_xor(ss, 16); ss += __shfl_xor(ss, 32);
                if (fq == 0) rowss[(size_t)tok * 16 + 4 * u.pn + wc] = ss;
            }
            asm volatile("" ::: "memory");
        }
    }
};

struct CmpEpi {
    static constexpr bool PERM = true, noepi = false; static constexpr int MIDK = 0, DEPHASE = 1, DEPHASE_TICKS = 0, NSTORE = 0;
    const float* biasp; bf16_t* hid;
    __device__ __forceinline__ void operator()(const f32x4 (&acc)[2][2][4][2], const Unit& u, int, int wr, int wc, int fr, int fq) const {
        const int kv = u.pm >= 32 ? 1 : 0; const int row0 = u.pm * BM + wr * 64 + fr;
#pragma unroll
        for (int bj = 0; bj < 2; ++bj) {
            const int col = bj * HALF + wc * 32 + 8 * fq;
            f32x4 b0 = (f32x4){0.f, 0.f, 0.f, 0.f}, b1 = b0;
            for (int ks = 0; ks < 16; ++ks) { b0 += *(const f32x4*)(biasp + ks * 512 + kv * 256 + col); b1 += *(const f32x4*)(biasp + ks * 512 + kv * 256 + col + 4); }
#pragma unroll
            for (int ai = 0; ai < 2; ++ai)
#pragma unroll
                for (int m = 0; m < 4; ++m) {
                    const int row = row0 + ai * HALF + m * 16;
                    f32x4 v0 = acc[ai][bj][m][0] + b0, v1 = acc[ai][bj][m][1] + b1;
#pragma unroll
                    for (int i = 0; i < 4; ++i) { v0[i] = siluf_(v0[i]); v1[i] = siluf_(v1[i]); }
                    u32x4 w; w.x = cvtpk(v0[0], v0[1]); w.y = cvtpk(v0[2], v0[3]); w.z = cvtpk(v1[0], v1[1]); w.w = cvtpk(v1[2], v1[3]);
                    *(u32x4*)(hid + (size_t)row * 256 + col) = w;
                }
        }
    }
};
struct CmpSched {
    const char* A; const char* Bt; int ldb; int nwg_c, c;
    __device__ __forceinline__ bool next(int i, Unit& u) const { if (c < 0) return false; const int L = i * nwg_c + c; if (L >= 64) return false; u.pm = L; u.pn = 0; u.e = 0; u.mt = 0; return true; }
    __device__ __forceinline__ const char* a_base(const Unit& u) const { return A + (size_t)u.pm * BM * 1024 * 2; }
    __device__ __forceinline__ unsigned a_voff(const Unit&, int, int h, int R, int C) const { return (unsigned)((h * HALF + R) * 1024 + C) * 2u; }
    __device__ __forceinline__ const char* b_base(const Unit& u) const { return Bt + (u.pm >= 32 ? (size_t)256 * 2048 * 2 : 0); }
    __device__ __forceinline__ int dephase_id() const { return 0; }
};
}
namespace att {
constexpr int A_KV = 0;
constexpr int A_IMP = 49152;
constexpr int A_SEL = 83968;
constexpr int A_WSF = 98304;
constexpr int A_OST = 100352;
constexpr float NEG_INF = -INFINITY;
constexpr float THR = 8.0f;
__device__ __forceinline__ int crow(int r, int hi) { return (r & 3) + 8 * (r >> 2) + 4 * hi; }
__device__ __forceinline__ void glds16(const void* gsrc, unsigned lds_dst) { unsigned keep;
    asm volatile("s_mov_b32 %0, m0\n\ts_mov_b32 m0, %2\n\ts_nop 0\n\tglobal_load_lds_dwordx4 %1, off\n\ts_mov_b32 m0, %0" : "=&s"(keep) : "v"(gsrc), "s"(lds_dst) : "memory"); }
#define ATT_WAIT_BAR(N) asm volatile("s_waitcnt vmcnt(" #N ") lgkmcnt(0)\n\ts_barrier" ::: "memory")
#define ATT_SBAR() __builtin_amdgcn_sched_barrier(0)

struct Ctx { LAS unsigned char* lds; int lane, r32, hi, wid; unsigned lds0; };
__device__ __forceinline__ int fresh(int v) { asm volatile("" : "+v"(v)); return v; }

__device__ __forceinline__ void qkt(f32x16& p0, f32x16& p1, const LAS unsigned char* Kslot, const bf16x8 (&qr)[4], int lane_) {
    const int lq = lane_now(); const int r32 = lq & 31, hi = lq >> 5;
    const LAS unsigned char* kb = Kslot + hi * 1024 + r32 * 16;
    const f32x16 z = {};
#pragma unroll
    for (int d0 = 0; d0 < 4; ++d0) {
        const bf16x8 b0 = *(const LAS bf16x8*)(kb + d0 * 2048);
        const bf16x8 b1 = *(const LAS bf16x8*)(kb + d0 * 2048 + 512);
        if (d0 == 0) { p0 = __builtin_amdgcn_mfma_f32_32x32x16_bf16(b0, qr[0], z, 0, 0, 0); p1 = __builtin_amdgcn_mfma_f32_32x32x16_bf16(b1, qr[0], z, 0, 0, 0); }
        else { p0 = __builtin_amdgcn_mfma_f32_32x32x16_bf16(b0, qr[d0], p0, 0, 0, 0); p1 = __builtin_amdgcn_mfma_f32_32x32x16_bf16(b1, qr[d0], p1, 0, 0, 0); } }
}
__device__ __forceinline__ void pv(f32x16 (&o)[2], int vb, bf16x8 pa0, bf16x8 pa1, bf16x8 pa2, bf16x8 pa3) {
#pragma unroll
    for (int d0 = 0; d0 < 2; ++d0) { s16x4 lo[4], hh[4];
#pragma unroll
        for (int ks = 0; ks < 4; ++ks) {
            asm volatile("ds_read_b64_tr_b16 %0,%1 offset:%c2" : "=&v"(lo[ks]) : "v"(vb), "i"(d0 * 4096 + ks * 1024) : "memory");
            asm volatile("ds_read_b64_tr_b16 %0,%1 offset:%c2" : "=&v"(hh[ks]) : "v"(vb), "i"(d0 * 4096 + ks * 1024 + 512) : "memory"); }
        asm volatile("s_waitcnt lgkmcnt(0)" ::: "memory"); ATT_SBAR();
#define ATT_PK(k) (bf16x8){lo[k][0], lo[k][1], lo[k][2], lo[k][3], hh[k][0], hh[k][1], hh[k][2], hh[k][3]}
        o[d0] = __builtin_amdgcn_mfma_f32_32x32x16_bf16(pa0, ATT_PK(0), o[d0], 0, 0, 0);
        o[d0] = __builtin_amdgcn_mfma_f32_32x32x16_bf16(pa1, ATT_PK(1), o[d0], 0, 0, 0);
        o[d0] = __builtin_amdgcn_mfma_f32_32x32x16_bf16(pa2, ATT_PK(2), o[d0], 0, 0, 0);
        o[d0] = __builtin_amdgcn_mfma_f32_32x32x16_bf16(pa3, ATT_PK(3), o[d0], 0, 0, 0);
#undef ATT_PK
    }
}
__device__ __forceinline__ float max3f(float a, float b, float c) { float r; asm("v_max3_f32 %0, %1, %2, %3" : "=v"(r) : "v"(a), "v"(b), "v"(c)); return r; }
__device__ __forceinline__ float max2f(float a, float b) { float r; asm("v_max_f32_e32 %0, %1, %2" : "=v"(r) : "v"(a), "v"(b)); return r; }
__device__ __forceinline__ float rowmax3(const f32x16& p0, const f32x16& p1) {
    float a = max3f(p0[0], p0[1], p1[0]), b = max3f(p0[2], p0[3], p1[1]); a = max3f(a, p1[2], p1[3]);
#pragma unroll
    for (int r = 4; r < 16; r += 4) { a = max3f(a, p0[r], p0[r + 1]); b = max3f(b, p0[r + 2], p0[r + 3]); a = max3f(a, p1[r], p1[r + 1]); b = max3f(b, p1[r + 2], p1[r + 3]); }
    const float m = max2f(a, b);
    auto rr = __builtin_amdgcn_permlane32_swap(__float_as_uint(m), __float_as_uint(m), false, false);
    return max2f(__uint_as_float(rr[0]), __uint_as_float(rr[1]));
}

__device__ __forceinline__ float rowmax(const f32x16& p0, const f32x16& p1) { return rowmax3(p0, p1); }
__device__ __forceinline__ float halfsum(float v) { auto rr = __builtin_amdgcn_permlane32_swap(__float_as_uint(v), __float_as_uint(v), false, false); return __uint_as_float(rr[0]) + __uint_as_float(rr[1]); }
#define ATT_PACK4(P, B) (u32x4){cvtpk(P[B], P[B + 1]), cvtpk(P[B + 2], P[B + 3]), cvtpk(P[B + 4], P[B + 5]), cvtpk(P[B + 6], P[B + 7])}
__device__ __forceinline__ void pv_tile(f32x16 (&o)[2], int vb, const f32x16& p0, const f32x16& p1) {
    const u32x4 w0 = ATT_PACK4(p0, 0), w1 = ATT_PACK4(p0, 8), w2 = ATT_PACK4(p1, 0), w3 = ATT_PACK4(p1, 8);
    pv(o, vb, __builtin_bit_cast(bf16x8, w0), __builtin_bit_cast(bf16x8, w1), __builtin_bit_cast(bf16x8, w2), __builtin_bit_cast(bf16x8, w3));
}
__device__ __forceinline__ void scale_rows(f32x16 (&o)[2], float f, const Ctx& C_) {
    Ctx C = C_; { const int l = lane_now(); C.r32 = l & 31; C.hi = l >> 5; }
    LAS float* wsf = (LAS float*)(C.lds + A_WSF) + C.wid * 64;
    if (C.hi == 0) wsf[C.r32] = f;
    asm volatile("s_waitcnt lgkmcnt(0)" ::: "memory");
#pragma unroll
    for (int g = 0; g < 4; ++g) { const f32x4 fv = *(const LAS f32x4*)(wsf + 8 * g + 4 * C.hi);
#pragma unroll
        for (int i = 0; i < 4; ++i) { o[0][4 * g + i] *= fv[i]; o[1][4 * g + i] *= fv[i]; } }
    asm volatile("s_waitcnt lgkmcnt(0)" ::: "memory");
}
__device__ __forceinline__ void axpy_rows(f32x16 (&acc)[2], const f32x16 (&o)[2], float f, const Ctx& C_) {
    Ctx C = C_; { const int l = lane_now(); C.r32 = l & 31; C.hi = l >> 5; }
    LAS float* wsf = (LAS float*)(C.lds + A_WSF) + C.wid * 64;
    if (C.hi == 0) wsf[C.r32] = f;
    asm volatile("s_waitcnt lgkmcnt(0)" ::: "memory");
#pragma unroll
    for (int g = 0; g < 4; ++g) { const f32x4 fv = *(const LAS f32x4*)(wsf + 8 * g + 4 * C.hi);
#pragma unroll
        for (int i = 0; i < 4; ++i) { acc[0][4 * g + i] += o[0][4 * g + i] * fv[i]; acc[1][4 * g + i] += o[1][4 * g + i] * fv[i]; } }
    asm volatile("s_waitcnt lgkmcnt(0)" ::: "memory");
}
struct SM { float m, l; f32x16 o[2]; };
__device__ __forceinline__ void sm_init(SM& s) { s.m = -1e30f; s.l = 0.f; s.o[0] = f32x16{}; s.o[1] = f32x16{}; }
__device__ __forceinline__ void sm_part1(SM& s, f32x16& p0, f32x16& p1, u32x4& w0, u32x4& w1, u32x4& w2, u32x4& w3, const Ctx& C) {
    const float rm = rowmax(p0, p1);
    if (__any(rm > s.m + THR)) {
        const float mn = fmaxf(s.m, rm); const float f = __builtin_amdgcn_exp2f(s.m - mn);
        s.l *= f; s.m = mn; scale_rows(s.o, f, C);
    }
    float sum = 0.f;
#pragma unroll
    for (int r = 0; r < 16; ++r) { p0[r] = __builtin_amdgcn_exp2f(p0[r] - s.m); p1[r] = __builtin_amdgcn_exp2f(p1[r] - s.m); sum += p0[r] + p1[r]; }
    s.l += sum;
    w0 = ATT_PACK4(p0, 0); w1 = ATT_PACK4(p0, 8); w2 = ATT_PACK4(p1, 0); w3 = ATT_PACK4(p1, 8);
}
template <int NS> __device__ __forceinline__ void dma_tile(const Ctx& C, const bf16_t* Kp, const bf16_t* Vp, long rs, int tile, int stage, int q, int base_off = 0) {
    const unsigned base = C.lds0 + (unsigned)(base_off + (stage * NS + q) * 16384);
    const long k0 = (long)tile * 64; const int lane = lane_now();
#pragma unroll
    for (int j = 0; j < NS; ++j) {
        const int pw = (NS == 1) ? C.wid : (2 * (C.wid & 3) + j);
        const bf16_t* ks = Kp + (k0 + lane) * rs + pw * 8;
        const bf16_t* vs = Vp + (k0 + 16 * (pw & 3) + (lane >> 2)) * rs + (pw >> 2) * 32 + (lane & 3) * 8;
        glds16(ks, (unsigned)__builtin_amdgcn_readfirstlane(base + pw * 1024));
        glds16(vs, (unsigned)__builtin_amdgcn_readfirstlane(base + 8192 + pw * 1024));
    }
}
template <int NS> __device__ __forceinline__ void wait_bar_tiles(int allowed) {
    if (allowed <= 0) ATT_WAIT_BAR(0);
    else if (allowed == 1) { if (NS == 1) ATT_WAIT_BAR(2); else ATT_WAIT_BAR(4); }
    else { if (NS == 1) ATT_WAIT_BAR(4); else ATT_WAIT_BAR(8); }
}
template <int NS, class MaskF, class SkipF>
__device__ __forceinline__ void run_pass(const Ctx& C, SM& st, const bf16x8 (&qr)[4], const bf16_t* Kp, const bf16_t* Vp, long rs, int t_lo, int t_hi, int nsteps, MaskF mask, SkipF skip) {
    const int q = (NS == 1) ? 0 : (C.wid >> 2);
    const int nvalid = t_hi - t_lo;
#pragma unroll
    for (int s = 0; s < 2; ++s) if (s < nvalid) dma_tile<NS>(C, Kp, Vp, rs, t_lo + s, s, q);
#pragma unroll 1
    for (int s = 0; s < nsteps; ++s) {
        wait_bar_tiles<NS>((s + 1 < nvalid) ? 1 : 0);
        if (s + 2 < nvalid) dma_tile<NS>(C, Kp, Vp, rs, t_lo + s + 2, (s + 2) % 3, q);
        if (s < nvalid && !skip(t_lo + s)) {
            const int sb = ((s % 3) * NS + q) * 16384;
            f32x16 p0, p1; qkt(p0, p1, C.lds + sb, qr, C.lane);
            mask(p0, p1, t_lo + s);
            u32x4 w0, w1, w2, w3; sm_part1(st, p0, p1, w0, w1, w2, w3, C);
            const int lv = lane_now(); const int vlane = ((lv >> 4) & 1) * 32 + (lv & 3) * 8 + (4 * (lv >> 5) + ((lv & 15) >> 2)) * 64;
            pv(st.o, (int)C.lds0 + sb + 8192 + vlane, __builtin_bit_cast(bf16x8, w0), __builtin_bit_cast(bf16x8, w1), __builtin_bit_cast(bf16x8, w2), __builtin_bit_cast(bf16x8, w3));
        }
    }
    ATT_WAIT_BAR(0);
}
__device__ __forceinline__ void store_o(const f32x16 (&o)[2], bf16_t* Ow, long pitch, const Ctx& C_) {
    Ctx C = C_; { const int l = lane_now(); C.lane = l; C.r32 = l & 31; C.hi = l >> 5; }
    LAS bf16_t* stg = (LAS bf16_t*)(C.lds + A_OST) + C.wid * 2048;
#pragma unroll
    for (int r = 0; r < 16; ++r) { const int orow = crow(r, C.hi);
#pragma unroll
        for (int d0 = 0; d0 < 2; ++d0) stg[orow * 64 + d0 * 32 + C.r32] = (bf16_t)(cvtpk(o[d0][r], 0.f) & 0xffffu); }
    asm volatile("s_waitcnt lgkmcnt(0)" ::: "memory");
#pragma unroll
    for (int i = 0; i < 4; ++i) { const int row = i * 8 + (C.lane >> 3), ch = C.lane & 7; const u32x4 v = *(const LAS u32x4*)(stg + row * 64 + ch * 8); *(u32x4*)(Ow + (long)row * pitch + ch * 8) = v; }
    asm volatile("s_waitcnt lgkmcnt(0)" ::: "memory");
}
__device__ __forceinline__ void load_q(bf16x8 (&qr)[4], const bf16_t* Qrow, int hi) {
#pragma unroll
    for (int d0 = 0; d0 < 4; ++d0) qr[d0] = *(const bf16x8*)(Qrow + d0 * 16 + hi * 8);
}

}
namespace att {
constexpr int F_K = 0, F_V = 24576, F_SLOT = 8192;
typedef LAS const char* lds_cptr;
typedef short v4i16_t __attribute__((ext_vector_type(4)));
__device__ __forceinline__ float fadd_s(float a, float b) { float r; asm("v_add_f32_e32 %0, %1, %2" : "=v"(r) : "v"(a), "v"(b)); return r; }
__device__ __forceinline__ float fsub_s(float a, float b) { float r; asm("v_sub_f32_e32 %0, %1, %2" : "=v"(r) : "v"(a), "v"(b)); return r; }
__device__ __forceinline__ void kload8(bf16x8* kf, lds_cptr kp) {
    kf[0] = *(const LAS bf16x8*)(kp);        kf[1] = *(const LAS bf16x8*)(kp + 512);
    kf[2] = *(const LAS bf16x8*)(kp + 2048); kf[3] = *(const LAS bf16x8*)(kp + 2560);
    kf[4] = *(const LAS bf16x8*)(kp + 4096); kf[5] = *(const LAS bf16x8*)(kp + 4608);
    kf[6] = *(const LAS bf16x8*)(kp + 6144); kf[7] = *(const LAS bf16x8*)(kp + 6656);
}
__device__ __forceinline__ void kload2(bf16x8* kf, lds_cptr kp, int j) { kf[2 * j] = *(const LAS bf16x8*)(kp + j * 2048); kf[2 * j + 1] = *(const LAS bf16x8*)(kp + j * 2048 + 512); }
__device__ __forceinline__ s16x4 vtr(lds_cptr p) { return __builtin_bit_cast(s16x4, __builtin_amdgcn_ds_read_tr16_b64_v4i16((LAS v4i16_t*)p)); }
__device__ __forceinline__ void fast_prefetch(const Ctx& C, const bf16_t* Kp, const bf16_t* Vp, int t_lo, int ntr) {
    const int lane = lane_now(); const int wid = C.wid;
    const bf16_t* ksrc = Kp + ((long)t_lo * 64 + lane) * 64 + wid * 8;
    const bf16_t* vsrc = Vp + ((long)t_lo * 64 + 16 * (wid & 3) + (lane >> 2)) * 64 + (wid >> 2) * 32 + (lane & 3) * 8;
    const unsigned kdst = C.lds0 + F_K + wid * 1024, vdst = C.lds0 + F_V + wid * 1024;
    glds16(ksrc, (unsigned)__builtin_amdgcn_readfirstlane(kdst)); glds16(vsrc, (unsigned)__builtin_amdgcn_readfirstlane(vdst));
    glds16(ksrc + (long)((1 < ntr) ? 1 : (ntr - 1)) * 4096, (unsigned)__builtin_amdgcn_readfirstlane(kdst + F_SLOT));
    glds16(ksrc + (long)((2 < ntr) ? 2 : (ntr - 1)) * 4096, (unsigned)__builtin_amdgcn_readfirstlane(kdst + 2 * F_SLOT));
}
__device__ __forceinline__ void fast_prefetch2(const Ctx& C, const bf16_t* Kp1, const bf16_t* Vp1, int n1, const bf16_t* Kp2, int t_lo2, int n2) {
    const int lane = lane_now(); const int wid = C.wid;
    const int koff = lane * 64 + wid * 8, voff = (16 * (wid & 3) + (lane >> 2)) * 64 + (wid >> 2) * 32 + (lane & 3) * 8;
    const unsigned kdst = C.lds0 + F_K + wid * 1024, vdst = C.lds0 + F_V + wid * 1024;
    const bf16_t* K2b = Kp2 + (long)t_lo2 * 4096;
    glds16(Kp1 + koff, (unsigned)__builtin_amdgcn_readfirstlane(kdst)); glds16(Vp1 + voff, (unsigned)__builtin_amdgcn_readfirstlane(vdst));
#pragma unroll
    for (int t = 1; t < 3; ++t) { const bool s2 = t >= n1; const int idx = s2 ? ((t - n1 < n2) ? (t - n1) : (n2 - 1)) : t;
        glds16((s2 ? K2b : Kp1) + (long)idx * 4096 + koff, (unsigned)__builtin_amdgcn_readfirstlane(kdst + t * F_SLOT)); }
}
template <int THRL, bool PRE, class MaskF>
__device__ __forceinline__ void fast_pass(const Ctx& C, const bf16x8 (&qr)[4], const bf16_t* Kp, const bf16_t* Vp, int t_lo, int ntr, MaskF mask, f32x16 (&o)[2], float& l_out) {
    const int lane = lane_now(), r32 = lane & 31, hi = lane >> 5; const int wid = C.wid;
    const unsigned lds0 = C.lds0;
    LAS float* wsf = (LAS float*)(C.lds + A_WSF) + wid * 64;
    int NT = ntr; if (NT < 4) NT = 4;
    const bf16_t* ksrc = Kp + ((long)t_lo * 64 + lane) * 64 + wid * 8;
    const bf16_t* vsrc = Vp + ((long)t_lo * 64 + 16 * (wid & 3) + (lane >> 2)) * 64 + (wid >> 2) * 32 + (lane & 3) * 8;
    const unsigned kdst = lds0 + F_K + wid * 1024, vdst = lds0 + F_V + wid * 1024;
#define FP_TSRC(t) ((long)(((t) < ntr) ? (t) : (ntr - 1)) * 4096)
#define DMA_K(t, slot) glds16(ksrc + FP_TSRC(t), (unsigned)__builtin_amdgcn_readfirstlane(kdst + (slot)))
#define DMA_V(t, slot) glds16(vsrc + FP_TSRC(t), (unsigned)__builtin_amdgcn_readfirstlane(vdst + (slot)))
    const int vb0 = (int)(lds0 + F_V) + ((lane >> 4) & 1) * 32 + (lane & 3) * 8 + (4 * hi + ((lane & 15) >> 2)) * 64;
    bf16x8 kf[8];
    const lds_cptr shm3 = (lds_cptr)C.lds; const lds_cptr kp0 = shm3 + F_K + hi * 1024 + r32 * 16; const lds_cptr vp0 = shm3 + F_V + ((lane >> 4) & 1) * 32 + (lane & 3) * 8 + (4 * hi + ((lane & 15) >> 2)) * 64;
    if (!PRE) { DMA_K(0, 0); DMA_V(0, 0); DMA_K(1, F_SLOT); }
    float mhat = 0.f, l_reg = 0.f; o[0] = f32x16{}; o[1] = f32x16{}; f32x16 negm; { float z_ = 0.f; asm volatile("" : "+v"(z_));
#pragma unroll
      for (int r = 0; r < 16; ++r) negm[r] = z_; }
#define CMASK(P0, P1, t) mask(P0, P1, (t))
    bool resc = false;
#define START(P0, P1) do { const float rm = rowmax3(P0, P1); resc = false; \
    { const float dl = rm; mhat = fadd_s(mhat, dl); \
      _Pragma("unroll") for (int r = 0; r < 16; ++r) { P0[r] = fsub_s(P0[r], dl); P1[r] = fsub_s(P1[r], dl); } \
      _Pragma("unroll") for (int r = 0; r < 16; ++r) negm[r] = -mhat; asm volatile("" : "+v"(negm)); } \
    _Pragma("unroll") for (int r = 0; r < 16; ++r) P0[r] = __builtin_amdgcn_exp2f(P0[r]); } while (0)
#define RESC() do { if (resc) { asm volatile("s_waitcnt lgkmcnt(0)" ::: "memory"); \
      _Pragma("unroll") for (int d_ = 0; d_ < 2; ++d_) _Pragma("unroll") for (int r = 0; r < 16; ++r) o[d_][r] *= wsf[crow(r, hi)]; } } while (0)
    f32x16 pA0, pA1, pB0, pB1;
    int sl_prev = 0, sl_cur = 0, sl_next = F_SLOT;
#define ROT() do { sl_prev = sl_cur; sl_cur = sl_next; sl_next = (sl_next == 2 * F_SLOT) ? 0 : sl_next + F_SLOT; } while (0)
    if (!PRE) DMA_K(2, 2 * F_SLOT);
    ATT_WAIT_BAR(3);
    { const LAS unsigned char* kb = C.lds + F_K + hi * 1024 + r32 * 16;
#pragma unroll
      for (int d0 = 0; d0 < 4; ++d0) { const bf16x8 b0 = *(const LAS bf16x8*)(kb + d0 * 2048); const bf16x8 b1 = *(const LAS bf16x8*)(kb + d0 * 2048 + 512);
          if (d0 == 0) { pA0 = __builtin_amdgcn_mfma_f32_32x32x16_bf16(b0, qr[0], negm, 0, 0, 0); pA1 = __builtin_amdgcn_mfma_f32_32x32x16_bf16(b1, qr[0], negm, 0, 0, 0); }
          else { pA0 = __builtin_amdgcn_mfma_f32_32x32x16_bf16(b0, qr[d0], pA0, 0, 0, 0); pA1 = __builtin_amdgcn_mfma_f32_32x32x16_bf16(b1, qr[d0], pA1, 0, 0, 0); } } }
    CMASK(pA0, pA1, 0);
    asm volatile("s_nop 15\n\ts_nop 7" : "+v"(pA0), "+v"(pA1));
    START(pA0, pA1);
#pragma unroll
    for (int r = 0; r < 16; ++r) pA1[r] = __builtin_amdgcn_exp2f(pA1[r]);
    ATT_WAIT_BAR(0);
    DMA_K(3, 0); DMA_V(1, F_SLOT);
    ROT();
    kload8(kf, kp0 + sl_cur);
    ATT_WAIT_BAR(2);
    s16x4 vlo[8], vhi[8]; u32x4 pw0, pw1, pw2, pw3;
#define PKW(P, B) cvtpk(P[B], P[B + 1])
#define PAF(k) __builtin_bit_cast(bf16x8, pw##k)
#define VFR(i) (bf16x8){vlo[i][0], vlo[i][1], vlo[i][2], vlo[i][3], vhi[i][0], vhi[i][1], vhi[i][2], vhi[i][3]}
#define PIN(x) asm volatile("" : "+v"(x))
#define MX3(a, b, c) __builtin_fmaxf(__builtin_fmaxf((a), (b)), (c))
#define GAPA(MF, A0, A1, A2, A3, W0, W1, PW) do { MF; sacc += A0; sacc += A1; sacc += A2; sacc += A3; PIN(sacc); W0; W1; PIN(PW); ATT_SBAR(); } while (0)
#define EX(v) __builtin_amdgcn_exp2f(v)
#define GAPB(MF, X, B) do { MF; X[B] = EX(X[B]); X[B + 1] = EX(X[B + 1]); X[B + 2] = EX(X[B + 2]); X[B + 3] = EX(X[B + 3]); PIN(X); ATT_SBAR(); } while (0)
#define VRD(i) do { vlo[i] = vtr(vp_ + (((i) >> 2) * 4096 + ((i) & 3) * 1024)); vhi[i] = vtr(vp_ + (((i) >> 2) * 4096 + ((i) & 3) * 1024 + 512)); } while (0)
#define KRD(G, j) do { if (G) { kload2(kf, kp0 + sl_next, j); ATT_SBAR(); } } while (0)
#define STEP(C0, C1, P0, P1, t, GK, GV, GL) do { ATT_SBAR(); \
    const lds_cptr vp_ = vp0 + sl_prev; \
    VRD(0); ATT_SBAR(); float sacc = (P0[0] + P0[1]); \
    GAPA(C0 = __builtin_amdgcn_mfma_f32_32x32x16_bf16(kf[0], qr[0], negm, 0, 0, 0), P0[2], P0[3], P0[4], P0[5],     pw0[0] = PKW(P0, 0), pw0[1] = PKW(P0, 2), pw0); \
    VRD(4); ATT_SBAR(); GAPA(C1 = __builtin_amdgcn_mfma_f32_32x32x16_bf16(kf[1], qr[0], negm, 0, 0, 0), P0[6], P0[7], P0[8], P0[9],     pw0[2] = PKW(P0, 4), pw0[3] = PKW(P0, 6), pw0); \
    VRD(1); ATT_SBAR(); GAPA(C0 = __builtin_amdgcn_mfma_f32_32x32x16_bf16(kf[2], qr[1], C0, 0, 0, 0),   P0[10], P0[11], P0[12], P0[13], pw1[0] = PKW(P0, 8), pw1[1] = PKW(P0, 10), pw1); \
    VRD(5); ATT_SBAR(); GAPA(C1 = __builtin_amdgcn_mfma_f32_32x32x16_bf16(kf[3], qr[1], C1, 0, 0, 0),   P0[14], P0[15], P1[0], P1[1],   pw1[2] = PKW(P0, 12), pw1[3] = PKW(P0, 14), pw1); \
    VRD(2); ATT_SBAR(); GAPA(C0 = __builtin_amdgcn_mfma_f32_32x32x16_bf16(kf[4], qr[2], C0, 0, 0, 0),   P1[2], P1[3], P1[4], P1[5],     pw2[0] = PKW(P1, 0), pw2[1] = PKW(P1, 2), pw2); \
    VRD(6); ATT_SBAR(); GAPA(C1 = __builtin_amdgcn_mfma_f32_32x32x16_bf16(kf[5], qr[2], C1, 0, 0, 0),   P1[6], P1[7], P1[8], P1[9],     pw2[2] = PKW(P1, 4), pw2[3] = PKW(P1, 6), pw2); \
    VRD(3); ATT_SBAR(); GAPA(C0 = __builtin_amdgcn_mfma_f32_32x32x16_bf16(kf[6], qr[3], C0, 0, 0, 0),   P1[10], P1[11], P1[12], P1[13], pw3[0] = PKW(P1, 8), pw3[1] = PKW(P1, 10), pw3); \
    VRD(7); ATT_SBAR(); GAPA(C1 = __builtin_amdgcn_mfma_f32_32x32x16_bf16(kf[7], qr[3], C1, 0, 0, 0),   P1[14], P1[15], 0.f, 0.f,       pw3[2] = PKW(P1, 12), pw3[3] = PKW(P1, 14), pw3); \
    l_reg += sacc; \
    if (GK) { DMA_K((t) + 3, sl_cur); } if (GV) { DMA_V((t) + 1, sl_next); } \
    CMASK(C0, C1, t); \
    { float a = MX3(C0[0], C0[1], C1[0]), b = MX3(C0[2], C0[3], C1[1]); a = MX3(a, C1[2], C1[3]); \
      _Pragma("unroll") for (int r = 4; r < 16; r += 4) { a = MX3(a, C0[r], C0[r + 1]); b = MX3(b, C0[r + 2], C0[r + 3]); a = MX3(a, C1[r], C1[r + 1]); b = MX3(b, C1[r + 2], C1[r + 3]); } \
      float rm = __builtin_fmaxf(a, b); { auto rr = __builtin_amdgcn_permlane32_swap(__float_as_uint(rm), __float_as_uint(rm), false, false); rm = __builtin_fmaxf(__uint_as_float(rr[0]), __uint_as_float(rr[1])); } \
      resc = false; \
      if (__builtin_expect(__any(rm > (float)THRL), 0)) { const float dl = __builtin_fmaxf(rm, 0.f); mhat += dl; \
        _Pragma("unroll") for (int r = 0; r < 16; ++r) { C0[r] -= dl; C1[r] -= dl; } \
        _Pragma("unroll") for (int r = 0; r < 16; ++r) negm[r] = -mhat; asm volatile("" : "+v"(negm)); \
        const float f = __builtin_amdgcn_exp2f(-dl); l_reg *= f; if (hi == 0) wsf[r32] = f; resc = true; } } \
    ATT_SBAR(); \
    GAPB(o[0] = __builtin_amdgcn_mfma_f32_32x32x16_bf16(PAF(0), VFR(0), o[0], 0, 0, 0), C0, 0); \
    GAPB(o[1] = __builtin_amdgcn_mfma_f32_32x32x16_bf16(PAF(0), VFR(4), o[1], 0, 0, 0), C0, 4); \
    KRD(GL, 0); GAPB(o[0] = __builtin_amdgcn_mfma_f32_32x32x16_bf16(PAF(1), VFR(1), o[0], 0, 0, 0), C0, 8); \
    KRD(GL, 1); GAPB(o[1] = __builtin_amdgcn_mfma_f32_32x32x16_bf16(PAF(1), VFR(5), o[1], 0, 0, 0), C0, 12); \
    KRD(GL, 2); GAPB(o[0] = __builtin_amdgcn_mfma_f32_32x32x16_bf16(PAF(2), VFR(2), o[0], 0, 0, 0), C1, 0); \
    KRD(GL, 3); GAPB(o[1] = __builtin_amdgcn_mfma_f32_32x32x16_bf16(PAF(2), VFR(6), o[1], 0, 0, 0), C1, 4); \
    GAPB(o[0] = __builtin_amdgcn_mfma_f32_32x32x16_bf16(PAF(3), VFR(3), o[0], 0, 0, 0), C1, 8); \
    GAPB(o[1] = __builtin_amdgcn_mfma_f32_32x32x16_bf16(PAF(3), VFR(7), o[1], 0, 0, 0), C1, 12); \
    } while (0)
    int t = 1;
    for (; t + 5 < NT; t += 2) {
        STEP(pB0, pB1, pA0, pA1, t, true, true, true);     ATT_WAIT_BAR(2); RESC(); ROT();
        STEP(pA0, pA1, pB0, pB1, t + 1, true, true, true); ATT_WAIT_BAR(2); RESC(); ROT();
    }
#define ENDW(tt) do { if ((tt) + 3 < NT) { ATT_WAIT_BAR(2); } else if ((tt) + 2 < NT) { ATT_WAIT_BAR(1); } else { ATT_WAIT_BAR(0); } } while (0)
    for (; t + 1 < NT; t += 2) {
        STEP(pB0, pB1, pA0, pA1, t, (t + 3 < NT), (t + 1 < NT), (t + 1 < NT));         ENDW(t);     RESC(); ROT();
        STEP(pA0, pA1, pB0, pB1, t + 1, (t + 4 < NT), (t + 2 < NT), (t + 2 < NT));     ENDW(t + 1); RESC(); ROT();
    }
#define DRAIN(X0, X1, SL) do { float sacc = X0[0] + X0[1]; \
      _Pragma("unroll") for (int r = 2; r < 16; ++r) sacc += X0[r]; \
      _Pragma("unroll") for (int r = 0; r < 16; ++r) sacc += X1[r]; \
      l_reg += sacc; \
      pw0 = (u32x4){PKW(X0, 0), PKW(X0, 2), PKW(X0, 4), PKW(X0, 6)}; pw1 = (u32x4){PKW(X0, 8), PKW(X0, 10), PKW(X0, 12), PKW(X0, 14)}; \
      pw2 = (u32x4){PKW(X1, 0), PKW(X1, 2), PKW(X1, 4), PKW(X1, 6)}; pw3 = (u32x4){PKW(X1, 8), PKW(X1, 10), PKW(X1, 12), PKW(X1, 14)}; \
      ATT_SBAR(); pv(o, vb0 + (SL), PAF(0), PAF(1), PAF(2), PAF(3)); } while (0)
    if (NT & 1) { DRAIN(pA0, pA1, sl_prev); }
    else { STEP(pB0, pB1, pA0, pA1, NT - 1, false, false, false); RESC(); DRAIN(pB0, pB1, sl_cur); }
#undef DRAIN
    l_out = l_reg;
    ATT_WAIT_BAR(0);
#undef FP_TSRC
#undef DMA_K
#undef DMA_V
#undef CMASK
#undef START
#undef RESC
#undef ROT
#undef PKW
#undef PAF
#undef VFR
#undef PIN
#undef MX3
#undef GAPA
#undef GAPB
#undef EX
#undef VRD
#undef KRD
#undef STEP
#undef ENDW
}

template <bool ADD> __device__ __forceinline__ void acc_rows(const f32x16 (&o)[2], float f, const Ctx& C_) {
    const int l = lane_now(), r32 = l & 31, hi = l >> 5;
    LAS float* wsf = (LAS float*)(C_.lds + A_WSF) + C_.wid * 64;
    if (hi == 0) wsf[r32] = f;
    asm volatile("s_waitcnt lgkmcnt(0)" ::: "memory");
    LAS float* lo = (LAS float*)(C_.lds + A_IMP + C_.wid * 4096) + 4 * hi * 64 + r32;
    LAS float* hp = (LAS float*)(C_.lds + A_OST + C_.wid * 4096) + 4 * hi * 64 + r32;
#pragma unroll
    for (int g = 0; g < 4; ++g) { const f32x4 fv = *(const LAS f32x4*)(wsf + 8 * g + 4 * hi);
#pragma unroll
        for (int i = 0; i < 4; ++i)
#pragma unroll
            for (int d0 = 0; d0 < 2; ++d0) { LAS float* p = ((g < 2) ? lo : hp) + ((i + 8 * (g & 1)) * 64 + 32 * d0);
                const float v = o[d0][4 * g + i] * fv[i]; if (ADD) *p += v; else *p = v; } }
    asm volatile("s_waitcnt lgkmcnt(0)" ::: "memory");
}
__device__ __forceinline__ void acc_flush(unsigned char* Ow, long pitch, const Ctx& C_) {
    const int l = lane_now();
#pragma unroll
    for (int i = 0; i < 4; ++i) { const int row = i * 8 + (l >> 3), ch = l & 7;
        const LAS float* p = (const LAS float*)(C_.lds + (row < 16 ? A_IMP : A_OST) + C_.wid * 4096) + (row & 15) * 64 + ch * 8;
        const f32x4 a = *(const LAS f32x4*)p * 16.f, b = *(const LAS f32x4*)(p + 4) * 16.f;
        u32x2 w; w.x = pk4_fp8(a[0], a[1], a[2], a[3]); w.y = pk4_fp8(b[0], b[1], b[2], b[3]);
        *(u32x2*)(Ow + (long)row * pitch + ch * 8) = w; }
    asm volatile("s_waitcnt lgkmcnt(0)" ::: "memory");
}
template <int THRL, bool PRE, class MaskF1, class MaskF2>
__device__ __forceinline__ void fast_pass2(const Ctx& C, const bf16x8 (&qr)[4], const bf16_t* Kp1, const bf16_t* Vp1, int n1, MaskF1 mask1, float g1,
                                           const bf16_t* Kp2, const bf16_t* Vp2, int t_lo2, int n2, MaskF2 mask2, float g2) {
    f32x16 o[2];
    const int lane = lane_now(), r32 = lane & 31, hi = lane >> 5; const int wid = C.wid;
    const unsigned lds0 = C.lds0;
    LAS float* wsf = (LAS float*)(C.lds + A_WSF) + wid * 64;
    int NT = (n1 + n2 + 1) & ~1; if (NT < 4) NT = 4;
    const int koff = lane * 64 + wid * 8, voff = (16 * (wid & 3) + (lane >> 2)) * 64 + (wid >> 2) * 32 + (lane & 3) * 8;
    const bf16_t* K2b = Kp2 + (long)t_lo2 * 4096; const bf16_t* V2b = Vp2 + (long)t_lo2 * 4096;
    const unsigned kdst = lds0 + F_K + wid * 1024, vdst = lds0 + F_V + wid * 1024;
#define FP_SEG2(t) ((t) >= n1)
#define FP_TIDX(t) (FP_SEG2(t) ? ((((t) - n1) < n2) ? ((t) - n1) : (n2 - 1)) : (t))
#define DMA_K(t, slot) glds16((FP_SEG2(t) ? K2b : Kp1) + (long)FP_TIDX(t) * 4096 + koff, (unsigned)__builtin_amdgcn_readfirstlane(kdst + (slot)))
#define DMA_V(t, slot) glds16((FP_SEG2(t) ? V2b : Vp1) + (long)FP_TIDX(t) * 4096 + voff, (unsigned)__builtin_amdgcn_readfirstlane(vdst + (slot)))
    const int vb0 = (int)(lds0 + F_V) + ((lane >> 4) & 1) * 32 + (lane & 3) * 8 + (4 * hi + ((lane & 15) >> 2)) * 64;
    bf16x8 kf[8];
    const lds_cptr shm3 = (lds_cptr)C.lds; const lds_cptr kp0 = shm3 + F_K + hi * 1024 + r32 * 16; const lds_cptr vp0 = shm3 + F_V + ((lane >> 4) & 1) * 32 + (lane & 3) * 8 + (4 * hi + ((lane & 15) >> 2)) * 64;
    if (!PRE) { DMA_K(0, 0); DMA_V(0, 0); DMA_K(1, F_SLOT); }
    float mhat = 0.f, l_reg = 0.f; o[0] = f32x16{}; o[1] = f32x16{}; const f32x16 zc = {};
#define CMASK(P0, P1, t) do { if ((t) < n1) mask1(P0, P1, (t)); else mask2(P0, P1, (t) - n1); } while (0)
    bool resc = false;
#define START(P0, P1) do { const float rm = rowmax3(P0, P1); resc = false; \
    { const float dl = rm; mhat = fadd_s(mhat, dl); \
      _Pragma("unroll") for (int r = 0; r < 16; ++r) { P0[r] = fsub_s(P0[r], dl); P1[r] = fsub_s(P1[r], dl); } \
      } \
    _Pragma("unroll") for (int r = 0; r < 16; ++r) P0[r] = __builtin_amdgcn_exp2f(P0[r]); } while (0)
#define RESC() do { if (resc) { asm volatile("s_waitcnt lgkmcnt(0)" ::: "memory"); \
      _Pragma("unroll") for (int d_ = 0; d_ < 2; ++d_) _Pragma("unroll") for (int r = 0; r < 16; ++r) o[d_][r] *= wsf[crow(r, hi)]; } } while (0)
    f32x16 pA0, pA1, pB0, pB1;
    int sl_prev = 0, sl_cur = 0, sl_next = F_SLOT;
#define SEAM_FIN(t) do { if ((t) == n1) { acc_rows<true>(o, g1 / halfsum(l_reg), C); o[0] = f32x16{}; o[1] = f32x16{}; l_reg = 0.f; } } while (0)
#define ROT() do { sl_prev = sl_cur; sl_cur = sl_next; sl_next = (sl_next == 2 * F_SLOT) ? 0 : sl_next + F_SLOT; } while (0)
    if (!PRE) DMA_K(2, 2 * F_SLOT);
    ATT_WAIT_BAR(3);
    { const LAS unsigned char* kb = C.lds + F_K + hi * 1024 + r32 * 16;
#pragma unroll
      for (int d0 = 0; d0 < 4; ++d0) { const bf16x8 b0 = *(const LAS bf16x8*)(kb + d0 * 2048); const bf16x8 b1 = *(const LAS bf16x8*)(kb + d0 * 2048 + 512);
          if (d0 == 0) { pA0 = __builtin_amdgcn_mfma_f32_32x32x16_bf16(b0, qr[0], zc, 0, 0, 0); pA1 = __builtin_amdgcn_mfma_f32_32x32x16_bf16(b1, qr[0], zc, 0, 0, 0); }
          else { pA0 = __builtin_amdgcn_mfma_f32_32x32x16_bf16(b0, qr[d0], pA0, 0, 0, 0); pA1 = __builtin_amdgcn_mfma_f32_32x32x16_bf16(b1, qr[d0], pA1, 0, 0, 0); } } }
    CMASK(pA0, pA1, 0);
    asm volatile("s_nop 15\n\ts_nop 7" : "+v"(pA0), "+v"(pA1));
    START(pA0, pA1);
#pragma unroll
    for (int r = 0; r < 16; ++r) pA1[r] = __builtin_amdgcn_exp2f(pA1[r]);
    ATT_WAIT_BAR(0);
    DMA_K(3, 0); DMA_V(1, F_SLOT);
    ROT();
    kload8(kf, kp0 + sl_cur);
    ATT_WAIT_BAR(2);
    s16x4 vlo[8], vhi[8]; u32x4 pw0, pw1, pw2, pw3;
#define PKW(P, B) cvtpk(P[B], P[B + 1])
#define PAF(k) __builtin_bit_cast(bf16x8, pw##k)
#define VFR(i) (bf16x8){vlo[i][0], vlo[i][1], vlo[i][2], vlo[i][3], vhi[i][0], vhi[i][1], vhi[i][2], vhi[i][3]}
#define PIN(x) asm volatile("" : "+v"(x))
#define MX3(a, b, c) __builtin_fmaxf(__builtin_fmaxf((a), (b)), (c))
#define GAPA(MF, A0, A1, A2, A3, W0, W1, PW) do { MF; sacc += A0; sacc += A1; sacc += A2; sacc += A3; PIN(sacc); W0; W1; PIN(PW); ATT_SBAR(); } while (0)
#define EX(v) __builtin_amdgcn_exp2f(v)
#define GAPB(MF, X, B) do { MF; X[B] = EX(X[B]); X[B + 1] = EX(X[B + 1]); X[B + 2] = EX(X[B + 2]); X[B + 3] = EX(X[B + 3]); PIN(X); ATT_SBAR(); } while (0)
#define VRD(i) do { vlo[i] = vtr(vp_ + (((i) >> 2) * 4096 + ((i) & 3) * 1024)); vhi[i] = vtr(vp_ + (((i) >> 2) * 4096 + ((i) & 3) * 1024 + 512)); } while (0)
#define KRD(G, j) do { if (G) { kload2(kf, kp0 + sl_next, j); ATT_SBAR(); } } while (0)
#define STEP(C0, C1, P0, P1, t, GK, GV, GL) do { ATT_SBAR(); \
    const lds_cptr vp_ = vp0 + sl_prev; \
    VRD(0); ATT_SBAR(); float sacc = (P0[0] + P0[1]); \
    GAPA(C0 = __builtin_amdgcn_mfma_f32_32x32x16_bf16(kf[0], qr[0], zc, 0, 0, 0), P0[2], P0[3], P0[4], P0[5],     pw0[0] = PKW(P0, 0), pw0[1] = PKW(P0, 2), pw0); \
    VRD(4); ATT_SBAR(); GAPA(C1 = __builtin_amdgcn_mfma_f32_32x32x16_bf16(kf[1], qr[0], zc, 0, 0, 0), P0[6], P0[7], P0[8], P0[9],     pw0[2] = PKW(P0, 4), pw0[3] = PKW(P0, 6), pw0); \
    VRD(1); ATT_SBAR(); GAPA(C0 = __builtin_amdgcn_mfma_f32_32x32x16_bf16(kf[2], qr[1], C0, 0, 0, 0),   P0[10], P0[11], P0[12], P0[13], pw1[0] = PKW(P0, 8), pw1[1] = PKW(P0, 10), pw1); \
    VRD(5); ATT_SBAR(); GAPA(C1 = __builtin_amdgcn_mfma_f32_32x32x16_bf16(kf[3], qr[1], C1, 0, 0, 0),   P0[14], P0[15], P1[0], P1[1],   pw1[2] = PKW(P0, 12), pw1[3] = PKW(P0, 14), pw1); \
    VRD(2); ATT_SBAR(); GAPA(C0 = __builtin_amdgcn_mfma_f32_32x32x16_bf16(kf[4], qr[2], C0, 0, 0, 0),   P1[2], P1[3], P1[4], P1[5],     pw2[0] = PKW(P1, 0), pw2[1] = PKW(P1, 2), pw2); \
    VRD(6); ATT_SBAR(); GAPA(C1 = __builtin_amdgcn_mfma_f32_32x32x16_bf16(kf[5], qr[2], C1, 0, 0, 0),   P1[6], P1[7], P1[8], P1[9],     pw2[2] = PKW(P1, 4), pw2[3] = PKW(P1, 6), pw2); \
    VRD(3); ATT_SBAR(); GAPA(C0 = __builtin_amdgcn_mfma_f32_32x32x16_bf16(kf[6], qr[3], C0, 0, 0, 0),   P1[10], P1[11], P1[12], P1[13], pw3[0] = PKW(P1, 8), pw3[1] = PKW(P1, 10), pw3); \
    VRD(7); ATT_SBAR(); GAPA(C1 = __builtin_amdgcn_mfma_f32_32x32x16_bf16(kf[7], qr[3], C1, 0, 0, 0),   P1[14], P1[15], 0.f, 0.f,       pw3[2] = PKW(P1, 12), pw3[3] = PKW(P1, 14), pw3); \
    l_reg += sacc; \
    if (GK) { DMA_K((t) + 3, sl_cur); } if (GV) { DMA_V((t) + 1, sl_next); } \
    _Pragma("unroll") for (int r = 0; r < 16; ++r) { C0[r] -= mhat; C1[r] -= mhat; } \
    CMASK(C0, C1, t); \
    { float a = MX3(C0[0], C0[1], C1[0]), b = MX3(C0[2], C0[3], C1[1]); a = MX3(a, C1[2], C1[3]); \
      _Pragma("unroll") for (int r = 4; r < 16; r += 4) { a = MX3(a, C0[r], C0[r + 1]); b = MX3(b, C0[r + 2], C0[r + 3]); a = MX3(a, C1[r], C1[r + 1]); b = MX3(b, C1[r + 2], C1[r + 3]); } \
      float rm = __builtin_fmaxf(a, b); { auto rr = __builtin_amdgcn_permlane32_swap(__float_as_uint(rm), __float_as_uint(rm), false, false); rm = __builtin_fmaxf(__uint_as_float(rr[0]), __uint_as_float(rr[1])); } \
      resc = false; \
      if ((t) == n1) { const float dl = rm; mhat += dl;                        \
        _Pragma("unroll") for (int r = 0; r < 16; ++r) { C0[r] -= dl; C1[r] -= dl; } \
        } \
      else if (__builtin_expect(__any(rm > (float)THRL), 0)) { const float dl = __builtin_fmaxf(rm, 0.f); mhat += dl; \
        _Pragma("unroll") for (int r = 0; r < 16; ++r) { C0[r] -= dl; C1[r] -= dl; } \
        const float f = __builtin_amdgcn_exp2f(-dl); l_reg *= f; if (hi == 0) wsf[r32] = f; resc = true; } } \
    ATT_SBAR(); \
    GAPB(o[0] = __builtin_amdgcn_mfma_f32_32x32x16_bf16(PAF(0), VFR(0), o[0], 0, 0, 0), C0, 0); \
    GAPB(o[1] = __builtin_amdgcn_mfma_f32_32x32x16_bf16(PAF(0), VFR(4), o[1], 0, 0, 0), C0, 4); \
    KRD(GL, 0); GAPB(o[0] = __builtin_amdgcn_mfma_f32_32x32x16_bf16(PAF(1), VFR(1), o[0], 0, 0, 0), C0, 8); \
    KRD(GL, 1); GAPB(o[1] = __builtin_amdgcn_mfma_f32_32x32x16_bf16(PAF(1), VFR(5), o[1], 0, 0, 0), C0, 12); \
    KRD(GL, 2); GAPB(o[0] = __builtin_amdgcn_mfma_f32_32x32x16_bf16(PAF(2), VFR(2), o[0], 0, 0, 0), C1, 0); \
    KRD(GL, 3); GAPB(o[1] = __builtin_amdgcn_mfma_f32_32x32x16_bf16(PAF(2), VFR(6), o[1], 0, 0, 0), C1, 4); \
    GAPB(o[0] = __builtin_amdgcn_mfma_f32_32x32x16_bf16(PAF(3), VFR(3), o[0], 0, 0, 0), C1, 8); \
    GAPB(o[1] = __builtin_amdgcn_mfma_f32_32x32x16_bf16(PAF(3), VFR(7), o[1], 0, 0, 0), C1, 12); \
    } while (0)
    int t = 1;
    for (; t + 5 < NT; t += 2) {
        STEP(pB0, pB1, pA0, pA1, t, true, true, true);     ATT_WAIT_BAR(2); RESC(); SEAM_FIN(t); ROT();
        STEP(pA0, pA1, pB0, pB1, t + 1, true, true, true); ATT_WAIT_BAR(2); RESC(); SEAM_FIN(t + 1); ROT();
    }
#define ENDW(tt) do { if ((tt) + 3 < NT) { ATT_WAIT_BAR(2); } else if ((tt) + 2 < NT) { ATT_WAIT_BAR(1); } else { ATT_WAIT_BAR(0); } } while (0)
    for (; t + 1 < NT; t += 2) {
        STEP(pB0, pB1, pA0, pA1, t, (t + 3 < NT), (t + 1 < NT), (t + 1 < NT));         ENDW(t);     RESC(); SEAM_FIN(t); ROT();
        STEP(pA0, pA1, pB0, pB1, t + 1, (t + 4 < NT), (t + 2 < NT), (t + 2 < NT));     ENDW(t + 1); RESC(); SEAM_FIN(t + 1); ROT();
    }
    STEP(pB0, pB1, pA0, pA1, NT - 1, false, false, false); RESC(); SEAM_FIN(NT - 1);
    { float sacc = pB0[0] + pB0[1];
#pragma unroll
      for (int r = 2; r < 16; ++r) sacc += pB0[r];
#pragma unroll
      for (int r = 0; r < 16; ++r) sacc += pB1[r];
      l_reg += sacc;
      pw0 = (u32x4){PKW(pB0, 0), PKW(pB0, 2), PKW(pB0, 4), PKW(pB0, 6)}; pw1 = (u32x4){PKW(pB0, 8), PKW(pB0, 10), PKW(pB0, 12), PKW(pB0, 14)};
      pw2 = (u32x4){PKW(pB1, 0), PKW(pB1, 2), PKW(pB1, 4), PKW(pB1, 6)}; pw3 = (u32x4){PKW(pB1, 8), PKW(pB1, 10), PKW(pB1, 12), PKW(pB1, 14)};
      ATT_SBAR(); pv(o, vb0 + sl_cur, PAF(0), PAF(1), PAF(2), PAF(3)); }
    acc_rows<true>(o, g2 / halfsum(l_reg), C);
    ATT_WAIT_BAR(0);
#undef FP_SEG2
#undef FP_TIDX
#undef SEAM_FIN
#undef DMA_K
#undef DMA_V
#undef CMASK
#undef START
#undef RESC
#undef ROT
#undef PKW
#undef PAF
#undef VFR
#undef PIN
#undef MX3
#undef GAPA
#undef GAPB
#undef EX
#undef VRD
#undef KRD
#undef STEP
#undef ENDW
}

}
namespace att {
template <int CTRL> __device__ __forceinline__ float dppf(float v) { return __uint_as_float(__builtin_amdgcn_update_dpp(0u, __float_as_uint(v), CTRL, 0xf, 0xf, true)); }
template <class T> __device__ __forceinline__ T* fresh_ptr(T* p) { asm volatile("" : "+v"(p)); return p; }
__device__ __forceinline__ void dil_unit(const Ctx& C, unsigned char* ws, int u, bf16_t* obraw, float* lse) {
    const int gi = u >> 9, v = u & 511, hw = C.wid >> 2, w4 = C.wid & 3;
    const int b = v >> 4, j = (v >> 3) & 1;
    int ds, res, blk, L;
    if (gi == 0) { ds = 1; res = 0; blk = 2 * (v & 7) + hw; L = 2048; }
    else if (gi == 1) { ds = 4; res = (v >> 1) & 3; blk = 2 * (v & 1) + hw; L = 512; }
    else { ds = 16; res = 2 * (v & 7) + hw; blk = 0; L = 128; }
    const int h6 = gi * 2 + j;
    const size_t tokbase = (size_t)b * SEQ + res;
    const bf16_t* Qp = (const bf16_t*)(ws + slot_off(SL_QB + h6)) + tokbase * 64;
    const bf16_t* Kp = (const bf16_t*)(ws + slot_off(SL_KB + h6)) + tokbase * 64;
    const bf16_t* Vp = (const bf16_t*)(ws + slot_off(SL_VB + h6)) + tokbase * 64;
    const long rs = (long)ds * 64;
    int t_lo = 2 * blk - 2; if (t_lo < 0) t_lo = 0; int t_hi = 2 * blk + 2; if (t_hi > L / 64) t_hi = L / 64;
    const int nsteps = (gi == 2) ? 2 : 4;
    const int l0_ = lane_now(); const int hi = l0_ >> 5;
    const int i0 = 128 * blk + 32 * w4, iq = i0 + (l0_ & 31);
    bf16x8 qr[4]; load_q(qr, Qp + (long)iq * rs, hi);
    SM st; sm_init(st);
    auto mask = [&](f32x16& p0, f32x16& p1, int tile) {
        const int lim = fresh(iq - 64 * tile - 4 * hi), lim2 = lim - 128;
#pragma unroll
        for (int r = 0; r < 16; ++r) { const int c = (r & 3) + 8 * (r >> 2);
            if (c > lim || c < lim2) p0[r] = NEG_INF;
            if (c + 32 > lim || c + 32 < lim2) p1[r] = NEG_INF; }
    };
    auto skip = [&](int tile) { return (64 * tile > i0 + 31) || (64 * tile + 63 < i0 - 128); };
    run_pass<2>(C, st, qr, Kp, Vp, rs, t_lo, t_hi, nsteps, mask, skip);
    const float lt = halfsum(st.l);
    const float inv = 1.0f / lt;
    scale_rows(st.o, inv, C);
    store_o(st.o, obraw + (tokbase + (size_t)i0 * ds) * 384 + h6 * 64, (long)ds * 384, C);
    if ((lane_now() >> 5) == 0) lse[(tokbase + (size_t)iq * ds) * 8 + h6] = (st.m + __builtin_amdgcn_logf(lt)) * 0.6931471805599453f;
    ATT_WAIT_BAR(0);
}

__device__ __forceinline__ void nsa_unit(const Ctx& C, unsigned char* ws, int b, int hk, int blk, unsigned char* oa) {
    const int g = C.wid >> 1, head = hk * 4 + g;
    const size_t tokbase = (size_t)b * SEQ;
    const bf16_t* qbase = (const bf16_t*)(ws + slot_off(SL_QA + head)) + (tokbase + 64 * blk + 32 * (C.wid & 1)) * 64;
    const bf16_t* gabase = (const bf16_t*)(ws + slot_off(SL_GA)) + (tokbase + 64 * blk + 32 * (C.wid & 1)) * 64;
#define NSA_LANE_STATE() const int l_ = lane_now(); const int r32_ = l_ & 31, hi = l_ >> 5; const int tq = 64 * blk + 32 * (C.wid & 1) + r32_; \
    const bf16_t* qrow = qbase + r32_ * 64; const bf16_t* ga = gabase + r32_ * 64
#ifndef PROBE_ZERO
#define PROBE_ZERO 0
#endif
    f32x16 ot[2]; ot[0] = f32x16{}; ot[1] = f32x16{};
    LAS float* imp = (LAS float*)(C.lds + A_IMP);
    LAS unsigned* sel = (LAS unsigned*)(C.lds + A_SEL);
#if defined(PROBE_DUP) && PROBE_DUP == 1
    for (int rep_ = 0; rep_ < 2; ++rep_)
#endif
    {
        ot[0] = f32x16{}; ot[1] = f32x16{};
        NSA_LANE_STATE();
        bf16x8 qr[4]; load_q(qr, qrow, hi);
        const float g_cmp = (PROBE_ZERO & 1) ? 0.f : bf2f(ga[head]);
        const int pair = hk * 32 + b;
        const bf16_t* Kc = (const bf16_t*)(ws + WS_KC) + (size_t)pair * 128 * 64;
        const bf16_t* Vc = (const bf16_t*)(ws + WS_KC + MiB) + (size_t)pair * 128 * 64;
        const bool two = blk >= 16;
#ifndef NSA_SPLIT_PASSES
        fast_prefetch2(C, (const bf16_t*)(ws + slot_off(SL_KSLC + hk)) + tokbase * 64, (const bf16_t*)(ws + slot_off(SL_VSLC + hk)) + tokbase * 64, blk + 1,
                       (const bf16_t*)(ws + slot_off(SL_KWIN + hk)) + tokbase * 64, blk >= 8 ? blk - 8 : 0, blk >= 8 ? 9 : blk + 1);
#else
        fast_prefetch(C, (const bf16_t*)(ws + slot_off(SL_KSLC + hk)) + tokbase * 64, (const bf16_t*)(ws + slot_off(SL_VSLC + hk)) + tokbase * 64, 0, blk + 1);
#endif
        dma_tile<1>(C, Kc, Vc, 64, 0, 0, 0, A_OST);
        if (two) dma_tile<1>(C, Kc, Vc, 64, 1, 1, 0, A_OST);
        ATT_WAIT_BAR(0);
        const int nlim = (tq - 31) >> 4;
        auto cmask = [&](f32x16& p0, f32x16& p1, int tile) {
            { const int lim = fresh(nlim - 64 * tile - 4 * hi);
#pragma unroll
              for (int r = 0; r < 16; ++r) { const int c = (r & 3) + 8 * (r >> 2); if (c > lim) p0[r] = NEG_INF; if (c + 32 > lim) p1[r] = NEG_INF; } } };
        float rm;
        { f32x16 s0, s1; qkt(s0, s1, C.lds + A_OST, qr, C.lane); cmask(s0, s1, 0); rm = rowmax(s0, s1);
          if (two) { qkt(s0, s1, C.lds + A_OST + 16384, qr, C.lane); cmask(s0, s1, 1); rm = fmaxf(rm, rowmax(s0, s1)); } }
        const bool has = rm > -1e29f; if (!has) rm = 0.f;
        LAS float* irh; { unsigned a_ = (unsigned)(size_t)(imp + (g * 64 + 32 * (C.wid & 1) + r32_) * 33 + hi); asm volatile("" : "+v"(a_)); irh = (LAS float*)(size_t)a_; }
        float sum = 0.f;
#pragma unroll
        for (int gq = 0; gq < 8; ++gq) irh[16 + 2 * gq] = 0.f;
        asm volatile("s_waitcnt lgkmcnt(0)" ::: "memory");
#pragma unroll
        for (int tile = 0; tile < 2; ++tile) {
            if (tile == 0 || two) {
                f32x16 s0, s1; qkt(s0, s1, C.lds + A_OST + tile * 16384, qr, C.lane); cmask(s0, s1, tile);
#pragma unroll
                for (int r = 0; r < 16; ++r) { s0[r] = __builtin_amdgcn_exp2f(s0[r] - rm); s1[r] = __builtin_amdgcn_exp2f(s1[r] - rm); sum += s0[r] + s1[r]; }
#pragma unroll
                for (int gq = 0; gq < 4; ++gq) { const float A0 = (s0[4 * gq] + s0[4 * gq + 1]) + (s0[4 * gq + 2] + 0.5f * s0[4 * gq + 3]), A1 = (s1[4 * gq] + s1[4 * gq + 1]) + (s1[4 * gq + 2] + 0.5f * s1[4 * gq + 3]);
                    if (tile == 0) { irh[2 * gq] = A0; irh[8 + 2 * gq] = A1; } else { irh[16 + 2 * gq] += A0; irh[24 + 2 * gq] += A1; } }
                asm volatile("s_waitcnt lgkmcnt(0)" ::: "memory");
#pragma unroll
                for (int gq = 0; gq < 4; ++gq) { const int j0 = 16 * tile + 2 * gq + 1, j1 = j0 + 8;
                    irh[j0] += 0.5f * s0[4 * gq + 3];
                    if (j1 < 31) irh[j1] += 0.5f * s1[4 * gq + 3]; else if (hi == 0) irh[j1] += 0.5f * s1[4 * gq + 3]; }
                asm volatile("s_waitcnt lgkmcnt(0)" ::: "memory");
                { const int lv = lane_now(); const int vlane = ((lv >> 4) & 1) * 32 + (lv & 3) * 8 + (4 * (lv >> 5) + ((lv & 15) >> 2)) * 64;
                  pv_tile(ot, (int)C.lds0 + A_OST + tile * 16384 + 8192 + vlane, s0, s1); }
            }
        }
        const float lt = halfsum(sum); const float inv = has ? 1.0f / lt : 0.f;
        if (hi == 0) ((LAS float*)(C.lds + A_SEL + 256))[g * 64 + 32 * (C.wid & 1) + (lane_now() & 31)] = inv;
        scale_rows(ot, g_cmp * inv, C);
        ATT_WAIT_BAR(0);
        {
            const int l_ = lane_now(); const int jb = l_ & 31, hf = l_ >> 5;
            const LAS float* nrm = (const LAS float*)(C.lds + A_SEL + 256);
            unsigned m0 = 1u | (1u << blk); if (blk >= 1) m0 |= 1u << (blk - 1);
            const int need = 8 - __builtin_popcount(m0), ncand = blk - 2;
            const bool cand = (jb >= 1) && (jb <= blk - 2);
#pragma unroll 1
            for (int it = 0; it < 4; ++it) {
                const int q = C.wid * 8 + 2 * it + hf; unsigned m = m0;
                if (ncand > 0) {
                    if (ncand <= need) { m |= ((1u << (blk - 1)) - 1u) & ~1u; }
                    else {
                        float sc = (imp[(0 * 64 + q) * 33 + jb] * nrm[q] + imp[(1 * 64 + q) * 33 + jb] * nrm[64 + q]) + (imp[(2 * 64 + q) * 33 + jb] * nrm[128 + q] + imp[(3 * 64 + q) * 33 + jb] * nrm[192 + q]);
#ifdef PROBE_SELINV
                        sc = 1e30f - sc;
#endif
                        if (!cand) sc = -1.f;
                        for (int r = 0; r < need; ++r) {
                            float mx = sc;
                            mx = fmaxf(mx, dppf<0xB1>(mx)); mx = fmaxf(mx, dppf<0x4E>(mx)); mx = fmaxf(mx, dppf<0x141>(mx)); mx = fmaxf(mx, dppf<0x140>(mx));
                            { const float up = __uint_as_float(__builtin_amdgcn_update_dpp(__float_as_uint(mx), __float_as_uint(mx), 0x142, 0xa, 0xf, false));
                              const float m2 = fmaxf(mx, up);
                              const float m31 = __uint_as_float(__builtin_amdgcn_readlane(__float_as_uint(m2), 31)), m63 = __uint_as_float(__builtin_amdgcn_readlane(__float_as_uint(m2), 63));
                              mx = hf ? m63 : m31; }
                            const unsigned long long bal = __ballot(sc == mx && sc >= 0.f);
                            const unsigned bm = hf ? (unsigned)(bal >> 32) : (unsigned)bal;
                            const int w = __ffs(bm) - 1;
                            if (w >= 0) { m |= 1u << w; if (jb == w) sc = -1.f; }
                        }
                    }
                }
                if (jb == 0) sel[q] = m;
            }
        }
        ATT_WAIT_BAR(0);
    }
    const unsigned mysel = sel[32 * (C.wid & 1) + (lane_now() & 31)];
    acc_rows<false>(ot, 1.0f, C);
#ifndef NSA_SPLIT_PASSES
    {
        const bf16_t* Kp1 = (const bf16_t*)(ws + slot_off(SL_KSLC + hk)) + tokbase * 64; const bf16_t* Vp1 = (const bf16_t*)(ws + slot_off(SL_VSLC + hk)) + tokbase * 64;
        const bf16_t* Kp2 = (const bf16_t*)(ws + slot_off(SL_KWIN + hk)) + tokbase * 64; const bf16_t* Vp2 = (const bf16_t*)(ws + slot_off(SL_VWIN + hk)) + tokbase * 64;
        const int n1 = blk + 1, t_lo2 = blk >= 8 ? blk - 8 : 0, n2 = blk + 1 - t_lo2;
        NSA_LANE_STATE();
        bf16x8 qr[4]; load_q(qr, qrow, hi);
        const float g_slc = (PROBE_ZERO & 2) ? 0.f : bf2f(ga[8 + head]), g_win = (PROBE_ZERO & 4) ? 0.f : bf2f(ga[16 + head]);
        auto mask1 = [&](f32x16& p0, f32x16& p1, int t) {
            const bool on = ((mysel >> t) & 1u);
            if (!__all(on) || t == blk) {
                if (!on) {
#pragma unroll
                    for (int r = 0; r < 16; ++r) { p0[r] = NEG_INF; p1[r] = NEG_INF; } }
                else if (t == blk) { const int lim = fresh(tq - 64 * t - 4 * hi);
#pragma unroll
                    for (int r = 0; r < 16; ++r) { const int c = (r & 3) + 8 * (r >> 2); if (c > lim) p0[r] = NEG_INF; if (c + 32 > lim) p1[r] = NEG_INF; } }
            }
        };
        auto mask2 = [&](f32x16& p0, f32x16& p1, int t) {
            if (t >= n2) {
#pragma unroll
                for (int r = 0; r < 16; ++r) { p0[r] = NEG_INF; p1[r] = NEG_INF; } }
            else if (t == n2 - 1 || (t == 0 && blk >= 8)) { const int lim = fresh(tq - 64 * (t_lo2 + t) - 4 * hi), lim2 = lim - 512;
#pragma unroll
                for (int r = 0; r < 16; ++r) { const int c = (r & 3) + 8 * (r >> 2);
                    if (c > lim || c < lim2) p0[r] = NEG_INF; if (c + 32 > lim || c + 32 < lim2) p1[r] = NEG_INF; } }
        };
        fast_pass2<8, true>(C, qr, Kp1, Vp1, n1, mask1, g_slc, Kp2, Vp2, t_lo2, n2, mask2, g_win);
    }
#else
    {
        const bf16_t* Kp = (const bf16_t*)(ws + slot_off(SL_KSLC + hk)) + tokbase * 64;
        const bf16_t* Vp = (const bf16_t*)(ws + slot_off(SL_VSLC + hk)) + tokbase * 64;
        const int ntr = blk + 1;
        NSA_LANE_STATE();
        bf16x8 qr[4]; load_q(qr, qrow, hi);
        const float g_slc = (PROBE_ZERO & 2) ? 0.f : bf2f(ga[8 + head]);
        auto mask = [&](f32x16& p0, f32x16& p1, int t) {
            const bool on = (t < ntr) && ((mysel >> t) & 1u);
            if (!__all(on) || t == blk) {
                if (!on) {
#pragma unroll
                    for (int r = 0; r < 16; ++r) { p0[r] = NEG_INF; p1[r] = NEG_INF; } }
                else if (t == blk) { const int lim = fresh(tq - 64 * t - 4 * hi);
#pragma unroll
                    for (int r = 0; r < 16; ++r) { const int c = (r & 3) + 8 * (r >> 2); if (c > lim) p0[r] = NEG_INF; if (c + 32 > lim) p1[r] = NEG_INF; } }
            }
        };
        f32x16 o[2]; float l;
        fast_pass<8, true>(C, qr, Kp, Vp, 0, ntr, mask, o, l);
        acc_rows<true>(o, g_slc * __builtin_amdgcn_rcpf(halfsum(l)), C);
#if defined(PROBE_DUP) && PROBE_DUP == 2
        fast_pass<8, false>(C, qr, Kp, Vp, 0, ntr, mask, o, l);
        acc_rows<true>(o, 0.f * halfsum(l), C);
#endif
    }
    {
        const bf16_t* Kp = (const bf16_t*)(ws + slot_off(SL_KWIN + hk)) + tokbase * 64;
        const bf16_t* Vp = (const bf16_t*)(ws + slot_off(SL_VWIN + hk)) + tokbase * 64;
        const int t_lo = blk >= 8 ? blk - 8 : 0, ntr = blk + 1 - t_lo;
        NSA_LANE_STATE();
        bf16x8 qr[4]; load_q(qr, qrow, hi);
        const float g_win = (PROBE_ZERO & 4) ? 0.f : bf2f(ga[16 + head]);
        auto mask = [&](f32x16& p0, f32x16& p1, int t) {
            if (t >= ntr) {
#pragma unroll
                for (int r = 0; r < 16; ++r) { p0[r] = NEG_INF; p1[r] = NEG_INF; } }
            else if (t == ntr - 1 || (t == 0 && blk >= 8)) { const int lim = fresh(tq - 64 * (t_lo + t) - 4 * hi), lim2 = lim - 512;
#pragma unroll
                for (int r = 0; r < 16; ++r) { const int c = (r & 3) + 8 * (r >> 2);
                    if (c > lim || c < lim2) p0[r] = NEG_INF; if (c + 32 > lim || c + 32 < lim2) p1[r] = NEG_INF; } }
        };
        f32x16 o[2]; float l;
        fast_pass<8, false>(C, qr, Kp, Vp, t_lo, ntr, mask, o, l);
        acc_rows<true>(o, g_win * __builtin_amdgcn_rcpf(halfsum(l)), C);
#if defined(PROBE_DUP) && PROBE_DUP == 3
        fast_pass<8, false>(C, qr, Kp, Vp, t_lo, ntr, mask, o, l);
        acc_rows<true>(o, 0.f * halfsum(l), C);
#endif
    }
#endif
    acc_flush(oa + (tokbase + 64 * blk + 32 * (C.wid & 1)) * 1024 + head * 64, 1024, C);
    ATT_WAIT_BAR(0);
}
}
__device__ __forceinline__ void pf4_router(Frame& F, const Args& a, const bool dry = false) {
#ifdef X1_BF16
    const bf16_t* x1 = WSP(bf16_t, WS_Y);
#else
    const float* x1 = a.out;
#endif
    const float* mod = WSP(float, WS_MOD); const float* rowss = WSP(float, WS_ROWSS);
    const float* b_group = (const float*)a.in[22]; const float* b_router = (const float*)a.in[24];
    const bf16_t* rhi = (const bf16_t*)(F.ws + WS_SMALL + 65536); const bf16_t* rlo = (const bf16_t*)(F.ws + WS_SMALL + 196608);
    unsigned char* h2 = WSP(unsigned char, WS_H);
    int* pick_e = (int*)(F.ws + WS_PICK); int* pick_pos = (int*)(F.ws + WS_PICK + 524288); float* pick_w = (float*)(F.ws + WS_PICK + 1048576); int* list = WSP(int, WS_LIST);
    LAS unsigned char* wch = F.lds; LAS float* mv = (LAS float*)(F.lds + 67584);
    LAS float* lg = (LAS float*)(F.lds + 75776) + F.wave * (32 * 40);
    LAS int* lc = (LAS int*)(F.lds + 116736); LAS int* gb = lc + 32;
    const int r32 = F_LANE() & 31, hi = F_LANE() >> 5;
    const int NGW = F.G * 8, ntask = NT_TOK / 32, iters = (ntask + NGW - 1) / NGW;
    for (int it = 0; it < iters; ++it) {
        const int task = it * NGW + F.vcu * 8 + F.wave; const bool valid = task < ntask;
        if (F_TID() < 32) lc[F_TID()] = 0;
        __syncthreads();
        int e1 = 0, e2 = 0, p1 = 0, p2 = 0; float w1 = 0.f, w2 = 0.f; int row = 0;
        f32x16 acc0 = {}, acc1 = {};
        {
            row = (valid ? task : 0) * 32 + r32; const int b = row >> 11;
            float ss = 0.f; { const f32x4* rp = (const f32x4*)(rowss + (size_t)row * 16); const f32x4 s0 = rp[0], s1 = rp[1], s2 = rp[2], s3 = rp[3];
                ss = ((s0[0] + s0[1]) + (s0[2] + s0[3])) + ((s1[0] + s1[1]) + (s1[2] + s1[3])) + ((s2[0] + s2[1]) + (s2[2] + s2[3])) + ((s3[0] + s3[1]) + (s3[2] + s3[3])); }
            const float rstd = __builtin_amdgcn_rsqf(ss * (1.f / DM) + EPS);
            unsigned char* hp = h2 + (size_t)row * DM + 8 * hi;
#ifdef X1_BF16
            const bf16_t* xr = x1 + (size_t)row * DM + 8 * hi;
            constexpr int XD = 8;
            u32x4 xq[XD];
#pragma unroll
            for (int j = 0; j < XD; ++j) xq[j] = *(const u32x4*)(xr + 16 * j);
#else
            const float* xr = x1 + (size_t)row * DM + 8 * hi;
            constexpr int XD = 4;
            f32x4 xq[XD][2];
#pragma unroll
            for (int j = 0; j < XD; ++j) { xq[j][0] = *(const f32x4*)(xr + 16 * j); xq[j][1] = *(const f32x4*)(xr + 16 * j + 4); }
#endif
            { const int t_ = F_TID(); const float* a2 = WSP(float, WS_SMALL + 524288) + (size_t)b * 1024; const float* s2 = mod + (size_t)b * 6144 + 3072;
              for (int i = t_; i < 2048; i += 512) mv[i] = (i < 1024) ? a2[i] : s2[i - 1024]; }
            const LAS unsigned char* wrd = wch + r32 * 528 + 16 * hi; const LAS float* mrd = mv + 8 * hi;
#pragma unroll 1
            for (int c = 0; c < 4; ++c) {
                __syncthreads();
                { const int t_ = F_TID();
#pragma unroll
                  for (int p = 0; p < 8; ++p) { const int piece = t_ + 512 * p, mat = piece >> 11, q = piece & 2047, col = q >> 5, kk = (q & 31) * 8;
                      const u32x4 v = *(const u32x4*)((mat ? rlo : rhi) + (size_t)col * 1024 + 256 * c + kk);
                      *(LAS u32x4*)(wch + mat * 33792 + col * 528 + kk * 2) = v; } }
                __syncthreads();
                if (valid) {
#pragma unroll 1
                for (int s4 = 0; s4 < 16; s4 += XD) {
#pragma unroll
                    for (int j = 0; j < XD; ++j) {
                        const int sl = s4 + j, s = 16 * c + sl;
#ifdef X1_BF16
                        const u32x4 xw = xq[j]; const f32x4 xa = {bflo(xw.x), bfhi(xw.x), bflo(xw.y), bfhi(xw.y)}, xb = {bflo(xw.z), bfhi(xw.z), bflo(xw.w), bfhi(xw.w)};
                        if (s + XD < 64) xq[j] = *(const u32x4*)(xr + 16 * (s + XD));
#else
                        const f32x4 xa = xq[j][0], xb = xq[j][1];
                        if (s + XD < 64) { xq[j][0] = *(const f32x4*)(xr + 16 * (s + XD)); xq[j][1] = *(const f32x4*)(xr + 16 * (s + XD) + 4); }
#endif
                        const f32x4 ca0 = *(const LAS f32x4*)(mrd + 16 * s), ca1 = *(const LAS f32x4*)(mrd + 16 * s + 4), ch0 = *(const LAS f32x4*)(mrd + 1024 + 16 * s), ch1 = *(const LAS f32x4*)(mrd + 1024 + 16 * s + 4);
                        const bf16x8 Ah0 = *(const LAS bf16x8*)(wrd + 32 * sl), Al0 = *(const LAS bf16x8*)(wrd + 33792 + 32 * sl);
                        const bf16x8 Ah1 = *(const LAS bf16x8*)(wrd + 32 * 528 + 32 * sl), Al1 = *(const LAS bf16x8*)(wrd + 33792 + 32 * 528 + 32 * sl);
                        const f32x4 va = (xa * rstd) * ca0 + ch0, vb = (xb * rstd) * ca1 + ch1;
                        { u32x2 w8; w8.x = pk4_fp8(va[0], va[1], va[2], va[3]); w8.y = pk4_fp8(vb[0], vb[1], vb[2], vb[3]); *(u32x2*)(hp + 16 * s) = w8; }
                        u32x4 whi; whi.x = cvtpk(va[0], va[1]); whi.y = cvtpk(va[2], va[3]); whi.z = cvtpk(vb[0], vb[1]); whi.w = cvtpk(vb[2], vb[3]);
                        u32x4 wlo; wlo.x = cvtpk(va[0] - bflo(whi.x), va[1] - bfhi(whi.x)); wlo.y = cvtpk(va[2] - bflo(whi.y), va[3] - bfhi(whi.y));
                        wlo.z = cvtpk(vb[0] - bflo(whi.z), vb[1] - bfhi(whi.z)); wlo.w = cvtpk(vb[2] - bflo(whi.w), vb[3] - bfhi(whi.w));
                        const bf16x8 Bh = __builtin_bit_cast(bf16x8, whi), Bl = __builtin_bit_cast(bf16x8, wlo);
                        acc0 = __builtin_amdgcn_mfma_f32_32x32x16_bf16(Ah0, Bh, acc0, 0, 0, 0); acc0 = __builtin_amdgcn_mfma_f32_32x32x16_bf16(Ah0, Bl, acc0, 0, 0, 0); acc0 = __builtin_amdgcn_mfma_f32_32x32x16_bf16(Al0, Bh, acc0, 0, 0, 0);
                        acc1 = __builtin_amdgcn_mfma_f32_32x32x16_bf16(Ah1, Bh, acc1, 0, 0, 0); acc1 = __builtin_amdgcn_mfma_f32_32x32x16_bf16(Ah1, Bl, acc1, 0, 0, 0); acc1 = __builtin_amdgcn_mfma_f32_32x32x16_bf16(Al1, Bh, acc1, 0, 0, 0);
                    }
                }
                }
            }
        }
        if (valid) {
            LAS float* lr = lg + r32 * 40;
#pragma unroll
            for (int gq = 0; gq < 4; ++gq) *(LAS f32x4*)(lr + 8 * gq + 4 * hi) = (f32x4){acc0[4 * gq], acc0[4 * gq + 1], acc0[4 * gq + 2], acc0[4 * gq + 3]};
            if (hi == 0) *(LAS f32x4*)(lr + 32) = (f32x4){acc1[0], acc1[1], acc1[2], acc1[3]};
            asm volatile("s_waitcnt lgkmcnt(0)" ::: "memory");
            if (hi == 0) {
                float gl[4];
#pragma unroll
                for (int i = 0; i < 4; ++i) gl[i] = lr[i] + b_group[i];
                int gi = 0; float gm = gl[0];
#pragma unroll
                for (int i = 1; i < 4; ++i) if (gl[i] > gm) { gm = gl[i]; gi = i; }
                float gsum = 0.f;
#pragma unroll
                for (int i = 0; i < 4; ++i) gsum += __expf(gl[i] - gm);
                const float gw = 1.0f / gsum;
                float el[8];
#pragma unroll
                for (int i = 0; i < 8; ++i) el[i] = lr[4 + 8 * gi + i] + b_router[gi * 8 + i];
                int i1 = 0; float v1 = el[0];
#pragma unroll
                for (int i = 1; i < 8; ++i) if (el[i] > v1) { v1 = el[i]; i1 = i; }
                int i2 = -1; float v2 = -INFINITY;
#pragma unroll
                for (int i = 0; i < 8; ++i) if (i != i1 && el[i] > v2) { v2 = el[i]; i2 = i; }
                const float pa = 1.0f / (1.0f + __expf(v2 - v1));
                w1 = gw * pa; w2 = gw * (1.0f - pa); e1 = gi * 8 + i1; e2 = gi * 8 + i2;
                p1 = __hip_atomic_fetch_add((int*)(lc + e1), 1, __ATOMIC_RELAXED, __HIP_MEMORY_SCOPE_WORKGROUP);
                p2 = __hip_atomic_fetch_add((int*)(lc + e2), 1, __ATOMIC_RELAXED, __HIP_MEMORY_SCOPE_WORKGROUP);
            }
        }
        __syncthreads();
        if (!dry && F_TID() < 32) { const int c = lc[F_TID()]; gb[F_TID()] = c ? (int)__hip_atomic_fetch_add(F.ctl + CW_CNT + 64 * F_TID(), (unsigned)c, RLX_AGENT) : 0; }
        __syncthreads();
        if (!dry && valid && hi == 0) {
            p1 += gb[e1]; p2 += gb[e2];
            pick_e[row * 2] = e1; pick_e[row * 2 + 1] = e2; pick_pos[row * 2] = p1; pick_pos[row * 2 + 1] = p2; pick_w[row * 2] = w1; pick_w[row * 2 + 1] = w2;
            list[(size_t)e1 * NT_TOK + p1] = row; list[(size_t)e2 * NT_TOK + p2] = row;
        }
        __syncthreads();
    }
}

__device__ __forceinline__ void moe_tables(Frame& F) {
    LAS int* cnt = (LAS int*)(F.lds + LDS_EXP); LAS int* pre = cnt + 32;
    if (F_TID() < 32) cnt[F_TID()] = (int)__hip_atomic_load(F.ctl + CW_CNT + 64 * F_TID(), RLX_AGENT);
    __syncthreads();
    if (F_TID() == 0) { int s = 0; for (int e = 0; e < 32; ++e) { pre[e] = s; s += (cnt[e] + 255) >> 8; } pre[32] = s; }
    __syncthreads();
}
namespace pg8 {
struct MoeSched {
    const char* A; const char* Bt; int lda, ldb; size_t bstride; bool gather; LAS unsigned char* lds; int G, c;
    __device__ __forceinline__ bool next(int i, Unit& u) const {
        const LAS int* pre = (const LAS int*)(lds + LDS_EXP) + 32;
        const int L = i * G + c; if (L >= 4 * pre[32]) return false;
        const int mtg = L >> 2;
        const int pk = pre[lane_now() & 31];
        const int e = __builtin_popcount((unsigned)__ballot(pk <= mtg)) - 1;
        u.pm = mtg; u.pn = L & 3; u.e = e; u.mt = mtg - pre[e]; return true;
    }
    __device__ __forceinline__ const char* a_base(const Unit& u) const { return gather ? A : A + (size_t)u.pm * BM * lda * 2; }
    __device__ __forceinline__ unsigned a_voff(const Unit&, int ui, int h, int R, int C) const {
        if (gather) { const int tok = ((const LAS int*)(lds + LDS_TOK))[ui * 256 + h * HALF + R]; return (unsigned)(tok * lda + C) * 2u; }
        return (unsigned)((h * HALF + R) * lda + C) * 2u; }
    __device__ __forceinline__ const char* b_base(const Unit& u) const { return Bt + (size_t)u.e * bstride + (size_t)u.pn * BM * ldb * 2; }
    __device__ __forceinline__ int dephase_id() const { return c; }
};
struct GuEpi {
    static constexpr bool PERM = true, noepi = false; static constexpr int MIDK = 0, DEPHASE = 1, DEPHASE_TICKS = 0, NSTORE = 8;
    unsigned char* hid;
    __device__ __forceinline__ void operator()(const f32x4 (&acc)[2][2][4][2], const Unit& u, int, int wr, int wc, int fr, int fq) const {
        const int row0 = u.pm * BM + wr * 64 + fr, col = u.pn * HALF + wc * 32 + 8 * fq;
#pragma unroll
        for (int ai = 0; ai < 2; ++ai)
#pragma unroll
            for (int m = 0; m < 4; ++m) {
                f32x4 v0, v1;
#pragma unroll
                for (int i = 0; i < 4; ++i) { v0[i] = clamp448(siluf_(acc[ai][0][m][0][i] * 0.015625f) * acc[ai][1][m][0][i] * 0.125f); v1[i] = clamp448(siluf_(acc[ai][0][m][1][i] * 0.015625f) * acc[ai][1][m][1][i] * 0.125f); }
                u32x2 w; w.x = pk4_fp8(v0[0], v0[1], v0[2], v0[3]); w.y = pk4_fp8(v1[0], v1[1], v1[2], v1[3]);
                *(u32x2*)(hid + (size_t)(row0 + ai * HALF + m * 16) * EFF + col) = w;
            }
    }
};
struct YEpi {
    static constexpr bool PERM = true, noepi = false; static constexpr int MIDK = 0, DEPHASE = 1, DEPHASE_TICKS = 0;
#ifdef PROBE_NOSTORE
    static constexpr int NSTORE = 0;
#else
    static constexpr int NSTORE = 16;
#endif
    unsigned char* Y; float osc; bool nostore;
    __device__ __forceinline__ void operator()(const f32x4 (&acc)[2][2][4][2], const Unit& u, int, int wr, int wc, int fr, int fq) const {
        const int row0 = u.pm * BM + wr * 64 + fr, col0 = u.pn * BM + wc * 32 + 8 * fq;
#pragma unroll
        for (int ai = 0; ai < 2; ++ai)
#pragma unroll
            for (int m = 0; m < 4; ++m)
#pragma unroll
                for (int bj = 0; bj < 2; ++bj) { const f32x4 v0 = acc[ai][bj][m][0] * osc, v1 = acc[ai][bj][m][1] * osc;
                    u32x2 w; w.x = pk4_fp8(clamp448(v0[0]), clamp448(v0[1]), clamp448(v0[2]), clamp448(v0[3])); w.y = pk4_fp8(clamp448(v1[0]), clamp448(v1[1]), clamp448(v1[2]), clamp448(v1[3]));
                    if (!nostore) *(u32x2*)(Y + (size_t)(row0 + ai * HALF + m * 16) * DM + col0 + bj * HALF) = w; else asm volatile("" :: "v"(w)); }
    }
};
}

__device__ __forceinline__ void moe_fill_tokens(Frame& F, const pg8::MoeSched& S) {
    const LAS int* cnt = (const LAS int*)(F.lds + LDS_EXP); LAS int* tokt = (LAS int*)(F.lds + LDS_TOK); const int* list = WSP(int, WS_LIST);
    if (F.wave < 4) {
        int tv[12]; const int tid = F_TID();
#pragma unroll
        for (int i = 0; i < 12; ++i) { pg8::Unit u; tv[i] = 0;
            if (S.next(i, u)) { const int idx = u.mt * 256 + tid; tv[i] = list[(size_t)u.e * NT_TOK + (idx < cnt[u.e] ? idx : 0)]; } }
#pragma unroll
        for (int i = 0; i < 12; ++i) tokt[i * 256 + tid] = tv[i]; }
    __syncthreads();
}

__device__ __forceinline__ void pi_combine(Frame& F, const Args& a, const float wsc = 1.0f) {
    const LAS int* pre = (const LAS int*)(F.lds + LDS_EXP) + 32;
    const int* pick_e = (const int*)(F.ws + WS_PICK); const int* pick_pos = (const int*)(F.ws + WS_PICK + 524288); const float* pick_w = (const float*)(F.ws + WS_PICK + 1048576);
    const unsigned char* Y = WSP(unsigned char, WS_R1); const float* mod = WSP(float, WS_MOD); float* out = a.out;
    const int gw = F.vcu * 8 + F.wave, NGW = F.G * 8, ln = F_LANE();
    struct Pk { int e0, e1, p0, p1; float w0, w1; };
#ifdef X1_BF16
    const bf16_t* x1b = WSP(bf16_t, WS_Y);
    struct Dat { unsigned a0[4], a1[4]; u32x2 x[4]; float w0, w1; };
#else
    struct Dat { unsigned a0[4], a1[4]; f32x4 x[4]; float w0, w1; };
#endif
    auto ldpk = [&](int r) { Pk k; k.e0 = pick_e[2 * r]; k.e1 = pick_e[2 * r + 1]; k.p0 = pick_pos[2 * r]; k.p1 = pick_pos[2 * r + 1]; k.w0 = pick_w[2 * r]; k.w1 = pick_w[2 * r + 1]; return k; };
    auto lddat = [&](int r, const Pk& k) { Dat d; d.w0 = k.w0 * wsc * 0.0625f; d.w1 = k.w1 * wsc * 0.0625f;
        const size_t s0 = (size_t)pre[k.e0] * 256 + k.p0, s1 = (size_t)pre[k.e1] * 256 + k.p1;
        const unsigned* y0 = (const unsigned*)(Y + s0 * DM) + ln; const unsigned* y1 = (const unsigned*)(Y + s1 * DM) + ln;
#ifdef X1_BF16
        const u32x2* xr = (const u32x2*)(x1b + (size_t)r * DM) + ln;
#else
        const f32x4* xr = (const f32x4*)(out + (size_t)r * DM) + ln;
#endif
#pragma unroll
        for (int j = 0; j < 4; ++j) { d.a0[j] = y0[64 * j]; d.a1[j] = y1[64 * j]; d.x[j] = xr[64 * j]; }
        return d; };
    f32x4 gtv[4];
    auto fin = [&](int r, const Dat& d) { f32x4* xw = (f32x4*)(out + (size_t)r * DM) + ln;
#pragma unroll
        for (int j = 0; j < 4; ++j) { const f32x4 g = gtv[j];
#ifdef X1_BF16
            f32x4 x = {bflo(d.x[j].x), bfhi(d.x[j].x), bflo(d.x[j].y), bfhi(d.x[j].y)};
#else
            f32x4 x = d.x[j];
#endif
            const f32x2 p0 = __builtin_amdgcn_cvt_pk_f32_fp8(d.a0[j], false), p1 = __builtin_amdgcn_cvt_pk_f32_fp8(d.a0[j], true), q0 = __builtin_amdgcn_cvt_pk_f32_fp8(d.a1[j], false), q1 = __builtin_amdgcn_cvt_pk_f32_fp8(d.a1[j], true);
            x[0] += g[0] * (d.w0 * p0[0] + d.w1 * q0[0]); x[1] += g[1] * (d.w0 * p0[1] + d.w1 * q0[1]);
            x[2] += g[2] * (d.w0 * p1[0] + d.w1 * q1[0]); x[3] += g[3] * (d.w0 * p1[1] + d.w1 * q1[1]); xw[64 * j] = x; } };
#pragma unroll 1
    for (int blk = gw; blk < NT_TOK / 32; blk += NGW) {
        const int m0 = blk * 32, b = m0 >> 11, m1 = m0 + 32;
        { const f32x4* gt = (const f32x4*)(mod + (size_t)b * 6144 + 5120) + ln;
#pragma unroll
          for (int j = 0; j < 4; ++j) gtv[j] = gt[64 * j]; }
        int r0 = m0;
        Pk k1 = ldpk(r0); Dat d0 = lddat(r0, k1);
        Pk k2 = ldpk(r0 + 1);
#pragma unroll 1
        for (; r0 < m1; ++r0) {
            const int r1 = r0 + 1, r2 = r0 + 2;
            Dat d1 = d0; if (r1 < m1) d1 = lddat(r1, k2);
            if (r2 < m1) k2 = ldpk(r2);
            fin(r0, d0);
            d0 = d1;
        }
    }
}
#ifndef MK_MODE
#define MK_MODE 2
#endif
constexpr int NPHASE = 12;
#ifndef REP_MASK
#define REP_MASK 0
#endif
#define REPS(k) (((REP_MASK >> (k)) & 1) ? 2 : 1)

__device__ __forceinline__ void pd_compress_stage2(Frame& F, const Args& a, int pm) {
    const int r32 = F_LANE() & 31, hi = F_LANE() >> 5, kv = pm >= 32 ? 1 : 0;
    const bf16_t* w2t = WSP(bf16_t, WS_CW2) + (size_t)kv * 64 * 256;
    const int rowg = 256 * pm + 32 * F.wave + r32;
    const bf16_t* hp = WSP(bf16_t, WS_CHID) + (size_t)rowg * 256 + 8 * hi;
    f32x16 acc0 = {}, acc1 = {};
#pragma unroll 4
    for (int s = 0; s < 16; ++s) {
        const bf16x8 B = *(const bf16x8*)(hp + 16 * s);
        const bf16x8 A0 = *(const bf16x8*)(w2t + (size_t)r32 * 256 + 16 * s + 8 * hi), A1 = *(const bf16x8*)(w2t + (size_t)(32 + r32) * 256 + 16 * s + 8 * hi);
        acc0 = __builtin_amdgcn_mfma_f32_32x32x16_bf16(A0, B, acc0, 0, 0, 0); acc1 = __builtin_amdgcn_mfma_f32_32x32x16_bf16(A1, B, acc1, 0, 0, 0);
    }
    const int mrow = rowg & 8191;
    bf16_t* dst = (bf16_t*)(F.ws + WS_KC + (kv ? MiB : 0)) + (size_t)mrow * 64;
    if (kv == 0) {
        float ss = 0.f;
#pragma unroll
        for (int r = 0; r < 16; ++r) ss += acc0[r] * acc0[r] + acc1[r] * acc1[r];
        ss = att::halfsum(ss);
        const float rstd = __builtin_amdgcn_rsqf(ss * (1.f / 64.f) + EPS);
        const float* nk = (const float*)a.in[9];
        const int b = (mrow >> 7) & 31, n = mrow & 127;
        const float* cc = WSP(float, WS_CROPE) + ((size_t)b * 128 + n) * 32; const float* sn = cc + 32 * 128 * 32;
#pragma unroll
        for (int gq = 0; gq < 4; ++gq) { const int d = 8 * gq + 4 * hi;
            const f32x4 g1 = *(const f32x4*)(nk + d), g2 = *(const f32x4*)(nk + 32 + d), c4 = *(const f32x4*)(cc + d), s4 = *(const f32x4*)(sn + d);
            f32x4 x1, x2;
#pragma unroll
            for (int i = 0; i < 4; ++i) { x1[i] = acc0[4 * gq + i] * rstd * g1[i]; x2[i] = acc1[4 * gq + i] * rstd * g2[i]; }
            const f32x4 o1 = x1 * c4 - x2 * s4, o2 = x1 * s4 + x2 * c4;
            u32x2 w1, w2; w1.x = cvtpk(o1[0], o1[1]); w1.y = cvtpk(o1[2], o1[3]); w2.x = cvtpk(o2[0], o2[1]); w2.y = cvtpk(o2[2], o2[3]);
            *(u32x2*)(dst + d) = w1; *(u32x2*)(dst + 32 + d) = w2; }
    } else {
#pragma unroll
        for (int gq = 0; gq < 4; ++gq) { const int d = 8 * gq + 4 * hi;
            u32x2 w1, w2; w1.x = cvtpk(acc0[4 * gq], acc0[4 * gq + 1]); w1.y = cvtpk(acc0[4 * gq + 2], acc0[4 * gq + 3]); w2.x = cvtpk(acc1[4 * gq], acc1[4 * gq + 1]); w2.y = cvtpk(acc1[4 * gq + 2], acc1[4 * gq + 3]);
            *(u32x2*)(dst + d) = w1; *(u32x2*)(dst + 32 + d) = w2; }
    }
}

__device__ __forceinline__ void pf1_scale_ob(Frame& F) {
    const float* lse = WSP(float, WS_LSE); const u32x2* src = (const u32x2*)(F.ws + WS_H + 64 * MiB); unsigned* dst = (unsigned*)(F.ws + WS_Y);
    const int gw = F.vcu * 8 + F.wave, NGW = F.G * 8, l = F_LANE();
    const int li = l & 31, half = l >> 5, j = li >> 4;
    for (int m0 = gw * 8; m0 < NT_TOK; m0 += NGW * 8) {
        float lv[4][3]; u32x2 wv[4][3];
#pragma unroll
        for (int q = 0; q < 4; ++q) { const size_t m = (size_t)(m0 + 2 * q + half);
#pragma unroll
            for (int gi = 0; gi < 3; ++gi) { lv[q][gi] = lse[m * 8 + 2 * gi + j]; wv[q][gi] = src[m * 96 + gi * 32 + li]; } }
        __builtin_amdgcn_sched_barrier(0);
#pragma unroll
        for (int q = 0; q < 4; ++q) { const size_t m = (size_t)(m0 + 2 * q + half);
            const float l0 = lv[q][0], l1 = lv[q][1], l2 = lv[q][2];
            const float mx = fmaxf(l0, fmaxf(l1, l2)); const float e0 = __expf(l0 - mx), e1 = __expf(l1 - mx), e2 = __expf(l2 - mx); const float inv = 16.0f * __builtin_amdgcn_rcpf(e0 + e1 + e2);
            const float al[3] = {(PROBE_ZERO & 8) ? 0.f : e0 * inv, (PROBE_ZERO & 8) ? 0.f : e1 * inv, (PROBE_ZERO & 8) ? 0.f : e2 * inv};
#pragma unroll
            for (int gi = 0; gi < 3; ++gi) { const u32x2 w = wv[q][gi]; dst[m * 256 + 128 + gi * 32 + li] = pk4_fp8(bflo(w.x) * al[gi], bfhi(w.x) * al[gi], bflo(w.y) * al[gi], bfhi(w.y) * al[gi]); }
            dst[m * 256 + 224 + li] = 0u; }
    }
}

__global__ void __launch_bounds__(512, 2) mk_fwd(Args args) {
    extern __shared__ __attribute__((aligned(16))) unsigned char lds_raw[];
    Frame F;
    F.lds = (LAS unsigned char*)lds_raw;
    F.MISC = (volatile LAS unsigned*)(F.lds + LDS_MISC);
    F.wave = __builtin_amdgcn_readfirstlane(threadIdx.x >> 6);
    F.G = gridDim.x; { const int bx = blockIdx.x; F.vcu = (F.G % 8 == 0) ? (bx % 8) * (F.G / 8) + bx / 8 : bx; }
    F.ws = args.ws; F.ctl = (unsigned*)(args.ws + WS_CTL);
    if (F_TID() < 64) ((LAS unsigned*)(F.lds + LDS_MISC))[F_TID()] = 0u;
    __syncthreads();
#if MK_MODE == 1
    cg::grid_group grid = cg::this_grid();
#define GRID_BAR() grid.sync()
#elif MK_MODE == 2
    XcdBarrier bar = xcd_barrier_post(F.ctl + CW_BAR, F.MISC + 8, F.wave);
#define GRID_BAR() xcd_barrier(bar)
#else
#define GRID_BAR() do {} while (0)
#endif
    int lo = args.ph_lo, hi = args.ph_hi; if (hi == 100 || hi == 102) { lo = 2; hi = 3; } if (hi == 101) { lo = 10; hi = 11; }
#ifndef PH_MASK
#define PH_MASK 0xfff
#endif
#define IN(k) (((PH_MASK >> (k)) & 1) && lo <= (k) && (k) < hi)
#ifdef PROBE_DBLBAR
#define SEAM(k) do { if (IN(k) && ((k) + 1 < hi)) { GRID_BAR(); GRID_BAR(); } } while (0)
#else
#define SEAM(k) do { if (IN(k) && ((k) + 1 < hi)) GRID_BAR(); } while (0)
#endif


    if (IN(0)) { pa_prologue(F, args); } SEAM(0);
    if (IN(1)) { pb_modnorm(F, (const float*)args.in[0], (const float*)args.in[5], WSP(float, WS_MOD), 0, 1024, WSP(bf16_t, WS_H), (const float*)args.in[6]); } SEAM(1);
    if (IN(2)) {
#ifdef PC_FP8
        pg8::DenseSched S; S.init(WSP(bf16_t, WS_H), 512, WSP(bf16_t, WS_WIN), 512, NT_TOK, NPROJ, F.G, (int)blockIdx.x);
#ifdef PROBE_HOT
        S.hot = args.ph_hi == 100;
#endif
#else
        pg8::DenseSched S; S.init(WSP(bf16_t, WS_H), 1024, WSP(bf16_t, WS_WIN), 1024, NT_TOK, NPROJ, F.G, (int)blockIdx.x);
#endif
        pg8::ProjEpi E{F.ws, (const int*)args.in[2], WSP(float, WS_ROPE), WSP(float, WS_ROPE) + (size_t)NT_TOK * 32, (const float*)args.in[8], (const float*)args.in[9], (const float*)args.in[16], (const float*)args.in[17], args.ph_hi == 100, args.ph_hi == 102};
#ifdef PC_FP8
        pg8::gemm_phase<pg8::ProjEpi, pg8::DenseSched, true, true>(F.lds, F.wave, 512, S, E);
#else
        pg8::gemm_phase<pg8::ProjEpi, pg8::DenseSched>(F.lds, F.wave, 1024, S, E);
#endif
    } SEAM(2);
    if (IN(3)) {
        const int ncw = F.G >= 128 ? 64 : (F.G > 1 ? F.G / 2 : 1);
        if ((int)blockIdx.x < ncw) {
            pg8::CmpSched S{(const char*)(F.ws + slot_off(SL_KCMP)), (const char*)(F.ws + WS_CW1), 2048, ncw, (int)blockIdx.x};
            pg8::CmpEpi E{WSP(float, WS_SMALL), WSP(bf16_t, WS_CHID)};
            pg8::gemm_phase<pg8::CmpEpi, pg8::CmpSched>(F.lds, F.wave, 2048, S, E);
            VM_WAIT(); __syncthreads();
            pg8::Unit u; for (int i = 0; S.next(i, u); ++i) pd_compress_stage2(F, args, u.pm);
        }
        if ((int)blockIdx.x >= ncw || F.G == 1) {
            att::Ctx C; C.lds = F.lds; C.lane = 0; C.r32 = 0; C.hi = 0; C.wid = F.wave; C.lds0 = (unsigned)(size_t)F.lds;
            const int nd = F.G == 1 ? 1 : F.G - ncw, c = F.G == 1 ? 0 : (int)blockIdx.x - ncw;
            for (int u = c; u < 1536; u += nd) att::dil_unit(C, F.ws, u, (bf16_t*)(F.ws + WS_H + 64 * MiB), WSP(float, WS_LSE));
        }
    } SEAM(3);
    if (IN(4)) {
        att::Ctx C; C.lds = F.lds; C.lane = 0; C.r32 = 0; C.hi = 0; C.wid = F.wave; C.lds0 = (unsigned)(size_t)F.lds;
        for (int v = F.vcu; v < 256; v += F.G) {
            const int bh = v >> 2, k = v & 3, b = bh >> 1, hk = bh & 1;
            for (int i = 0; i < 8; ++i) { const int blk = (i & 1) ? (8 * (i >> 1) + 7 - k) : (8 * (i >> 1) + k); att::nsa_unit(C, F.ws, b, hk, 31 - blk, F.ws + WS_Y); }
        }
        pf1_scale_ob(F);
    } SEAM(4);
    if (IN(5)) {
        pg8::DenseSched S; S.init(F.ws + WS_Y, 512, F.ws + WS_WUPA, 512, NT_TOK, DM, F.G, (int)blockIdx.x);
        pg8::Up2Epi E{F.ws, F.ws + WS_R1 + 64 * MiB};
        pg8::gemm_phase<pg8::Up2Epi, pg8::DenseSched, true, true>(F.lds, F.wave, 512, S, E);
    } SEAM(5);
    if (IN(7)) {
#ifdef PF3_FP8
        pg8::DenseSched S; S.init(F.ws + WS_R1 + 64 * MiB, 512, WSP(bf16_t, WS_WOUT), 512, NT_TOK, DM, F.G, (int)blockIdx.x);
#ifdef X1_BF16
        pg8::OutEpi E{(const float*)args.in[0], WSP(float, WS_Y), WSP(float, WS_MOD), WSP(float, WS_ROWSS), 1.0f / (16.f * 64.f)};
#else
        pg8::OutEpi E{(const float*)args.in[0], args.out, WSP(float, WS_MOD), WSP(float, WS_ROWSS), 1.0f / (16.f * 64.f)};
#endif
        pg8::gemm_phase<pg8::OutEpi, pg8::DenseSched, true, true>(F.lds, F.wave, 512, S, E);
#else
        pg8::DenseSched S; S.init(WSP(bf16_t, WS_Y), 1024, WSP(bf16_t, WS_WOUT), 1024, NT_TOK, DM, F.G, (int)blockIdx.x);
        pg8::OutEpi E{(const float*)args.in[0], args.out, WSP(float, WS_MOD), WSP(float, WS_ROWSS), 1.0f};
        pg8::gemm_phase<pg8::OutEpi, pg8::DenseSched>(F.lds, F.wave, 1024, S, E);
#endif
    } SEAM(7);
    if (IN(8)) { pf4_router(F, args);
#if defined(PROBE_DRY) && PROBE_DRY == 8
        GRID_BAR(); pf4_router(F, args, true);
#endif
    } SEAM(8);
    if (IN(9)) {
        moe_tables(F);
        pg8::MoeSched S{(const char*)(F.ws + WS_H), (const char*)(F.ws + WS_WGU), 512, 512, (size_t)1024 * 1024, true, F.lds, F.G, F.vcu};
        moe_fill_tokens(F, S);
        pg8::GuEpi E{WSP(unsigned char, WS_R2)};
        pg8::gemm_phase<pg8::GuEpi, pg8::MoeSched, true, true>(F.lds, F.wave, 512, S, E);
    } SEAM(9);
    if (IN(10)) {
        moe_tables(F);
        pg8::MoeSched S{(const char*)(F.ws + WS_R2), (const char*)(F.ws + WS_WD), 256, 256, (size_t)1024 * 512, false, F.lds, F.G, F.vcu};
        pg8::YEpi E{F.ws + WS_R1, 16.0f / (8.0f * 64.0f), args.ph_hi == 101};
#ifndef PH_ALIGN
#define PH_ALIGN true
#endif
        pg8::gemm_phase<pg8::YEpi, pg8::MoeSched, PH_ALIGN, true>(F.lds, F.wave, 256, S, E);
    } SEAM(10);
    if (IN(11)) { moe_tables(F); pi_combine(F, args);
#if defined(PROBE_DRY) && PROBE_DRY == 11
        GRID_BAR(); pi_combine(F, args, 0.0f);
#endif
    }
#undef IN
#undef SEAM
}

#ifdef PROBE_MFMA
__global__ void __launch_bounds__(512, 2) probe_mfma(float* sink, int iters) {
    typedef int v8i __attribute__((ext_vector_type(8)));
    const unsigned lane = threadIdx.x;
    v8i a[4], b[4];
    for (int i = 0; i < 4; ++i) for (int j = 0; j < 8; ++j) { unsigned h = lane * 2654435761u + i * 40503u + j * 9973u; h ^= h >> 13; h *= 0x5bd1e995u; h ^= h >> 15; a[i][j] = (int)(h & 0xbfbfbfbfu); h *= 0x9e3779b1u; h ^= h >> 11; b[i][j] = (int)(h & 0xbfbfbfbfu); }
    f32x4 acc[16];
    for (int i = 0; i < 16; ++i) acc[i] = (f32x4){0.f, 0.f, 0.f, 0.f};
#pragma unroll 1
    for (int it = 0; it < iters; ++it) {
#if PROBE_MFMA == 1
#pragma unroll
        for (int i = 0; i < 16; ++i) asm volatile("v_mfma_f32_16x16x128_f8f6f4 %0, %1, %2, %0" : "+v"(acc[i]) : "v"(a[i & 3]), "v"(b[i >> 2]));
#else
#pragma unroll
        for (int i = 0; i < 16; ++i) { bf16x8 x0, x1, y0, y1;
            for (int j = 0; j < 4; ++j) { ((int*)&x0)[j] = a[i & 3][j] & 0x3fff3fff; ((int*)&x1)[j] = a[i & 3][4 + j] & 0x3fff3fff; ((int*)&y0)[j] = b[i >> 2][j] & 0x3fff3fff; ((int*)&y1)[j] = b[i >> 2][4 + j] & 0x3fff3fff; }
            asm volatile("v_mfma_f32_16x16x32_bf16 %0, %1, %2, %0\n\tv_mfma_f32_16x16x32_bf16 %0, %3, %4, %0" : "+v"(acc[i]) : "v"(x0), "v"(y0), "v"(x1), "v"(y1)); }
#endif
    }
    asm volatile("s_nop 15\n\ts_nop 15" ::: "memory");
    float sum = 0.f; for (int i = 0; i < 16; ++i) sum += acc[i][0] + acc[i][1] + acc[i][2] + acc[i][3];
    if (sum == 12345.678f) sink[0] = sum;
}
#endif
extern "C" void kernel_launch(void* const* d_in, const int* in_sizes, int n_in, void* d_out, int out_size, void* d_ws, size_t ws_size, hipStream_t stream) {
    static int grid = 0;
    if (grid == 0) {
        if (n_in != 28 || in_sizes[0] != NT_TOK * DM || out_size != NT_TOK * DM || ws_size < WS_END) {
            fprintf(stderr, "kernel_launch: shape/workspace mismatch (n_in %d, in0 %d, out %d, ws %zu, need %zu)\n", n_in, n_in > 0 ? in_sizes[0] : -1, out_size, ws_size, (size_t)WS_END); grid = -1; return; }
        int dev = 0, cus = 0, per_cu = 0;
        hipGetDevice(&dev); hipDeviceGetAttribute(&cus, hipDeviceAttributeMultiprocessorCount, dev);
        if (hipFuncSetAttribute((const void*)mk_fwd, hipFuncAttributeMaxDynamicSharedMemorySize, LDS_BYTES) != hipSuccess) { fprintf(stderr, "kernel_launch: hipFuncSetAttribute failed\n"); grid = -1; return; }
        if (hipOccupancyMaxActiveBlocksPerMultiprocessor(&per_cu, (const void*)mk_fwd, 512, LDS_BYTES) != hipSuccess || per_cu < 1) { fprintf(stderr, "kernel_launch: occupancy query says %d blocks per CU\n", per_cu); per_cu = 1; }
        (void)hipGetLastError();
        grid = cus;
        fprintf(stderr, "kernel_launch: %d CUs, occupancy %d, grid %d\n", cus, per_cu, grid);
    }
    if (grid < 0) return;
    hipMemsetAsync((char*)d_ws + WS_CTL, 0, CTL_ZERO_BYTES, stream);
    Args a{};
    for (int i = 0; i < 28; ++i) a.in[i] = d_in[i];
    a.out = (float*)d_out; a.ws = (unsigned char*)d_ws;
#if MK_MODE == 0
#ifdef PROBE_NOSTORE
    for (int p = 0; p < NPHASE; ++p) { a.ph_lo = p; a.ph_hi = p + 1; hipLaunchKernelGGL(mk_fwd, dim3(grid), dim3(512), LDS_BYTES, stream, a);
        if (p == 10) { a.ph_lo = 10; a.ph_hi = 101; hipLaunchKernelGGL(mk_fwd, dim3(grid), dim3(512), LDS_BYTES, stream, a); } }
    if (0)
#endif
#ifdef PROBE_NOEPI
    for (int p = 0; p < NPHASE; ++p) { a.ph_lo = p; a.ph_hi = p + 1; hipLaunchKernelGGL(mk_fwd, dim3(grid), dim3(512), LDS_BYTES, stream, a);
        if (p == 2) { a.ph_lo = 2; a.ph_hi = PROBE_NOEPI == 2 ? 102 : 100; hipLaunchKernelGGL(mk_fwd, dim3(grid), dim3(512), LDS_BYTES, stream, a); } }
    if (0)
#endif
    for (int p = 0; p < NPHASE; ++p) for (int r = 0; r < REPS(p); ++r) { a.ph_lo = p; a.ph_hi = p + 1; hipLaunchKernelGGL(mk_fwd, dim3(grid), dim3(512), LDS_BYTES, stream, a); }
#ifdef PROBE_MFMA
    hipFuncSetAttribute((const void*)probe_mfma, hipFuncAttributeMaxDynamicSharedMemorySize, LDS_BYTES);
    hipLaunchKernelGGL(probe_mfma, dim3(grid), dim3(512), LDS_BYTES, stream, (float*)((char*)d_ws + WS_CTL), PROBE_ITERS);
#endif
#elif MK_MODE == 1
    a.ph_lo = 0; a.ph_hi = NPHASE;
    void* kargs[] = {&a};
    hipError_t e = hipLaunchCooperativeKernel((const void*)mk_fwd, dim3(grid), dim3(512), kargs, LDS_BYTES, stream);
    if (e != hipSuccess) fprintf(stderr, "cooperative launch failed: %s (grid %d)\n", hipGetErrorString(e), grid);
#else
    a.ph_lo = 0; a.ph_hi = NPHASE;
    hipLaunchKernelGGL(mk_fwd, dim3(grid), dim3(512), LDS_BYTES, stream, a);
#endif
}
```
